# Optimizing an MI355X kernel written in HIP

```python
import math
import jax
import jax.numpy as jnp
from jax import lax
import numpy as np

D_MODEL = 1024
BATCH = 8
SEQ = 8192
DEPTH = 1

DIFF_HEADS = 4
DIFF_HEAD_DIM = 64
DIFF_V_DIM = 2 * DIFF_HEAD_DIM
DSA_HEADS = 8
DSA_HEAD_DIM = 64
IDX_HEADS = 8
IDX_DIM = 64
DSA_TOPK = 256
Q_BLOCK = 128
N_EXPERTS = 256
TOP_K = 8
N_GROUPS = 8
TOPK_GROUPS = 4
D_EXPERT = 256
D_SHARED = 256
ROUTED_SCALE = 2.5
MOE_BLOCK = 64
EPS = 1e-6

DIFF_QK_W = DIFF_HEADS * 2 * DIFF_HEAD_DIM
DIFF_V_W = DIFF_HEADS * DIFF_V_DIM
DSA_W = DSA_HEADS * DSA_HEAD_DIM
IDX_Q_W = IDX_HEADS * IDX_DIM
IN_COLS = 2 * DIFF_QK_W + DIFF_V_W + 3 * DSA_W + IDX_Q_W + IDX_DIM + IDX_HEADS
SPLITS = (DIFF_QK_W, 2 * DIFF_QK_W, 2 * DIFF_QK_W + DIFF_V_W,
          2 * DIFF_QK_W + DIFF_V_W + DSA_W, 2 * DIFF_QK_W + DIFF_V_W + 2 * DSA_W,
          2 * DIFF_QK_W + DIFF_V_W + 3 * DSA_W, 2 * DIFF_QK_W + DIFF_V_W + 3 * DSA_W + IDX_Q_W,
          2 * DIFF_QK_W + DIFF_V_W + 3 * DSA_W + IDX_Q_W + IDX_DIM)
MIX_W = DIFF_V_W + DSA_W

kernel_name = "hymba_diffattn_dsa_moe_alibi_adaln"


def rmsnorm(x, g):
    xf = x.astype(jnp.float32)
    y = xf * lax.rsqrt(jnp.mean(xf * xf, axis=-1, keepdims=True) + EPS)
    return (y * g.astype(jnp.float32)).astype(x.dtype)


def alibi_slopes(n):
    return 2.0 ** (-8.0 * jnp.arange(1, n + 1, dtype=jnp.float32) / n)


def diff_attention(q, k, v, lam, lam_init, subln_g):
    B, S, H, _, Dh = q.shape
    Dv = v.shape[-1]
    slopes = alibi_slopes(H)
    scale = Dh ** -0.5
    kpos = jnp.arange(S)

    def block(i):
        q0 = i * Q_BLOCK
        qb = lax.dynamic_slice_in_dim(q, q0, Q_BLOCK, axis=1)
        s = jnp.einsum('bqhmd,bkhmd->bhmqk', qb, k).astype(jnp.float32) * scale
        dist = ((q0 + jnp.arange(Q_BLOCK))[:, None] - kpos[None, :]).astype(jnp.float32)
        s = s - (slopes[:, None, None] * dist)[None, :, None]
        s = jnp.where((dist >= 0)[None, None, None], s, -jnp.inf)
        p = jax.nn.softmax(s, axis=-1)
        a = p[:, :, 0] - lam * p[:, :, 1]
        return jnp.einsum('bhqk,bkhe->bqhe', a.astype(v.dtype), v)

    out = lax.map(block, jnp.arange(S // Q_BLOCK))
    out = out.transpose(1, 0, 2, 3, 4).reshape(B, S, H, Dv)
    out = rmsnorm(out, subln_g) * (1.0 - lam_init)
    return out.reshape(B, S, H * Dv)


def dsa_attention(q, k, v, iq, ik, iw, topk):
    B, S, H, Dh = q.shape
    slopes = alibi_slopes(H)
    scale = Dh ** -0.5
    idx_scale = IDX_DIM ** -0.5
    kpos = jnp.arange(S)
    gather = jax.vmap(lambda a, j: a[j])

    def block(i):
        q0 = i * Q_BLOCK
        qpos = q0 + jnp.arange(Q_BLOCK)
        iqb = lax.dynamic_slice_in_dim(iq, q0, Q_BLOCK, axis=1)
        iwb = lax.dynamic_slice_in_dim(iw, q0, Q_BLOCK, axis=1).astype(jnp.float32)
        logits = jnp.einsum('bqhd,bkd->bqhk', iqb, ik).astype(jnp.float32) * idx_scale
        score = jnp.einsum('bqh,bqhk->bqk', iwb, jax.nn.relu(logits))
        score = jnp.where((kpos[None, :] <= qpos[:, None])[None], score, -jnp.inf)
        _, sel = lax.top_k(score, topk)
        kg = gather(k, sel)
        vg = gather(v, sel)
        qb = lax.dynamic_slice_in_dim(q, q0, Q_BLOCK, axis=1)
        s = jnp.einsum('bqhd,bqkhd->bqhk', qb, kg).astype(jnp.float32) * scale
        dist = (qpos[None, :, None] - sel).astype(jnp.float32)
        s = s - slopes[None, None, :, None] * dist[:, :, None, :]
        s = jnp.where((dist >= 0)[:, :, None, :], s, -jnp.inf)
        p = jax.nn.softmax(s, axis=-1)
        return jnp.einsum('bqhk,bqkhd->bqhd', p.astype(v.dtype), vg)

    out = lax.map(block, jnp.arange(S // Q_BLOCK))
    return out.transpose(1, 0, 2, 3, 4).reshape(B, S, H * Dh)


def swiglu(h, wg, wu, wd):
    return (jax.nn.silu(h @ wg) * (h @ wu)) @ wd


def route(h, router_w, router_bias):
    T = h.shape[0]
    scores = jax.nn.sigmoid((h @ router_w).astype(jnp.float32))
    biased = scores + router_bias.astype(jnp.float32)
    grp = biased.reshape(T, N_GROUPS, N_EXPERTS // N_GROUPS)
    grp_score = lax.top_k(grp, 2)[0].sum(-1)
    _, grp_idx = lax.top_k(grp_score, TOPK_GROUPS)
    grp_mask = (grp_idx[..., None] == jnp.arange(N_GROUPS)).any(axis=-2)
    allowed = jnp.repeat(grp_mask, N_EXPERTS // N_GROUPS, axis=-1)
    _, eidx = lax.top_k(jnp.where(allowed, biased, -jnp.inf), TOP_K)
    w = jnp.take_along_axis(scores, eidx, axis=-1)
    w = w / jnp.sum(w, axis=-1, keepdims=True) * ROUTED_SCALE
    return eidx, w


def routed_experts(h, router_w, router_bias, w_gate, w_up, w_down):
    T, D = h.shape
    eidx, gates = route(h, router_w, router_bias)
    P = T * TOP_K
    n_blocks = P // MOE_BLOCK + N_EXPERTS
    e_flat = eidx.reshape(P)
    tok_flat = jnp.arange(P, dtype=jnp.int32) // TOP_K
    g_flat = gates.reshape(P).astype(h.dtype)
    order = jnp.argsort(e_flat)
    e_s, t_s, g_s = e_flat[order], tok_flat[order], g_flat[order]
    counts = jnp.bincount(e_flat, length=N_EXPERTS)
    padded = (counts + MOE_BLOCK - 1) // MOE_BLOCK * MOE_BLOCK
    start = jnp.cumsum(counts) - counts
    pstart = jnp.cumsum(padded) - padded
    pend = pstart + padded
    dest = pstart[e_s] + (jnp.arange(P) - start[e_s])
    slot_tok = jnp.full((n_blocks * MOE_BLOCK,), T, jnp.int32).at[dest].set(t_s)
    slot_gate = jnp.zeros((n_blocks * MOE_BLOCK,), h.dtype).at[dest].set(g_s)
    block_exp = jnp.minimum(jnp.searchsorted(pend, jnp.arange(n_blocks) * MOE_BLOCK, side='right'),
                            N_EXPERTS - 1)
    h_pad = jnp.concatenate([h, jnp.zeros((1, D), h.dtype)], axis=0)

    def blk(args):
        toks, g, e = args
        xb = h_pad[toks]
        return swiglu(xb, w_gate[e], w_up[e], w_down[e]) * g[:, None]

    y = lax.map(blk, (slot_tok.reshape(n_blocks, MOE_BLOCK),
                      slot_gate.reshape(n_blocks, MOE_BLOCK), block_exp))
    return jax.ops.segment_sum(y.reshape(-1, D), slot_tok, num_segments=T + 1)[:T]


def setup_inputs(seed: int = 0) -> dict:
    key = jax.random.key(seed)
    ks = iter(jax.random.split(key, 32))
    D, L = D_MODEL, DEPTH
    nrm = lambda shape, s: jax.random.normal(next(ks), shape, jnp.float32) * s
    gain = lambda shape: 1.0 + 0.02 * jax.random.normal(next(ks), shape, jnp.float32)
    return {
        "x": nrm((BATCH, SEQ, D), 1.0),
        "c": nrm((BATCH, D), 1.0),
        "ada_w": nrm((L, D, 6 * D), 0.5 * D ** -0.5),
        "ada_b": nrm((L, 6 * D), 0.02),
        "norm1_g": gain((L, D)),
        "norm2_g": gain((L, D)),
        "w_in": nrm((L, D, IN_COLS), D ** -0.5),
        "diff_q_norm_g": gain((L, DIFF_HEAD_DIM)),
        "diff_k_norm_g": gain((L, DIFF_HEAD_DIM)),
        "lam_q1": nrm((L, DIFF_HEAD_DIM), 0.1),
        "lam_k1": nrm((L, DIFF_HEAD_DIM), 0.1),
        "lam_q2": nrm((L, DIFF_HEAD_DIM), 0.1),
        "lam_k2": nrm((L, DIFF_HEAD_DIM), 0.1),
        "diff_subln_g": gain((L, DIFF_V_DIM)),
        "dsa_q_norm_g": gain((L, DSA_HEAD_DIM)),
        "dsa_k_norm_g": gain((L, DSA_HEAD_DIM)),
        "idx_k_norm_g": gain((L, IDX_DIM)),
        "w_out": nrm((L, MIX_W, D), MIX_W ** -0.5),
        "router_w": nrm((L, D, N_EXPERTS), D ** -0.5),
        "router_bias": nrm((L, N_EXPERTS), 0.01),
        "exp_w_gate": nrm((L, N_EXPERTS, D, D_EXPERT), D ** -0.5),
        "exp_w_up": nrm((L, N_EXPERTS, D, D_EXPERT), D ** -0.5),
        "exp_w_down": nrm((L, N_EXPERTS, D_EXPERT, D), D_EXPERT ** -0.5),
        "shared_w_gate": nrm((L, D, D_SHARED), D ** -0.5),
        "shared_w_up": nrm((L, D, D_SHARED), D ** -0.5),
        "shared_w_down": nrm((L, D_SHARED, D), D_SHARED ** -0.5),
    }


def reference(x, c, ada_w, ada_b, norm1_g, norm2_g, w_in, diff_q_norm_g, diff_k_norm_g,
              lam_q1, lam_k1, lam_q2, lam_k2, diff_subln_g, dsa_q_norm_g, dsa_k_norm_g,
              idx_k_norm_g, w_out, router_w, router_bias, exp_w_gate, exp_w_up, exp_w_down,
              shared_w_gate, shared_w_up, shared_w_down):
    B, S, D = x.shape
    topk = min(DSA_TOPK, S // 4)
    cond = jax.nn.silu(c)
    for l in range(DEPTH):
        mod = cond @ ada_w[l] + ada_b[l]
        sh1, sc1, g1, sh2, sc2, g2 = [m[:, None, :] for m in jnp.split(mod, 6, axis=-1)]

        h = rmsnorm(x, norm1_g[l]) * (1.0 + sc1) + sh1
        proj = h @ w_in[l]
        dq, dk, dv, sq, sk, sv, iq, ik, iw = jnp.split(proj, SPLITS, axis=-1)

        dq = rmsnorm(dq.reshape(B, S, DIFF_HEADS, 2, DIFF_HEAD_DIM), diff_q_norm_g[l])
        dk = rmsnorm(dk.reshape(B, S, DIFF_HEADS, 2, DIFF_HEAD_DIM), diff_k_norm_g[l])
        dv = dv.reshape(B, S, DIFF_HEADS, DIFF_V_DIM)
        lam_init = 0.8 - 0.6 * math.exp(-0.3 * l)
        lam = (jnp.exp(jnp.sum(lam_q1[l] * lam_k1[l])) - jnp.exp(jnp.sum(lam_q2[l] * lam_k2[l]))
               + lam_init)
        diff_out = diff_attention(dq, dk, dv, lam, lam_init, diff_subln_g[l])

        sq = rmsnorm(sq.reshape(B, S, DSA_HEADS, DSA_HEAD_DIM), dsa_q_norm_g[l])
        sk = rmsnorm(sk.reshape(B, S, DSA_HEADS, DSA_HEAD_DIM), dsa_k_norm_g[l])
        sv = sv.reshape(B, S, DSA_HEADS, DSA_HEAD_DIM)
        iq = iq.reshape(B, S, IDX_HEADS, IDX_DIM)
        ik = rmsnorm(ik, idx_k_norm_g[l])
        iw = iw * (IDX_HEADS ** -0.5)
        dsa_out = dsa_attention(sq, sk, sv, iq, ik, iw, topk)

        mix = jnp.concatenate([diff_out, dsa_out], axis=-1) @ w_out[l]
        x = x + g1 * mix

        h2 = rmsnorm(x, norm2_g[l]) * (1.0 + sc2) + sh2
        shared = swiglu(h2, shared_w_gate[l], shared_w_up[l], shared_w_down[l])
        routed = lax.map(lambda hs: routed_experts(hs, router_w[l], router_bias[l], exp_w_gate[l],
                                                   exp_w_up[l], exp_w_down[l]), h2)
        x = x + g2 * (shared + routed)
    return x
```

```cpp
#include <hip/hip_runtime.h>
#include <stdint.h>

#define DI __device__ __forceinline__
#define LAS __attribute__((address_space(3)))
typedef unsigned short bf16_t;
typedef short bf16x8 __attribute__((ext_vector_type(8)));
typedef short s16x4 __attribute__((ext_vector_type(4)));
typedef float f32x16 __attribute__((ext_vector_type(16)));
typedef float f32x4 __attribute__((ext_vector_type(4)));
typedef float f32x2 __attribute__((ext_vector_type(2)));
typedef __bf16 bf16v2 __attribute__((ext_vector_type(2)));
typedef unsigned u32x4 __attribute__((ext_vector_type(4)));
typedef unsigned u32x2 __attribute__((ext_vector_type(2)));
typedef unsigned long long u64;
#define MFMA32(a, b, c) __builtin_amdgcn_mfma_f32_32x32x16_bf16((a), (b), (c), 0, 0, 0)

constexpr int NB = 8, NS = 8192, ND = 1024, NT = NB * NS;
constexpr int IN_COLS = 3656, NPAD = 3712;
constexpr int NEXP = 256, NEXP1 = 257;
constexpr int NCHUNK = 4, CHUNK_T = NT / NCHUNK;
constexpr int NPAIR = 9;
constexpr float EPSF = 1e-6f;
constexpr float LOG2E = 1.4426950408889634f;

constexpr size_t MiB = 1048576;
constexpr size_t OFF_BAR = 0;
constexpr size_t OFF_MOD = 16384;
constexpr size_t OFF_CNT = OFF_MOD + 196608;
constexpr size_t OFF_ERR = OFF_CNT + 8192;
constexpr size_t ZERO_BYTES = 262144;
constexpr size_t OFF_WIN = 1 * MiB;
constexpr size_t OFF_WOUT = OFF_WIN + (size_t)NPAD * 1024 * 2;
constexpr size_t OFF_WRT = OFF_WOUT + 2 * MiB;
constexpr size_t OFF_WGU = 12 * MiB;
constexpr size_t OFF_WD = OFF_WGU + (size_t)NEXP1 * 512 * 1024 * 2;
constexpr size_t OFF_R1 = OFF_WD + (size_t)NEXP1 * 1024 * 256 * 2;
constexpr size_t OFF_H = OFF_R1;
constexpr size_t OFF_QD = OFF_H + 128 * MiB;
constexpr size_t OFF_KD = OFF_QD + 64 * MiB;
constexpr size_t OFF_VDT = OFF_KD + 64 * MiB;
constexpr size_t OFF_QS = OFF_VDT + 64 * MiB;
constexpr size_t OFF_KS = OFF_QS + 64 * MiB;
constexpr size_t OFF_VST = OFF_KS + 64 * MiB;
constexpr size_t OFF_IQ = OFF_VST + 64 * MiB;
constexpr size_t OFF_IK = OFF_IQ + 64 * MiB;
constexpr size_t OFF_IW = OFF_IK + 8 * MiB;
constexpr size_t OFF_MASK = OFF_IW + 2 * MiB;
constexpr size_t END_A = OFF_MASK + 64 * MiB;
constexpr size_t OFF_H2 = OFF_R1;
constexpr size_t OFF_LIST = OFF_H2 + 128 * MiB;
constexpr size_t OFF_EIDX = OFF_LIST + (size_t)NCHUNK * NEXP1 * CHUNK_T * 4;
constexpr size_t OFF_GATE = OFF_EIDX + 2 * MiB;
constexpr size_t OFF_ACT = OFF_GATE + 2 * MiB;
constexpr size_t ACT_BYTES = (size_t)CHUNK_T * NPAIR * 256 * 2;
constexpr size_t OFF_Y = OFF_ACT + 2 * ACT_BYTES;
constexpr size_t END_B = OFF_Y + (size_t)CHUNK_T * NPAIR * 1024 * 2;
constexpr size_t WS_NEED = END_A > END_B ? END_A : END_B;

struct Params {
    const float *x, *c, *ada_w, *ada_b, *norm1_g, *norm2_g, *w_in, *dq_g, *dk_g, *lq1, *lk1, *lq2, *lk2, *subln_g, *sq_g, *sk_g, *ik_g,
        *w_out, *router_w, *router_b, *ew_gate, *ew_up, *ew_down, *sw_gate, *sw_up, *sw_down;
    float* out;
    char* ws;
};

DI unsigned pk2(float a, float b) { f32x2 f = {a, b}; bf16v2 r = __builtin_convertvector(f, bf16v2); return __builtin_bit_cast(unsigned, r); }
DI float bf2f(bf16_t v) { return __uint_as_float(((unsigned)v) << 16); }
DI float bflo(unsigned u) { return __uint_as_float(u << 16); }
DI float bfhi(unsigned u) { return __uint_as_float(u & 0xffff0000u); }
DI int crow(int i, int hf) { return (i & 3) + 8 * (i >> 2) + 4 * hf; }
constexpr int LROW = 144;
DI int lofs(int row, int chunk) { return row * LROW + chunk * 16; }
DI float wave_sum(float v) {
#pragma unroll
    for (int d = 32; d >= 1; d >>= 1) v += __shfl_xor(v, d);
    return v;
}
DI float silu_f(float v) { return v / (1.f + __expf(-v)); }

#define XB_TMO      128
#define XB_XCNT(j)  (256  + 64 * (j))
#define XB_XSUB(j)  (1280 + 64 * (j))
#define XB_XGEN(j)  (2304 + 64 * (j))
#define XB_TOP      3328
#define XB_TOPGEN   3392
#define XCD_BAR_WORDS 3456
#define XB_SPIN_CAP (1u << 18)

__device__ __forceinline__ unsigned xb_ld(unsigned* p)              { return __hip_atomic_load(p, __ATOMIC_RELAXED, __HIP_MEMORY_SCOPE_AGENT); }
__device__ __forceinline__ unsigned xb_add(unsigned* p, unsigned v) { return __hip_atomic_fetch_add(p, v, __ATOMIC_RELAXED, __HIP_MEMORY_SCOPE_AGENT); }
__device__ __forceinline__ unsigned xb_xcc_id() { return (unsigned)__builtin_amdgcn_s_getreg((3 << 11) | 20) & 0xFu; }
#define XB_SPIN(cond, bar) do { unsigned _sp = 0; while (cond) { __builtin_amdgcn_s_sleep(1); \
    if ((++_sp & 255u) == 0u) { if (xb_ld(&(bar)[XB_TMO])) break; if (_sp > XB_SPIN_CAP) { atomicAdd(&(bar)[XB_TMO], 1u); break; } } } } while (0)

struct XcdBarrier {
    unsigned* bar; unsigned x;
    volatile LAS unsigned* st;
};
__device__ __forceinline__ XcdBarrier xcd_barrier_post(unsigned* bar, volatile LAS unsigned* st) {
    XcdBarrier b; b.bar = bar; b.x = xb_xcc_id(); b.st = st;
    if (threadIdx.x == 0) (void)xb_add(&bar[XB_XCNT(b.x)], 1u);
    return b;
}
__device__ __forceinline__ void xcd_barrier_complete(unsigned* bar, unsigned x, unsigned& nloc, unsigned& nx) {
    const unsigned G = gridDim.x * gridDim.y * gridDim.z;
    unsigned sum, cnt, mine, sp = 0u;
    for (;;) {
        sum = 0u; cnt = 0u; mine = 0u;
#pragma unroll
        for (unsigned j = 0; j < 16; ++j) { const unsigned c = xb_ld(&bar[XB_XCNT(j)]); sum += c; cnt += (c > 0u) ? 1u : 0u; mine = (j == x) ? c : mine; }
        if (sum == G) break;
        __builtin_amdgcn_s_sleep(1);
        if ((++sp & 255u) == 0u) { if (xb_ld(&bar[XB_TMO])) break; if (sp > XB_SPIN_CAP) { atomicAdd(&bar[XB_TMO], 1u); break; } }
    }
    nloc = mine > 0u ? mine : 1u; nx = cnt > 0u ? cnt : 1u;
}
__device__ __forceinline__ void xcd_barrier(const XcdBarrier& b) {
    asm volatile("s_waitcnt vmcnt(0)" ::: "memory");
    __syncthreads();
    if (threadIdx.x == 0) {
        unsigned* bar = b.bar;
        __builtin_amdgcn_s_waitcnt(0);
        unsigned nloc = b.st[0], nx = b.st[1];
        if (nloc == 0u) { xcd_barrier_complete(bar, b.x, nloc, nx); b.st[0] = nloc; b.st[1] = nx; }
        const unsigned old = xb_add(&bar[XB_XSUB(b.x)], 1u);
        const unsigned gen = old / nloc;
        if (old + 1u == (gen + 1u) * nloc) {
            __builtin_amdgcn_fence(__ATOMIC_RELEASE, "agent");
            asm volatile("s_waitcnt vmcnt(0)" ::: "memory");
            const unsigned og = xb_add(&bar[XB_TOP], 1u);
            const unsigned tg = og / nx;
            if (og + 1u == (tg + 1u) * nx) xb_add(&bar[XB_TOPGEN], 1u);
            else XB_SPIN(xb_ld(&bar[XB_TOPGEN]) == tg, bar);
            __builtin_amdgcn_fence(__ATOMIC_ACQUIRE, "agent");
            xb_add(&bar[XB_XGEN(b.x)], 1u);
            asm volatile("s_waitcnt vmcnt(0)" ::: "memory");
        } else {
            XB_SPIN(xb_ld(&bar[XB_XGEN(b.x)]) == gen, bar);
            __builtin_amdgcn_fence(__ATOMIC_ACQUIRE, "agent");
            asm volatile("s_waitcnt vmcnt(0)" ::: "memory");
        }
    }
    __syncthreads();
}

constexpr int GT_B = 128 * LROW;
constexpr int GT_STAGE = 2 * 128 * LROW;
constexpr int SM_EXTRA = 2 * GT_STAGE;
constexpr int SMEM_BYTES = SM_EXTRA + 4096;
#define MK_ONE_LAUNCH 0


DI void phase_adaln(const Params& P, char* smem) {
    float* mod = (float*)(P.ws + OFF_MOD);
    float* sc = (float*)smem;
    float* red = sc + 8192;
    const int tid = threadIdx.x;
    __syncthreads();
    for (int i = tid; i < 8192; i += 256) sc[i] = silu_f(P.c[i]);
    __syncthreads();
    const int kg = tid >> 4, cn = tid & 15;
    for (int it = blockIdx.x; it < 384; it += gridDim.x) {
        const int n = it * 16 + cn;
        float acc[8];
#pragma unroll
        for (int b = 0; b < 8; ++b) acc[b] = 0.f;
#pragma unroll 8
        for (int kk = 0; kk < 64; ++kk) {
            const int k = kg * 64 + kk;
            const float w = P.ada_w[(size_t)k * 6144 + n];
#pragma unroll
            for (int b = 0; b < 8; ++b) acc[b] += sc[b * 1024 + k] * w;
        }
#pragma unroll
        for (int b = 0; b < 8; ++b) red[(kg * 8 + b) * 16 + cn] = acc[b];
        __syncthreads();
        if (tid < 128) {
            const int b = tid >> 4;
            float s = P.ada_b[n];
#pragma unroll
            for (int g = 0; g < 16; ++g) s += red[(g * 8 + b) * 16 + cn];
            mod[b * 6144 + n] = s;
        }
        __syncthreads();
    }
}

DI void phase_norm(const float* __restrict__ xin, const float* __restrict__ g, const float* __restrict__ mod, int sh_off, int sc_off, bf16_t* __restrict__ dst) {
    const int lane = threadIdx.x & 63, w = threadIdx.x >> 6;
    for (int row = blockIdx.x * 4 + w; row < NT; row += gridDim.x * 4) {
        const int b = row >> 13;
        const float* xr = xin + (size_t)row * 1024;
        f32x4 v[4]; float ss = 0.f;
#pragma unroll
        for (int i = 0; i < 4; ++i) { v[i] = *(const f32x4*)(xr + 256 * i + 4 * lane); ss += v[i][0] * v[i][0] + v[i][1] * v[i][1] + v[i][2] * v[i][2] + v[i][3] * v[i][3]; }
        ss = wave_sum(ss);
        const float rstd = rsqrtf(ss * (1.f / 1024.f) + EPSF);
#pragma unroll
        for (int i = 0; i < 4; ++i) {
            const int col = 256 * i + 4 * lane;
            const f32x4 gg = *(const f32x4*)(g + col);
            const f32x4 sh = *(const f32x4*)(mod + b * 6144 + sh_off + col);
            const f32x4 sc = *(const f32x4*)(mod + b * 6144 + sc_off + col);
            float o[4];
#pragma unroll
            for (int j = 0; j < 4; ++j) o[j] = v[i][j] * rstd * gg[j] * (1.f + sc[j]) + sh[j];
            u32x2 pk; pk[0] = pk2(o[0], o[1]); pk[1] = pk2(o[2], o[3]);
            *(u32x2*)(dst + (size_t)row * 1024 + col) = pk;
        }
    }
}

DI int gu_row(int f, int is_up) { return (f >> 6) * 128 + (((f >> 5) & 1) * 2 + is_up) * 32 + (f & 31); }
DI void cvt_tile(float* t, const float* __restrict__ src, int ldsrc, int nvalid, int k0, int n0, bf16_t* __restrict__ dst, int ldd, int mode) {
    const int tid = threadIdx.x;
    __syncthreads();
#pragma unroll
    for (int i = 0; i < 16; ++i) {
        const int idx = tid + 256 * i, kk = idx >> 6, nn = idx & 63;
        float v = 0.f;
        if (n0 + nn < nvalid) v = src[(size_t)(k0 + kk) * ldsrc + n0 + nn];
        t[kk * 65 + nn] = v;
    }
    __syncthreads();
    const int nn = tid >> 2, kq = (tid & 3) * 16;
    unsigned pk[8];
#pragma unroll
    for (int j = 0; j < 8; ++j) pk[j] = pk2(t[(kq + 2 * j) * 65 + nn], t[(kq + 2 * j + 1) * 65 + nn]);
    const int n = n0 + nn;
    const int drow = mode == 0 ? n : gu_row(n, mode - 1);
    bf16_t* d = dst + (size_t)drow * ldd + k0 + kq;
    *(u32x4*)(d) = (u32x4){pk[0], pk[1], pk[2], pk[3]};
    *(u32x4*)(d + 8) = (u32x4){pk[4], pk[5], pk[6], pk[7]};
}
constexpr int CVT_SMALL = 928 + 256 + 64;
constexpr int CVT_ITEMS = CVT_SMALL + NEXP1 * 192;
DI void phase_convert(const Params& P, char* smem) {
    float* t = (float*)smem;
    bf16_t* win = (bf16_t*)(P.ws + OFF_WIN); bf16_t* wout = (bf16_t*)(P.ws + OFF_WOUT); bf16_t* wrt = (bf16_t*)(P.ws + OFF_WRT);
    bf16_t* wgu = (bf16_t*)(P.ws + OFF_WGU); bf16_t* wd = (bf16_t*)(P.ws + OFF_WD);
    for (int it = blockIdx.x; it < CVT_ITEMS; it += gridDim.x) {
        if (it < 928) { cvt_tile(t, P.w_in, IN_COLS, IN_COLS, (it & 15) * 64, (it >> 4) * 64, win, 1024, 0); }
        else if (it < 928 + 256) { const int r = it - 928; cvt_tile(t, P.w_out, 1024, 1024, (r & 15) * 64, (r >> 4) * 64, wout, 1024, 0); }
        else if (it < CVT_SMALL) { const int r = it - 928 - 256; cvt_tile(t, P.router_w, 256, 256, (r & 15) * 64, (r >> 4) * 64, wrt, 1024, 0); }
        else {
            const int r = it - CVT_SMALL, e = r / 192, sub = r % 192;
            if (sub < 128) {
                const int up = sub >> 6, s2 = sub & 63;
                const float* src = e < NEXP ? (up ? P.ew_up : P.ew_gate) + (size_t)e * 1024 * 256 : (up ? P.sw_up : P.sw_gate);
                cvt_tile(t, src, 256, 256, (s2 & 15) * 64, (s2 >> 4) * 64, wgu + (size_t)e * 512 * 1024, 1024, 1 + up);
            } else {
                const int s2 = sub - 128;
                const float* src = e < NEXP ? P.ew_down + (size_t)e * 256 * 1024 : P.sw_down;
                cvt_tile(t, src, 1024, 1024, (s2 & 3) * 64, (s2 >> 2) * 64, wd + (size_t)e * 1024 * 256, 256, 0);
            }
        }
    }
}

template <bool SWAP, class AFn>
DI void gemm_tile(char* lds, AFn arow, const bf16_t* __restrict__ Bt, int ldb, int K, f32x16 (&acc)[2][2]) {
    const int tid = threadIdx.x, lane = tid & 63, w = tid >> 6, wm = w >> 1, wn = w & 1, l31 = lane & 31, hf = lane >> 5;
    const bf16_t* ap[4]; const bf16_t* bp[4]; int so[4];
#pragma unroll
    for (int i = 0; i < 4; ++i) {
        const int id = tid + 256 * i, row = id >> 3, ch = id & 7;
        const bf16_t* a = arow(row);
        ap[i] = a ? a + ch * 8 : nullptr;
        bp[i] = Bt + (size_t)row * ldb + ch * 8;
        so[i] = lofs(row, ch);
    }
#pragma unroll
    for (int mi = 0; mi < 2; ++mi)
#pragma unroll
        for (int ni = 0; ni < 2; ++ni)
#pragma unroll
            for (int i = 0; i < 16; ++i) acc[mi][ni][i] = 0.f;
    u32x4 ra[4], rb[4];
    const u32x4 z4 = {0u, 0u, 0u, 0u};
#pragma unroll
    for (int i = 0; i < 4; ++i) { ra[i] = ap[i] ? *(const u32x4*)(ap[i]) : z4; rb[i] = *(const u32x4*)(bp[i]); }
    __syncthreads();
#pragma unroll
    for (int i = 0; i < 4; ++i) { *(u32x4*)(lds + so[i]) = ra[i]; *(u32x4*)(lds + GT_B + so[i]) = rb[i]; }
    __syncthreads();
    const int nk = K >> 6;
    for (int kt = 0; kt < nk; ++kt) {
        const char* cur = lds + (kt & 1) * GT_STAGE;
        const bool more = kt + 1 < nk;
        if (more) {
            const int k0 = (kt + 1) * 64;
#pragma unroll
            for (int i = 0; i < 4; ++i) { ra[i] = ap[i] ? *(const u32x4*)(ap[i] + k0) : z4; rb[i] = *(const u32x4*)(bp[i] + k0); }
        }
#pragma unroll
        for (int ks = 0; ks < 4; ++ks) {
            const int ch = 2 * ks + hf;
            bf16x8 af[2], bfr[2];
#pragma unroll
            for (int mi = 0; mi < 2; ++mi) af[mi] = *(const bf16x8*)(cur + lofs(64 * wm + 32 * mi + l31, ch));
#pragma unroll
            for (int ni = 0; ni < 2; ++ni) bfr[ni] = *(const bf16x8*)(cur + GT_B + lofs(64 * wn + 32 * ni + l31, ch));
#pragma unroll
            for (int mi = 0; mi < 2; ++mi)
#pragma unroll
                for (int ni = 0; ni < 2; ++ni)
                    acc[mi][ni] = SWAP ? MFMA32(bfr[ni], af[mi], acc[mi][ni]) : MFMA32(af[mi], bfr[ni], acc[mi][ni]);
        }
        if (more) {
            char* nxt = lds + ((kt + 1) & 1) * GT_STAGE;
#pragma unroll
            for (int i = 0; i < 4; ++i) { *(u32x4*)(nxt + so[i]) = ra[i]; *(u32x4*)(nxt + GT_B + so[i]) = rb[i]; }
        }
        __syncthreads();
    }
}

struct DenseRows { const bf16_t* base; int ld; DI const bf16_t* operator()(int r) const { return base + (size_t)r * ld; } };

DI void epi_rows_bf16(const f32x16 (&acc)[2][2], int row0, bf16_t* __restrict__ dst, int ldo, int cb, const float* __restrict__ gain, bool do_norm) {
    const int lane = threadIdx.x & 63, w = threadIdx.x >> 6, wm = w >> 1, wn = w & 1, l31 = lane & 31, hf = lane >> 5;
#pragma unroll
    for (int mi = 0; mi < 2; ++mi) {
        const int tok = row0 + 64 * wm + 32 * mi + l31;
        float rstd = 1.f;
        if (do_norm) {
            float ss = 0.f;
#pragma unroll
            for (int ni = 0; ni < 2; ++ni)
#pragma unroll
                for (int i = 0; i < 16; ++i) ss += acc[mi][ni][i] * acc[mi][ni][i];
            ss += __shfl_xor(ss, 32);
            rstd = rsqrtf(ss * (1.f / 64.f) + EPSF);
        }
        bf16_t* drow = dst + (size_t)tok * ldo + cb + 64 * wn;
#pragma unroll
        for (int ni = 0; ni < 2; ++ni)
#pragma unroll
            for (int q4 = 0; q4 < 4; ++q4) {
                const int f = 32 * ni + 8 * q4 + 4 * hf;
                float o[4];
#pragma unroll
                for (int r = 0; r < 4; ++r) { o[r] = acc[mi][ni][4 * q4 + r] * rstd; if (do_norm) o[r] *= gain[f + r]; }
                u32x2 pk; pk[0] = pk2(o[0], o[1]); pk[1] = pk2(o[2], o[3]);
                *(u32x2*)(drow + f) = pk;
            }
    }
}
DI void epi_vt(const f32x16 (&acc)[2][2], int row0, bf16_t* __restrict__ vt, int dv, int nheads, int colbase  ) {
    const int lane = threadIdx.x & 63, w = threadIdx.x >> 6, wm = w >> 1, wn = w & 1, l31 = lane & 31, hf = lane >> 5;
    const int b = row0 >> 13, s0 = row0 & (NS - 1);
#pragma unroll
    for (int ni = 0; ni < 2; ++ni) {
        const int c = colbase + 64 * wn + 32 * ni + l31;
        const int head = c / dv, d = c % dv;
        bf16_t* vrow = vt + ((size_t)(b * nheads + head) * dv + d) * NS + s0;
#pragma unroll
        for (int mi = 0; mi < 2; ++mi)
#pragma unroll
            for (int q4 = 0; q4 < 4; ++q4) {
                u32x2 pk; pk[0] = pk2(acc[mi][ni][4 * q4], acc[mi][ni][4 * q4 + 1]); pk[1] = pk2(acc[mi][ni][4 * q4 + 2], acc[mi][ni][4 * q4 + 3]);
                *(u32x2*)(vrow + 64 * wm + 32 * mi + 8 * q4 + 4 * hf) = pk;
            }
    }
}
constexpr int INPROJ_NJ = 29, INPROJ_ITEMS = (NT / 128) * INPROJ_NJ;
DI void phase_inproj(const Params& P, char* smem) {
    const bf16_t* h = (const bf16_t*)(P.ws + OFF_H);
    const bf16_t* win = (const bf16_t*)(P.ws + OFF_WIN);
    for (int it = blockIdx.x; it < INPROJ_ITEMS; it += gridDim.x) {
        const int xcd = it & 7, loc = it >> 3;
        const int mt = (loc / INPROJ_NJ) * 8 + xcd, j = loc % INPROJ_NJ;
        const int row0 = mt * 128;
        DenseRows ar{h + (size_t)row0 * 1024, 1024};
        const bf16_t* Bt = win + (size_t)j * 128 * 1024;
        f32x16 acc[2][2];
        const int grp = j >> 2, jj = j & 3;
        if (grp == 2 || grp == 5) {
            gemm_tile<false>(smem, ar, Bt, 1024, 1024, acc);
            if (grp == 2) epi_vt(acc, row0, (bf16_t*)(P.ws + OFF_VDT), 128, 4, jj * 128);
            else epi_vt(acc, row0, (bf16_t*)(P.ws + OFF_VST), 64, 8, jj * 128);
        } else {
            gemm_tile<true>(smem, ar, Bt, 1024, 1024, acc);
            if (grp == 0) epi_rows_bf16(acc, row0, (bf16_t*)(P.ws + OFF_QD), 512, jj * 128, P.dq_g, true);
            else if (grp == 1) epi_rows_bf16(acc, row0, (bf16_t*)(P.ws + OFF_KD), 512, jj * 128, P.dk_g, true);
            else if (grp == 3) epi_rows_bf16(acc, row0, (bf16_t*)(P.ws + OFF_QS), 512, jj * 128, P.sq_g, true);
            else if (grp == 4) epi_rows_bf16(acc, row0, (bf16_t*)(P.ws + OFF_KS), 512, jj * 128, P.sk_g, true);
            else if (grp == 6) epi_rows_bf16(acc, row0, (bf16_t*)(P.ws + OFF_IQ), 512, jj * 128, P.dq_g, false);
            else {
                const int lane = threadIdx.x & 63, w = threadIdx.x >> 6, wm = w >> 1, wn = w & 1, l31 = lane & 31, hf = lane >> 5;
                if (wn == 0) {
                    bf16_t* ik = (bf16_t*)(P.ws + OFF_IK);
#pragma unroll
                    for (int mi = 0; mi < 2; ++mi) {
                        const int tok = row0 + 64 * wm + 32 * mi + l31;
                        float ss = 0.f;
#pragma unroll
                        for (int ni = 0; ni < 2; ++ni)
#pragma unroll
                            for (int i = 0; i < 16; ++i) ss += acc[mi][ni][i] * acc[mi][ni][i];
                        ss += __shfl_xor(ss, 32);
                        const float rstd = rsqrtf(ss * (1.f / 64.f) + EPSF);
#pragma unroll
                        for (int ni = 0; ni < 2; ++ni)
#pragma unroll
                            for (int q4 = 0; q4 < 4; ++q4) {
                                const int f = 32 * ni + 8 * q4 + 4 * hf;
                                float o[4];
#pragma unroll
                                for (int r = 0; r < 4; ++r) o[r] = acc[mi][ni][4 * q4 + r] * rstd * P.ik_g[f + r];
                                u32x2 pk; pk[0] = pk2(o[0], o[1]); pk[1] = pk2(o[2], o[3]);
                                *(u32x2*)(ik + (size_t)tok * 64 + f) = pk;
                            }
                    }
                } else {
                    float* iw = (float*)(P.ws + OFF_IW);
                    const float s = 0.35355339059327373f * 0.125f;
#pragma unroll
                    for (int mi = 0; mi < 2; ++mi) {
                        const int tok = row0 + 64 * wm + 32 * mi + l31;
                        f32x4 o = {acc[mi][0][0] * s, acc[mi][0][1] * s, acc[mi][0][2] * s, acc[mi][0][3] * s};
                        *(f32x4*)(iw + (size_t)tok * 8 + 4 * hf) = o;
                    }
                }
            }
        }
    }
}

constexpr int TK_CAP = 512, TK_HI = 480;
DI unsigned topk_prune(volatile LAS unsigned* buf, volatile LAS unsigned* hist, int cnt) {
    const int lane = threadIdx.x & 63;
    unsigned e[8];
#pragma unroll
    for (int i = 0; i < 8; ++i) { const int idx = lane + 64 * i; e[i] = idx < cnt ? buf[idx] : 0u; }
    unsigned prefix = 0u, want = 256u;
#pragma unroll
    for (int p = 3; p >= 0; --p) {
        const int sh = 8 * p;
#pragma unroll
        for (int j = 0; j < 4; ++j) hist[4 * lane + j] = 0u;
        asm volatile("" ::: "memory");
#pragma unroll
        for (int i = 0; i < 8; ++i) {
            const bool m = (e[i] != 0u) && (p == 3 || (e[i] >> (sh + 8)) == prefix);
            if (m) __hip_atomic_fetch_add((LAS unsigned*)&hist[(e[i] >> sh) & 255u], 1u, __ATOMIC_RELAXED, __HIP_MEMORY_SCOPE_WORKGROUP);
        }
        asm volatile("" ::: "memory");
        const unsigned h0 = hist[4 * lane], h1 = hist[4 * lane + 1], h2 = hist[4 * lane + 2], h3 = hist[4 * lane + 3];
        const unsigned s4 = h0 + h1 + h2 + h3;
        unsigned suf = s4;
#pragma unroll
        for (int d = 1; d < 64; d <<= 1) { const unsigned t = __shfl_down(suf, d); if (lane + d < 64) suf += t; }
        const unsigned above = suf - s4;
        const bool own = (above < want) && (want <= suf);
        unsigned bsel = 0u, cum = above;
        if (cum + h3 >= want) bsel = 3u;
        else { cum += h3; if (cum + h2 >= want) bsel = 2u; else { cum += h2; if (cum + h1 >= want) bsel = 1u; else { cum += h1; bsel = 0u; } } }
        const u64 om = __ballot(own);
        const int ol = om ? (int)__builtin_ctzll(om) : 0;
        const unsigned bin = (unsigned)__shfl((int)(4u * lane + bsel), ol);
        const unsigned cm = (unsigned)__shfl((int)cum, ol);
        prefix = (prefix << 8) | bin; want -= cm;
    }
    const unsigned V = prefix;
    int base = 0;
#pragma unroll
    for (int i = 0; i < 8; ++i) {
        const bool keep = (e[i] != 0u) && (e[i] >= V);
        const u64 mk = __ballot(keep);
        const int pos = base + __builtin_popcountll(mk & ((1ull << lane) - 1ull));
        if (keep) buf[pos] = e[i];
        base += __builtin_popcountll(mk);
    }
    asm volatile("" ::: "memory");
    return V;
}

DI void indexer_item(const Params& P, char* smem, int b, int q0) {
    const int lane = threadIdx.x & 63, w = threadIdx.x >> 6, l31 = lane & 31, hf = lane >> 5;
    const int qbase = q0 + 8 * w;
    const bf16_t* IQ = (const bf16_t*)(P.ws + OFF_IQ);
    const bf16_t* IK = (const bf16_t*)(P.ws + OFF_IK);
    const float* IW = (const float*)(P.ws + OFF_IW);
    volatile LAS unsigned* buf = (volatile LAS unsigned*)(LAS char*)(smem + w * 8 * 2048);
    volatile LAS unsigned* hist = (volatile LAS unsigned*)(LAS char*)(smem + 65536 + w * 1024);
    bf16x8 af[2][4];
    {
        const int m = l31, qs = 2 * ((m >> 2) & 1) + (m >> 4), head = 4 * ((m >> 3) & 1) + (m & 3);
#pragma unroll
        for (int mt = 0; mt < 2; ++mt) {
            const size_t tok = (size_t)b * NS + qbase + 4 * mt + qs;
#pragma unroll
            for (int ks = 0; ks < 4; ++ks) af[mt][ks] = *(const bf16x8*)(IQ + tok * 512 + head * 64 + ks * 16 + hf * 8);
        }
    }
    float iwv[2][2][8]; int qpos[2][2]; unsigned tau[2][2]; int cnt[2][2];
#pragma unroll
    for (int mt = 0; mt < 2; ++mt)
#pragma unroll
        for (int j = 0; j < 2; ++j) {
            qpos[mt][j] = qbase + 4 * mt + 2 * hf + j; tau[mt][j] = 0u; cnt[mt][j] = 0;
            const float* p = IW + ((size_t)b * NS + qpos[mt][j]) * 8;
            const f32x4 a = *(const f32x4*)p, c = *(const f32x4*)(p + 4);
#pragma unroll
            for (int r = 0; r < 4; ++r) { iwv[mt][j][r] = a[r]; iwv[mt][j][4 + r] = c[r]; }
        }
    const int nkt = ((qbase + 7) >> 5) + 1;
    const bf16_t* ikb = IK + (size_t)b * NS * 64 + (size_t)l31 * 64 + hf * 8;
    bf16x8 bfr[4];
#pragma unroll
    for (int ks = 0; ks < 4; ++ks) bfr[ks] = *(const bf16x8*)(ikb + ks * 16);
    for (int kt = 0; kt < nkt; ++kt) {
        const int k0 = kt * 32;
        bf16x8 bn[4];
        if (kt + 1 < nkt) {
#pragma unroll
            for (int ks = 0; ks < 4; ++ks) bn[ks] = *(const bf16x8*)(ikb + (size_t)(k0 + 32) * 64 + ks * 16);
        } else {
#pragma unroll
            for (int ks = 0; ks < 4; ++ks) bn[ks] = bfr[ks];
        }
        f32x16 acc[2];
#pragma unroll
        for (int mt = 0; mt < 2; ++mt) {
#pragma unroll
            for (int i = 0; i < 16; ++i) acc[mt][i] = 0.f;
#pragma unroll
            for (int ks = 0; ks < 4; ++ks) acc[mt] = MFMA32(af[mt][ks], bfr[ks], acc[mt]);
        }
        const int kidx = k0 + l31;
#pragma unroll
        for (int mt = 0; mt < 2; ++mt)
#pragma unroll
            for (int j = 0; j < 2; ++j) {
                float s = 0.f;
#pragma unroll
                for (int t = 0; t < 8; ++t) s += iwv[mt][j][t] * fmaxf(acc[mt][8 * j + t], 0.f);
                const unsigned u = __float_as_uint(s);
                const unsigned ord = (u >> 31) ? ~u : (u | 0x80000000u);
                const unsigned pk = (ord & 0xFFFFE000u) | (unsigned)(8191 - kidx);
                const bool pass = (kidx <= qpos[mt][j]) && (pk > tau[mt][j]);
                const u64 mk = __ballot(pass);
                const unsigned hm = hf ? (unsigned)(mk >> 32) : (unsigned)mk;
                const int pos = cnt[mt][j] + __builtin_popcount(hm & ((1u << l31) - 1u));
                if (pass) buf[(4 * mt + 2 * hf + j) * TK_CAP + pos] = pk;
                cnt[mt][j] += __builtin_popcount(hm);
            }
        const bool anyhi = cnt[0][0] > TK_HI || cnt[0][1] > TK_HI || cnt[1][0] > TK_HI || cnt[1][1] > TK_HI;
        if (__ballot(anyhi) != 0ull) {
#pragma unroll 1
            for (int s8 = 0; s8 < 8; ++s8) {
                const int mt = s8 >> 2, j = (s8 >> 1) & 1, h2 = s8 & 1;
                const int cv = mt ? (j ? cnt[1][1] : cnt[1][0]) : (j ? cnt[0][1] : cnt[0][0]);
                const int c = __builtin_amdgcn_readlane(cv, 32 * h2);
                if (c > TK_HI) {
                    const unsigned V = topk_prune(buf + (4 * mt + 2 * h2 + j) * TK_CAP, hist, c);
#pragma unroll
                    for (int a = 0; a < 2; ++a)
#pragma unroll
                        for (int d = 0; d < 2; ++d)
                            if (hf == h2 && a == mt && d == j) { tau[a][d] = V; cnt[a][d] = 256; }
                }
            }
        }
#pragma unroll
        for (int ks = 0; ks < 4; ++ks) bfr[ks] = bn[ks];
    }
#pragma unroll 1
    for (int s8 = 0; s8 < 8; ++s8) {
        const int mt = s8 >> 2, j = (s8 >> 1) & 1, h2 = s8 & 1;
        const int cv = mt ? (j ? cnt[1][1] : cnt[1][0]) : (j ? cnt[0][1] : cnt[0][0]);
        int c = __builtin_amdgcn_readlane(cv, 32 * h2);
        volatile LAS unsigned* qb = buf + (4 * mt + 2 * h2 + j) * TK_CAP;
        if (c > 256) { (void)topk_prune(qb, hist, c); c = 256; }
#pragma unroll
        for (int t = 0; t < 4; ++t) qb[256 + 4 * lane + t] = 0u;
        asm volatile("" ::: "memory");
#pragma unroll
        for (int t = 0; t < 4; ++t) {
            const int idx = lane + 64 * t;
            if (idx < c) {
                const unsigned e = qb[idx]; const unsigned kk = 8191u - (e & 8191u);
                __hip_atomic_fetch_or((LAS unsigned*)&qb[256 + (kk >> 5)], 1u << (kk & 31u), __ATOMIC_RELAXED, __HIP_MEMORY_SCOPE_WORKGROUP);
            }
        }
        asm volatile("" ::: "memory");
    }
    u64* mask = (u64*)(P.ws + OFF_MASK);
    const int ktmax = (q0 | 127) >> 6;
    const int qi = lane & 7;
#pragma unroll 1
    for (int it = 0; it < 16; ++it) {
        const int kt = it * 8 + (lane >> 3);
        if (kt <= ktmax) {
            const unsigned lo = buf[qi * TK_CAP + 256 + 2 * kt], hi = buf[qi * TK_CAP + 256 + 2 * kt + 1];
            mask[((size_t)(b * 128 + kt)) * NS + qbase + qi] = ((u64)hi << 32) | lo;
        }
    }
}

constexpr int AT_K = 64 * LROW;
template <int NDB, bool BM>
DI void attn_tile(const char* Kt, const char* Vt, const bf16x8 (&qf)[4], f32x16 (&o)[NDB], float& mrun, float& lrun,
                  int qpos, int k0, float c1, float c2, bool diag, u64 mword) {
    const int lane = threadIdx.x & 63, l31 = lane & 31, hf = lane >> 5;
    const char* kbase = Kt + l31 * LROW + hf * 16;
    const char* vbase = Vt + l31 * LROW + hf * 8;
    const float bias0 = -c2 * (float)(qpos - k0 - 4 * hf);
#pragma unroll 1
    for (int kbi = 0; kbi < 2; ++kbi) {
        const int kb = 1 - kbi;
        f32x16 st;
#pragma unroll
        for (int i = 0; i < 16; ++i) st[i] = 0.f;
#pragma unroll
        for (int ks = 0; ks < 4; ++ks) {
            const bf16x8 kf = *(const bf16x8*)(kbase + kb * 32 * LROW + ks * 32);
            st = MFMA32(kf, qf[ks], st);
        }
        const unsigned mw = BM ? (unsigned)((kb ? (unsigned)(mword >> 32) : (unsigned)mword) >> (4 * hf)) : 0u;
        float mx = -INFINITY;
#pragma unroll
        for (int i = 0; i < 16; ++i) {
            const int ko = 32 * kb + (i & 3) + 8 * (i >> 2);
            float v = st[i] * c1 + (bias0 + c2 * (float)ko);
            bool ok = true;
            if (BM) ok = (mw >> ((i & 3) + 8 * (i >> 2))) & 1u;
            if (diag) ok = ok && (k0 + ko + 4 * hf <= qpos);
            v = ok ? v : -INFINITY;
            st[i] = v; mx = fmaxf(mx, v);
        }
        mx = fmaxf(mx, __shfl_xor(mx, 32));
        const float mnew = fmaxf(mrun, mx);
        const float msafe = (mnew == -INFINITY) ? 0.f : mnew;
        const float alpha = __builtin_amdgcn_exp2f(mrun - msafe);
        float ls = 0.f;
#pragma unroll
        for (int i = 0; i < 16; ++i) { const float p = __builtin_amdgcn_exp2f(st[i] - msafe); st[i] = p; ls += p; }
        lrun = lrun * alpha + ls; mrun = mnew;
        if (__ballot(alpha != 1.f) != 0ull) {
#pragma unroll
            for (int db = 0; db < NDB; ++db)
#pragma unroll
                for (int i = 0; i < 16; ++i) o[db][i] *= alpha;
        }
#pragma unroll
        for (int s = 0; s < 2; ++s) {
            u32x4 pp;
#pragma unroll
            for (int t = 0; t < 4; ++t) pp[t] = pk2(st[8 * s + 2 * t], st[8 * s + 2 * t + 1]);
            const bf16x8 pf = __builtin_bit_cast(bf16x8, pp);
#pragma unroll
            for (int db = 0; db < NDB; ++db) {
                const s16x4 lo = *(const s16x4*)(vbase + db * 32 * LROW + (4 * kb + 2 * s) * 16);
                const s16x4 hi = *(const s16x4*)(vbase + db * 32 * LROW + (4 * kb + 2 * s) * 16 + 16);
                const bf16x8 vf = __builtin_shufflevector(lo, hi, 0, 1, 2, 3, 4, 5, 6, 7);
                o[db] = MFMA32(vf, pf, o[db]);
            }
        }
    }
}

DI void diffattn_item(const Params& P, char* smem, int b, int h, int qb) {
    const int tid = threadIdx.x, lane = tid & 63, w = tid >> 6, l31 = lane & 31, hf = lane >> 5;
    const int map = w & 1, qsub = w >> 1;
    const int q0 = qb * 64;
    const bf16_t* Qd = (const bf16_t*)(P.ws + OFF_QD);
    const bf16_t* Kd = (const bf16_t*)(P.ws + OFF_KD);
    const bf16_t* VdT = (const bf16_t*)(P.ws + OFF_VDT);
    const int qpos = q0 + 32 * qsub + l31;
    bf16x8 qf[4];
#pragma unroll
    for (int ks = 0; ks < 4; ++ks) qf[ks] = *(const bf16x8*)(Qd + ((size_t)b * NS + qpos) * 512 + h * 128 + map * 64 + ks * 16 + hf * 8);
    const float slope = exp2f(-2.f * (float)(h + 1));
    const float c1 = 0.125f * LOG2E, c2 = slope * LOG2E;
    f32x16 o[4];
#pragma unroll
    for (int db = 0; db < 4; ++db)
#pragma unroll
        for (int i = 0; i < 16; ++i) o[db][i] = 0.f;
    float mrun = -INFINITY, lrun = 0.f;
    const int lrow = tid >> 3, lch = tid & 7;
    const bf16_t* kp = Kd + ((size_t)b * NS + lrow) * 512 + h * 128 + lch * 8;
    const bf16_t* vp = VdT + ((size_t)(b * 4 + h) * 128 + lrow) * NS + lch * 8;
    const int so = lofs(lrow, lch);
    const int ktd = qb;
    u32x4 rk1[2], rk2[2], rv[4];
    {
        const int k0 = ktd * 64;
#pragma unroll
        for (int i = 0; i < 2; ++i) { rk1[i] = *(const u32x4*)(kp + (size_t)(k0 + 32 * i) * 512); rk2[i] = *(const u32x4*)(kp + (size_t)(k0 + 32 * i) * 512 + 64); }
#pragma unroll
        for (int i = 0; i < 4; ++i) rv[i] = *(const u32x4*)(vp + (size_t)(32 * i) * NS + k0);
    }
    __syncthreads();
#pragma unroll
    for (int i = 0; i < 2; ++i) { *(u32x4*)(smem + so + i * 32 * LROW) = rk1[i]; *(u32x4*)(smem + AT_K + so + i * 32 * LROW) = rk2[i]; }
#pragma unroll
    for (int i = 0; i < 4; ++i) *(u32x4*)(smem + 2 * AT_K + so + i * 32 * LROW) = rv[i];
    __syncthreads();
    int st = 0;
    for (int kt = ktd; kt >= 0; --kt) {
        const char* cur = smem + st * GT_STAGE;
        if (kt > 0) {
            const int k0 = (kt - 1) * 64;
#pragma unroll
            for (int i = 0; i < 2; ++i) { rk1[i] = *(const u32x4*)(kp + (size_t)(k0 + 32 * i) * 512); rk2[i] = *(const u32x4*)(kp + (size_t)(k0 + 32 * i) * 512 + 64); }
#pragma unroll
            for (int i = 0; i < 4; ++i) rv[i] = *(const u32x4*)(vp + (size_t)(32 * i) * NS + k0);
        }
        attn_tile<4, false>(cur + map * AT_K, cur + 2 * AT_K, qf, o, mrun, lrun, qpos, kt * 64, c1, c2, kt == ktd, 0ull);
        if (kt > 0) {
            char* nxt = smem + (st ^ 1) * GT_STAGE;
#pragma unroll
            for (int i = 0; i < 2; ++i) { *(u32x4*)(nxt + so + i * 32 * LROW) = rk1[i]; *(u32x4*)(nxt + AT_K + so + i * 32 * LROW) = rk2[i]; }
#pragma unroll
            for (int i = 0; i < 4; ++i) *(u32x4*)(nxt + 2 * AT_K + so + i * 32 * LROW) = rv[i];
        }
        __syncthreads();
        st ^= 1;
    }
    const float ltot = lrun + __shfl_xor(lrun, 32);
    const float inv = 1.f / ltot;
    float la, lb;
    { const float a = P.lq1[lane] * P.lk1[lane], c = P.lq2[lane] * P.lk2[lane]; la = wave_sum(a); lb = wave_sum(c); }
    const float lam = __expf(la) - __expf(lb) + 0.2f;
    float* X = (float*)smem;
    if (map == 1) {
#pragma unroll
        for (int db = 0; db < 4; ++db)
#pragma unroll
            for (int q4 = 0; q4 < 4; ++q4) {
                f32x4 v;
#pragma unroll
                for (int r = 0; r < 4; ++r) v[r] = o[db][4 * q4 + r] * inv * lam;
                *(f32x4*)(X + (qsub * 32 + l31) * 132 + 32 * db + 8 * q4 + 4 * hf) = v;
            }
    }
    __syncthreads();
    if (map == 0) {
        float ss = 0.f;
#pragma unroll
        for (int db = 0; db < 4; ++db)
#pragma unroll
            for (int q4 = 0; q4 < 4; ++q4) {
                const f32x4 v2 = *(const f32x4*)(X + (qsub * 32 + l31) * 132 + 32 * db + 8 * q4 + 4 * hf);
#pragma unroll
                for (int r = 0; r < 4; ++r) { const float v = o[db][4 * q4 + r] * inv - v2[r]; o[db][4 * q4 + r] = v; ss += v * v; }
            }
        ss += __shfl_xor(ss, 32);
        const float rstd = rsqrtf(ss * (1.f / 128.f) + EPSF) * 0.8f;
        bf16_t* ao = (bf16_t*)(P.ws + OFF_H) + ((size_t)b * NS + qpos) * 1024 + h * 128;
#pragma unroll
        for (int db = 0; db < 4; ++db)
#pragma unroll
            for (int q4 = 0; q4 < 4; ++q4) {
                const int d = 32 * db + 8 * q4 + 4 * hf;
                const f32x4 g = *(const f32x4*)(P.subln_g + d);
                u32x2 pk; pk[0] = pk2(o[db][4 * q4] * rstd * g[0], o[db][4 * q4 + 1] * rstd * g[1]); pk[1] = pk2(o[db][4 * q4 + 2] * rstd * g[2], o[db][4 * q4 + 3] * rstd * g[3]);
                *(u32x2*)(ao + d) = pk;
            }
    }
    __syncthreads();
}

DI void dsa_item(const Params& P, char* smem, int b, int h, int qb) {
    const int tid = threadIdx.x, lane = tid & 63, w = tid >> 6, l31 = lane & 31, hf = lane >> 5;
    const int q0 = qb * 128;
    const bf16_t* Qs = (const bf16_t*)(P.ws + OFF_QS);
    const bf16_t* Ks = (const bf16_t*)(P.ws + OFF_KS);
    const bf16_t* VsT = (const bf16_t*)(P.ws + OFF_VST);
    const u64* mask = (const u64*)(P.ws + OFF_MASK);
    const int qpos = q0 + 32 * w + l31;
    bf16x8 qf[4];
#pragma unroll
    for (int ks = 0; ks < 4; ++ks) qf[ks] = *(const bf16x8*)(Qs + ((size_t)b * NS + qpos) * 512 + h * 64 + ks * 16 + hf * 8);
    const float slope = exp2f(-(float)(h + 1));
    const float c1 = 0.125f * LOG2E, c2 = slope * LOG2E;
    f32x16 o[2];
#pragma unroll
    for (int db = 0; db < 2; ++db)
#pragma unroll
        for (int i = 0; i < 16; ++i) o[db][i] = 0.f;
    float mrun = -INFINITY, lrun = 0.f;
    const int lrow = tid >> 3, lch = tid & 7;
    const bf16_t* kp = Ks + ((size_t)b * NS + lrow) * 512 + h * 64 + lch * 8;
    const bf16_t* vp = VsT + ((size_t)(b * 8 + h) * 64 + lrow) * NS + lch * 8;
    const int so = lofs(lrow, lch);
    const int ktd = 2 * qb + 1;
    u32x4 rk[2], rv[2];
    {
        const int k0 = ktd * 64;
#pragma unroll
        for (int i = 0; i < 2; ++i) { rk[i] = *(const u32x4*)(kp + (size_t)(k0 + 32 * i) * 512); rv[i] = *(const u32x4*)(vp + (size_t)(32 * i) * NS + k0); }
    }
    __syncthreads();
#pragma unroll
    for (int i = 0; i < 2; ++i) { *(u32x4*)(smem + so + i * 32 * LROW) = rk[i]; *(u32x4*)(smem + AT_K + so + i * 32 * LROW) = rv[i]; }
    __syncthreads();
    int st = 0;
    const int qwmax = q0 + 32 * w + 31, qwmin = q0 + 32 * w;
    for (int kt = ktd; kt >= 0; --kt) {
        const char* cur = smem + st * 2 * AT_K;
        const int k0 = kt * 64;
        u64 mword = 0ull;
        if (k0 <= qwmax) mword = mask[((size_t)(b * 128 + kt)) * NS + qpos];
        if (kt > 0) {
            const int kn = (kt - 1) * 64;
#pragma unroll
            for (int i = 0; i < 2; ++i) { rk[i] = *(const u32x4*)(kp + (size_t)(kn + 32 * i) * 512); rv[i] = *(const u32x4*)(vp + (size_t)(32 * i) * NS + kn); }
        }
        if (k0 <= qwmax && __ballot(mword != 0ull) != 0ull)
            attn_tile<2, true>(cur, cur + AT_K, qf, o, mrun, lrun, qpos, k0, c1, c2, k0 + 63 > qwmin, mword);
        if (kt > 0) {
            char* nxt = smem + (st ^ 1) * 2 * AT_K;
#pragma unroll
            for (int i = 0; i < 2; ++i) { *(u32x4*)(nxt + so + i * 32 * LROW) = rk[i]; *(u32x4*)(nxt + AT_K + so + i * 32 * LROW) = rv[i]; }
        }
        __syncthreads();
        st ^= 1;
    }
    const float ltot = lrun + __shfl_xor(lrun, 32);
    const float inv = 1.f / ltot;
    bf16_t* ao = (bf16_t*)(P.ws + OFF_H) + ((size_t)b * NS + qpos) * 1024 + 512 + h * 64;
#pragma unroll
    for (int db = 0; db < 2; ++db)
#pragma unroll
        for (int q4 = 0; q4 < 4; ++q4) {
            const int d = 32 * db + 8 * q4 + 4 * hf;
            u32x2 pk; pk[0] = pk2(o[db][4 * q4] * inv, o[db][4 * q4 + 1] * inv); pk[1] = pk2(o[db][4 * q4 + 2] * inv, o[db][4 * q4 + 3] * inv);
            *(u32x2*)(ao + d) = pk;
        }
}

constexpr int P3_ITEMS = 256 * 8;
DI void phase_indexer(const Params& P, char* smem) {
    for (int it = blockIdx.x; it < P3_ITEMS; it += gridDim.x) {
        const int g = 255 - (it >> 3), b = it & 7;
        __syncthreads();
        indexer_item(P, smem, b, g * 32);
    }
    __syncthreads();
}
constexpr int P4A_ITEMS = 128 * 32, P4B_ITEMS = 64 * 64;
DI void phase_attn(const Params& P, char* smem) {
    for (int it = blockIdx.x; it < P4A_ITEMS; it += gridDim.x) {
        const int qb = 127 - (it >> 5), s = it & 31;
        diffattn_item(P, smem, s >> 2, s & 3, qb);
    }
    for (int it = blockIdx.x; it < P4B_ITEMS; it += gridDim.x) {
        const int qb = 63 - (it >> 6), s = it & 63;
        dsa_item(P, smem, s >> 3, s & 7, qb);
    }
}

constexpr int OUTPROJ_ITEMS = (NT / 128) * 8;
DI void phase_outproj(const Params& P, char* smem) {
    const bf16_t* ao = (const bf16_t*)(P.ws + OFF_H);
    const bf16_t* wout = (const bf16_t*)(P.ws + OFF_WOUT);
    const float* mod = (const float*)(P.ws + OFF_MOD);
    const int lane = threadIdx.x & 63, w = threadIdx.x >> 6, wm = w >> 1, wn = w & 1, l31 = lane & 31, hf = lane >> 5;
    for (int it = blockIdx.x; it < OUTPROJ_ITEMS; it += gridDim.x) {
        const int xcd = it & 7, loc = it >> 3;
        const int mt = (loc >> 3) * 8 + xcd, j = loc & 7;
        const int row0 = mt * 128, b = row0 >> 13;
        DenseRows ar{ao + (size_t)row0 * 1024, 1024};
        f32x16 acc[2][2];
        gemm_tile<true>(smem, ar, wout + (size_t)j * 128 * 1024, 1024, 1024, acc);
        const float* g1 = mod + b * 6144 + 2048;
#pragma unroll
        for (int mi = 0; mi < 2; ++mi) {
            const size_t tok = (size_t)row0 + 64 * wm + 32 * mi + l31;
#pragma unroll
            for (int ni = 0; ni < 2; ++ni)
#pragma unroll
                for (int q4 = 0; q4 < 4; ++q4) {
                    const int n = 128 * j + 64 * wn + 32 * ni + 8 * q4 + 4 * hf;
                    const f32x4 xv = *(const f32x4*)(P.x + tok * 1024 + n);
                    const f32x4 gv = *(const f32x4*)(g1 + n);
                    f32x4 ov;
#pragma unroll
                    for (int r = 0; r < 4; ++r) ov[r] = xv[r] + gv[r] * acc[mi][ni][4 * q4 + r];
                    *(f32x4*)(P.out + tok * 1024 + n) = ov;
                }
        }
    }
}

constexpr int ROUTER_ITEMS = (NT / 128) * 2;
DI void phase_router(const Params& P, char* smem) {
    const bf16_t* h2 = (const bf16_t*)(P.ws + OFF_H2);
    const bf16_t* wrt = (const bf16_t*)(P.ws + OFF_WRT);
    float* logits = (float*)(P.ws + OFF_Y);
    const int lane = threadIdx.x & 63, w = threadIdx.x >> 6, wm = w >> 1, wn = w & 1, l31 = lane & 31, hf = lane >> 5;
    for (int it = blockIdx.x; it < ROUTER_ITEMS; it += gridDim.x) {
        const int mt = it >> 1, j = it & 1;
        const int row0 = mt * 128;
        DenseRows ar{h2 + (size_t)row0 * 1024, 1024};
        f32x16 acc[2][2];
        gemm_tile<true>(smem, ar, wrt + (size_t)j * 128 * 1024, 1024, 1024, acc);
#pragma unroll
        for (int mi = 0; mi < 2; ++mi) {
            const size_t tok = (size_t)row0 + 64 * wm + 32 * mi + l31;
#pragma unroll
            for (int ni = 0; ni < 2; ++ni)
#pragma unroll
                for (int q4 = 0; q4 < 4; ++q4) {
                    const int n = 128 * j + 64 * wn + 32 * ni + 8 * q4 + 4 * hf;
                    f32x4 ov = {acc[mi][ni][4 * q4], acc[mi][ni][4 * q4 + 1], acc[mi][ni][4 * q4 + 2], acc[mi][ni][4 * q4 + 3]};
                    *(f32x4*)(logits + tok * 256 + n) = ov;
                }
        }
    }
}

DI void phase_route(const Params& P) {
    const float* logits = (const float*)(P.ws + OFF_Y);
    int* cnt = (int*)(P.ws + OFF_CNT);
    int* list = (int*)(P.ws + OFF_LIST);
    int* eidx = (int*)(P.ws + OFF_EIDX);
    float* gates = (float*)(P.ws + OFF_GATE);
    const int lane = threadIdx.x & 63, w = threadIdx.x >> 6;
    const f32x4 bias = *(const f32x4*)(P.router_b + 4 * lane);
    for (int t = blockIdx.x * 4 + w; t < NT; t += gridDim.x * 4) {
        const f32x4 lg = *(const f32x4*)(logits + (size_t)t * 256 + 4 * lane);
        float sc[4], cand[4];
#pragma unroll
        for (int i = 0; i < 4; ++i) { sc[i] = 1.f / (1.f + __expf(-lg[i])); cand[i] = sc[i] + bias[i]; }
        float t1 = fmaxf(cand[0], cand[1]), t2 = fminf(cand[0], cand[1]);
#pragma unroll
        for (int i = 2; i < 4; ++i) { const float v = cand[i]; t2 = fmaxf(t2, fminf(t1, v)); t1 = fmaxf(t1, v); }
#pragma unroll
        for (int d = 1; d < 8; d <<= 1) {
            const float o1 = __shfl_xor(t1, d), o2 = __shfl_xor(t2, d);
            const float n1 = fmaxf(t1, o1), n2 = fmaxf(fminf(t1, o1), fmaxf(t2, o2));
            t1 = n1; t2 = n2;
        }
        const float gs = t1 + t2;
        const int myg = lane >> 3;
        int rank = 0;
#pragma unroll
        for (int g = 0; g < 8; ++g) { const float sg = __shfl(gs, 8 * g); rank += (sg > gs || (sg == gs && g < myg)) ? 1 : 0; }
        if (rank >= 4) {
#pragma unroll
            for (int i = 0; i < 4; ++i) cand[i] = -INFINITY;
        }
        int sel[8]; float wv[8]; float wsum = 0.f;
#pragma unroll
        for (int k = 0; k < 8; ++k) {
            float bv = cand[0]; int bi = 0;
#pragma unroll
            for (int i = 1; i < 4; ++i) if (cand[i] > bv) { bv = cand[i]; bi = i; }
            int be = 4 * lane + bi;
#pragma unroll
            for (int d = 32; d >= 1; d >>= 1) {
                const float ov = __shfl_xor(bv, d); const int oe = __shfl_xor(be, d);
                if (ov > bv || (ov == bv && oe < be)) { bv = ov; be = oe; }
            }
            const int ol = be >> 2, oi = be & 3;
            float mys = (oi == 0) ? sc[0] : (oi == 1) ? sc[1] : (oi == 2) ? sc[2] : sc[3];
            const float ws_ = __shfl(mys, ol);
            if (lane == ol) {
#pragma unroll
                for (int i = 0; i < 4; ++i) if (i == oi) cand[i] = -INFINITY;
            }
            sel[k] = be; wv[k] = ws_; wsum += ws_;
        }
        const float rs = 2.5f / wsum;
        int my_e = 256; float my_g = 1.f;
#pragma unroll
        for (int k = 0; k < 8; ++k) if (lane == k) { my_e = sel[k]; my_g = wv[k] * rs; }
        const int c = t >> 14, tl = t & (CHUNK_T - 1);
        if (lane < 8) {
            eidx[(size_t)t * 8 + lane] = my_e; gates[(size_t)t * 8 + lane] = my_g;
            const int pos = atomicAdd(&cnt[c * NEXP1 + my_e], 1);
            list[((size_t)c * NEXP1 + my_e) * CHUNK_T + pos] = tl * NPAIR + lane;
        } else if (lane == 8) {
            list[((size_t)c * NEXP1 + 256) * CHUNK_T + tl] = tl * NPAIR + 8;
        }
    }
}

DI int moe_build_tiles(const Params& P, char* smem, int c) {
    int* tstart = (int*)(smem + SM_EXTRA);
    int* wsum = (int*)(smem + SM_EXTRA + 1536);
    const int* cnt = (const int*)(P.ws + OFF_CNT) + c * NEXP1;
    const int e = threadIdx.x, lane = e & 63, w = e >> 6;
    __syncthreads();
    const int n = (cnt[e] + 127) >> 7;
    int inc = n;
#pragma unroll
    for (int d = 1; d < 64; d <<= 1) { const int t = __shfl_up(inc, d); if (lane >= d) inc += t; }
    if (lane == 63) wsum[w] = inc;
    __syncthreads();
    int off = 0;
#pragma unroll
    for (int i = 0; i < 4; ++i) if (i < w) off += wsum[i];
    tstart[e] = off + inc - n;
    if (e == 255) { tstart[256] = off + inc; tstart[257] = off + inc + CHUNK_T / 128; }
    __syncthreads();
    return tstart[NEXP1];
}
DI int moe_find_expert(const int* tstart, int tile) {
    int lo = 0, hi = NEXP1;
    while (hi - lo > 1) { const int mid = (lo + hi) >> 1; if (tstart[mid] <= tile) lo = mid; else hi = mid; }
    return lo;
}
struct GatherRows {
    const bf16_t* base; int ld; const int* pid; int div;
    DI const bf16_t* operator()(int r) const { const int p = pid[r]; return p < 0 ? nullptr : base + (size_t)(p / div) * ld; }
};
DI void phase_moe_g1(const Params& P, char* smem, int c) {
    const int total = moe_build_tiles(P, smem, c);
    const int* tstart = (const int*)(smem + SM_EXTRA);
    int* pid = (int*)(smem + SM_EXTRA + 2048);
    const int* cnt = (const int*)(P.ws + OFF_CNT) + c * NEXP1;
    const int* list = (const int*)(P.ws + OFF_LIST) + (size_t)c * NEXP1 * CHUNK_T;
    const bf16_t* h2 = (const bf16_t*)(P.ws + OFF_H2) + (size_t)c * CHUNK_T * 1024;
    const bf16_t* wgu = (const bf16_t*)(P.ws + OFF_WGU);
    bf16_t* act = (bf16_t*)(P.ws + OFF_ACT + (size_t)(c & 1) * ACT_BYTES);
    const int lane = threadIdx.x & 63, w = threadIdx.x >> 6, wm = w >> 1, wn = w & 1, l31 = lane & 31, hf = lane >> 5;
    for (int it = blockIdx.x; it < total * 4; it += gridDim.x) {
        const int tile = it >> 2, j = it & 3;
        const int e = moe_find_expert(tstart, tile), ti = tile - tstart[e];
        const int n = e < NEXP ? cnt[e] : CHUNK_T;
        __syncthreads();
        if (threadIdx.x < 128) { const int li = ti * 128 + threadIdx.x; pid[threadIdx.x] = li < n ? list[(size_t)e * CHUNK_T + li] : -1; }
        __syncthreads();
        GatherRows ar{h2, 1024, pid, NPAIR};
        f32x16 acc[2][2];
        gemm_tile<true>(smem, ar, wgu + ((size_t)e * 512 + j * 128) * 1024, 1024, 1024, acc);
#pragma unroll
        for (int mi = 0; mi < 2; ++mi) {
            const int p = pid[64 * wm + 32 * mi + l31];
            if (p >= 0) {
                bf16_t* arow_ = act + (size_t)p * 256 + 64 * j + 32 * wn;
#pragma unroll
                for (int q4 = 0; q4 < 4; ++q4) {
                    float o[4];
#pragma unroll
                    for (int r = 0; r < 4; ++r) { const float g = acc[mi][0][4 * q4 + r], u = acc[mi][1][4 * q4 + r]; o[r] = silu_f(g) * u; }
                    u32x2 pk; pk[0] = pk2(o[0], o[1]); pk[1] = pk2(o[2], o[3]);
                    *(u32x2*)(arow_ + 8 * q4 + 4 * hf) = pk;
                }
            }
        }
    }
}
DI void phase_moe_g2(const Params& P, char* smem, int c) {
    const int total = moe_build_tiles(P, smem, c);
    const int* tstart = (const int*)(smem + SM_EXTRA);
    int* pid = (int*)(smem + SM_EXTRA + 2048);
    const int* cnt = (const int*)(P.ws + OFF_CNT) + c * NEXP1;
    const int* list = (const int*)(P.ws + OFF_LIST) + (size_t)c * NEXP1 * CHUNK_T;
    const float* gates = (const float*)(P.ws + OFF_GATE) + (size_t)c * CHUNK_T * 8;
    const bf16_t* wd = (const bf16_t*)(P.ws + OFF_WD);
    const bf16_t* act = (const bf16_t*)(P.ws + OFF_ACT + (size_t)(c & 1) * ACT_BYTES);
    bf16_t* y = (bf16_t*)(P.ws + OFF_Y);
    const int lane = threadIdx.x & 63, w = threadIdx.x >> 6, wm = w >> 1, wn = w & 1, l31 = lane & 31, hf = lane >> 5;
    for (int it = blockIdx.x; it < total * 8; it += gridDim.x) {
        const int tile = it >> 3, j = it & 7;
        const int e = moe_find_expert(tstart, tile), ti = tile - tstart[e];
        const int n = e < NEXP ? cnt[e] : CHUNK_T;
        __syncthreads();
        if (threadIdx.x < 128) { const int li = ti * 128 + threadIdx.x; pid[threadIdx.x] = li < n ? list[(size_t)e * CHUNK_T + li] : -1; }
        __syncthreads();
        GatherRows ar{act, 256, pid, 1};
        f32x16 acc[2][2];
        gemm_tile<true>(smem, ar, wd + ((size_t)e * 1024 + j * 128) * 256, 256, 256, acc);
#pragma unroll
        for (int mi = 0; mi < 2; ++mi) {
            const int p = pid[64 * wm + 32 * mi + l31];
            if (p >= 0) {
                const int k = p % NPAIR, tl = p / NPAIR;
                const float g = k < 8 ? gates[(size_t)tl * 8 + k] : 1.f;
                bf16_t* yrow = y + (size_t)p * 1024 + 128 * j + 64 * wn;
#pragma unroll
                for (int ni = 0; ni < 2; ++ni)
#pragma unroll
                    for (int q4 = 0; q4 < 4; ++q4) {
                        u32x2 pk; pk[0] = pk2(acc[mi][ni][4 * q4] * g, acc[mi][ni][4 * q4 + 1] * g); pk[1] = pk2(acc[mi][ni][4 * q4 + 2] * g, acc[mi][ni][4 * q4 + 3] * g);
                        *(u32x2*)(yrow + 32 * ni + 8 * q4 + 4 * hf) = pk;
                    }
            }
        }
    }
}
DI void phase_moe_combine(const Params& P, int c) {
    const bf16_t* y = (const bf16_t*)(P.ws + OFF_Y);
    const float* mod = (const float*)(P.ws + OFF_MOD);
    const int lane = threadIdx.x & 63, w = threadIdx.x >> 6;
    for (int tl = blockIdx.x * 4 + w; tl < CHUNK_T; tl += gridDim.x * 4) {
        const size_t t = (size_t)c * CHUNK_T + tl;
        const int b = (int)(t >> 13);
        const float* g2 = mod + b * 6144 + 5120;
#pragma unroll
        for (int i = 0; i < 4; ++i) {
            const int col = 256 * i + 4 * lane;
            float s[4] = {0.f, 0.f, 0.f, 0.f};
#pragma unroll
            for (int k = 0; k < NPAIR; ++k) {
                const u32x2 v = *(const u32x2*)(y + ((size_t)tl * NPAIR + k) * 1024 + col);
                s[0] += bflo(v[0]); s[1] += bfhi(v[0]); s[2] += bflo(v[1]); s[3] += bfhi(v[1]);
            }
            const f32x4 xv = *(const f32x4*)(P.out + t * 1024 + col);
            const f32x4 gv = *(const f32x4*)(g2 + col);
            f32x4 ov;
#pragma unroll
            for (int r = 0; r < 4; ++r) ov[r] = xv[r] + gv[r] * s[r];
            *(f32x4*)(P.out + t * 1024 + col) = ov;
        }
    }
}

constexpr int NPHASE = 18;
template <int PH> DI void run_phase(const Params& P, char* smem) {
    float* mod = (float*)(P.ws + OFF_MOD);
    if constexpr (PH == 0) phase_adaln(P, smem);
    else if constexpr (PH == 1) { phase_norm(P.x, P.norm1_g, mod, 0, 1024, (bf16_t*)(P.ws + OFF_H)); phase_convert(P, smem); }
    else if constexpr (PH == 2) phase_inproj(P, smem);
    else if constexpr (PH == 3) phase_indexer(P, smem);
    else if constexpr (PH == 4) phase_attn(P, smem);
    else if constexpr (PH == 5) phase_outproj(P, smem);
    else if constexpr (PH == 6) phase_norm(P.out, P.norm2_g, mod, 3072, 4096, (bf16_t*)(P.ws + OFF_H2));
    else if constexpr (PH == 7) phase_router(P, smem);
    else if constexpr (PH == 8) phase_route(P);
    else if constexpr (PH == 9) phase_moe_g1(P, smem, 0);
    else if constexpr (PH == 10) phase_moe_g2(P, smem, 0);
    else if constexpr (PH == 11) { phase_moe_g1(P, smem, 1); phase_moe_combine(P, 0); }
    else if constexpr (PH == 12) phase_moe_g2(P, smem, 1);
    else if constexpr (PH == 13) { phase_moe_g1(P, smem, 2); phase_moe_combine(P, 1); }
    else if constexpr (PH == 14) phase_moe_g2(P, smem, 2);
    else if constexpr (PH == 15) { phase_moe_g1(P, smem, 3); phase_moe_combine(P, 2); }
    else if constexpr (PH == 16) phase_moe_g2(P, smem, 3);
    else if constexpr (PH == 17) phase_moe_combine(P, 3);
}
#define MK_RUN(PH) if constexpr (P0 <= PH && PH < P1) { run_phase<PH>(P, smem); if constexpr (PH + 1 < P1) xcd_barrier(bar); }
template <int P0, int P1>
__global__ void __launch_bounds__(256, 2) mk_kernel(Params P) {
    __shared__ __attribute__((aligned(16))) char smem[SMEM_BYTES];
    __shared__ uint4 xb_words;
    if (threadIdx.x == 0) xb_words = make_uint4(0u, 0u, 0u, 0u);
    __syncthreads();
    XcdBarrier bar;
    if constexpr (P1 - P0 > 1) bar = xcd_barrier_post((unsigned*)(P.ws + OFF_BAR), (volatile LAS unsigned*)&xb_words);
    MK_RUN(0) MK_RUN(1) MK_RUN(2) MK_RUN(3) MK_RUN(4) MK_RUN(5) MK_RUN(6) MK_RUN(7) MK_RUN(8)
    MK_RUN(9) MK_RUN(10) MK_RUN(11) MK_RUN(12) MK_RUN(13) MK_RUN(14) MK_RUN(15) MK_RUN(16) MK_RUN(17)
}

template <int P0, int P1> static void launch_range(const Params& p, hipStream_t stream) {
    static int grid = 0;
    if (!grid) {
        int dev = 0, cus = 0, per_cu = 0;
        (void)hipGetDevice(&dev);
        (void)hipDeviceGetAttribute(&cus, hipDeviceAttributeMultiprocessorCount, dev);
        (void)hipOccupancyMaxActiveBlocksPerMultiprocessor(&per_cu, mk_kernel<P0, P1>, 256, 0);
        if (cus <= 0) cus = 256;
        if (per_cu < 1) per_cu = 1;
        grid = cus * (per_cu < 2 ? per_cu : 2);
    }
    mk_kernel<P0, P1><<<dim3(grid), dim3(256), 0, stream>>>(p);
}

extern "C" void kernel_launch(void* const* d_in, const int* in_sizes, int n_in, void* d_out, int out_size, void* d_ws, size_t ws_size, hipStream_t stream) {
    if (ws_size < WS_NEED) return;
    Params p{};
    const float** f = (const float**)&p;
    for (int i = 0; i < 26; ++i) f[i] = (const float*)d_in[i];
    p.out = (float*)d_out;
    p.ws = (char*)d_ws;
    (void)hipMemsetAsync(d_ws, 0, ZERO_BYTES, stream);
#if MK_ONE_LAUNCH
    launch_range<0, NPHASE>(p, stream);
#else
    launch_range<0, 1>(p, stream); launch_range<1, 2>(p, stream); launch_range<2, 3>(p, stream); launch_range<3, 4>(p, stream);
    launch_range<4, 5>(p, stream); launch_range<5, 6>(p, stream); launch_range<6, 7>(p, stream); launch_range<7, 8>(p, stream);
    launch_range<8, 9>(p, stream); launch_range<9, 10>(p, stream); launch_range<10, 11>(p, stream); launch_range<11, 12>(p, stream);
    launch_range<12, 13>(p, stream); launch_range<13, 14>(p, stream); launch_range<14, 15>(p, stream); launch_range<15, 16>(p, stream);
    launch_range<16, 17>(p, stream); launch_range<17, 18>(p, stream);
#endif
}
```

```cpp
#include <hip/hip_runtime.h>
#include <stdint.h>

#define DI __device__ __forceinline__
#define LAS __attribute__((address_space(3)))
typedef unsigned short bf16_t;
typedef short bf16x8 __attribute__((ext_vector_type(8)));
typedef short s16x4 __attribute__((ext_vector_type(4)));
typedef float f32x16 __attribute__((ext_vector_type(16)));
typedef float f32x4 __attribute__((ext_vector_type(4)));
typedef float f32x2 __attribute__((ext_vector_type(2)));
typedef __bf16 bf16v2 __attribute__((ext_vector_type(2)));
typedef unsigned u32x4 __attribute__((ext_vector_type(4)));
typedef unsigned u32x2 __attribute__((ext_vector_type(2)));
typedef unsigned long long u64;
#define MFMA32(a, b, c) __builtin_amdgcn_mfma_f32_32x32x16_bf16((a), (b), (c), 0, 0, 0)

constexpr int NB = 8, NS = 8192, ND = 1024, NT = NB * NS;
constexpr int IN_COLS = 3656, NPAD = 3712;
constexpr int NEXP = 256, NEXP1 = 257;
constexpr int NCHUNK = 4, CHUNK_T = NT / NCHUNK;
constexpr int NPAIR = 9;
constexpr float EPSF = 1e-6f;
constexpr float LOG2E = 1.4426950408889634f;

constexpr size_t MiB = 1048576;
constexpr size_t OFF_BAR = 0;
constexpr size_t OFF_MOD = 16384;
constexpr size_t OFF_CNT = OFF_MOD + 196608;
constexpr size_t OFF_ERR = OFF_CNT + 8192;
constexpr size_t ZERO_BYTES = 262144;
constexpr size_t OFF_WIN = 1 * MiB;
constexpr size_t OFF_WOUT = OFF_WIN + (size_t)NPAD * 1024 * 2;
constexpr size_t OFF_WRT = OFF_WOUT + 2 * MiB;
constexpr size_t OFF_WGU = 12 * MiB;
constexpr size_t OFF_WD = OFF_WGU + (size_t)NEXP1 * 512 * 1024 * 2;
constexpr size_t OFF_R1 = OFF_WD + (size_t)NEXP1 * 1024 * 256 * 2;
constexpr size_t OFF_H = OFF_R1;
constexpr size_t OFF_QD = OFF_H + 128 * MiB;
constexpr size_t OFF_KD = OFF_QD + 64 * MiB;
constexpr size_t OFF_VDT = OFF_KD + 64 * MiB;
constexpr size_t OFF_QS = OFF_VDT + 64 * MiB;
constexpr size_t OFF_KS = OFF_QS + 64 * MiB;
constexpr size_t OFF_VST = OFF_KS + 64 * MiB;
constexpr size_t OFF_IQ = OFF_VST + 64 * MiB;
constexpr size_t OFF_IK = OFF_IQ + 64 * MiB;
constexpr size_t OFF_IW = OFF_IK + 8 * MiB;
constexpr size_t OFF_MASK = OFF_IW + 2 * MiB;
constexpr size_t END_A = OFF_MASK + 64 * MiB;
constexpr size_t OFF_H2 = OFF_R1;
constexpr size_t OFF_LIST = OFF_H2 + 128 * MiB;
constexpr size_t OFF_EIDX = OFF_LIST + (size_t)NCHUNK * NEXP1 * CHUNK_T * 4;
constexpr size_t OFF_GATE = OFF_EIDX + 2 * MiB;
constexpr size_t OFF_ACT = OFF_GATE + 2 * MiB;
constexpr size_t ACT_BYTES = (size_t)CHUNK_T * NPAIR * 256 * 2;
constexpr size_t OFF_Y = OFF_ACT + 2 * ACT_BYTES;
constexpr size_t END_B = OFF_Y + (size_t)CHUNK_T * NPAIR * 1024 * 2;
constexpr size_t WS_NEED = END_A > END_B ? END_A : END_B;

struct Params {
    const float *x, *c, *ada_w, *ada_b, *norm1_g, *norm2_g, *w_in, *dq_g, *dk_g, *lq1, *lk1, *lq2, *lk2, *subln_g, *sq_g, *sk_g, *ik_g,
        *w_out, *router_w, *router_b, *ew_gate, *ew_up, *ew_down, *sw_gate, *sw_up, *sw_down;
    float* out;
    char* ws;
};

DI unsigned pk2(float a, float b) { f32x2 f = {a, b}; bf16v2 r = __builtin_convertvector(f, bf16v2); return __builtin_bit_cast(unsigned, r); }
DI float bf2f(bf16_t v) { return __uint_as_float(((unsigned)v) << 16); }
DI float bflo(unsigned u) { return __uint_as_float(u << 16); }
DI float bfhi(unsigned u) { return __uint_as_float(u & 0xffff0000u); }
DI int crow(int i, int hf) { return (i & 3) + 8 * (i >> 2) + 4 * hf; }
constexpr int LROW = 144;
DI int lofs(int row, int chunk) { return row * LROW + chunk * 16; }
DI float wave_sum(float v) {
#pragma unroll
    for (int d = 32; d >= 1; d >>= 1) v += __shfl_xor(v, d);
    return v;
}
DI float silu_f(float v) { return v / (1.f + __expf(-v)); }

#define XB_TMO      128
#define XB_XCNT(j)  (256  + 64 * (j))
#define XB_XSUB(j)  (1280 + 64 * (j))
#define XB_XGEN(j)  (2304 + 64 * (j))
#define XB_TOP      3328
#define XB_TOPGEN   3392
#define XCD_BAR_WORDS 3456
#define XB_SPIN_CAP (1u << 18)

__device__ __forceinline__ unsigned xb_ld(unsigned* p)              { return __hip_atomic_load(p, __ATOMIC_RELAXED, __HIP_MEMORY_SCOPE_AGENT); }
__device__ __forceinline__ unsigned xb_add(unsigned* p, unsigned v) { return __hip_atomic_fetch_add(p, v, __ATOMIC_RELAXED, __HIP_MEMORY_SCOPE_AGENT); }
__device__ __forceinline__ unsigned xb_xcc_id() { return (unsigned)__builtin_amdgcn_s_getreg((3 << 11) | 20) & 0xFu; }
#define XB_SPIN(cond, bar) do { unsigned _sp = 0; while (cond) { __builtin_amdgcn_s_sleep(1); \
    if ((++_sp & 255u) == 0u) { if (xb_ld(&(bar)[XB_TMO])) break; if (_sp > XB_SPIN_CAP) { atomicAdd(&(bar)[XB_TMO], 1u); break; } } } } while (0)

struct XcdBarrier {
    unsigned* bar; unsigned x;
    volatile LAS unsigned* st;
};
__device__ __forceinline__ XcdBarrier xcd_barrier_post(unsigned* bar, volatile LAS unsigned* st) {
    XcdBarrier b; b.bar = bar; b.x = xb_xcc_id(); b.st = st;
    if (threadIdx.x == 0) (void)xb_add(&bar[XB_XCNT(b.x)], 1u);
    return b;
}
__device__ __forceinline__ void xcd_barrier_complete(unsigned* bar, unsigned x, unsigned& nloc, unsigned& nx) {
    const unsigned G = gridDim.x * gridDim.y * gridDim.z;
    unsigned sum, cnt, mine, sp = 0u;
    for (;;) {
        sum = 0u; cnt = 0u; mine = 0u;
#pragma unroll
        for (unsigned j = 0; j < 16; ++j) { const unsigned c = xb_ld(&bar[XB_XCNT(j)]); sum += c; cnt += (c > 0u) ? 1u : 0u; mine = (j == x) ? c : mine; }
        if (sum == G) break;
        __builtin_amdgcn_s_sleep(1);
        if ((++sp & 255u) == 0u) { if (xb_ld(&bar[XB_TMO])) break; if (sp > XB_SPIN_CAP) { atomicAdd(&bar[XB_TMO], 1u); break; } }
    }
    nloc = mine > 0u ? mine : 1u; nx = cnt > 0u ? cnt : 1u;
}
__device__ __forceinline__ void xcd_barrier(const XcdBarrier& b) {
    asm volatile("s_waitcnt vmcnt(0)" ::: "memory");
    __syncthreads();
    if (threadIdx.x == 0) {
        unsigned* bar = b.bar;
        __builtin_amdgcn_s_waitcnt(0);
        unsigned nloc = b.st[0], nx = b.st[1];
        if (nloc == 0u) { xcd_barrier_complete(bar, b.x, nloc, nx); b.st[0] = nloc; b.st[1] = nx; }
        const unsigned old = xb_add(&bar[XB_XSUB(b.x)], 1u);
        const unsigned gen = old / nloc;
        if (old + 1u == (gen + 1u) * nloc) {
            __builtin_amdgcn_fence(__ATOMIC_RELEASE, "agent");
            asm volatile("s_waitcnt vmcnt(0)" ::: "memory");
            const unsigned og = xb_add(&bar[XB_TOP], 1u);
            const unsigned tg = og / nx;
            if (og + 1u == (tg + 1u) * nx) xb_add(&bar[XB_TOPGEN], 1u);
            else XB_SPIN(xb_ld(&bar[XB_TOPGEN]) == tg, bar);
            __builtin_amdgcn_fence(__ATOMIC_ACQUIRE, "agent");
            xb_add(&bar[XB_XGEN(b.x)], 1u);
            asm volatile("s_waitcnt vmcnt(0)" ::: "memory");
        } else {
            XB_SPIN(xb_ld(&bar[XB_XGEN(b.x)]) == gen, bar);
            __builtin_amdgcn_fence(__ATOMIC_ACQUIRE, "agent");
            asm volatile("s_waitcnt vmcnt(0)" ::: "memory");
        }
    }
    __syncthreads();
}

constexpr int GT_B = 128 * LROW;
constexpr int GT_STAGE = 2 * 128 * LROW;
constexpr int SM_EXTRA = 2 * GT_STAGE;
constexpr int SMEM_BYTES = SM_EXTRA + 4096;
#define MK_ONE_LAUNCH 1


DI void phase_adaln(const Params& P, char* smem) {
    float* mod = (float*)(P.ws + OFF_MOD);
    float* sc = (float*)smem;
    float* red = sc + 8192;
    const int tid = threadIdx.x;
    __syncthreads();
    for (int i = tid; i < 8192; i += 256) sc[i] = silu_f(P.c[i]);
    __syncthreads();
    const int kg = tid >> 4, cn = tid & 15;
    for (int it = blockIdx.x; it < 384; it += gridDim.x) {
        const int n = it * 16 + cn;
        float acc[8];
#pragma unroll
        for (int b = 0; b < 8; ++b) acc[b] = 0.f;
#pragma unroll 8
        for (int kk = 0; kk < 64; ++kk) {
            const int k = kg * 64 + kk;
            const float w = P.ada_w[(size_t)k * 6144 + n];
#pragma unroll
            for (int b = 0; b < 8; ++b) acc[b] += sc[b * 1024 + k] * w;
        }
#pragma unroll
        for (int b = 0; b < 8; ++b) red[(kg * 8 + b) * 16 + cn] = acc[b];
        __syncthreads();
        if (tid < 128) {
            const int b = tid >> 4;
            float s = P.ada_b[n];
#pragma unroll
            for (int g = 0; g < 16; ++g) s += red[(g * 8 + b) * 16 + cn];
            mod[b * 6144 + n] = s;
        }
        __syncthreads();
    }
}

DI void phase_norm(const float* __restrict__ xin, const float* __restrict__ g, const float* __restrict__ mod, int sh_off, int sc_off, bf16_t* __restrict__ dst) {
    const int lane = threadIdx.x & 63, w = threadIdx.x >> 6;
    for (int row = blockIdx.x * 4 + w; row < NT; row += gridDim.x * 4) {
        const int b = row >> 13;
        const float* xr = xin + (size_t)row * 1024;
        f32x4 v[4]; float ss = 0.f;
#pragma unroll
        for (int i = 0; i < 4; ++i) { v[i] = *(const f32x4*)(xr + 256 * i + 4 * lane); ss += v[i][0] * v[i][0] + v[i][1] * v[i][1] + v[i][2] * v[i][2] + v[i][3] * v[i][3]; }
        ss = wave_sum(ss);
        const float rstd = rsqrtf(ss * (1.f / 1024.f) + EPSF);
#pragma unroll
        for (int i = 0; i < 4; ++i) {
            const int col = 256 * i + 4 * lane;
            const f32x4 gg = *(const f32x4*)(g + col);
            const f32x4 sh = *(const f32x4*)(mod + b * 6144 + sh_off + col);
            const f32x4 sc = *(const f32x4*)(mod + b * 6144 + sc_off + col);
            float o[4];
#pragma unroll
            for (int j = 0; j < 4; ++j) o[j] = v[i][j] * rstd * gg[j] * (1.f + sc[j]) + sh[j];
            u32x2 pk; pk[0] = pk2(o[0], o[1]); pk[1] = pk2(o[2], o[3]);
            *(u32x2*)(dst + (size_t)row * 1024 + col) = pk;
        }
    }
}

DI int gu_row(int f, int is_up) { return (f >> 6) * 128 + (((f >> 5) & 1) * 2 + is_up) * 32 + (f & 31); }
DI void cvt_tile(float* t, const float* __restrict__ src, int ldsrc, int nvalid, int k0, int n0, bf16_t* __restrict__ dst, int ldd, int mode) {
    const int tid = threadIdx.x;
    __syncthreads();
#pragma unroll
    for (int i = 0; i < 16; ++i) {
        const int idx = tid + 256 * i, kk = idx >> 6, nn = idx & 63;
        float v = 0.f;
        if (n0 + nn < nvalid) v = src[(size_t)(k0 + kk) * ldsrc + n0 + nn];
        t[kk * 65 + nn] = v;
    }
    __syncthreads();
    const int nn = tid >> 2, kq = (tid & 3) * 16;
    unsigned pk[8];
#pragma unroll
    for (int j = 0; j < 8; ++j) pk[j] = pk2(t[(kq + 2 * j) * 65 + nn], t[(kq + 2 * j + 1) * 65 + nn]);
    const int n = n0 + nn;
    const int drow = mode == 0 ? n : gu_row(n, mode - 1);
    bf16_t* d = dst + (size_t)drow * ldd + k0 + kq;
    *(u32x4*)(d) = (u32x4){pk[0], pk[1], pk[2], pk[3]};
    *(u32x4*)(d + 8) = (u32x4){pk[4], pk[5], pk[6], pk[7]};
}
constexpr int CVT_SMALL = 928 + 256 + 64;
constexpr int CVT_ITEMS = CVT_SMALL + NEXP1 * 192;
DI void phase_convert(const Params& P, char* smem) {
    float* t = (float*)smem;
    bf16_t* win = (bf16_t*)(P.ws + OFF_WIN); bf16_t* wout = (bf16_t*)(P.ws + OFF_WOUT); bf16_t* wrt = (bf16_t*)(P.ws + OFF_WRT);
    bf16_t* wgu = (bf16_t*)(P.ws + OFF_WGU); bf16_t* wd = (bf16_t*)(P.ws + OFF_WD);
    for (int it = blockIdx.x; it < CVT_ITEMS; it += gridDim.x) {
        if (it < 928) { cvt_tile(t, P.w_in, IN_COLS, IN_COLS, (it & 15) * 64, (it >> 4) * 64, win, 1024, 0); }
        else if (it < 928 + 256) { const int r = it - 928; cvt_tile(t, P.w_out, 1024, 1024, (r & 15) * 64, (r >> 4) * 64, wout, 1024, 0); }
        else if (it < CVT_SMALL) { const int r = it - 928 - 256; cvt_tile(t, P.router_w, 256, 256, (r & 15) * 64, (r >> 4) * 64, wrt, 1024, 0); }
        else {
            const int r = it - CVT_SMALL, e = r / 192, sub = r % 192;
            if (sub < 128) {
                const int up = sub >> 6, s2 = sub & 63;
                const float* src = e < NEXP ? (up ? P.ew_up : P.ew_gate) + (size_t)e * 1024 * 256 : (up ? P.sw_up : P.sw_gate);
                cvt_tile(t, src, 256, 256, (s2 & 15) * 64, (s2 >> 4) * 64, wgu + (size_t)e * 512 * 1024, 1024, 1 + up);
            } else {
                const int s2 = sub - 128;
                const float* src = e < NEXP ? P.ew_down + (size_t)e * 256 * 1024 : P.sw_down;
                cvt_tile(t, src, 1024, 1024, (s2 & 3) * 64, (s2 >> 2) * 64, wd + (size_t)e * 1024 * 256, 256, 0);
            }
        }
    }
}

template <bool SWAP, class AFn>
DI void gemm_tile(char* lds, AFn arow, const bf16_t* __restrict__ Bt, int ldb, int K, f32x16 (&acc)[2][2]) {
    const int tid = threadIdx.x, lane = tid & 63, w = tid >> 6, wm = w >> 1, wn = w & 1, l31 = lane & 31, hf = lane >> 5;
    const bf16_t* ap[4]; const bf16_t* bp[4]; int so[4];
#pragma unroll
    for (int i = 0; i < 4; ++i) {
        const int id = tid + 256 * i, row = id >> 3, ch = id & 7;
        const bf16_t* a = arow(row);
        ap[i] = a ? a + ch * 8 : nullptr;
        bp[i] = Bt + (size_t)row * ldb + ch * 8;
        so[i] = lofs(row, ch);
    }
#pragma unroll
    for (int mi = 0; mi < 2; ++mi)
#pragma unroll
        for (int ni = 0; ni < 2; ++ni)
#pragma unroll
            for (int i = 0; i < 16; ++i) acc[mi][ni][i] = 0.f;
    u32x4 ra[4], rb[4];
    const u32x4 z4 = {0u, 0u, 0u, 0u};
#pragma unroll
    for (int i = 0; i < 4; ++i) { ra[i] = ap[i] ? *(const u32x4*)(ap[i]) : z4; rb[i] = *(const u32x4*)(bp[i]); }
    __syncthreads();
#pragma unroll
    for (int i = 0; i < 4; ++i) { *(u32x4*)(lds + so[i]) = ra[i]; *(u32x4*)(lds + GT_B + so[i]) = rb[i]; }
    __syncthreads();
    const int nk = K >> 6;
    for (int kt = 0; kt < nk; ++kt) {
        const char* cur = lds + (kt & 1) * GT_STAGE;
        const bool more = kt + 1 < nk;
        if (more) {
            const int k0 = (kt + 1) * 64;
#pragma unroll
            for (int i = 0; i < 4; ++i) { ra[i] = ap[i] ? *(const u32x4*)(ap[i] + k0) : z4; rb[i] = *(const u32x4*)(bp[i] + k0); }
        }
#pragma unroll
        for (int ks = 0; ks < 4; ++ks) {
            const int ch = 2 * ks + hf;
            bf16x8 af[2], bfr[2];
#pragma unroll
            for (int mi = 0; mi < 2; ++mi) af[mi] = *(const bf16x8*)(cur + lofs(64 * wm + 32 * mi + l31, ch));
#pragma unroll
            for (int ni = 0; ni < 2; ++ni) bfr[ni] = *(const bf16x8*)(cur + GT_B + lofs(64 * wn + 32 * ni + l31, ch));
#pragma unroll
            for (int mi = 0; mi < 2; ++mi)
#pragma unroll
                for (int ni = 0; ni < 2; ++ni)
                    acc[mi][ni] = SWAP ? MFMA32(bfr[ni], af[mi], acc[mi][ni]) : MFMA32(af[mi], bfr[ni], acc[mi][ni]);
        }
        if (more) {
            char* nxt = lds + ((kt + 1) & 1) * GT_STAGE;
#pragma unroll
            for (int i = 0; i < 4; ++i) { *(u32x4*)(nxt + so[i]) = ra[i]; *(u32x4*)(nxt + GT_B + so[i]) = rb[i]; }
        }
        __syncthreads();
    }
}

struct DenseRows { const bf16_t* base; int ld; DI const bf16_t* operator()(int r) const { return base + (size_t)r * ld; } };

DI void epi_rows_bf16(const f32x16 (&acc)[2][2], int row0, bf16_t* __restrict__ dst, int ldo, int cb, const float* __restrict__ gain, bool do_norm) {
    const int lane = threadIdx.x & 63, w = threadIdx.x >> 6, wm = w >> 1, wn = w & 1, l31 = lane & 31, hf = lane >> 5;
#pragma unroll
    for (int mi = 0; mi < 2; ++mi) {
        const int tok = row0 + 64 * wm + 32 * mi + l31;
        float rstd = 1.f;
        if (do_norm) {
            float ss = 0.f;
#pragma unroll
            for (int ni = 0; ni < 2; ++ni)
#pragma unroll
                for (int i = 0; i < 16; ++i) ss += acc[mi][ni][i] * acc[mi][ni][i];
            ss += __shfl_xor(ss, 32);
            rstd = rsqrtf(ss * (1.f / 64.f) + EPSF);
        }
        bf16_t* drow = dst + (size_t)tok * ldo + cb + 64 * wn;
#pragma unroll
        for (int ni = 0; ni < 2; ++ni)
#pragma unroll
            for (int q4 = 0; q4 < 4; ++q4) {
                const int f = 32 * ni + 8 * q4 + 4 * hf;
                float o[4];
#pragma unroll
                for (int r = 0; r < 4; ++r) { o[r] = acc[mi][ni][4 * q4 + r] * rstd; if (do_norm) o[r] *= gain[f + r]; }
                u32x2 pk; pk[0] = pk2(o[0], o[1]); pk[1] = pk2(o[2], o[3]);
                *(u32x2*)(drow + f) = pk;
            }
    }
}
DI void epi_vt(const f32x16 (&acc)[2][2], int row0, bf16_t* __restrict__ vt, int dv, int nheads, int colbase  ) {
    const int lane = threadIdx.x & 63, w = threadIdx.x >> 6, wm = w >> 1, wn = w & 1, l31 = lane & 31, hf = lane >> 5;
    const int b = row0 >> 13, s0 = row0 & (NS - 1);
#pragma unroll
    for (int ni = 0; ni < 2; ++ni) {
        const int c = colbase + 64 * wn + 32 * ni + l31;
        const int head = c / dv, d = c % dv;
        bf16_t* vrow = vt + ((size_t)(b * nheads + head) * dv + d) * NS + s0;
#pragma unroll
        for (int mi = 0; mi < 2; ++mi)
#pragma unroll
            for (int q4 = 0; q4 < 4; ++q4) {
                u32x2 pk; pk[0] = pk2(acc[mi][ni][4 * q4], acc[mi][ni][4 * q4 + 1]); pk[1] = pk2(acc[mi][ni][4 * q4 + 2], acc[mi][ni][4 * q4 + 3]);
                *(u32x2*)(vrow + 64 * wm + 32 * mi + 8 * q4 + 4 * hf) = pk;
            }
    }
}
constexpr int INPROJ_NJ = 29, INPROJ_ITEMS = (NT / 128) * INPROJ_NJ;
DI void phase_inproj(const Params& P, char* smem) {
    const bf16_t* h = (const bf16_t*)(P.ws + OFF_H);
    const bf16_t* win = (const bf16_t*)(P.ws + OFF_WIN);
    for (int it = blockIdx.x; it < INPROJ_ITEMS; it += gridDim.x) {
        const int xcd = it & 7, loc = it >> 3;
        const int mt = (loc / INPROJ_NJ) * 8 + xcd, j = loc % INPROJ_NJ;
        const int row0 = mt * 128;
        DenseRows ar{h + (size_t)row0 * 1024, 1024};
        const bf16_t* Bt = win + (size_t)j * 128 * 1024;
        f32x16 acc[2][2];
        const int grp = j >> 2, jj = j & 3;
        if (grp == 2 || grp == 5) {
            gemm_tile<false>(smem, ar, Bt, 1024, 1024, acc);
            if (grp == 2) epi_vt(acc, row0, (bf16_t*)(P.ws + OFF_VDT), 128, 4, jj * 128);
            else epi_vt(acc, row0, (bf16_t*)(P.ws + OFF_VST), 64, 8, jj * 128);
        } else {
            gemm_tile<true>(smem, ar, Bt, 1024, 1024, acc);
            if (grp == 0) epi_rows_bf16(acc, row0, (bf16_t*)(P.ws + OFF_QD), 512, jj * 128, P.dq_g, true);
            else if (grp == 1) epi_rows_bf16(acc, row0, (bf16_t*)(P.ws + OFF_KD), 512, jj * 128, P.dk_g, true);
            else if (grp == 3) epi_rows_bf16(acc, row0, (bf16_t*)(P.ws + OFF_QS), 512, jj * 128, P.sq_g, true);
            else if (grp == 4) epi_rows_bf16(acc, row0, (bf16_t*)(P.ws + OFF_KS), 512, jj * 128, P.sk_g, true);
            else if (grp == 6) epi_rows_bf16(acc, row0, (bf16_t*)(P.ws + OFF_IQ), 512, jj * 128, P.dq_g, false);
            else {
                const int lane = threadIdx.x & 63, w = threadIdx.x >> 6, wm = w >> 1, wn = w & 1, l31 = lane & 31, hf = lane >> 5;
                if (wn == 0) {
                    bf16_t* ik = (bf16_t*)(P.ws + OFF_IK);
#pragma unroll
                    for (int mi = 0; mi < 2; ++mi) {
                        const int tok = row0 + 64 * wm + 32 * mi + l31;
                        float ss = 0.f;
#pragma unroll
                        for (int ni = 0; ni < 2; ++ni)
#pragma unroll
                            for (int i = 0; i < 16; ++i) ss += acc[mi][ni][i] * acc[mi][ni][i];
                        ss += __shfl_xor(ss, 32);
                        const float rstd = rsqrtf(ss * (1.f / 64.f) + EPSF);
#pragma unroll
                        for (int ni = 0; ni < 2; ++ni)
#pragma unroll
                            for (int q4 = 0; q4 < 4; ++q4) {
                                const int f = 32 * ni + 8 * q4 + 4 * hf;
                                float o[4];
#pragma unroll
                                for (int r = 0; r < 4; ++r) o[r] = acc[mi][ni][4 * q4 + r] * rstd * P.ik_g[f + r];
                                u32x2 pk; pk[0] = pk2(o[0], o[1]); pk[1] = pk2(o[2], o[3]);
                                *(u32x2*)(ik + (size_t)tok * 64 + f) = pk;
                            }
                    }
                } else {
                    float* iw = (float*)(P.ws + OFF_IW);
                    const float s = 0.35355339059327373f * 0.125f;
#pragma unroll
                    for (int mi = 0; mi < 2; ++mi) {
                        const int tok = row0 + 64 * wm + 32 * mi + l31;
                        f32x4 o = {acc[mi][0][0] * s, acc[mi][0][1] * s, acc[mi][0][2] * s, acc[mi][0][3] * s};
                        *(f32x4*)(iw + (size_t)tok * 8 + 4 * hf) = o;
                    }
                }
            }
        }
    }
}

constexpr int TK_CAP = 512, TK_HI = 480;
DI unsigned topk_prune(volatile LAS unsigned* buf, volatile LAS unsigned* hist, int cnt) {
    const int lane = threadIdx.x & 63;
    unsigned e[8];
#pragma unroll
    for (int i = 0; i < 8; ++i) { const int idx = lane + 64 * i; e[i] = idx < cnt ? buf[idx] : 0u; }
    unsigned prefix = 0u, want = 256u;
#pragma unroll
    for (int p = 3; p >= 0; --p) {
        const int sh = 8 * p;
#pragma unroll
        for (int j = 0; j < 4; ++j) hist[4 * lane + j] = 0u;
        asm volatile("" ::: "memory");
#pragma unroll
        for (int i = 0; i < 8; ++i) {
            const bool m = (e[i] != 0u) && (p == 3 || (e[i] >> (sh + 8)) == prefix);
            if (m) __hip_atomic_fetch_add((LAS unsigned*)&hist[(e[i] >> sh) & 255u], 1u, __ATOMIC_RELAXED, __HIP_MEMORY_SCOPE_WORKGROUP);
        }
        asm volatile("" ::: "memory");
        const unsigned h0 = hist[4 * lane], h1 = hist[4 * lane + 1], h2 = hist[4 * lane + 2], h3 = hist[4 * lane + 3];
        const unsigned s4 = h0 + h1 + h2 + h3;
        unsigned suf = s4;
#pragma unroll
        for (int d = 1; d < 64; d <<= 1) { const unsigned t = __shfl_down(suf, d); if (lane + d < 64) suf += t; }
        const unsigned above = suf - s4;
        const bool own = (above < want) && (want <= suf);
        unsigned bsel = 0u, cum = above;
        if (cum + h3 >= want) bsel = 3u;
        else { cum += h3; if (cum + h2 >= want) bsel = 2u; else { cum += h2; if (cum + h1 >= want) bsel = 1u; else { cum += h1; bsel = 0u; } } }
        const u64 om = __ballot(own);
        const int ol = om ? (int)__builtin_ctzll(om) : 0;
        const unsigned bin = (unsigned)__shfl((int)(4u * lane + bsel), ol);
        const unsigned cm = (unsigned)__shfl((int)cum, ol);
        prefix = (prefix << 8) | bin; want -= cm;
    }
    const unsigned V = prefix;
    int base = 0;
#pragma unroll
    for (int i = 0; i < 8; ++i) {
        const bool keep = (e[i] != 0u) && (e[i] >= V);
        const u64 mk = __ballot(keep);
        const int pos = base + __builtin_popcountll(mk & ((1ull << lane) - 1ull));
        if (keep) buf[pos] = e[i];
        base += __builtin_popcountll(mk);
    }
    asm volatile("" ::: "memory");
    return V;
}

DI void indexer_item(const Params& P, char* smem, int b, int q0) {
    const int lane = threadIdx.x & 63, w = threadIdx.x >> 6, l31 = lane & 31, hf = lane >> 5;
    const int qbase = q0 + 8 * w;
    const bf16_t* IQ = (const bf16_t*)(P.ws + OFF_IQ);
    const bf16_t* IK = (const bf16_t*)(P.ws + OFF_IK);
    const float* IW = (const float*)(P.ws + OFF_IW);
    volatile LAS unsigned* buf = (volatile LAS unsigned*)(LAS char*)(smem + w * 8 * 2048);
    volatile LAS unsigned* hist = (volatile LAS unsigned*)(LAS char*)(smem + 65536 + w * 1024);
    bf16x8 af[2][4];
    {
        const int m = l31, qs = 2 * ((m >> 2) & 1) + (m >> 4), head = 4 * ((m >> 3) & 1) + (m & 3);
#pragma unroll
        for (int mt = 0; mt < 2; ++mt) {
            const size_t tok = (size_t)b * NS + qbase + 4 * mt + qs;
#pragma unroll
            for (int ks = 0; ks < 4; ++ks) af[mt][ks] = *(const bf16x8*)(IQ + tok * 512 + head * 64 + ks * 16 + hf * 8);
        }
    }
    float iwv[2][2][8]; int qpos[2][2]; unsigned tau[2][2]; int cnt[2][2];
#pragma unroll
    for (int mt = 0; mt < 2; ++mt)
#pragma unroll
        for (int j = 0; j < 2; ++j) {
            qpos[mt][j] = qbase + 4 * mt + 2 * hf + j; tau[mt][j] = 0u; cnt[mt][j] = 0;
            const float* p = IW + ((size_t)b * NS + qpos[mt][j]) * 8;
            const f32x4 a = *(const f32x4*)p, c = *(const f32x4*)(p + 4);
#pragma unroll
            for (int r = 0; r < 4; ++r) { iwv[mt][j][r] = a[r]; iwv[mt][j][4 + r] = c[r]; }
        }
    const int nkt = ((qbase + 7) >> 5) + 1;
    const bf16_t* ikb = IK + (size_t)b * NS * 64 + (size_t)l31 * 64 + hf * 8;
    bf16x8 bfr[4];
#pragma unroll
    for (int ks = 0; ks < 4; ++ks) bfr[ks] = *(const bf16x8*)(ikb + ks * 16);
    for (int kt = 0; kt < nkt; ++kt) {
        const int k0 = kt * 32;
        bf16x8 bn[4];
        if (kt + 1 < nkt) {
#pragma unroll
            for (int ks = 0; ks < 4; ++ks) bn[ks] = *(const bf16x8*)(ikb + (size_t)(k0 + 32) * 64 + ks * 16);
        } else {
#pragma unroll
            for (int ks = 0; ks < 4; ++ks) bn[ks] = bfr[ks];
        }
        f32x16 acc[2];
#pragma unroll
        for (int mt = 0; mt < 2; ++mt) {
#pragma unroll
            for (int i = 0; i < 16; ++i) acc[mt][i] = 0.f;
#pragma unroll
            for (int ks = 0; ks < 4; ++ks) acc[mt] = MFMA32(af[mt][ks], bfr[ks], acc[mt]);
        }
        const int kidx = k0 + l31;
#pragma unroll
        for (int mt = 0; mt < 2; ++mt)
#pragma unroll
            for (int j = 0; j < 2; ++j) {
                float s = 0.f;
#pragma unroll
                for (int t = 0; t < 8; ++t) s += iwv[mt][j][t] * fmaxf(acc[mt][8 * j + t], 0.f);
                const unsigned u = __float_as_uint(s);
                const unsigned ord = (u >> 31) ? ~u : (u | 0x80000000u);
                const unsigned pk = (ord & 0xFFFFE000u) | (unsigned)(8191 - kidx);
                const bool pass = (kidx <= qpos[mt][j]) && (pk > tau[mt][j]);
                const u64 mk = __ballot(pass);
                const unsigned hm = hf ? (unsigned)(mk >> 32) : (unsigned)mk;
                const int pos = cnt[mt][j] + __builtin_popcount(hm & ((1u << l31) - 1u));
                if (pass) buf[(4 * mt + 2 * hf + j) * TK_CAP + pos] = pk;
                cnt[mt][j] += __builtin_popcount(hm);
            }
        const bool anyhi = cnt[0][0] > TK_HI || cnt[0][1] > TK_HI || cnt[1][0] > TK_HI || cnt[1][1] > TK_HI;
        if (__ballot(anyhi) != 0ull) {
#pragma unroll 1
            for (int s8 = 0; s8 < 8; ++s8) {
                const int mt = s8 >> 2, j = (s8 >> 1) & 1, h2 = s8 & 1;
                const int cv = mt ? (j ? cnt[1][1] : cnt[1][0]) : (j ? cnt[0][1] : cnt[0][0]);
                const int c = __builtin_amdgcn_readlane(cv, 32 * h2);
                if (c > TK_HI) {
                    const unsigned V = topk_prune(buf + (4 * mt + 2 * h2 + j) * TK_CAP, hist, c);
#pragma unroll
                    for (int a = 0; a < 2; ++a)
#pragma unroll
                        for (int d = 0; d < 2; ++d)
                            if (hf == h2 && a == mt && d == j) { tau[a][d] = V; cnt[a][d] = 256; }
                }
            }
        }
#pragma unroll
        for (int ks = 0; ks < 4; ++ks) bfr[ks] = bn[ks];
    }
#pragma unroll 1
    for (int s8 = 0; s8 < 8; ++s8) {
        const int mt = s8 >> 2, j = (s8 >> 1) & 1, h2 = s8 & 1;
        const int cv = mt ? (j ? cnt[1][1] : cnt[1][0]) : (j ? cnt[0][1] : cnt[0][0]);
        int c = __builtin_amdgcn_readlane(cv, 32 * h2);
        volatile LAS unsigned* qb = buf + (4 * mt + 2 * h2 + j) * TK_CAP;
        if (c > 256) { (void)topk_prune(qb, hist, c); c = 256; }
#pragma unroll
        for (int t = 0; t < 4; ++t) qb[256 + 4 * lane + t] = 0u;
        asm volatile("" ::: "memory");
#pragma unroll
        for (int t = 0; t < 4; ++t) {
            const int idx = lane + 64 * t;
            if (idx < c) {
                const unsigned e = qb[idx]; const unsigned kk = 8191u - (e & 8191u);
                __hip_atomic_fetch_or((LAS unsigned*)&qb[256 + (kk >> 5)], 1u << (kk & 31u), __ATOMIC_RELAXED, __HIP_MEMORY_SCOPE_WORKGROUP);
            }
        }
        asm volatile("" ::: "memory");
    }
    u64* mask = (u64*)(P.ws + OFF_MASK);
    const int ktmax = (q0 | 127) >> 6;
    const int qi = lane & 7;
#pragma unroll 1
    for (int it = 0; it < 16; ++it) {
        const int kt = it * 8 + (lane >> 3);
        if (kt <= ktmax) {
            const unsigned lo = buf[qi * TK_CAP + 256 + 2 * kt], hi = buf[qi * TK_CAP + 256 + 2 * kt + 1];
            mask[((size_t)(b * 128 + kt)) * NS + qbase + qi] = ((u64)hi << 32) | lo;
        }
    }
}

constexpr int AT_K = 64 * LROW;
template <int NDB, bool BM>
DI void attn_tile(const char* Kt, const char* Vt, const bf16x8 (&qf)[4], f32x16 (&o)[NDB], float& mrun, float& lrun,
                  int qpos, int k0, float c1, float c2, bool diag, u64 mword) {
    const int lane = threadIdx.x & 63, l31 = lane & 31, hf = lane >> 5;
    const char* kbase = Kt + l31 * LROW + hf * 16;
    const char* vbase = Vt + l31 * LROW + hf * 8;
    const float bias0 = -c2 * (float)(qpos - k0 - 4 * hf);
#pragma unroll 1
    for (int kbi = 0; kbi < 2; ++kbi) {
        const int kb = 1 - kbi;
        f32x16 st;
#pragma unroll
        for (int i = 0; i < 16; ++i) st[i] = 0.f;
#pragma unroll
        for (int ks = 0; ks < 4; ++ks) {
            const bf16x8 kf = *(const bf16x8*)(kbase + kb * 32 * LROW + ks * 32);
            st = MFMA32(kf, qf[ks], st);
        }
        const unsigned mw = BM ? (unsigned)((kb ? (unsigned)(mword >> 32) : (unsigned)mword) >> (4 * hf)) : 0u;
        float mx = -INFINITY;
#pragma unroll
        for (int i = 0; i < 16; ++i) {
            const int ko = 32 * kb + (i & 3) + 8 * (i >> 2);
            float v = st[i] * c1 + (bias0 + c2 * (float)ko);
            bool ok = true;
            if (BM) ok = (mw >> ((i & 3) + 8 * (i >> 2))) & 1u;
            if (diag) ok = ok && (k0 + ko + 4 * hf <= qpos);
            v = ok ? v : -INFINITY;
            st[i] = v; mx = fmaxf(mx, v);
        }
        mx = fmaxf(mx, __shfl_xor(mx, 32));
        const float mnew = fmaxf(mrun, mx);
        const float msafe = (mnew == -INFINITY) ? 0.f : mnew;
        const float alpha = __builtin_amdgcn_exp2f(mrun - msafe);
        float ls = 0.f;
#pragma unroll
        for (int i = 0; i < 16; ++i) { const float p = __builtin_amdgcn_exp2f(st[i] - msafe); st[i] = p; ls += p; }
        lrun = lrun * alpha + ls; mrun = mnew;
        if (__ballot(alpha != 1.f) != 0ull) {
#pragma unroll
            for (int db = 0; db < NDB; ++db)
#pragma unroll
                for (int i = 0; i < 16; ++i) o[db][i] *= alpha;
        }
#pragma unroll
        for (int s = 0; s < 2; ++s) {
            u32x4 pp;
#pragma unroll
            for (int t = 0; t < 4; ++t) pp[t] = pk2(st[8 * s + 2 * t], st[8 * s + 2 * t + 1]);
            const bf16x8 pf = __builtin_bit_cast(bf16x8, pp);
#pragma unroll
            for (int db = 0; db < NDB; ++db) {
                const s16x4 lo = *(const s16x4*)(vbase + db * 32 * LROW + (4 * kb + 2 * s) * 16);
                const s16x4 hi = *(const s16x4*)(vbase + db * 32 * LROW + (4 * kb + 2 * s) * 16 + 16);
                const bf16x8 vf = __builtin_shufflevector(lo, hi, 0, 1, 2, 3, 4, 5, 6, 7);
                o[db] = MFMA32(vf, pf, o[db]);
            }
        }
    }
}

DI void diffattn_item(const Params& P, char* smem, int b, int h, int qb) {
    const int tid = threadIdx.x, lane = tid & 63, w = tid >> 6, l31 = lane & 31, hf = lane >> 5;
    const int map = w & 1, qsub = w >> 1;
    const int q0 = qb * 64;
    const bf16_t* Qd = (const bf16_t*)(P.ws + OFF_QD);
    const bf16_t* Kd = (const bf16_t*)(P.ws + OFF_KD);
    const bf16_t* VdT = (const bf16_t*)(P.ws + OFF_VDT);
    const int qpos = q0 + 32 * qsub + l31;
    bf16x8 qf[4];
#pragma unroll
    for (int ks = 0; ks < 4; ++ks) qf[ks] = *(const bf16x8*)(Qd + ((size_t)b * NS + qpos) * 512 + h * 128 + map * 64 + ks * 16 + hf * 8);
    const float slope = exp2f(-2.f * (float)(h + 1));
    const float c1 = 0.125f * LOG2E, c2 = slope * LOG2E;
    f32x16 o[4];
#pragma unroll
    for (int db = 0; db < 4; ++db)
#pragma unroll
        for (int i = 0; i < 16; ++i) o[db][i] = 0.f;
    float mrun = -INFINITY, lrun = 0.f;
    const int lrow = tid >> 3, lch = tid & 7;
    const bf16_t* kp = Kd + ((size_t)b * NS + lrow) * 512 + h * 128 + lch * 8;
    const bf16_t* vp = VdT + ((size_t)(b * 4 + h) * 128 + lrow) * NS + lch * 8;
    const int so = lofs(lrow, lch);
    const int ktd = qb;
    u32x4 rk1[2], rk2[2], rv[4];
    {
        const int k0 = ktd * 64;
#pragma unroll
        for (int i = 0; i < 2; ++i) { rk1[i] = *(const u32x4*)(kp + (size_t)(k0 + 32 * i) * 512); rk2[i] = *(const u32x4*)(kp + (size_t)(k0 + 32 * i) * 512 + 64); }
#pragma unroll
        for (int i = 0; i < 4; ++i) rv[i] = *(const u32x4*)(vp + (size_t)(32 * i) * NS + k0);
    }
    __syncthreads();
#pragma unroll
    for (int i = 0; i < 2; ++i) { *(u32x4*)(smem + so + i * 32 * LROW) = rk1[i]; *(u32x4*)(smem + AT_K + so + i * 32 * LROW) = rk2[i]; }
#pragma unroll
    for (int i = 0; i < 4; ++i) *(u32x4*)(smem + 2 * AT_K + so + i * 32 * LROW) = rv[i];
    __syncthreads();
    int st = 0;
    for (int kt = ktd; kt >= 0; --kt) {
        const char* cur = smem + st * GT_STAGE;
        if (kt > 0) {
            const int k0 = (kt - 1) * 64;
#pragma unroll
            for (int i = 0; i < 2; ++i) { rk1[i] = *(const u32x4*)(kp + (size_t)(k0 + 32 * i) * 512); rk2[i] = *(const u32x4*)(kp + (size_t)(k0 + 32 * i) * 512 + 64); }
#pragma unroll
            for (int i = 0; i < 4; ++i) rv[i] = *(const u32x4*)(vp + (size_t)(32 * i) * NS + k0);
        }
        attn_tile<4, false>(cur + map * AT_K, cur + 2 * AT_K, qf, o, mrun, lrun, qpos, kt * 64, c1, c2, kt == ktd, 0ull);
        if (kt > 0) {
            char* nxt = smem + (st ^ 1) * GT_STAGE;
#pragma unroll
            for (int i = 0; i < 2; ++i) { *(u32x4*)(nxt + so + i * 32 * LROW) = rk1[i]; *(u32x4*)(nxt + AT_K + so + i * 32 * LROW) = rk2[i]; }
#pragma unroll
            for (int i = 0; i < 4; ++i) *(u32x4*)(nxt + 2 * AT_K + so + i * 32 * LROW) = rv[i];
        }
        __syncthreads();
        st ^= 1;
    }
    const float ltot = lrun + __shfl_xor(lrun, 32);
    const float inv = 1.f / ltot;
    float la, lb;
    { const float a = P.lq1[lane] * P.lk1[lane], c = P.lq2[lane] * P.lk2[lane]; la = wave_sum(a); lb = wave_sum(c); }
    const float lam = __expf(la) - __expf(lb) + 0.2f;
    float* X = (float*)smem;
    if (map == 1) {
#pragma unroll
        for (int db = 0; db < 4; ++db)
#pragma unroll
            for (int q4 = 0; q4 < 4; ++q4) {
                f32x4 v;
#pragma unroll
                for (int r = 0; r < 4; ++r) v[r] = o[db][4 * q4 + r] * inv * lam;
                *(f32x4*)(X + (qsub * 32 + l31) * 132 + 32 * db + 8 * q4 + 4 * hf) = v;
            }
    }
    __syncthreads();
    if (map == 0) {
        float ss = 0.f;
#pragma unroll
        for (int db = 0; db < 4; ++db)
#pragma unroll
            for (int q4 = 0; q4 < 4; ++q4) {
                const f32x4 v2 = *(const f32x4*)(X + (qsub * 32 + l31) * 132 + 32 * db + 8 * q4 + 4 * hf);
#pragma unroll
                for (int r = 0; r < 4; ++r) { const float v = o[db][4 * q4 + r] * inv - v2[r]; o[db][4 * q4 + r] = v; ss += v * v; }
            }
        ss += __shfl_xor(ss, 32);
        const float rstd = rsqrtf(ss * (1.f / 128.f) + EPSF) * 0.8f;
        bf16_t* ao = (bf16_t*)(P.ws + OFF_H) + ((size_t)b * NS + qpos) * 1024 + h * 128;
#pragma unroll
        for (int db = 0; db < 4; ++db)
#pragma unroll
            for (int q4 = 0; q4 < 4; ++q4) {
                const int d = 32 * db + 8 * q4 + 4 * hf;
                const f32x4 g = *(const f32x4*)(P.subln_g + d);
                u32x2 pk; pk[0] = pk2(o[db][4 * q4] * rstd * g[0], o[db][4 * q4 + 1] * rstd * g[1]); pk[1] = pk2(o[db][4 * q4 + 2] * rstd * g[2], o[db][4 * q4 + 3] * rstd * g[3]);
                *(u32x2*)(ao + d) = pk;
            }
    }
    __syncthreads();
}

DI void dsa_item(const Params& P, char* smem, int b, int h, int qb) {
    const int tid = threadIdx.x, lane = tid & 63, w = tid >> 6, l31 = lane & 31, hf = lane >> 5;
    const int q0 = qb * 128;
    const bf16_t* Qs = (const bf16_t*)(P.ws + OFF_QS);
    const bf16_t* Ks = (const bf16_t*)(P.ws + OFF_KS);
    const bf16_t* VsT = (const bf16_t*)(P.ws + OFF_VST);
    const u64* mask = (const u64*)(P.ws + OFF_MASK);
    const int qpos = q0 + 32 * w + l31;
    bf16x8 qf[4];
#pragma unroll
    for (int ks = 0; ks < 4; ++ks) qf[ks] = *(const bf16x8*)(Qs + ((size_t)b * NS + qpos) * 512 + h * 64 + ks * 16 + hf * 8);
    const float slope = exp2f(-(float)(h + 1));
    const float c1 = 0.125f * LOG2E, c2 = slope * LOG2E;
    f32x16 o[2];
#pragma unroll
    for (int db = 0; db < 2; ++db)
#pragma unroll
        for (int i = 0; i < 16; ++i) o[db][i] = 0.f;
    float mrun = -INFINITY, lrun = 0.f;
    const int lrow = tid >> 3, lch = tid & 7;
    const bf16_t* kp = Ks + ((size_t)b * NS + lrow) * 512 + h * 64 + lch * 8;
    const bf16_t* vp = VsT + ((size_t)(b * 8 + h) * 64 + lrow) * NS + lch * 8;
    const int so = lofs(lrow, lch);
    const int ktd = 2 * qb + 1;
    u32x4 rk[2], rv[2];
    {
        const int k0 = ktd * 64;
#pragma unroll
        for (int i = 0; i < 2; ++i) { rk[i] = *(const u32x4*)(kp + (size_t)(k0 + 32 * i) * 512); rv[i] = *(const u32x4*)(vp + (size_t)(32 * i) * NS + k0); }
    }
    __syncthreads();
#pragma unroll
    for (int i = 0; i < 2; ++i) { *(u32x4*)(smem + so + i * 32 * LROW) = rk[i]; *(u32x4*)(smem + AT_K + so + i * 32 * LROW) = rv[i]; }
    __syncthreads();
    int st = 0;
    const int qwmax = q0 + 32 * w + 31, qwmin = q0 + 32 * w;
    for (int kt = ktd; kt >= 0; --kt) {
        const char* cur = smem + st * 2 * AT_K;
        const int k0 = kt * 64;
        u64 mword = 0ull;
        if (k0 <= qwmax) mword = mask[((size_t)(b * 128 + kt)) * NS + qpos];
        if (kt > 0) {
            const int kn = (kt - 1) * 64;
#pragma unroll
            for (int i = 0; i < 2; ++i) { rk[i] = *(const u32x4*)(kp + (size_t)(kn + 32 * i) * 512); rv[i] = *(const u32x4*)(vp + (size_t)(32 * i) * NS + kn); }
        }
        if (k0 <= qwmax && __ballot(mword != 0ull) != 0ull)
            attn_tile<2, true>(cur, cur + AT_K, qf, o, mrun, lrun, qpos, k0, c1, c2, k0 + 63 > qwmin, mword);
        if (kt > 0) {
            char* nxt = smem + (st ^ 1) * 2 * AT_K;
#pragma unroll
            for (int i = 0; i < 2; ++i) { *(u32x4*)(nxt + so + i * 32 * LROW) = rk[i]; *(u32x4*)(nxt + AT_K + so + i * 32 * LROW) = rv[i]; }
        }
        __syncthreads();
        st ^= 1;
    }
    const float ltot = lrun + __shfl_xor(lrun, 32);
    const float inv = 1.f / ltot;
    bf16_t* ao = (bf16_t*)(P.ws + OFF_H) + ((size_t)b * NS + qpos) * 1024 + 512 + h * 64;
#pragma unroll
    for (int db = 0; db < 2; ++db)
#pragma unroll
        for (int q4 = 0; q4 < 4; ++q4) {
            const int d = 32 * db + 8 * q4 + 4 * hf;
            u32x2 pk; pk[0] = pk2(o[db][4 * q4] * inv, o[db][4 * q4 + 1] * inv); pk[1] = pk2(o[db][4 * q4 + 2] * inv, o[db][4 * q4 + 3] * inv);
            *(u32x2*)(ao + d) = pk;
        }
}

constexpr int P3_ITEMS = 256 * 8;
DI void phase_indexer(const Params& P, char* smem) {
    for (int it = blockIdx.x; it < P3_ITEMS; it += gridDim.x) {
        const int g = 255 - (it >> 3), b = it & 7;
        __syncthreads();
        indexer_item(P, smem, b, g * 32);
    }
    __syncthreads();
}
constexpr int P4A_ITEMS = 128 * 32, P4B_ITEMS = 64 * 64;
DI void phase_attn(const Params& P, char* smem) {
    for (int it = blockIdx.x; it < P4A_ITEMS; it += gridDim.x) {
        const int qb = 127 - (it >> 5), s = it & 31;
        diffattn_item(P, smem, s >> 2, s & 3, qb);
    }
    for (int it = blockIdx.x; it < P4B_ITEMS; it += gridDim.x) {
        const int qb = 63 - (it >> 6), s = it & 63;
        dsa_item(P, smem, s >> 3, s & 7, qb);
    }
}

constexpr int OUTPROJ_ITEMS = (NT / 128) * 8;
DI void phase_outproj(const Params& P, char* smem) {
    const bf16_t* ao = (const bf16_t*)(P.ws + OFF_H);
    const bf16_t* wout = (const bf16_t*)(P.ws + OFF_WOUT);
    const float* mod = (const float*)(P.ws + OFF_MOD);
    const int lane = threadIdx.x & 63, w = threadIdx.x >> 6, wm = w >> 1, wn = w & 1, l31 = lane & 31, hf = lane >> 5;
    for (int it = blockIdx.x; it < OUTPROJ_ITEMS; it += gridDim.x) {
        const int xcd = it & 7, loc = it >> 3;
        const int mt = (loc >> 3) * 8 + xcd, j = loc & 7;
        const int row0 = mt * 128, b = row0 >> 13;
        DenseRows ar{ao + (size_t)row0 * 1024, 1024};
        f32x16 acc[2][2];
        gemm_tile<true>(smem, ar, wout + (size_t)j * 128 * 1024, 1024, 1024, acc);
        const float* g1 = mod + b * 6144 + 2048;
#pragma unroll
        for (int mi = 0; mi < 2; ++mi) {
            const size_t tok = (size_t)row0 + 64 * wm + 32 * mi + l31;
#pragma unroll
            for (int ni = 0; ni < 2; ++ni)
#pragma unroll
                for (int q4 = 0; q4 < 4; ++q4) {
                    const int n = 128 * j + 64 * wn + 32 * ni + 8 * q4 + 4 * hf;
                    const f32x4 xv = *(const f32x4*)(P.x + tok * 1024 + n);
                    const f32x4 gv = *(const f32x4*)(g1 + n);
                    f32x4 ov;
#pragma unroll
                    for (int r = 0; r < 4; ++r) ov[r] = xv[r] + gv[r] * acc[mi][ni][4 * q4 + r];
                    *(f32x4*)(P.out + tok * 1024 + n) = ov;
                }
        }
    }
}

constexpr int ROUTER_ITEMS = (NT / 128) * 2;
DI void phase_router(const Params& P, char* smem) {
    const bf16_t* h2 = (const bf16_t*)(P.ws + OFF_H2);
    const bf16_t* wrt = (const bf16_t*)(P.ws + OFF_WRT);
    float* logits = (float*)(P.ws + OFF_Y);
    const int lane = threadIdx.x & 63, w = threadIdx.x >> 6, wm = w >> 1, wn = w & 1, l31 = lane & 31, hf = lane >> 5;
    for (int it = blockIdx.x; it < ROUTER_ITEMS; it += gridDim.x) {
        const int mt = it >> 1, j = it & 1;
        const int row0 = mt * 128;
        DenseRows ar{h2 + (size_t)row0 * 1024, 1024};
        f32x16 acc[2][2];
        gemm_tile<true>(smem, ar, wrt + (size_t)j * 128 * 1024, 1024, 1024, acc);
#pragma unroll
        for (int mi = 0; mi < 2; ++mi) {
            const size_t tok = (size_t)row0 + 64 * wm + 32 * mi + l31;
#pragma unroll
            for (int ni = 0; ni < 2; ++ni)
#pragma unroll
                for (int q4 = 0; q4 < 4; ++q4) {
                    const int n = 128 * j + 64 * wn + 32 * ni + 8 * q4 + 4 * hf;
                    f32x4 ov = {acc[mi][ni][4 * q4], acc[mi][ni][4 * q4 + 1], acc[mi][ni][4 * q4 + 2], acc[mi][ni][4 * q4 + 3]};
                    *(f32x4*)(logits + tok * 256 + n) = ov;
                }
        }
    }
}

DI void phase_route(const Params& P) {
    const float* logits = (const float*)(P.ws + OFF_Y);
    int* cnt = (int*)(P.ws + OFF_CNT);
    int* list = (int*)(P.ws + OFF_LIST);
    int* eidx = (int*)(P.ws + OFF_EIDX);
    float* gates = (float*)(P.ws + OFF_GATE);
    const int lane = threadIdx.x & 63, w = threadIdx.x >> 6;
    const f32x4 bias = *(const f32x4*)(P.router_b + 4 * lane);
    for (int t = blockIdx.x * 4 + w; t < NT; t += gridDim.x * 4) {
        const f32x4 lg = *(const f32x4*)(logits + (size_t)t * 256 + 4 * lane);
        float sc[4], cand[4];
#pragma unroll
        for (int i = 0; i < 4; ++i) { sc[i] = 1.f / (1.f + __expf(-lg[i])); cand[i] = sc[i] + bias[i]; }
        float t1 = fmaxf(cand[0], cand[1]), t2 = fminf(cand[0], cand[1]);
#pragma unroll
        for (int i = 2; i < 4; ++i) { const float v = cand[i]; t2 = fmaxf(t2, fminf(t1, v)); t1 = fmaxf(t1, v); }
#pragma unroll
        for (int d = 1; d < 8; d <<= 1) {
            const float o1 = __shfl_xor(t1, d), o2 = __shfl_xor(t2, d);
            const float n1 = fmaxf(t1, o1), n2 = fmaxf(fminf(t1, o1), fmaxf(t2, o2));
            t1 = n1; t2 = n2;
        }
        const float gs = t1 + t2;
        const int myg = lane >> 3;
        int rank = 0;
#pragma unroll
        for (int g = 0; g < 8; ++g) { const float sg = __shfl(gs, 8 * g); rank += (sg > gs || (sg == gs && g < myg)) ? 1 : 0; }
        if (rank >= 4) {
#pragma unroll
            for (int i = 0; i < 4; ++i) cand[i] = -INFINITY;
        }
        int sel[8]; float wv[8]; float wsum = 0.f;
#pragma unroll
        for (int k = 0; k < 8; ++k) {
            float bv = cand[0]; int bi = 0;
#pragma unroll
            for (int i = 1; i < 4; ++i) if (cand[i] > bv) { bv = cand[i]; bi = i; }
            int be = 4 * lane + bi;
#pragma unroll
            for (int d = 32; d >= 1; d >>= 1) {
                const float ov = __shfl_xor(bv, d); const int oe = __shfl_xor(be, d);
                if (ov > bv || (ov == bv && oe < be)) { bv = ov; be = oe; }
            }
            const int ol = be >> 2, oi = be & 3;
            float mys = (oi == 0) ? sc[0] : (oi == 1) ? sc[1] : (oi == 2) ? sc[2] : sc[3];
            const float ws_ = __shfl(mys, ol);
            if (lane == ol) {
#pragma unroll
                for (int i = 0; i < 4; ++i) if (i == oi) cand[i] = -INFINITY;
            }
            sel[k] = be; wv[k] = ws_; wsum += ws_;
        }
        const float rs = 2.5f / wsum;
        int my_e = 256; float my_g = 1.f;
#pragma unroll
        for (int k = 0; k < 8; ++k) if (lane == k) { my_e = sel[k]; my_g = wv[k] * rs; }
        const int c = t >> 14, tl = t & (CHUNK_T - 1);
        if (lane < 8) {
            eidx[(size_t)t * 8 + lane] = my_e; gates[(size_t)t * 8 + lane] = my_g;
            const int pos = atomicAdd(&cnt[c * NEXP1 + my_e], 1);
            list[((size_t)c * NEXP1 + my_e) * CHUNK_T + pos] = tl * NPAIR + lane;
        } else if (lane == 8) {
            list[((size_t)c * NEXP1 + 256) * CHUNK_T + tl] = tl * NPAIR + 8;
        }
    }
}

DI int moe_build_tiles(const Params& P, char* smem, int c) {
    int* tstart = (int*)(smem + SM_EXTRA);
    int* wsum = (int*)(smem + SM_EXTRA + 1536);
    const int* cnt = (const int*)(P.ws + OFF_CNT) + c * NEXP1;
    const int e = threadIdx.x, lane = e & 63, w = e >> 6;
    __syncthreads();
    const int n = (cnt[e] + 127) >> 7;
    int inc = n;
#pragma unroll
    for (int d = 1; d < 64; d <<= 1) { const int t = __shfl_up(inc, d); if (lane >= d) inc += t; }
    if (lane == 63) wsum[w] = inc;
    __syncthreads();
    int off = 0;
#pragma unroll
    for (int i = 0; i < 4; ++i) if (i < w) off += wsum[i];
    tstart[e] = off + inc - n;
    if (e == 255) { tstart[256] = off + inc; tstart[257] = off + inc + CHUNK_T / 128; }
    __syncthreads();
    return tstart[NEXP1];
}
DI int moe_find_expert(const int* tstart, int tile) {
    int lo = 0, hi = NEXP1;
    while (hi - lo > 1) { const int mid = (lo + hi) >> 1; if (tstart[mid] <= tile) lo = mid; else hi = mid; }
    return lo;
}
struct GatherRows {
    const bf16_t* base; int ld; const int* pid; int div;
    DI const bf16_t* operator()(int r) const { const int p = pid[r]; return p < 0 ? nullptr : base + (size_t)(p / div) * ld; }
};
DI void phase_moe_g1(const Params& P, char* smem, int c) {
    const int total = moe_build_tiles(P, smem, c);
    const int* tstart = (const int*)(smem + SM_EXTRA);
    int* pid = (int*)(smem + SM_EXTRA + 2048);
    const int* cnt = (const int*)(P.ws + OFF_CNT) + c * NEXP1;
    const int* list = (const int*)(P.ws + OFF_LIST) + (size_t)c * NEXP1 * CHUNK_T;
    const bf16_t* h2 = (const bf16_t*)(P.ws + OFF_H2) + (size_t)c * CHUNK_T * 1024;
    const bf16_t* wgu = (const bf16_t*)(P.ws + OFF_WGU);
    bf16_t* act = (bf16_t*)(P.ws + OFF_ACT + (size_t)(c & 1) * ACT_BYTES);
    const int lane = threadIdx.x & 63, w = threadIdx.x >> 6, wm = w >> 1, wn = w & 1, l31 = lane & 31, hf = lane >> 5;
    for (int it = blockIdx.x; it < total * 4; it += gridDim.x) {
        const int tile = it >> 2, j = it & 3;
        const int e = moe_find_expert(tstart, tile), ti = tile - tstart[e];
        const int n = e < NEXP ? cnt[e] : CHUNK_T;
        __syncthreads();
        if (threadIdx.x < 128) { const int li = ti * 128 + threadIdx.x; pid[threadIdx.x] = li < n ? list[(size_t)e * CHUNK_T + li] : -1; }
        __syncthreads();
        GatherRows ar{h2, 1024, pid, NPAIR};
        f32x16 acc[2][2];
        gemm_tile<true>(smem, ar, wgu + ((size_t)e * 512 + j * 128) * 1024, 1024, 1024, acc);
#pragma unroll
        for (int mi = 0; mi < 2; ++mi) {
            const int p = pid[64 * wm + 32 * mi + l31];
            if (p >= 0) {
                bf16_t* arow_ = act + (size_t)p * 256 + 64 * j + 32 * wn;
#pragma unroll
                for (int q4 = 0; q4 < 4; ++q4) {
                    float o[4];
#pragma unroll
                    for (int r = 0; r < 4; ++r) { const float g = acc[mi][0][4 * q4 + r], u = acc[mi][1][4 * q4 + r]; o[r] = silu_f(g) * u; }
                    u32x2 pk; pk[0] = pk2(o[0], o[1]); pk[1] = pk2(o[2], o[3]);
                    *(u32x2*)(arow_ + 8 * q4 + 4 * hf) = pk;
                }
            }
        }
    }
}
DI void phase_moe_g2(const Params& P, char* smem, int c) {
    const int total = moe_build_tiles(P, smem, c);
    const int* tstart = (const int*)(smem + SM_EXTRA);
    int* pid = (int*)(smem + SM_EXTRA + 2048);
    const int* cnt = (const int*)(P.ws + OFF_CNT) + c * NEXP1;
    const int* list = (const int*)(P.ws + OFF_LIST) + (size_t)c * NEXP1 * CHUNK_T;
    const float* gates = (const float*)(P.ws + OFF_GATE) + (size_t)c * CHUNK_T * 8;
    const bf16_t* wd = (const bf16_t*)(P.ws + OFF_WD);
    const bf16_t* act = (const bf16_t*)(P.ws + OFF_ACT + (size_t)(c & 1) * ACT_BYTES);
    bf16_t* y = (bf16_t*)(P.ws + OFF_Y);
    const int lane = threadIdx.x & 63, w = threadIdx.x >> 6, wm = w >> 1, wn = w & 1, l31 = lane & 31, hf = lane >> 5;
    for (int it = blockIdx.x; it < total * 8; it += gridDim.x) {
        const int tile = it >> 3, j = it & 7;
        const int e = moe_find_expert(tstart, tile), ti = tile - tstart[e];
        const int n = e < NEXP ? cnt[e] : CHUNK_T;
        __syncthreads();
        if (threadIdx.x < 128) { const int li = ti * 128 + threadIdx.x; pid[threadIdx.x] = li < n ? list[(size_t)e * CHUNK_T + li] : -1; }
        __syncthreads();
        GatherRows ar{act, 256, pid, 1};
        f32x16 acc[2][2];
        gemm_tile<true>(smem, ar, wd + ((size_t)e * 1024 + j * 128) * 256, 256, 256, acc);
#pragma unroll
        for (int mi = 0; mi < 2; ++mi) {
            const int p = pid[64 * wm + 32 * mi + l31];
            if (p >= 0) {
                const int k = p % NPAIR, tl = p / NPAIR;
                const float g = k < 8 ? gates[(size_t)tl * 8 + k] : 1.f;
                bf16_t* yrow = y + (size_t)p * 1024 + 128 * j + 64 * wn;
#pragma unroll
                for (int ni = 0; ni < 2; ++ni)
#pragma unroll
                    for (int q4 = 0; q4 < 4; ++q4) {
                        u32x2 pk; pk[0] = pk2(acc[mi][ni][4 * q4] * g, acc[mi][ni][4 * q4 + 1] * g); pk[1] = pk2(acc[mi][ni][4 * q4 + 2] * g, acc[mi][ni][4 * q4 + 3] * g);
                        *(u32x2*)(yrow + 32 * ni + 8 * q4 + 4 * hf) = pk;
                    }
            }
        }
    }
}
DI void phase_moe_combine(const Params& P, int c) {
    const bf16_t* y = (const bf16_t*)(P.ws + OFF_Y);
    const float* mod = (const float*)(P.ws + OFF_MOD);
    const int lane = threadIdx.x & 63, w = threadIdx.x >> 6;
    for (int tl = blockIdx.x * 4 + w; tl < CHUNK_T; tl += gridDim.x * 4) {
        const size_t t = (size_t)c * CHUNK_T + tl;
        const int b = (int)(t >> 13);
        const float* g2 = mod + b * 6144 + 5120;
#pragma unroll
        for (int i = 0; i < 4; ++i) {
            const int col = 256 * i + 4 * lane;
            float s[4] = {0.f, 0.f, 0.f, 0.f};
#pragma unroll
            for (int k = 0; k < NPAIR; ++k) {
                const u32x2 v = *(const u32x2*)(y + ((size_t)tl * NPAIR + k) * 1024 + col);
                s[0] += bflo(v[0]); s[1] += bfhi(v[0]); s[2] += bflo(v[1]); s[3] += bfhi(v[1]);
            }
            const f32x4 xv = *(const f32x4*)(P.out + t * 1024 + col);
            const f32x4 gv = *(const f32x4*)(g2 + col);
            f32x4 ov;
#pragma unroll
            for (int r = 0; r < 4; ++r) ov[r] = xv[r] + gv[r] * s[r];
            *(f32x4*)(P.out + t * 1024 + col) = ov;
        }
    }
}

constexpr int NPHASE = 18;
template <int PH> DI void run_phase(const Params& P, char* smem) {
    float* mod = (float*)(P.ws + OFF_MOD);
    if constexpr (PH == 0) phase_adaln(P, smem);
    else if constexpr (PH == 1) { phase_norm(P.x, P.norm1_g, mod, 0, 1024, (bf16_t*)(P.ws + OFF_H)); phase_convert(P, smem); }
    else if constexpr (PH == 2) phase_inproj(P, smem);
    else if constexpr (PH == 3) phase_indexer(P, smem);
    else if constexpr (PH == 4) phase_attn(P, smem);
    else if constexpr (PH == 5) phase_outproj(P, smem);
    else if constexpr (PH == 6) phase_norm(P.out, P.norm2_g, mod, 3072, 4096, (bf16_t*)(P.ws + OFF_H2));
    else if constexpr (PH == 7) phase_router(P, smem);
    else if constexpr (PH == 8) phase_route(P);
    else if constexpr (PH == 9) phase_moe_g1(P, smem, 0);
    else if constexpr (PH == 10) phase_moe_g2(P, smem, 0);
    else if constexpr (PH == 11) { phase_moe_g1(P, smem, 1); phase_moe_combine(P, 0); }
    else if constexpr (PH == 12) phase_moe_g2(P, smem, 1);
    else if constexpr (PH == 13) { phase_moe_g1(P, smem, 2); phase_moe_combine(P, 1); }
    else if constexpr (PH == 14) phase_moe_g2(P, smem, 2);
    else if constexpr (PH == 15) { phase_moe_g1(P, smem, 3); phase_moe_combine(P, 2); }
    else if constexpr (PH == 16) phase_moe_g2(P, smem, 3);
    else if constexpr (PH == 17) phase_moe_combine(P, 3);
}
#define MK_RUN(PH) if constexpr (P0 <= PH && PH < P1) { run_phase<PH>(P, smem); if constexpr (PH + 1 < P1) xcd_barrier(bar); }
template <int P0, int P1>
__global__ void __launch_bounds__(256, 2) mk_kernel(Params P) {
    __shared__ __attribute__((aligned(16))) char smem[SMEM_BYTES];
    __shared__ uint4 xb_words;
    if (threadIdx.x == 0) xb_words = make_uint4(0u, 0u, 0u, 0u);
    __syncthreads();
    XcdBarrier bar;
    if constexpr (P1 - P0 > 1) bar = xcd_barrier_post((unsigned*)(P.ws + OFF_BAR), (volatile LAS unsigned*)&xb_words);
    MK_RUN(0) MK_RUN(1) MK_RUN(2) MK_RUN(3) MK_RUN(4) MK_RUN(5) MK_RUN(6) MK_RUN(7) MK_RUN(8)
    MK_RUN(9) MK_RUN(10) MK_RUN(11) MK_RUN(12) MK_RUN(13) MK_RUN(14) MK_RUN(15) MK_RUN(16) MK_RUN(17)
}

template <int P0, int P1> static void launch_range(const Params& p, hipStream_t stream) {
    static int grid = 0;
    if (!grid) {
        int dev = 0, cus = 0, per_cu = 0;
        (void)hipGetDevice(&dev);
        (void)hipDeviceGetAttribute(&cus, hipDeviceAttributeMultiprocessorCount, dev);
        (void)hipOccupancyMaxActiveBlocksPerMultiprocessor(&per_cu, mk_kernel<P0, P1>, 256, 0);
        if (cus <= 0) cus = 256;
        if (per_cu < 1) per_cu = 1;
        grid = cus * (per_cu < 2 ? per_cu : 2);
    }
    mk_kernel<P0, P1><<<dim3(grid), dim3(256), 0, stream>>>(p);
}

extern "C" void kernel_launch(void* const* d_in, const int* in_sizes, int n_in, void* d_out, int out_size, void* d_ws, size_t ws_size, hipStream_t stream) {
    if (ws_size < WS_NEED) return;
    Params p{};
    const float** f = (const float**)&p;
    for (int i = 0; i < 26; ++i) f[i] = (const float*)d_in[i];
    p.out = (float*)d_out;
    p.ws = (char*)d_ws;
    (void)hipMemsetAsync(d_ws, 0, ZERO_BYTES, stream);
#if MK_ONE_LAUNCH
    launch_range<0, NPHASE>(p, stream);
#else
    launch_range<0, 1>(p, stream); launch_range<1, 2>(p, stream); launch_range<2, 3>(p, stream); launch_range<3, 4>(p, stream);
    launch_range<4, 5>(p, stream); launch_range<5, 6>(p, stream); launch_range<6, 7>(p, stream); launch_range<7, 8>(p, stream);
    launch_range<8, 9>(p, stream); launch_range<9, 10>(p, stream); launch_range<10, 11>(p, stream); launch_range<11, 12>(p, stream);
    launch_range<12, 13>(p, stream); launch_range<13, 14>(p, stream); launch_range<14, 15>(p, stream); launch_range<15, 16>(p, stream);
    launch_range<16, 17>(p, stream); launch_range<17, 18>(p, stream);
#endif
}
```

```cpp
#include <hip/hip_runtime.h>
#include <stdint.h>

#define DI __device__ __forceinline__
#define LAS __attribute__((address_space(3)))
typedef unsigned short bf16_t;
typedef short bf16x8 __attribute__((ext_vector_type(8)));
typedef short s16x4 __attribute__((ext_vector_type(4)));
typedef float f32x16 __attribute__((ext_vector_type(16)));
typedef float f32x4 __attribute__((ext_vector_type(4)));
typedef float f32x2 __attribute__((ext_vector_type(2)));
typedef __bf16 bf16v2 __attribute__((ext_vector_type(2)));
typedef unsigned u32x4 __attribute__((ext_vector_type(4)));
typedef unsigned u32x2 __attribute__((ext_vector_type(2)));
typedef unsigned long long u64;
#define MFMA32(a, b, c) __builtin_amdgcn_mfma_f32_32x32x16_bf16((a), (b), (c), 0, 0, 0)

constexpr int NB = 8, NS = 8192, ND = 1024, NT = NB * NS;
constexpr int IN_COLS = 3656, NPAD = 3840;
constexpr int NTH = 512, NW = 8;
constexpr int NEXP = 256, NEXP1 = 257;
constexpr int NCHUNK = 4, CHUNK_T = NT / NCHUNK;
constexpr int NPAIR = 9;
constexpr float EPSF = 1e-6f;
constexpr float LOG2E = 1.4426950408889634f;

constexpr size_t MiB = 1048576;
constexpr size_t OFF_BAR = 0;
constexpr size_t OFF_MOD = 16384;
constexpr size_t OFF_CNT = OFF_MOD + 196608;
constexpr size_t OFF_ERR = OFF_CNT + 8192;
constexpr size_t OFF_Q = OFF_ERR;
constexpr size_t OFF_ITEMS = OFF_ERR + 1024;
constexpr size_t OFF_ZROW = 245760;
constexpr size_t ZERO_BYTES = 262144;
constexpr size_t OFF_WIN = 1 * MiB;
constexpr size_t OFF_WOUT = OFF_WIN + (size_t)NPAD * 1024 * 2;
constexpr size_t OFF_WRT = OFF_WOUT + 2 * MiB;
constexpr size_t OFF_WGU = 12 * MiB;
constexpr size_t OFF_WD = OFF_WGU + (size_t)NEXP1 * 512 * 1024 * 2;
constexpr size_t OFF_R1 = OFF_WD + (size_t)NEXP1 * 1024 * 256 * 2;
constexpr size_t OFF_H = OFF_R1;
constexpr size_t OFF_QD = OFF_H + 128 * MiB;
constexpr size_t OFF_KD = OFF_QD + 64 * MiB;
constexpr size_t OFF_VDT = OFF_KD + 64 * MiB;
constexpr size_t OFF_QS = OFF_VDT + 64 * MiB;
constexpr size_t OFF_KS = OFF_QS + 64 * MiB;
constexpr size_t OFF_VST = OFF_KS + 64 * MiB;
constexpr size_t OFF_IQ = OFF_VST + 64 * MiB;
constexpr size_t OFF_IK = OFF_IQ + 64 * MiB;
constexpr size_t OFF_IW = OFF_IK + 8 * MiB;
constexpr size_t OFF_MASK = OFF_IW + 2 * MiB;
constexpr size_t END_A = OFF_MASK + 64 * MiB;
constexpr size_t OFF_H2 = OFF_R1;
constexpr size_t OFF_LIST = OFF_H2 + 128 * MiB;
constexpr size_t OFF_EIDX = OFF_LIST + (size_t)NCHUNK * NEXP1 * CHUNK_T * 4;
constexpr size_t OFF_GATE = OFF_EIDX + 2 * MiB;
constexpr size_t OFF_ACT = OFF_GATE + 2 * MiB;
constexpr size_t ACT_BYTES = (size_t)CHUNK_T * NPAIR * 256 * 2;
constexpr size_t OFF_Y = OFF_ACT + 2 * ACT_BYTES;
constexpr size_t END_B = OFF_Y + (size_t)CHUNK_T * NPAIR * 1024 * 2;
constexpr size_t WS_NEED = END_A > END_B ? END_A : END_B;

struct Params {
    const float *x, *c, *ada_w, *ada_b, *norm1_g, *norm2_g, *w_in, *dq_g, *dk_g, *lq1, *lk1, *lq2, *lk2, *subln_g, *sq_g, *sk_g, *ik_g,
        *w_out, *router_w, *router_b, *ew_gate, *ew_up, *ew_down, *sw_gate, *sw_up, *sw_down;
    float* out;
    char* ws;
};

DI unsigned pk2(float a, float b) { f32x2 f = {a, b}; bf16v2 r = __builtin_convertvector(f, bf16v2); return __builtin_bit_cast(unsigned, r); }
DI float bf2f(bf16_t v) { return __uint_as_float(((unsigned)v) << 16); }
DI float bflo(unsigned u) { return __uint_as_float(u << 16); }
DI float bfhi(unsigned u) { return __uint_as_float(u & 0xffff0000u); }
DI int crow(int i, int hf) { return (i & 3) + 8 * (i >> 2) + 4 * hf; }
constexpr int LROW = 144;
DI int lofs(int row, int chunk) { return row * LROW + chunk * 16; }
DI float wave_sum(float v) {
#pragma unroll
    for (int d = 32; d >= 1; d >>= 1) v += __shfl_xor(v, d);
    return v;
}
DI float silu_f(float v) { return v / (1.f + __expf(-v)); }

#define XB_TMO      128
#define XB_XCNT(j)  (256  + 64 * (j))
#define XB_XSUB(j)  (1280 + 64 * (j))
#define XB_XGEN(j)  (2304 + 64 * (j))
#define XB_TOP      3328
#define XB_TOPGEN   3392
#define XCD_BAR_WORDS 3456
#define XB_SPIN_CAP (1u << 18)

__device__ __forceinline__ unsigned xb_ld(unsigned* p)              { return __hip_atomic_load(p, __ATOMIC_RELAXED, __HIP_MEMORY_SCOPE_AGENT); }
__device__ __forceinline__ unsigned xb_add(unsigned* p, unsigned v) { return __hip_atomic_fetch_add(p, v, __ATOMIC_RELAXED, __HIP_MEMORY_SCOPE_AGENT); }
__device__ __forceinline__ unsigned xb_xcc_id() { return (unsigned)__builtin_amdgcn_s_getreg((3 << 11) | 20) & 0xFu; }
#define XB_SPIN(cond, bar) do { unsigned _sp = 0; while (cond) { __builtin_amdgcn_s_sleep(1); \
    if ((++_sp & 255u) == 0u) { if (xb_ld(&(bar)[XB_TMO])) break; if (_sp > XB_SPIN_CAP) { atomicAdd(&(bar)[XB_TMO], 1u); break; } } } } while (0)

struct XcdBarrier {
    unsigned* bar; unsigned x;
    volatile LAS unsigned* st;
};
__device__ __forceinline__ XcdBarrier xcd_barrier_post(unsigned* bar, volatile LAS unsigned* st) {
    XcdBarrier b; b.bar = bar; b.x = xb_xcc_id(); b.st = st;
    if (threadIdx.x == 0) (void)xb_add(&bar[XB_XCNT(b.x)], 1u);
    return b;
}
__device__ __forceinline__ void xcd_barrier_complete(unsigned* bar, unsigned x, unsigned& nloc, unsigned& nx) {
    const unsigned G = gridDim.x * gridDim.y * gridDim.z;
    unsigned sum, cnt, mine, sp = 0u;
    for (;;) {
        sum = 0u; cnt = 0u; mine = 0u;
#pragma unroll
        for (unsigned j = 0; j < 16; ++j) { const unsigned c = xb_ld(&bar[XB_XCNT(j)]); sum += c; cnt += (c > 0u) ? 1u : 0u; mine = (j == x) ? c : mine; }
        if (sum == G) break;
        __builtin_amdgcn_s_sleep(1);
        if ((++sp & 255u) == 0u) { if (xb_ld(&bar[XB_TMO])) break; if (sp > XB_SPIN_CAP) { atomicAdd(&bar[XB_TMO], 1u); break; } }
    }
    nloc = mine > 0u ? mine : 1u; nx = cnt > 0u ? cnt : 1u;
}
__device__ __forceinline__ void xcd_barrier(const XcdBarrier& b) {
    asm volatile("s_waitcnt vmcnt(0)" ::: "memory");
    __syncthreads();
    if (threadIdx.x == 0) {
        unsigned* bar = b.bar;
        __builtin_amdgcn_s_waitcnt(0);
        unsigned nloc = b.st[0], nx = b.st[1];
        if (nloc == 0u) { xcd_barrier_complete(bar, b.x, nloc, nx); b.st[0] = nloc; b.st[1] = nx; }
        const unsigned old = xb_add(&bar[XB_XSUB(b.x)], 1u);
        const unsigned gen = old / nloc;
        if (old + 1u == (gen + 1u) * nloc) {
            __builtin_amdgcn_fence(__ATOMIC_RELEASE, "agent");
            asm volatile("s_waitcnt vmcnt(0)" ::: "memory");
            const unsigned og = xb_add(&bar[XB_TOP], 1u);
            const unsigned tg = og / nx;
            if (og + 1u == (tg + 1u) * nx) xb_add(&bar[XB_TOPGEN], 1u);
            else XB_SPIN(xb_ld(&bar[XB_TOPGEN]) == tg, bar);
            __builtin_amdgcn_fence(__ATOMIC_ACQUIRE, "agent");
            xb_add(&bar[XB_XGEN(b.x)], 1u);
            asm volatile("s_waitcnt vmcnt(0)" ::: "memory");
        } else {
            XB_SPIN(xb_ld(&bar[XB_XGEN(b.x)]) == gen, bar);
            __builtin_amdgcn_fence(__ATOMIC_ACQUIRE, "agent");
            asm volatile("s_waitcnt vmcnt(0)" ::: "memory");
        }
    }
    __syncthreads();
}

constexpr int GT_B = 256 * LROW;
constexpr int GT_STAGE = 2 * 256 * LROW;
constexpr int SM_EXTRA = 2 * GT_STAGE;
constexpr int SMEM_BYTES = SM_EXTRA + 4096;
#define MK_ONE_LAUNCH 1


constexpr int ATT_ITEMS = 4096;
DI int attn_item_cost(int type, int h, int qb) {
    if (type == 0) { const int win = h == 0 ? 4 : h == 1 ? 13 : h == 2 ? 47 : 1000; const int tiles = min(2 * qb + 2, win + 2); return (tiles * 6) / 4; }
    const int win = h == 0 ? 3 : h == 1 ? 4 : h == 2 ? 7 : h == 3 ? 13 : h == 4 ? 24 : h == 5 ? 47 : h == 6 ? 93 : 1000;
    const int tiles = min(4 * qb + 4, win + 4); return (tiles * 5) / 4;
}
DI int attn_item_code(int i) {
    if (i < 2048) { const int qb = i & 63, h = (i >> 6) & 3, b = i >> 8; return (b << 16) | (h << 8) | qb; }
    const int j = i - 2048; const int qb = j & 31, h = (j >> 5) & 7, b = j >> 8; return (1 << 20) | (b << 16) | (h << 8) | qb;
}
DI void build_attn_items(const Params& P, char* smem) {
    int* hist = (int*)smem;
    int* wsum = hist + 256;
    int* items = (int*)(P.ws + OFF_ITEMS);
    const int tid = threadIdx.x, lane = tid & 63, w = tid >> 6;
    __syncthreads();
    if (tid < 256) hist[tid] = 0;
    __syncthreads();
    for (int i = tid; i < ATT_ITEMS; i += NTH) { const int c = attn_item_code(i); atomicAdd(&hist[255 - min(255, attn_item_cost(c >> 20, (c >> 8) & 255, c & 255))], 1); }
    __syncthreads();
    int n = 0, inc = 0;
    if (tid < 256) {
        n = hist[tid]; inc = n;
#pragma unroll
        for (int d = 1; d < 64; d <<= 1) { const int t = __shfl_up(inc, d); if (lane >= d) inc += t; }
        if (lane == 63) wsum[w] = inc;
    }
    __syncthreads();
    if (tid < 256) {
        int off = 0;
#pragma unroll
        for (int i = 0; i < 4; ++i) if (i < w) off += wsum[i];
        hist[tid] = off + inc - n;
    }
    __syncthreads();
    for (int i = tid; i < ATT_ITEMS; i += NTH) {
        const int c = attn_item_code(i);
        const int pos = atomicAdd(&hist[255 - min(255, attn_item_cost(c >> 20, (c >> 8) & 255, c & 255))], 1);
        items[pos] = c;
    }
    __syncthreads();
}

DI void phase_adaln(const Params& P, char* smem) {
    float* mod = (float*)(P.ws + OFF_MOD);
    float* sc = (float*)smem;
    float* red = sc + 8192;
    const int tid = threadIdx.x;
    if (blockIdx.x == 0) build_attn_items(P, smem);
    __syncthreads();
    for (int i = tid; i < 8192; i += NTH) sc[i] = silu_f(P.c[i]);
    __syncthreads();
    const int kg = tid >> 4, cn = tid & 15;
    for (int it = blockIdx.x; it < 384; it += gridDim.x) {
        const int n = it * 16 + cn;
        float acc[8];
#pragma unroll
        for (int b = 0; b < 8; ++b) acc[b] = 0.f;
#pragma unroll 8
        for (int kk = 0; kk < 32; ++kk) {
            const int k = kg * 32 + kk;
            const float w = P.ada_w[(size_t)k * 6144 + n];
#pragma unroll
            for (int b = 0; b < 8; ++b) acc[b] += sc[b * 1024 + k] * w;
        }
#pragma unroll
        for (int b = 0; b < 8; ++b) red[(kg * 8 + b) * 16 + cn] = acc[b];
        __syncthreads();
        if (tid < 128) {
            const int b = tid >> 4;
            float s = P.ada_b[n];
#pragma unroll
            for (int g = 0; g < 32; ++g) s += red[(g * 8 + b) * 16 + cn];
            mod[b * 6144 + n] = s;
        }
        __syncthreads();
    }
}

DI void phase_norm(const float* __restrict__ xin, const float* __restrict__ g, const float* __restrict__ mod, int sh_off, int sc_off, bf16_t* __restrict__ dst) {
    const int lane = threadIdx.x & 63, w = threadIdx.x >> 6;
    for (int row = blockIdx.x * NW + w; row < NT; row += gridDim.x * NW) {
        const int b = row >> 13;
        const float* xr = xin + (size_t)row * 1024;
        f32x4 v[4]; float ss = 0.f;
#pragma unroll
        for (int i = 0; i < 4; ++i) { v[i] = *(const f32x4*)(xr + 256 * i + 4 * lane); ss += v[i][0] * v[i][0] + v[i][1] * v[i][1] + v[i][2] * v[i][2] + v[i][3] * v[i][3]; }
        ss = wave_sum(ss);
        const float rstd = rsqrtf(ss * (1.f / 1024.f) + EPSF);
#pragma unroll
        for (int i = 0; i < 4; ++i) {
            const int col = 256 * i + 4 * lane;
            const f32x4 gg = *(const f32x4*)(g + col);
            const f32x4 sh = *(const f32x4*)(mod + b * 6144 + sh_off + col);
            const f32x4 sc = *(const f32x4*)(mod + b * 6144 + sc_off + col);
            float o[4];
#pragma unroll
            for (int j = 0; j < 4; ++j) o[j] = v[i][j] * rstd * gg[j] * (1.f + sc[j]) + sh[j];
            u32x2 pk; pk[0] = pk2(o[0], o[1]); pk[1] = pk2(o[2], o[3]);
            *(u32x2*)(dst + (size_t)row * 1024 + col) = pk;
        }
    }
}

DI int gu_row(int f, int is_up) { return (f >> 6) * 128 + (((f >> 5) & 1) * 2 + is_up) * 32 + (f & 31); }
DI void cvt_tile(float* t, const float* __restrict__ src, int ldsrc, int nvalid, int k0, int n0, bf16_t* __restrict__ dst, int ldd, int mode) {
    const int tid = threadIdx.x;
    __syncthreads();
#pragma unroll
    for (int i = 0; i < 8; ++i) {
        const int idx = tid + NTH * i, kk = idx >> 6, nn = idx & 63;
        float v = 0.f;
        if (n0 + nn < nvalid) v = src[(size_t)(k0 + kk) * ldsrc + n0 + nn];
        t[kk * 65 + nn] = v;
    }
    __syncthreads();
    const int nn = tid >> 3, kq = (tid & 7) * 8;
    unsigned pk[4];
#pragma unroll
    for (int j = 0; j < 4; ++j) pk[j] = pk2(t[(kq + 2 * j) * 65 + nn], t[(kq + 2 * j + 1) * 65 + nn]);
    const int n = n0 + nn;
    const int drow = mode == 0 ? n : gu_row(n, mode - 1);
    bf16_t* d = dst + (size_t)drow * ldd + k0 + kq;
    *(u32x4*)(d) = (u32x4){pk[0], pk[1], pk[2], pk[3]};
}
constexpr int CVT_WIN = 16 * (NPAD / 64);
constexpr int CVT_SMALL = CVT_WIN + 256 + 64;
constexpr int CVT_ITEMS = CVT_SMALL + NEXP1 * 192;
DI void phase_convert(const Params& P, char* smem) {
    float* t = (float*)smem;
    bf16_t* win = (bf16_t*)(P.ws + OFF_WIN); bf16_t* wout = (bf16_t*)(P.ws + OFF_WOUT); bf16_t* wrt = (bf16_t*)(P.ws + OFF_WRT);
    bf16_t* wgu = (bf16_t*)(P.ws + OFF_WGU); bf16_t* wd = (bf16_t*)(P.ws + OFF_WD);
    for (int it = blockIdx.x; it < CVT_ITEMS; it += gridDim.x) {
        if (it < CVT_WIN) { cvt_tile(t, P.w_in, IN_COLS, IN_COLS, (it & 15) * 64, (it >> 4) * 64, win, 1024, 0); }
        else if (it < CVT_WIN + 256) { const int r = it - CVT_WIN; cvt_tile(t, P.w_out, 1024, 1024, (r & 15) * 64, (r >> 4) * 64, wout, 1024, 0); }
        else if (it < CVT_SMALL) { const int r = it - CVT_WIN - 256; cvt_tile(t, P.router_w, 256, 256, (r & 15) * 64, (r >> 4) * 64, wrt, 1024, 0); }
        else {
            const int r = it - CVT_SMALL, e = r / 192, sub = r % 192;
            if (sub < 128) {
                const int up = sub >> 6, s2 = sub & 63;
                const float* src = e < NEXP ? (up ? P.ew_up : P.ew_gate) + (size_t)e * 1024 * 256 : (up ? P.sw_up : P.sw_gate);
                cvt_tile(t, src, 256, 256, (s2 & 15) * 64, (s2 >> 4) * 64, wgu + (size_t)e * 512 * 1024, 1024, 1 + up);
            } else {
                const int s2 = sub - 128;
                const float* src = e < NEXP ? P.ew_down + (size_t)e * 256 * 1024 : P.sw_down;
                cvt_tile(t, src, 1024, 1024, (s2 & 3) * 64, (s2 >> 2) * 64, wd + (size_t)e * 1024 * 256, 256, 0);
            }
        }
    }
}

template <int BM> struct GemmGeo { static constexpr int NI = BM == 256 ? 4 : 2, WN = BM == 256 ? 2 : 4, AP = BM / 64; };
template <bool SWAP, int BM, class AFn, class Epi>
DI void gemm_stream(char* lds, AFn arow, const bf16_t* __restrict__ Bt, int ldb, int nksh, int nsub, Epi epi) {
    constexpr int NI = GemmGeo<BM>::NI, WN = GemmGeo<BM>::WN, AP = GemmGeo<BM>::AP;
    const int tid = threadIdx.x, lane = tid & 63, w = tid >> 6, wm = w / WN, wn = w % WN, l31 = lane & 31, hf = lane >> 5;
    const int nk = 1 << nksh, total = nsub << nksh;
    const int lrow = tid >> 3, lch = tid & 7;
    const bf16_t* ap[AP];
#pragma unroll
    for (int i = 0; i < AP; ++i) { const bf16_t* a = arow(lrow + 64 * i); ap[i] = a ? a + lch * 8 : nullptr; }
    const int so = lofs(lrow, lch);
    const bf16_t* bp = Bt + (size_t)lrow * ldb + lch * 8;
    const size_t bsub = (size_t)256 * ldb, brow64 = (size_t)64 * ldb;
    f32x16 acc[2][NI];
#pragma unroll
    for (int mi = 0; mi < 2; ++mi)
#pragma unroll
        for (int ni = 0; ni < NI; ++ni)
#pragma unroll
            for (int i = 0; i < 16; ++i) acc[mi][ni][i] = 0.f;
    u32x4 ra[AP], rb[4];
    const u32x4 z4 = {0u, 0u, 0u, 0u};
    auto load_part = [&](int s, int part) {
        const int t = s >> nksh, k0 = (s & (nk - 1)) * 64;
        const bf16_t* b0 = bp + t * bsub + k0;
        if (AP == 4) {
            if (part < 2) {
#pragma unroll
                for (int i = 0; i < 2; ++i) { const int q = 2 * part + i; ra[q] = ap[q] ? *(const u32x4*)(ap[q] + k0) : z4; }
            } else {
#pragma unroll
                for (int i = 0; i < 2; ++i) { const int q = 2 * (part - 2) + i; rb[q] = *(const u32x4*)(b0 + q * brow64); }
            }
        } else {
            if (part == 0) {
#pragma unroll
                for (int i = 0; i < AP; ++i) ra[i] = ap[i] ? *(const u32x4*)(ap[i] + k0) : z4;
            } else if (part < 3) {
#pragma unroll
                for (int i = 0; i < 2; ++i) { const int q = 2 * (part - 1) + i; rb[q] = *(const u32x4*)(b0 + q * brow64); }
            }
        }
    };
    auto store = [&](char* stg) {
#pragma unroll
        for (int i = 0; i < AP; ++i) *(u32x4*)(stg + so + i * 64 * LROW) = ra[i];
#pragma unroll
        for (int i = 0; i < 4; ++i) *(u32x4*)(stg + GT_B + so + i * 64 * LROW) = rb[i];
    };
    auto compute = [&](const char* cur, int snext) {
        const char* abase = cur + (64 * wm + l31) * LROW + hf * 16;
        const char* bbase = cur + GT_B + (32 * NI * wn + l31) * LROW + hf * 16;
#pragma unroll
        for (int ks = 0; ks < 4; ++ks) {
            bf16x8 af[2];
#pragma unroll
            for (int mi = 0; mi < 2; ++mi) af[mi] = *(const bf16x8*)(abase + mi * 32 * LROW + ks * 32);
#pragma unroll
            for (int nh = 0; nh < NI / 2; ++nh) {
                bf16x8 bfr[2];
#pragma unroll
                for (int n2 = 0; n2 < 2; ++n2) bfr[n2] = *(const bf16x8*)(bbase + (2 * nh + n2) * 32 * LROW + ks * 32);
#pragma unroll
                for (int mi = 0; mi < 2; ++mi)
#pragma unroll
                    for (int n2 = 0; n2 < 2; ++n2)
                        acc[mi][2 * nh + n2] = SWAP ? MFMA32(bfr[n2], af[mi], acc[mi][2 * nh + n2]) : MFMA32(af[mi], bfr[n2], acc[mi][2 * nh + n2]);
                if (NI == 4 && nh == 0) __builtin_amdgcn_sched_barrier(0);
            }
            __builtin_amdgcn_sched_barrier(0);
            load_part(snext, ks);
            __builtin_amdgcn_sched_barrier(0);
        }
    };
#pragma unroll
    for (int part = 0; part < 4; ++part) load_part(0, part);
    __syncthreads();
    store(lds);
    __syncthreads();
    for (int s = 0; s < total; ++s) {
        char* cur = lds + (s & 1) * GT_STAGE;
        char* nxt = lds + ((s & 1) ^ 1) * GT_STAGE;
        compute(cur, min(s + 1, total - 1));
        if ((s & (nk - 1)) == nk - 1) {
            epi(s >> nksh, acc);
#pragma unroll
            for (int mi = 0; mi < 2; ++mi)
#pragma unroll
                for (int ni = 0; ni < NI; ++ni)
#pragma unroll
                    for (int i = 0; i < 16; ++i) acc[mi][ni][i] = 0.f;
        }
        store(nxt);
        __syncthreads();
    }
}

constexpr int DS_B = 256 * 64, DS_STAGE = 512 * 64;
constexpr int DS_NST = 3;
constexpr int EP_SCR = DS_NST * DS_STAGE, EP_WAVE = 32 * 136;
template <class XF, class RowPtrFn>
DI void stage_store_chunk(char* smem, const f32x16& a0, const f32x16& a1, XF xf, RowPtrFn rowptr) {
    const int lane = threadIdx.x & 63, w = threadIdx.x >> 6, l31 = lane & 31, hf = lane >> 5;
    LAS char* scr = (LAS char*)smem + EP_SCR + w * EP_WAVE;
#pragma unroll
    for (int n2 = 0; n2 < 2; ++n2)
#pragma unroll
        for (int q4 = 0; q4 < 4; ++q4) {
            const f32x16& a = n2 ? a1 : a0;
            u32x2 pk; pk[0] = pk2(xf(n2, 4 * q4, a[4 * q4]), xf(n2, 4 * q4 + 1, a[4 * q4 + 1])); pk[1] = pk2(xf(n2, 4 * q4 + 2, a[4 * q4 + 2]), xf(n2, 4 * q4 + 3, a[4 * q4 + 3]));
            *(LAS u32x2*)(scr + l31 * 136 + (32 * n2 + 8 * q4 + 4 * hf) * 2) = pk;
        }
    const int rr = lane >> 4, c = lane & 15;
#pragma unroll
    for (int i = 0; i < 8; ++i) {
        const int r = rr + 4 * i;
        const u32x2 d = *(const LAS u32x2*)(scr + r * 136 + c * 8);
        bf16_t* g = rowptr(r);
        if (g) *(u32x2*)(g + c * 4) = d;
    }
}

template <bool SWAP, int BM, class AFn, class Epi>
DI void gemm_dma(char* lds_generic, AFn arow, const bf16_t* __restrict__ Bt, int ldb, int nksh, int nsub, const bf16_t* zrow, Epi epi) {
    constexpr int NI = GemmGeo<BM>::NI, WN = GemmGeo<BM>::WN, NA = BM / 128;
    LAS char* lds = (LAS char*)lds_generic;
    const int tid = threadIdx.x, lane = tid & 63, w = tid >> 6, wm = w / WN, wn = w % WN, l31 = lane & 31, hf = lane >> 5;
    const int nh = 2 << nksh, total = nsub * nh;
    const bf16_t* asrc[NA]; const bf16_t* bsrc[2];
#pragma unroll
    for (int i = 0; i < NA; ++i) {
        const int row = 16 * (w + 8 * i) + (lane >> 2), c = (lane & 3) ^ ((row >> 2) & 3);
        const bf16_t* a = arow(row);
        asrc[i] = (a ? a : zrow) + c * 8;
    }
#pragma unroll
    for (int i = 0; i < 2; ++i) {
        const int row = 16 * (w + 8 * i) + (lane >> 2), c = (lane & 3) ^ ((row >> 2) & 3);
        bsrc[i] = Bt + (size_t)row * ldb + c * 8;
    }
    const size_t bsub = (size_t)256 * ldb;
    auto dma = [&](int hs, int stage) {
        const int t = hs / nh, k0 = (hs - t * nh) * 32;
        LAS char* stg = lds + stage * DS_STAGE;
#pragma unroll
        for (int i = 0; i < NA; ++i)
            __builtin_amdgcn_global_load_lds((const unsigned*)(asrc[i] + k0), (LAS unsigned*)(stg + (w + 8 * i) * 1024), 16, 0, 0);
#pragma unroll
        for (int i = 0; i < 2; ++i)
            __builtin_amdgcn_global_load_lds((const unsigned*)(bsrc[i] + t * bsub + k0), (LAS unsigned*)(stg + DS_B + (w + 8 * i) * 1024), 16, 0, 0);
    };
    const int f = (l31 >> 2) & 3;
    const int lbase = l31 * 64 + ((hf ^ (f & 1)) << 4);
    const int o0 = lbase + (((f >> 1) & 1) << 5), o1 = lbase + ((((f >> 1) & 1) ^ 1) << 5);
    f32x16 acc[2][NI];
#pragma unroll
    for (int mi = 0; mi < 2; ++mi)
#pragma unroll
        for (int ni = 0; ni < NI; ++ni)
#pragma unroll
            for (int i = 0; i < 16; ++i) acc[mi][ni][i] = 0.f;
    asm volatile("s_waitcnt vmcnt(0) lgkmcnt(0)" ::: "memory");
    __builtin_amdgcn_s_barrier();
    dma(0, 0); dma(1, 1);
    constexpr int NDMA = NA + 2;
    for (int hs = 0; hs < total; ++hs) {
        if constexpr (NDMA == 4) asm volatile("s_waitcnt vmcnt(4)" ::: "memory"); else asm volatile("s_waitcnt vmcnt(3)" ::: "memory");
        asm volatile("s_waitcnt lgkmcnt(0)" ::: "memory");
        __builtin_amdgcn_s_barrier();
        dma(min(hs + 2, total - 1), (hs + 2) % DS_NST);
        const LAS char* stg = lds + (hs % DS_NST) * DS_STAGE;
        const LAS char* abase = stg + (64 * wm) * 64;
        const LAS char* bbase = stg + DS_B + (32 * NI * wn) * 64;
#pragma unroll
        for (int ks = 0; ks < 2; ++ks) {
            const int o = ks ? o1 : o0;
            bf16x8 af[2], bfr[NI];
#pragma unroll
            for (int mi = 0; mi < 2; ++mi) af[mi] = *(const LAS bf16x8*)(abase + mi * 2048 + o);
#pragma unroll
            for (int ni = 0; ni < NI; ++ni) bfr[ni] = *(const LAS bf16x8*)(bbase + ni * 2048 + o);
#pragma unroll
            for (int mi = 0; mi < 2; ++mi)
#pragma unroll
                for (int ni = 0; ni < NI; ++ni)
                    acc[mi][ni] = SWAP ? MFMA32(bfr[ni], af[mi], acc[mi][ni]) : MFMA32(af[mi], bfr[ni], acc[mi][ni]);
        }
        if ((hs % nh) == nh - 1) {
            epi(hs / nh, acc);
#pragma unroll
            for (int mi = 0; mi < 2; ++mi)
#pragma unroll
                for (int ni = 0; ni < NI; ++ni)
#pragma unroll
                    for (int i = 0; i < 16; ++i) acc[mi][ni][i] = 0.f;
        }
    }
    asm volatile("s_waitcnt vmcnt(0) lgkmcnt(0)" ::: "memory");
    __builtin_amdgcn_s_barrier();
}

struct DenseRows { static constexpr bool kDense = true; const bf16_t* base; int ld; DI const bf16_t* operator()(int r) const { return base + (size_t)r * ld; } };

DI void epi_rows_bf16(char* smem, const f32x16 (&acc)[2][4], int row0, bf16_t* __restrict__ dst, int ldo, int cb, const float* gain, bool do_norm) {
    const int lane = threadIdx.x & 63, w = threadIdx.x >> 6, wm = w >> 1, wn = w & 1, hf = lane >> 5;
#pragma unroll
    for (int mi = 0; mi < 2; ++mi)
#pragma unroll
        for (int pr = 0; pr < 2; ++pr) {
            float rstd = 1.f;
            if (do_norm) {
                float ss = 0.f;
#pragma unroll
                for (int n2 = 0; n2 < 2; ++n2)
#pragma unroll
                    for (int i = 0; i < 16; ++i) ss += acc[mi][2 * pr + n2][i] * acc[mi][2 * pr + n2][i];
                ss += __shfl_xor(ss, 32);
                rstd = rsqrtf(ss * (1.f / 64.f) + EPSF);
            }
            bf16_t* base = dst + (size_t)(row0 + 64 * wm + 32 * mi) * ldo + cb + 128 * wn + 64 * pr;
            int zo = 0; asm volatile("" : "+v"(zo));
            const float* gch = gain + zo;
            stage_store_chunk(smem, acc[mi][2 * pr], acc[mi][2 * pr + 1],
                              [&](int n2, int i, float x) { float o = x * rstd; if (do_norm) o *= gch[32 * n2 + crow(i, hf)]; return o; },
                              [&](int r) { return base + (size_t)r * ldo; });
        }
}
DI void epi_vt(char* smem, const f32x16 (&acc)[2][4], int row0, bf16_t* __restrict__ vt, int dv, int nheads, int colbase  ) {
    const int w = threadIdx.x >> 6, wm = w >> 1, wn = w & 1;
    const int b = row0 >> 13, s0 = row0 & (NS - 1);
#pragma unroll
    for (int ni = 0; ni < 4; ++ni) {
        const int c0 = colbase + 128 * wn + 32 * ni;
        bf16_t* base = vt + ((size_t)b * 512 + c0) * NS + s0 + 64 * wm;
        stage_store_chunk(smem, acc[0][ni], acc[1][ni], [](int, int, float x) { return x; }, [&](int r) { return base + (size_t)r * NS; });
    }
}
DI void phase_inproj(const Params& P, char* smem) {
    const bf16_t* zrow = (const bf16_t*)(P.ws + OFF_ZROW);
    const bf16_t* h = (const bf16_t*)(P.ws + OFF_H);
    const bf16_t* win = (const bf16_t*)(P.ws + OFF_WIN);
    float* gl = (float*)(smem + SM_EXTRA);
    __syncthreads();
    {
        const int v = threadIdx.x >> 6, i = threadIdx.x & 63;
        if (v == 0) gl[i] = P.dq_g[i];
        else if (v == 1) gl[64 + i] = P.dk_g[i];
        else if (v == 2) gl[128 + i] = P.sq_g[i];
        else if (v == 3) gl[192 + i] = P.sk_g[i];
        else if (v == 4) gl[256 + i] = P.ik_g[i];
    }
    __syncthreads();
    for (int it = blockIdx.x; it < (NT / 256) * 10; it += gridDim.x) {
#ifdef XP_MAP2
        const int mt = it & 255, jj = it >> 8;
#else
        const int xcd = it & 7, loc = it >> 3;
        const int jj = loc % 10, mt = (loc / 10) * 8 + xcd;
#endif
        const int j = jj < 4 ? jj : jj < 8 ? jj + 2 : jj + 4;
        const int row0 = mt * 256, grp = j >> 1, cb = (j & 1) * 256;
        DenseRows ar{h + (size_t)row0 * 1024, 1024};
        bf16_t* dst = (bf16_t*)(P.ws + (grp == 0 ? OFF_QD : grp == 1 ? OFF_KD : grp == 3 ? OFF_QS : grp == 4 ? OFF_KS : OFF_IQ));
        const float* gain = gl + 64 * (grp == 0 ? 0 : grp == 1 ? 1 : grp == 3 ? 2 : 3);
        const bool do_norm = grp != 6;
#ifdef XP_DUPEPI
        gemm_dma<true, 256>(smem, ar, win + (size_t)j * 256 * 1024, 1024, 4, 1, zrow, [&](int, const f32x16 (&acc)[2][4]) { epi_rows_bf16(smem, acc, row0, dst, 512, cb, gain, do_norm); asm volatile("" ::: "memory"); epi_rows_bf16(smem, acc, row0, dst, 512, cb, gain, do_norm); });
#else
        gemm_dma<true, 256>(smem, ar, win + (size_t)j * 256 * 1024, 1024, 4, 1, zrow, [&](int, const f32x16 (&acc)[2][4]) { epi_rows_bf16(smem, acc, row0, dst, 512, cb, gain, do_norm); });
#endif
    }
    for (int it = blockIdx.x; it < (NT / 256) * 4; it += gridDim.x) {
        const int xcd = it & 7, loc = it >> 3;
        const int jj = loc & 3, mt = (loc >> 2) * 8 + xcd;
        const int j = jj < 2 ? 4 + jj : 8 + jj;
        const int row0 = mt * 256, cb = (j & 1) * 256;
        DenseRows ar{h + (size_t)row0 * 1024, 1024};
        bf16_t* vt = (bf16_t*)(P.ws + (jj < 2 ? OFF_VDT : OFF_VST));
        const int dv = jj < 2 ? 128 : 64, nh = jj < 2 ? 4 : 8;
        gemm_dma<false, 256>(smem, ar, win + (size_t)j * 256 * 1024, 1024, 4, 1, zrow, [&](int, const f32x16 (&acc)[2][4]) { epi_vt(smem, acc, row0, vt, dv, nh, cb); });
    }
    for (int mt = blockIdx.x; mt < NT / 256; mt += gridDim.x) {
        const int row0 = mt * 256;
        DenseRows ar{h + (size_t)row0 * 1024, 1024};
        gemm_dma<true, 256>(smem, ar, win + (size_t)14 * 256 * 1024, 1024, 4, 1, zrow, [&](int, const f32x16 (&acc)[2][4]) {
            const int lane = threadIdx.x & 63, w = threadIdx.x >> 6, wm = w >> 1, wn = w & 1, l31 = lane & 31, hf = lane >> 5;
            if (wn == 0) {
                bf16_t* ik = (bf16_t*)(P.ws + OFF_IK);
                float* iw = (float*)(P.ws + OFF_IW);
                const float s = 0.35355339059327373f * 0.125f;
#pragma unroll
                for (int mi = 0; mi < 2; ++mi) {
                    const int tok = row0 + 64 * wm + 32 * mi + l31;
                    float ss = 0.f;
#pragma unroll
                    for (int ni = 0; ni < 2; ++ni)
#pragma unroll
                        for (int i = 0; i < 16; ++i) ss += acc[mi][ni][i] * acc[mi][ni][i];
                    ss += __shfl_xor(ss, 32);
                    const float rstd = rsqrtf(ss * (1.f / 64.f) + EPSF);
#pragma unroll
                    for (int ni = 0; ni < 2; ++ni)
#pragma unroll
                        for (int q4 = 0; q4 < 4; ++q4) {
                            const int f = 32 * ni + 8 * q4 + 4 * hf;
                            float o[4];
#pragma unroll
                            for (int r = 0; r < 4; ++r) o[r] = acc[mi][ni][4 * q4 + r] * rstd * gl[256 + f + r];
                            u32x2 pk; pk[0] = pk2(o[0], o[1]); pk[1] = pk2(o[2], o[3]);
                            *(u32x2*)(ik + (size_t)tok * 64 + f) = pk;
                        }
                    f32x4 o = {acc[mi][2][0] * s, acc[mi][2][1] * s, acc[mi][2][2] * s, acc[mi][2][3] * s};
                    *(f32x4*)(iw + (size_t)tok * 8 + 4 * hf) = o;
                }
            }
        });
    }
}

constexpr int TK_CAP = 512, TK_HI = 480;
DI unsigned topk_prune(volatile LAS unsigned* buf, volatile LAS unsigned* hist, int cnt) {
    const int lane = threadIdx.x & 63;
    unsigned e[8];
#pragma unroll
    for (int i = 0; i < 8; ++i) { const int idx = lane + 64 * i; e[i] = idx < cnt ? buf[idx] : 0u; }
    unsigned prefix = 0u, want = 256u;
#pragma unroll
    for (int p = 3; p >= 0; --p) {
        const int sh = 8 * p;
#pragma unroll
        for (int j = 0; j < 4; ++j) hist[4 * lane + j] = 0u;
        asm volatile("" ::: "memory");
#pragma unroll
        for (int i = 0; i < 8; ++i) {
            const bool m = (e[i] != 0u) && (p == 3 || (e[i] >> (sh + 8)) == prefix);
            if (m) __hip_atomic_fetch_add((LAS unsigned*)&hist[(e[i] >> sh) & 255u], 1u, __ATOMIC_RELAXED, __HIP_MEMORY_SCOPE_WORKGROUP);
        }
        asm volatile("" ::: "memory");
        const unsigned h0 = hist[4 * lane], h1 = hist[4 * lane + 1], h2 = hist[4 * lane + 2], h3 = hist[4 * lane + 3];
        const unsigned s4 = h0 + h1 + h2 + h3;
        unsigned suf = s4;
#pragma unroll
        for (int d = 1; d < 64; d <<= 1) { const unsigned t = __shfl_down(suf, d); if (lane + d < 64) suf += t; }
        const unsigned above = suf - s4;
        const bool own = (above < want) && (want <= suf);
        unsigned bsel = 0u, cum = above;
        if (cum + h3 >= want) bsel = 3u;
        else { cum += h3; if (cum + h2 >= want) bsel = 2u; else { cum += h2; if (cum + h1 >= want) bsel = 1u; else { cum += h1; bsel = 0u; } } }
        const u64 om = __ballot(own);
        const int ol = om ? (int)__builtin_ctzll(om) : 0;
        const unsigned bin = (unsigned)__shfl((int)(4u * lane + bsel), ol);
        const unsigned cm = (unsigned)__shfl((int)cum, ol);
        prefix = (prefix << 8) | bin; want -= cm;
    }
    const unsigned V = prefix;
    int base = 0;
#pragma unroll
    for (int i = 0; i < 8; ++i) {
        const bool keep = (e[i] != 0u) && (e[i] >= V);
        const u64 mk = __ballot(keep);
        const int pos = base + __builtin_popcountll(mk & ((1ull << lane) - 1ull));
        if (keep) buf[pos] = e[i];
        base += __builtin_popcountll(mk);
    }
    asm volatile("" ::: "memory");
    return V;
}

DI void indexer_item(const Params& P, char* smem, int b, int q0) {
    const int lane = threadIdx.x & 63, w = threadIdx.x >> 6, l31 = lane & 31, hf = lane >> 5;
    const int qbase = q0 + 8 * w;
    const bf16_t* IQ = (const bf16_t*)(P.ws + OFF_IQ);
    const bf16_t* IK = (const bf16_t*)(P.ws + OFF_IK);
    const float* IW = (const float*)(P.ws + OFF_IW);
    volatile LAS unsigned* buf = (volatile LAS unsigned*)(LAS char*)(smem + w * 8 * 2048);
    volatile LAS unsigned* hist = (volatile LAS unsigned*)(LAS char*)(smem + 131072 + w * 1024);
    bf16x8 af[2][4];
    {
        const int m = l31, qs = 2 * ((m >> 2) & 1) + (m >> 4), head = 4 * ((m >> 3) & 1) + (m & 3);
#pragma unroll
        for (int mt = 0; mt < 2; ++mt) {
            const size_t tok = (size_t)b * NS + qbase + 4 * mt + qs;
#pragma unroll
            for (int ks = 0; ks < 4; ++ks) af[mt][ks] = *(const bf16x8*)(IQ + tok * 512 + head * 64 + ks * 16 + hf * 8);
        }
    }
    float iwv[2][2][8]; int qpos[2][2]; unsigned tau[2][2]; int cnt[2][2];
#pragma unroll
    for (int mt = 0; mt < 2; ++mt)
#pragma unroll
        for (int j = 0; j < 2; ++j) {
            qpos[mt][j] = qbase + 4 * mt + 2 * hf + j; tau[mt][j] = 0u; cnt[mt][j] = 0;
            const float* p = IW + ((size_t)b * NS + qpos[mt][j]) * 8;
            const f32x4 a = *(const f32x4*)p, c = *(const f32x4*)(p + 4);
#pragma unroll
            for (int r = 0; r < 4; ++r) { iwv[mt][j][r] = a[r]; iwv[mt][j][4 + r] = c[r]; }
        }
    const int nkt = ((qbase + 7) >> 5) + 1;
    const bf16_t* ikb = IK + (size_t)b * NS * 64 + (size_t)l31 * 64 + hf * 8;
    bf16x8 bfr[4];
#pragma unroll
    for (int ks = 0; ks < 4; ++ks) bfr[ks] = *(const bf16x8*)(ikb + ks * 16);
    for (int kt = 0; kt < nkt; ++kt) {
        const int k0 = kt * 32;
        bf16x8 bn[4];
        if (kt + 1 < nkt) {
#pragma unroll
            for (int ks = 0; ks < 4; ++ks) bn[ks] = *(const bf16x8*)(ikb + (size_t)(k0 + 32) * 64 + ks * 16);
        } else {
#pragma unroll
            for (int ks = 0; ks < 4; ++ks) bn[ks] = bfr[ks];
        }
        f32x16 acc[2];
#pragma unroll
        for (int mt = 0; mt < 2; ++mt) {
#pragma unroll
            for (int i = 0; i < 16; ++i) acc[mt][i] = 0.f;
#pragma unroll
            for (int ks = 0; ks < 4; ++ks) acc[mt] = MFMA32(af[mt][ks], bfr[ks], acc[mt]);
        }
        const int kidx = k0 + l31;
#pragma unroll
        for (int mt = 0; mt < 2; ++mt)
#pragma unroll
            for (int j = 0; j < 2; ++j) {
                float s = 0.f;
#pragma unroll
                for (int t = 0; t < 8; ++t) s += iwv[mt][j][t] * fmaxf(acc[mt][8 * j + t], 0.f);
                const unsigned u = __float_as_uint(s);
                const unsigned ord = (u >> 31) ? ~u : (u | 0x80000000u);
                const unsigned pk = (ord & 0xFFFFE000u) | (unsigned)(8191 - kidx);
                const bool pass = (kidx <= qpos[mt][j]) && (pk > tau[mt][j]);
                const u64 mk = __ballot(pass);
                const unsigned hm = hf ? (unsigned)(mk >> 32) : (unsigned)mk;
                const int pos = cnt[mt][j] + __builtin_popcount(hm & ((1u << l31) - 1u));
                if (pass) buf[(4 * mt + 2 * hf + j) * TK_CAP + pos] = pk;
                cnt[mt][j] += __builtin_popcount(hm);
            }
        const bool anyhi = cnt[0][0] > TK_HI || cnt[0][1] > TK_HI || cnt[1][0] > TK_HI || cnt[1][1] > TK_HI;
        if (__ballot(anyhi) != 0ull) {
#pragma unroll 1
            for (int s8 = 0; s8 < 8; ++s8) {
                const int mt = s8 >> 2, j = (s8 >> 1) & 1, h2 = s8 & 1;
                const int cv = mt ? (j ? cnt[1][1] : cnt[1][0]) : (j ? cnt[0][1] : cnt[0][0]);
                const int c = __builtin_amdgcn_readlane(cv, 32 * h2);
                if (c > TK_HI) {
                    const unsigned V = topk_prune(buf + (4 * mt + 2 * h2 + j) * TK_CAP, hist, c);
#pragma unroll
                    for (int a = 0; a < 2; ++a)
#pragma unroll
                        for (int d = 0; d < 2; ++d)
                            if (hf == h2 && a == mt && d == j) { tau[a][d] = V; cnt[a][d] = 256; }
                }
            }
        }
#pragma unroll
        for (int ks = 0; ks < 4; ++ks) bfr[ks] = bn[ks];
    }
#pragma unroll 1
    for (int s8 = 0; s8 < 8; ++s8) {
        const int mt = s8 >> 2, j = (s8 >> 1) & 1, h2 = s8 & 1;
        const int cv = mt ? (j ? cnt[1][1] : cnt[1][0]) : (j ? cnt[0][1] : cnt[0][0]);
        int c = __builtin_amdgcn_readlane(cv, 32 * h2);
        volatile LAS unsigned* qb = buf + (4 * mt + 2 * h2 + j) * TK_CAP;
        if (c > 256) { (void)topk_prune(qb, hist, c); c = 256; }
#pragma unroll
        for (int t = 0; t < 4; ++t) qb[256 + 4 * lane + t] = 0u;
        asm volatile("" ::: "memory");
#pragma unroll
        for (int t = 0; t < 4; ++t) {
            const int idx = lane + 64 * t;
            if (idx < c) {
                const unsigned e = qb[idx]; const unsigned kk = 8191u - (e & 8191u);
                __hip_atomic_fetch_or((LAS unsigned*)&qb[256 + (kk >> 5)], 1u << (kk & 31u), __ATOMIC_RELAXED, __HIP_MEMORY_SCOPE_WORKGROUP);
            }
        }
        asm volatile("" ::: "memory");
    }
    u64* mask = (u64*)(P.ws + OFF_MASK);
    const int ktmax = (q0 | 255) >> 6;
    const int qi = lane & 7;
#pragma unroll 1
    for (int it = 0; it < 16; ++it) {
        const int kt = it * 8 + (lane >> 3);
        if (kt <= ktmax) {
            const unsigned lo = buf[qi * TK_CAP + 256 + 2 * kt], hi = buf[qi * TK_CAP + 256 + 2 * kt + 1];
            mask[((size_t)(b * 128 + kt)) * NS + qbase + qi] = ((u64)hi << 32) | lo;
        }
    }
}

constexpr int AT_K = 64 * LROW;
constexpr int AT_DSTAGE = 4 * AT_K;
template <int NDB, bool BM>
DI void attn_tile(const char* Kt, const char* Vt, const bf16x8 (&qf)[4], f32x16 (&o)[NDB], float& mrun, float& lrun,
                  int qpos, int k0, float c1, float c2, bool diag, u64 mword) {
    const int lane = threadIdx.x & 63, l31 = lane & 31, hf = lane >> 5;
    const char* kbase = Kt + l31 * LROW + hf * 16;
    const char* vbase = Vt + l31 * LROW + hf * 8;
    const float bias0 = -c2 * (float)(qpos - k0 - 4 * hf);
#pragma unroll 1
    for (int kbi = 0; kbi < 2; ++kbi) {
        const int kb = 1 - kbi;
        f32x16 st;
#pragma unroll
        for (int i = 0; i < 16; ++i) st[i] = 0.f;
#pragma unroll
        for (int ks = 0; ks < 4; ++ks) {
            const bf16x8 kf = *(const bf16x8*)(kbase + kb * 32 * LROW + ks * 32);
            st = MFMA32(kf, qf[ks], st);
        }
        const unsigned mw = BM ? (unsigned)((kb ? (unsigned)(mword >> 32) : (unsigned)mword) >> (4 * hf)) : 0u;
        float mx = -INFINITY;
#pragma unroll
        for (int i = 0; i < 16; ++i) {
            const int ko = 32 * kb + (i & 3) + 8 * (i >> 2);
            float v = st[i] * c1 + (bias0 + c2 * (float)ko);
            bool ok = true;
            if (BM) ok = (mw >> ((i & 3) + 8 * (i >> 2))) & 1u;
            if (diag) ok = ok && (k0 + ko + 4 * hf <= qpos);
            v = ok ? v : -INFINITY;
            st[i] = v; mx = fmaxf(mx, v);
        }
        mx = fmaxf(mx, __shfl_xor(mx, 32));
        const float mnew = fmaxf(mrun, mx);
        const float msafe = (mnew == -INFINITY) ? 0.f : mnew;
        const float alpha = __builtin_amdgcn_exp2f(mrun - msafe);
        float ls = 0.f;
#pragma unroll
        for (int i = 0; i < 16; ++i) { const float p = __builtin_amdgcn_exp2f(st[i] - msafe); st[i] = p; ls += p; }
        lrun = lrun * alpha + ls; mrun = mnew;
        if (__ballot(alpha != 1.f) != 0ull) {
#pragma unroll
            for (int db = 0; db < NDB; ++db)
#pragma unroll
                for (int i = 0; i < 16; ++i) o[db][i] *= alpha;
        }
#pragma unroll
        for (int s = 0; s < 2; ++s) {
            u32x4 pp;
#pragma unroll
            for (int t = 0; t < 4; ++t) pp[t] = pk2(st[8 * s + 2 * t], st[8 * s + 2 * t + 1]);
            const bf16x8 pf = __builtin_bit_cast(bf16x8, pp);
#pragma unroll
            for (int db = 0; db < NDB; ++db) {
                const s16x4 lo = *(const s16x4*)(vbase + db * 32 * LROW + (4 * kb + 2 * s) * 16);
                const s16x4 hi = *(const s16x4*)(vbase + db * 32 * LROW + (4 * kb + 2 * s) * 16 + 16);
                const bf16x8 vf = __builtin_shufflevector(lo, hi, 0, 1, 2, 3, 4, 5, 6, 7);
                o[db] = MFMA32(vf, pf, o[db]);
            }
        }
    }
}

DI void diffattn_item(const Params& P, char* smem, int b, int h, int qb) {
    const int tid = threadIdx.x, lane = tid & 63, w = tid >> 6, l31 = lane & 31, hf = lane >> 5;
    const int map = w & 1, qsub = w >> 1;
    const int q0 = qb * 128;
    const bf16_t* Qd = (const bf16_t*)(P.ws + OFF_QD);
    const bf16_t* Kd = (const bf16_t*)(P.ws + OFF_KD);
    const bf16_t* VdT = (const bf16_t*)(P.ws + OFF_VDT);
    const int qpos = q0 + 32 * qsub + l31;
    bf16x8 qf[4];
#pragma unroll
    for (int ks = 0; ks < 4; ++ks) qf[ks] = *(const bf16x8*)(Qd + ((size_t)b * NS + qpos) * 512 + h * 128 + map * 64 + ks * 16 + hf * 8);
    const float slope = exp2f(-2.f * (float)(h + 1));
    const float c1 = 0.125f * LOG2E, c2 = slope * LOG2E;
    float gq = fabsf(P.dq_g[lane]), gk = fabsf(P.dk_g[lane]);
#pragma unroll
    for (int d = 32; d >= 1; d >>= 1) { gq = fmaxf(gq, __shfl_xor(gq, d)); gk = fmaxf(gk, __shfl_xor(gk, d)); }
    const float B2 = 64.f * gq * gk * 1.008f * c1;
    int* flags = (int*)(smem + SM_EXTRA + 3072);
    int par = 0;
    f32x16 o[4];
#pragma unroll
    for (int db = 0; db < 4; ++db)
#pragma unroll
        for (int i = 0; i < 16; ++i) o[db][i] = 0.f;
    float mrun = -INFINITY, lrun = 0.f;
    const int lrow = tid >> 3, lch = tid & 7;
    const bf16_t* kp = Kd + ((size_t)b * NS + lrow) * 512 + h * 128 + lch * 8;
    const bf16_t* vp = VdT + ((size_t)(b * 4 + h) * 128 + lrow) * NS + lch * 8;
    const int so = lofs(lrow, lch);
    const int ktd = 2 * qb + 1;
    const int qwmax = q0 + 32 * qsub + 31, qwmin = q0 + 32 * qsub;
    u32x4 rk1, rk2, rv[2];
    {
        const int k0 = ktd * 64;
        rk1 = *(const u32x4*)(kp + (size_t)k0 * 512); rk2 = *(const u32x4*)(kp + (size_t)k0 * 512 + 64);
#pragma unroll
        for (int i = 0; i < 2; ++i) rv[i] = *(const u32x4*)(vp + (size_t)(64 * i) * NS + k0);
    }
    __syncthreads();
    *(u32x4*)(smem + so) = rk1; *(u32x4*)(smem + AT_K + so) = rk2;
#pragma unroll
    for (int i = 0; i < 2; ++i) *(u32x4*)(smem + 2 * AT_K + so + i * 64 * LROW) = rv[i];
    __syncthreads();
    int st = 0;
    for (int kt = ktd; kt >= 0; --kt) {
        const char* cur = smem + st * AT_DSTAGE;
        const int k0 = kt * 64;
        if (kt > 0) {
            const int kn = (kt - 1) * 64;
            rk1 = *(const u32x4*)(kp + (size_t)kn * 512); rk2 = *(const u32x4*)(kp + (size_t)kn * 512 + 64);
#pragma unroll
            for (int i = 0; i < 2; ++i) rv[i] = *(const u32x4*)(vp + (size_t)(64 * i) * NS + kn);
        }
        if (k0 <= qwmax)
            attn_tile<4, false>(cur + map * AT_K, cur + 2 * AT_K, qf, o, mrun, lrun, qpos, k0, c1, c2, k0 + 63 > qwmin, 0ull);
        {
            const float ub = B2 - c2 * (float)(qpos - (k0 - 1));
            const bool stop = __all(ub < mrun - 40.f);
            if (lane == 0) flags[par * 8 + w] = stop ? 1 : 0;
        }
        if (kt > 0) {
            char* nxt = smem + (st ^ 1) * AT_DSTAGE;
            *(u32x4*)(nxt + so) = rk1; *(u32x4*)(nxt + AT_K + so) = rk2;
#pragma unroll
            for (int i = 0; i < 2; ++i) *(u32x4*)(nxt + 2 * AT_K + so + i * 64 * LROW) = rv[i];
        }
        __syncthreads();
        int allstop = 1;
#pragma unroll
        for (int i = 0; i < 8; ++i) allstop &= flags[par * 8 + i];
        st ^= 1; par ^= 1;
        if (allstop) break;
    }
    const float ltot = lrun + __shfl_xor(lrun, 32);
    const float inv = 1.f / ltot;
    float la, lb;
    { const float a = P.lq1[lane] * P.lk1[lane], c = P.lq2[lane] * P.lk2[lane]; la = wave_sum(a); lb = wave_sum(c); }
    const float lam = __expf(la) - __expf(lb) + 0.2f;
    float* X = (float*)smem;
    if (map == 1) {
#pragma unroll
        for (int db = 0; db < 4; ++db)
#pragma unroll
            for (int q4 = 0; q4 < 4; ++q4) {
                f32x4 v;
#pragma unroll
                for (int r = 0; r < 4; ++r) v[r] = o[db][4 * q4 + r] * inv * lam;
                *(f32x4*)(X + (qsub * 32 + l31) * 132 + 32 * db + 8 * q4 + 4 * hf) = v;
            }
    }
    __syncthreads();
    if (map == 0) {
        float ss = 0.f;
#pragma unroll
        for (int db = 0; db < 4; ++db)
#pragma unroll
            for (int q4 = 0; q4 < 4; ++q4) {
                const f32x4 v2 = *(const f32x4*)(X + (qsub * 32 + l31) * 132 + 32 * db + 8 * q4 + 4 * hf);
#pragma unroll
                for (int r = 0; r < 4; ++r) { const float v = o[db][4 * q4 + r] * inv - v2[r]; o[db][4 * q4 + r] = v; ss += v * v; }
            }
        ss += __shfl_xor(ss, 32);
        const float rstd = rsqrtf(ss * (1.f / 128.f) + EPSF) * 0.8f;
        bf16_t* ao = (bf16_t*)(P.ws + OFF_H) + ((size_t)b * NS + qpos) * 1024 + h * 128;
#pragma unroll
        for (int db = 0; db < 4; ++db)
#pragma unroll
            for (int q4 = 0; q4 < 4; ++q4) {
                const int d = 32 * db + 8 * q4 + 4 * hf;
                const f32x4 g = *(const f32x4*)(P.subln_g + d);
                u32x2 pk; pk[0] = pk2(o[db][4 * q4] * rstd * g[0], o[db][4 * q4 + 1] * rstd * g[1]); pk[1] = pk2(o[db][4 * q4 + 2] * rstd * g[2], o[db][4 * q4 + 3] * rstd * g[3]);
                *(u32x2*)(ao + d) = pk;
            }
    }
    __syncthreads();
}

DI void dsa_item(const Params& P, char* smem, int b, int h, int qb) {
    const int tid = threadIdx.x, lane = tid & 63, w = tid >> 6, l31 = lane & 31, hf = lane >> 5;
    const int q0 = qb * 256;
    const bf16_t* Qs = (const bf16_t*)(P.ws + OFF_QS);
    const bf16_t* Ks = (const bf16_t*)(P.ws + OFF_KS);
    const bf16_t* VsT = (const bf16_t*)(P.ws + OFF_VST);
    const u64* mask = (const u64*)(P.ws + OFF_MASK);
    const int qpos = q0 + 32 * w + l31;
    bf16x8 qf[4];
#pragma unroll
    for (int ks = 0; ks < 4; ++ks) qf[ks] = *(const bf16x8*)(Qs + ((size_t)b * NS + qpos) * 512 + h * 64 + ks * 16 + hf * 8);
    const float slope = exp2f(-(float)(h + 1));
    const float c1 = 0.125f * LOG2E, c2 = slope * LOG2E;
    float gq = fabsf(P.sq_g[lane]), gk = fabsf(P.sk_g[lane]);
#pragma unroll
    for (int d = 32; d >= 1; d >>= 1) { gq = fmaxf(gq, __shfl_xor(gq, d)); gk = fmaxf(gk, __shfl_xor(gk, d)); }
    const float B2 = 64.f * gq * gk * 1.008f * c1;
    int* flags = (int*)(smem + SM_EXTRA + 3072);
    int par = 0;
    f32x16 o[2];
#pragma unroll
    for (int db = 0; db < 2; ++db)
#pragma unroll
        for (int i = 0; i < 16; ++i) o[db][i] = 0.f;
    float mrun = -INFINITY, lrun = 0.f;
    const int lrow = tid >> 3, lch = tid & 7;
    const bf16_t* kp = Ks + ((size_t)b * NS + lrow) * 512 + h * 64 + lch * 8;
    const bf16_t* vp = VsT + ((size_t)(b * 8 + h) * 64 + lrow) * NS + lch * 8;
    const int so = lofs(lrow, lch);
    const int ktd = 4 * qb + 3;
    u32x4 rk, rv;
    {
        const int k0 = ktd * 64;
        rk = *(const u32x4*)(kp + (size_t)k0 * 512); rv = *(const u32x4*)(vp + k0);
    }
    __syncthreads();
    *(u32x4*)(smem + so) = rk; *(u32x4*)(smem + AT_K + so) = rv;
    __syncthreads();
    int st = 0;
    const int qwmax = q0 + 32 * w + 31;
    for (int kt = ktd; kt >= 0; --kt) {
        const char* cur = smem + st * 2 * AT_K;
        const int k0 = kt * 64;
        u64 mword = 0ull;
        if (k0 <= qwmax) mword = mask[((size_t)(b * 128 + kt)) * NS + qpos];
        if (kt > 0) {
            const int kn = (kt - 1) * 64;
            rk = *(const u32x4*)(kp + (size_t)kn * 512); rv = *(const u32x4*)(vp + kn);
        }
        if (k0 <= qwmax && __ballot(mword != 0ull) != 0ull)
            attn_tile<2, true>(cur, cur + AT_K, qf, o, mrun, lrun, qpos, k0, c1, c2, false, mword);
        {
            const float ub = B2 - c2 * (float)(qpos - (k0 - 1));
            const bool stop = __all(ub < mrun - 40.f);
            if (lane == 0) flags[par * 8 + w] = stop ? 1 : 0;
        }
        if (kt > 0) {
            char* nxt = smem + (st ^ 1) * 2 * AT_K;
            *(u32x4*)(nxt + so) = rk; *(u32x4*)(nxt + AT_K + so) = rv;
        }
        __syncthreads();
        int allstop = 1;
#pragma unroll
        for (int i = 0; i < 8; ++i) allstop &= flags[par * 8 + i];
        st ^= 1; par ^= 1;
        if (allstop) break;
    }
    const float ltot = lrun + __shfl_xor(lrun, 32);
    const float inv = 1.f / ltot;
    bf16_t* ao = (bf16_t*)(P.ws + OFF_H) + ((size_t)b * NS + qpos) * 1024 + 512 + h * 64;
#pragma unroll
    for (int db = 0; db < 2; ++db)
#pragma unroll
        for (int q4 = 0; q4 < 4; ++q4) {
            const int d = 32 * db + 8 * q4 + 4 * hf;
            u32x2 pk; pk[0] = pk2(o[db][4 * q4] * inv, o[db][4 * q4 + 1] * inv); pk[1] = pk2(o[db][4 * q4 + 2] * inv, o[db][4 * q4 + 3] * inv);
            *(u32x2*)(ao + d) = pk;
        }
}

constexpr int P3_ITEMS = 128 * 8;
DI void phase_indexer(const Params& P, char* smem) {
    for (int it = blockIdx.x; it < P3_ITEMS; it += gridDim.x) {
        const int g = 127 - (it >> 3), b = it & 7;
        __syncthreads();
        indexer_item(P, smem, b, g * 64);
    }
    __syncthreads();
}
DI void phase_attn(const Params& P, char* smem, int qidx) {
    int* qctr = (int*)(P.ws + OFF_Q) + qidx;
    const int* items = (const int*)(P.ws + OFF_ITEMS);
    volatile int* s_it = (volatile int*)(smem + SM_EXTRA + 3200);
    for (;;) {
        __syncthreads();
        if (threadIdx.x == 0) *s_it = atomicAdd(qctr, 1);
        __syncthreads();
        const int it = *s_it;
        if (it >= ATT_ITEMS) break;
        const int code = items[it];
        const int b = (code >> 16) & 15, h = (code >> 8) & 255, qb = code & 255;
        if ((code >> 20) == 0) diffattn_item(P, smem, b, h, qb);
        else dsa_item(P, smem, b, h, qb);
    }
}

constexpr int OUTPROJ_ITEMS = (NT / 256) * 4;
DI void phase_outproj(const Params& P, char* smem) {
    const bf16_t* zrow = (const bf16_t*)(P.ws + OFF_ZROW);
    const bf16_t* ao = (const bf16_t*)(P.ws + OFF_H);
    const bf16_t* wout = (const bf16_t*)(P.ws + OFF_WOUT);
    bf16_t* mix = (bf16_t*)(P.ws + OFF_QD);
    const int lane = threadIdx.x & 63, w = threadIdx.x >> 6, wm = w >> 1, wn = w & 1, l31 = lane & 31, hf = lane >> 5;
    for (int it = blockIdx.x; it < OUTPROJ_ITEMS; it += gridDim.x) {
        const int xcd = it & 7, loc = it >> 3;
        const int mt = (loc >> 2) * 8 + xcd, j = loc & 3;
        const int row0 = mt * 256;
        DenseRows ar{ao + (size_t)row0 * 1024, 1024};
        gemm_dma<true, 256>(smem, ar, wout + (size_t)j * 256 * 1024, 1024, 4, 1, zrow, [&](int, const f32x16 (&acc)[2][4]) {
#pragma unroll
            for (int mi = 0; mi < 2; ++mi)
#pragma unroll
                for (int pr = 0; pr < 2; ++pr) {
                    bf16_t* base = mix + ((size_t)row0 + 64 * wm + 32 * mi) * 1024 + 256 * j + 128 * wn + 64 * pr;
                    stage_store_chunk(smem, acc[mi][2 * pr], acc[mi][2 * pr + 1], [](int, int, float x) { return x; }, [&](int r) { return base + (size_t)r * 1024; });
                }
        });
    }
}
DI void phase_resnorm2(const Params& P) {
    const bf16_t* mix = (const bf16_t*)(P.ws + OFF_QD);
    const float* mod = (const float*)(P.ws + OFF_MOD);
    bf16_t* h2 = (bf16_t*)(P.ws + OFF_H2);
    const int lane = threadIdx.x & 63, w = threadIdx.x >> 6;
    for (int row = blockIdx.x * NW + w; row < NT; row += gridDim.x * NW) {
        const int b = row >> 13;
        const float* mb = mod + b * 6144;
        f32x4 v[4]; float ss = 0.f;
#pragma unroll
        for (int i = 0; i < 4; ++i) {
            const int col = 256 * i + 4 * lane;
            const f32x4 xv = *(const f32x4*)(P.x + (size_t)row * 1024 + col);
            const u32x2 mv = *(const u32x2*)(mix + (size_t)row * 1024 + col);
            const f32x4 g1 = *(const f32x4*)(mb + 2048 + col);
            v[i][0] = xv[0] + g1[0] * bflo(mv[0]); v[i][1] = xv[1] + g1[1] * bfhi(mv[0]);
            v[i][2] = xv[2] + g1[2] * bflo(mv[1]); v[i][3] = xv[3] + g1[3] * bfhi(mv[1]);
            *(f32x4*)(P.out + (size_t)row * 1024 + col) = v[i];
            ss += v[i][0] * v[i][0] + v[i][1] * v[i][1] + v[i][2] * v[i][2] + v[i][3] * v[i][3];
        }
        ss = wave_sum(ss);
        const float rstd = rsqrtf(ss * (1.f / 1024.f) + EPSF);
#pragma unroll
        for (int i = 0; i < 4; ++i) {
            const int col = 256 * i + 4 * lane;
            const f32x4 gg = *(const f32x4*)(P.norm2_g + col);
            const f32x4 sh = *(const f32x4*)(mb + 3072 + col);
            const f32x4 sc = *(const f32x4*)(mb + 4096 + col);
            float o[4];
#pragma unroll
            for (int j = 0; j < 4; ++j) o[j] = v[i][j] * rstd * gg[j] * (1.f + sc[j]) + sh[j];
            u32x2 pk; pk[0] = pk2(o[0], o[1]); pk[1] = pk2(o[2], o[3]);
            *(u32x2*)(h2 + (size_t)row * 1024 + col) = pk;
        }
    }
}

constexpr int ROUTER_ITEMS = NT / 256;
DI void phase_router(const Params& P, char* smem) {
    const bf16_t* zrow = (const bf16_t*)(P.ws + OFF_ZROW);
    const bf16_t* h2 = (const bf16_t*)(P.ws + OFF_H2);
    const bf16_t* wrt = (const bf16_t*)(P.ws + OFF_WRT);
    float* logits = (float*)(P.ws + OFF_Y);
    const int lane = threadIdx.x & 63, w = threadIdx.x >> 6, wm = w >> 1, wn = w & 1, l31 = lane & 31, hf = lane >> 5;
    for (int it = blockIdx.x; it < ROUTER_ITEMS; it += gridDim.x) {
        const int row0 = it * 256;
        DenseRows ar{h2 + (size_t)row0 * 1024, 1024};
        gemm_dma<true, 256>(smem, ar, wrt, 1024, 4, 1, zrow, [&](int, const f32x16 (&acc)[2][4]) {
#pragma unroll
            for (int mi = 0; mi < 2; ++mi) {
                const size_t tok = (size_t)row0 + 64 * wm + 32 * mi + l31;
#pragma unroll
                for (int ni = 0; ni < 4; ++ni)
#pragma unroll
                    for (int q4 = 0; q4 < 4; ++q4) {
                        const int n = 128 * wn + 32 * ni + 8 * q4 + 4 * hf;
                        f32x4 ov = {acc[mi][ni][4 * q4], acc[mi][ni][4 * q4 + 1], acc[mi][ni][4 * q4 + 2], acc[mi][ni][4 * q4 + 3]};
                        *(f32x4*)(logits + tok * 256 + n) = ov;
                    }
            }
        });
    }
}

DI void phase_route(const Params& P) {
    const float* logits = (const float*)(P.ws + OFF_Y);
    int* cnt = (int*)(P.ws + OFF_CNT);
    int* list = (int*)(P.ws + OFF_LIST);
    int* eidx = (int*)(P.ws + OFF_EIDX);
    float* gates = (float*)(P.ws + OFF_GATE);
    const int lane = threadIdx.x & 63, w = threadIdx.x >> 6;
    const f32x4 bias = *(const f32x4*)(P.router_b + 4 * lane);
    for (int t = blockIdx.x * NW + w; t < NT; t += gridDim.x * NW) {
        const f32x4 lg = *(const f32x4*)(logits + (size_t)t * 256 + 4 * lane);
        float sc[4], cand[4];
#pragma unroll
        for (int i = 0; i < 4; ++i) { sc[i] = 1.f / (1.f + __expf(-lg[i])); cand[i] = sc[i] + bias[i]; }
        float t1 = fmaxf(cand[0], cand[1]), t2 = fminf(cand[0], cand[1]);
#pragma unroll
        for (int i = 2; i < 4; ++i) { const float v = cand[i]; t2 = fmaxf(t2, fminf(t1, v)); t1 = fmaxf(t1, v); }
#pragma unroll
        for (int d = 1; d < 8; d <<= 1) {
            const float o1 = __shfl_xor(t1, d), o2 = __shfl_xor(t2, d);
            const float n1 = fmaxf(t1, o1), n2 = fmaxf(fminf(t1, o1), fmaxf(t2, o2));
            t1 = n1; t2 = n2;
        }
        const float gs = t1 + t2;
        const int myg = lane >> 3;
        int rank = 0;
#pragma unroll
        for (int g = 0; g < 8; ++g) { const float sg = __shfl(gs, 8 * g); rank += (sg > gs || (sg == gs && g < myg)) ? 1 : 0; }
        if (rank >= 4) {
#pragma unroll
            for (int i = 0; i < 4; ++i) cand[i] = -INFINITY;
        }
        int sel[8]; float wv[8]; float wsum = 0.f;
#pragma unroll
        for (int k = 0; k < 8; ++k) {
            float bv = cand[0]; int bi = 0;
#pragma unroll
            for (int i = 1; i < 4; ++i) if (cand[i] > bv) { bv = cand[i]; bi = i; }
            int be = 4 * lane + bi;
#pragma unroll
            for (int d = 32; d >= 1; d >>= 1) {
                const float ov = __shfl_xor(bv, d); const int oe = __shfl_xor(be, d);
                if (ov > bv || (ov == bv && oe < be)) { bv = ov; be = oe; }
            }
            const int ol = be >> 2, oi = be & 3;
            float mys = (oi == 0) ? sc[0] : (oi == 1) ? sc[1] : (oi == 2) ? sc[2] : sc[3];
            const float ws_ = __shfl(mys, ol);
            if (lane == ol) {
#pragma unroll
                for (int i = 0; i < 4; ++i) if (i == oi) cand[i] = -INFINITY;
            }
            sel[k] = be; wv[k] = ws_; wsum += ws_;
        }
        const float rs = 2.5f / wsum;
        int my_e = 256; float my_g = 1.f;
#pragma unroll
        for (int k = 0; k < 8; ++k) if (lane == k) { my_e = sel[k]; my_g = wv[k] * rs; }
        const int c = t >> 14, tl = t & (CHUNK_T - 1);
        if (lane < 8) {
            eidx[(size_t)t * 8 + lane] = my_e; gates[(size_t)t * 8 + lane] = my_g;
            const int pos = atomicAdd(&cnt[c * NEXP1 + my_e], 1);
            list[((size_t)c * NEXP1 + my_e) * CHUNK_T + pos] = tl * NPAIR + lane;
        } else if (lane == 8) {
            list[((size_t)c * NEXP1 + 256) * CHUNK_T + tl] = tl * NPAIR + 8;
        }
    }
}

DI int moe_build_tiles(const Params& P, char* smem, int c) {
    int* tstart = (int*)(smem + SM_EXTRA);
    int* wsum = (int*)(smem + SM_EXTRA + 1536);
    const int* cnt = (const int*)(P.ws + OFF_CNT) + c * NEXP1;
    const int e = threadIdx.x, lane = e & 63, w = e >> 6;
    __syncthreads();
    int n = 0, inc = 0;
    if (e < 256) {
        n = (cnt[e] + 127) >> 7; inc = n;
#pragma unroll
        for (int d = 1; d < 64; d <<= 1) { const int t = __shfl_up(inc, d); if (lane >= d) inc += t; }
        if (lane == 63) wsum[w] = inc;
    }
    __syncthreads();
    if (e < 256) {
        int off = 0;
#pragma unroll
        for (int i = 0; i < 4; ++i) if (i < w) off += wsum[i];
        tstart[e] = off + inc - n;
        if (e == 255) { tstart[256] = off + inc; tstart[257] = off + inc + CHUNK_T / 128; }
    }
    __syncthreads();
    return tstart[NEXP1];
}
DI int moe_find_expert(const int* tstart, int tile) {
    int lo = 0, hi = NEXP1;
    while (hi - lo > 1) { const int mid = (lo + hi) >> 1; if (tstart[mid] <= tile) lo = mid; else hi = mid; }
    return lo;
}
struct GatherRows {
    static constexpr bool kDense = false;
    const bf16_t* base; int ld; const int* pid; int div;
    DI const bf16_t* operator()(int r) const { const int p = pid[r]; return p < 0 ? nullptr : base + (size_t)(p / div) * ld; }
};
DI void phase_moe_g1(const Params& P, char* smem, int c) {
    const bf16_t* zrow = (const bf16_t*)(P.ws + OFF_ZROW);
    const int total = moe_build_tiles(P, smem, c);
    const int* tstart = (const int*)(smem + SM_EXTRA);
    int* pid = (int*)(smem + SM_EXTRA + 2048);
    const int* cnt = (const int*)(P.ws + OFF_CNT) + c * NEXP1;
    const int* list = (const int*)(P.ws + OFF_LIST) + (size_t)c * NEXP1 * CHUNK_T;
    const bf16_t* h2 = (const bf16_t*)(P.ws + OFF_H2) + (size_t)c * CHUNK_T * 1024;
    const bf16_t* wgu = (const bf16_t*)(P.ws + OFF_WGU);
    bf16_t* act = (bf16_t*)(P.ws + OFF_ACT + (size_t)(c & 1) * ACT_BYTES);
    const int lane = threadIdx.x & 63, w = threadIdx.x >> 6, wm = w >> 2, wn = w & 3, l31 = lane & 31, hf = lane >> 5;
    for (int it = blockIdx.x; it < total * 2; it += gridDim.x) {
        const int tile = it >> 1, half = it & 1;
        const int e = moe_find_expert(tstart, tile), ti = tile - tstart[e];
        const int n = e < NEXP ? cnt[e] : CHUNK_T;
        __syncthreads();
        if (threadIdx.x < 128) { const int li = ti * 128 + threadIdx.x; pid[threadIdx.x] = li < n ? list[(size_t)e * CHUNK_T + li] : -1; }
        __syncthreads();
        GatherRows ar{h2, 1024, pid, NPAIR};
        gemm_dma<true, 128>(smem, ar, wgu + ((size_t)e * 512 + half * 256) * 1024, 1024, 4, 1, zrow, [&](int, const f32x16 (&acc)[2][2]) {
#pragma unroll
            for (int mi = 0; mi < 2; ++mi) {
                const int p = pid[64 * wm + 32 * mi + l31];
                if (p >= 0) {
                    bf16_t* arow_ = act + (size_t)p * 256 + 128 * half + 32 * wn;
#pragma unroll
                    for (int q4 = 0; q4 < 4; ++q4) {
                        float o[4];
#pragma unroll
                        for (int r = 0; r < 4; ++r) { const float g = acc[mi][0][4 * q4 + r], u = acc[mi][1][4 * q4 + r]; o[r] = silu_f(g) * u; }
                        u32x2 pk; pk[0] = pk2(o[0], o[1]); pk[1] = pk2(o[2], o[3]);
                        *(u32x2*)(arow_ + 8 * q4 + 4 * hf) = pk;
                    }
                }
            }
        });
    }
}
DI void phase_moe_g2(const Params& P, char* smem, int c) {
    const bf16_t* zrow = (const bf16_t*)(P.ws + OFF_ZROW);
    const int total = moe_build_tiles(P, smem, c);
    const int* tstart = (const int*)(smem + SM_EXTRA);
    int* pid = (int*)(smem + SM_EXTRA + 2048);
    float* gsm = (float*)(smem + SM_EXTRA + 2560);
    const int* cnt = (const int*)(P.ws + OFF_CNT) + c * NEXP1;
    const int* list = (const int*)(P.ws + OFF_LIST) + (size_t)c * NEXP1 * CHUNK_T;
    const float* gates = (const float*)(P.ws + OFF_GATE) + (size_t)c * CHUNK_T * 8;
    const bf16_t* wd = (const bf16_t*)(P.ws + OFF_WD);
    const bf16_t* act = (const bf16_t*)(P.ws + OFF_ACT + (size_t)(c & 1) * ACT_BYTES);
    bf16_t* y = (bf16_t*)(P.ws + OFF_Y);
    const int lane = threadIdx.x & 63, w = threadIdx.x >> 6, wm = w >> 2, wn = w & 3, l31 = lane & 31, hf = lane >> 5;
    for (int it = blockIdx.x; it < total * 2; it += gridDim.x) {
        const int tile = it >> 1, half = it & 1;
        const int e = moe_find_expert(tstart, tile), ti = tile - tstart[e];
        const int n = e < NEXP ? cnt[e] : CHUNK_T;
        __syncthreads();
        if (threadIdx.x < 128) {
            const int li = ti * 128 + threadIdx.x; const int pp = li < n ? list[(size_t)e * CHUNK_T + li] : -1;
            pid[threadIdx.x] = pp;
            float g = 1.f;
            if (pp >= 0 && (pp % NPAIR) < 8) g = gates[(size_t)(pp / NPAIR) * 8 + (pp % NPAIR)];
            gsm[threadIdx.x] = g;
        }
        __syncthreads();
        GatherRows ar{act, 256, pid, 1};
        gemm_dma<true, 128>(smem, ar, wd + ((size_t)e * 1024 + half * 512) * 256, 256, 2, 2, zrow, [&](int t, const f32x16 (&acc)[2][2]) {
            const int cb = half * 512 + t * 256 + 64 * wn;
#pragma unroll
            for (int mi = 0; mi < 2; ++mi) {
                const int p = pid[64 * wm + 32 * mi + l31];
                float g = 0.f;
                if (p >= 0) { const int k = p % NPAIR, tl = p / NPAIR; g = k < 8 ? gsm[64 * wm + 32 * mi + l31] : 1.f; (void)tl; }
                const int* prow = pid + 64 * wm + 32 * mi;
                stage_store_chunk(smem, acc[mi][0], acc[mi][1], [&](int, int, float x) { return x * g; }, [&](int r) { const int pp = prow[r]; return pp >= 0 ? y + (size_t)pp * 1024 + cb : (bf16_t*)nullptr; });
            }
        });
    }
}
DI void phase_moe_combine(const Params& P, int c) {
    const bf16_t* y = (const bf16_t*)(P.ws + OFF_Y);
    const float* mod = (const float*)(P.ws + OFF_MOD);
    const int lane = threadIdx.x & 63, w = threadIdx.x >> 6;
    for (int tl = blockIdx.x * NW + w; tl < CHUNK_T; tl += gridDim.x * NW) {
        const size_t t = (size_t)c * CHUNK_T + tl;
        const int b = (int)(t >> 13);
        const float* g2 = mod + b * 6144 + 5120;
#pragma unroll
        for (int i = 0; i < 4; ++i) {
            const int col = 256 * i + 4 * lane;
            float s[4] = {0.f, 0.f, 0.f, 0.f};
#pragma unroll
            for (int k = 0; k < NPAIR; ++k) {
                const u32x2 v = *(const u32x2*)(y + ((size_t)tl * NPAIR + k) * 1024 + col);
                s[0] += bflo(v[0]); s[1] += bfhi(v[0]); s[2] += bflo(v[1]); s[3] += bfhi(v[1]);
            }
            const f32x4 xv = *(const f32x4*)(P.out + t * 1024 + col);
            const f32x4 gv = *(const f32x4*)(g2 + col);
            f32x4 ov;
#pragma unroll
            for (int r = 0; r < 4; ++r) ov[r] = xv[r] + gv[r] * s[r];
            *(f32x4*)(P.out + t * 1024 + col) = ov;
        }
    }
}

constexpr int NPHASE = 18;
template <int PH, int REP = 0> DI void run_phase(const Params& Pin, char* smem) {
    Params P = Pin;
    asm volatile("" : "+s"(P.ws));
    float* mod = (float*)(P.ws + OFF_MOD);
    if constexpr (PH == 0) phase_adaln(P, smem);
    else if constexpr (PH == 1) { phase_norm(P.x, P.norm1_g, mod, 0, 1024, (bf16_t*)(P.ws + OFF_H)); phase_convert(P, smem); }
    else if constexpr (PH == 2) phase_inproj(P, smem);
    else if constexpr (PH == 3) phase_indexer(P, smem);
    else if constexpr (PH == 4) phase_attn(P, smem, REP);
    else if constexpr (PH == 5) phase_outproj(P, smem);
    else if constexpr (PH == 6) phase_resnorm2(P);
    else if constexpr (PH == 7) phase_router(P, smem);
    else if constexpr (PH == 8) phase_route(P);
    else if constexpr (PH == 9) phase_moe_g1(P, smem, 0);
    else if constexpr (PH == 10) phase_moe_g2(P, smem, 0);
    else if constexpr (PH == 11) { phase_moe_g1(P, smem, 1); phase_moe_combine(P, 0); }
    else if constexpr (PH == 12) phase_moe_g2(P, smem, 1);
    else if constexpr (PH == 13) { phase_moe_g1(P, smem, 2); phase_moe_combine(P, 1); }
    else if constexpr (PH == 14) phase_moe_g2(P, smem, 2);
    else if constexpr (PH == 15) { phase_moe_g1(P, smem, 3); phase_moe_combine(P, 2); }
    else if constexpr (PH == 16) phase_moe_g2(P, smem, 3);
    else if constexpr (PH == 17) phase_moe_combine(P, 3);
}
#ifndef DUP_PHASE
#define DUP_PHASE -1
#endif
#ifndef PROBE_PHASE
#define PROBE_PHASE -1
#endif
#ifndef PROBE_SCALE
#define PROBE_SCALE 0.1f
#endif
#define MK_RUN(PH) if constexpr (P0 <= PH && PH < P1) { \
    unsigned long long t0_ = 0; if constexpr (PH == PROBE_PHASE) t0_ = __builtin_amdgcn_s_memrealtime(); \
    run_phase<PH>(P, smem); if constexpr (PH == DUP_PHASE) { xcd_barrier(bar); run_phase<PH, 1>(P, smem); } \
    if constexpr (PH + 1 < P1 || PH == PROBE_PHASE) xcd_barrier(bar); \
    if constexpr (PH == PROBE_PHASE) { if (blockIdx.x == 0 && threadIdx.x == 0) *(volatile unsigned*)(P.ws + OFF_ERR + 512) = (unsigned)(__builtin_amdgcn_s_memrealtime() - t0_); } }
template <int P0, int P1>
__global__ void __launch_bounds__(NTH, 2) mk_kernel(Params P) {
    __shared__ __attribute__((aligned(16))) char smem[SMEM_BYTES + 16];
    if (threadIdx.x == 0) *(uint4*)(smem + SMEM_BYTES) = make_uint4(0u, 0u, 0u, 0u);
    __syncthreads();
    XcdBarrier bar;
    if constexpr (P1 - P0 > 1 || PROBE_PHASE >= 0) bar = xcd_barrier_post((unsigned*)(P.ws + OFF_BAR), (volatile LAS unsigned*)(LAS char*)(smem + SMEM_BYTES));
    MK_RUN(0) MK_RUN(1) MK_RUN(2) MK_RUN(3) MK_RUN(4) MK_RUN(5) MK_RUN(6) MK_RUN(7) MK_RUN(8)
    MK_RUN(9) MK_RUN(10) MK_RUN(11) MK_RUN(12) MK_RUN(13) MK_RUN(14) MK_RUN(15) MK_RUN(16) MK_RUN(17)
    if constexpr (PROBE_PHASE >= 0) {
        xcd_barrier(bar);
        const float us = (float)(*(volatile unsigned*)(P.ws + OFF_ERR + 512)) * 0.01f;
        const float cval = sqrtf(us * PROBE_SCALE);
        for (size_t i = (size_t)blockIdx.x * NTH + threadIdx.x; i < (size_t)NT * 1024 / 4; i += (size_t)gridDim.x * NTH) ((f32x4*)P.out)[i] = (f32x4){cval, cval, cval, cval};
    }
}

template <int P0, int P1> static void launch_range(const Params& p, hipStream_t stream) {
    static int grid = 0;
    if (!grid) {
        int dev = 0, cus = 0, per_cu = 0;
        (void)hipGetDevice(&dev);
        (void)hipDeviceGetAttribute(&cus, hipDeviceAttributeMultiprocessorCount, dev);
        (void)(void)hipOccupancyMaxActiveBlocksPerMultiprocessor(&per_cu, mk_kernel<P0, P1>, NTH, 0);
        if (cus <= 0) cus = 256;
        if (per_cu < 1) per_cu = 1;
        grid = cus * (per_cu < 1 ? 1 : 1);
    }
    mk_kernel<P0, P1><<<dim3(grid), dim3(NTH), 0, stream>>>(p);
}

extern "C" void kernel_launch(void* const* d_in, const int* in_sizes, int n_in, void* d_out, int out_size, void* d_ws, size_t ws_size, hipStream_t stream) {
    if (ws_size < WS_NEED) return;
    if (ws_size < WS_NEED) return;
    Params p{};
    const float** f = (const float**)&p;
    for (int i = 0; i < 26; ++i) f[i] = (const float*)d_in[i];
    p.out = (float*)d_out;
    p.ws = (char*)d_ws;
    (void)hipMemsetAsync(d_ws, 0, ZERO_BYTES, stream);
#if MK_ONE_LAUNCH
    launch_range<0, NPHASE>(p, stream);
#else
    launch_range<0, 1>(p, stream); launch_range<1, 2>(p, stream); launch_range<2, 3>(p, stream); launch_range<3, 4>(p, stream);
    launch_range<4, 5>(p, stream); launch_range<5, 6>(p, stream); launch_range<6, 7>(p, stream); launch_range<7, 8>(p, stream);
    launch_range<8, 9>(p, stream); launch_range<9, 10>(p, stream); launch_range<10, 11>(p, stream); launch_range<11, 12>(p, stream);
    launch_range<12, 13>(p, stream); launch_range<13, 14>(p, stream); launch_range<14, 15>(p, stream); launch_range<15, 16>(p, stream);
    launch_range<16, 17>(p, stream); launch_range<17, 18>(p, stream);
#endif
}
```

```cpp
#include <hip/hip_runtime.h>
#include <stdint.h>

#define DI __device__ __forceinline__
#define LAS __attribute__((address_space(3)))
typedef unsigned short bf16_t;
typedef short bf16x8 __attribute__((ext_vector_type(8)));
typedef short s16x4 __attribute__((ext_vector_type(4)));
typedef float f32x16 __attribute__((ext_vector_type(16)));
typedef float f32x4 __attribute__((ext_vector_type(4)));
typedef float f32x2 __attribute__((ext_vector_type(2)));
typedef __bf16 bf16v2 __attribute__((ext_vector_type(2)));
typedef unsigned u32x4 __attribute__((ext_vector_type(4)));
typedef unsigned u32x2 __attribute__((ext_vector_type(2)));
typedef unsigned long long u64;
#define MFMA32(a, b, c) __builtin_amdgcn_mfma_f32_32x32x16_bf16((a), (b), (c), 0, 0, 0)

constexpr int NB = 8, NS = 8192, ND = 1024, NT = NB * NS;
constexpr int IN_COLS = 3656, NPAD = 3840;
constexpr int NTH = 512, NW = 8;
constexpr int NEXP = 256, NEXP1 = 257;
constexpr int NCHUNK = 4, CHUNK_T = NT / NCHUNK;
constexpr int NPAIR = 9;
constexpr float EPSF = 1e-6f;
constexpr float LOG2E = 1.4426950408889634f;

constexpr size_t MiB = 1048576;
constexpr size_t OFF_BAR = 0;
constexpr size_t OFF_MOD = 16384;
constexpr size_t OFF_CNT = OFF_MOD + 196608;
constexpr size_t OFF_ERR = OFF_CNT + 8192;
constexpr size_t OFF_Q = OFF_ERR;
constexpr size_t OFF_XRANK = OFF_ERR + 128;
constexpr size_t OFF_XQ = OFF_ERR + 256;
constexpr size_t OFF_ITEMS = OFF_ERR + 1024;
constexpr size_t OFF_ZROW = 245760;
constexpr size_t ZERO_BYTES = 262144;
constexpr size_t OFF_WIN = 1 * MiB;
constexpr size_t OFF_WOUT = OFF_WIN + (size_t)NPAD * 1024 * 2;
constexpr size_t OFF_WRT = OFF_WOUT + 2 * MiB;
constexpr size_t OFF_WGU = 12 * MiB;
constexpr size_t OFF_WD = OFF_WGU + (size_t)NEXP1 * 512 * 1024 * 2;
constexpr size_t OFF_R1 = OFF_WD + (size_t)NEXP1 * 1024 * 256 * 2;
constexpr size_t OFF_H = OFF_R1;
constexpr size_t OFF_QD = OFF_H + 128 * MiB;
constexpr size_t OFF_KD = OFF_QD + 64 * MiB;
constexpr size_t OFF_VDT = OFF_KD + 64 * MiB;
constexpr size_t OFF_QS = OFF_VDT + 64 * MiB;
constexpr size_t OFF_KS = OFF_QS + 64 * MiB;
constexpr size_t OFF_VST = OFF_KS + 64 * MiB;
constexpr size_t OFF_IQ = OFF_VST + 64 * MiB;
constexpr size_t OFF_IK = OFF_IQ + 64 * MiB;
constexpr size_t OFF_IW = OFF_IK + 8 * MiB;
constexpr size_t OFF_MASK = OFF_IW + 2 * MiB;
constexpr size_t END_A = OFF_MASK + 64 * MiB;
constexpr size_t OFF_H2 = OFF_R1;
constexpr size_t OFF_LIST = OFF_H2 + 128 * MiB;
constexpr size_t OFF_EIDX = OFF_LIST + (size_t)NCHUNK * NEXP1 * CHUNK_T * 4;
constexpr size_t OFF_GATE = OFF_EIDX + 2 * MiB;
constexpr size_t OFF_ACT = OFF_GATE + 2 * MiB;
constexpr size_t ACT_BYTES = (size_t)CHUNK_T * NPAIR * 256 * 2;
constexpr size_t OFF_Y = OFF_ACT + 2 * ACT_BYTES;
constexpr size_t END_B = OFF_Y + (size_t)CHUNK_T * NPAIR * 1024 * 2;
constexpr size_t WS_NEED = END_A > END_B ? END_A : END_B;

struct Params {
    const float *x, *c, *ada_w, *ada_b, *norm1_g, *norm2_g, *w_in, *dq_g, *dk_g, *lq1, *lk1, *lq2, *lk2, *subln_g, *sq_g, *sk_g, *ik_g,
        *w_out, *router_w, *router_b, *ew_gate, *ew_up, *ew_down, *sw_gate, *sw_up, *sw_down;
    float* out;
    char* ws;
};

DI unsigned pk2(float a, float b) { f32x2 f = {a, b}; bf16v2 r = __builtin_convertvector(f, bf16v2); return __builtin_bit_cast(unsigned, r); }
DI float bf2f(bf16_t v) { return __uint_as_float(((unsigned)v) << 16); }
DI float bflo(unsigned u) { return __uint_as_float(u << 16); }
DI float bfhi(unsigned u) { return __uint_as_float(u & 0xffff0000u); }
DI int crow(int i, int hf) { return (i & 3) + 8 * (i >> 2) + 4 * hf; }
constexpr int LROW = 144;
DI int lofs(int row, int chunk) { return row * LROW + chunk * 16; }
DI float wave_sum(float v) {
#pragma unroll
    for (int d = 32; d >= 1; d >>= 1) v += __shfl_xor(v, d);
    return v;
}
DI float silu_f(float v) { return v / (1.f + __expf(-v)); }

#define XB_TMO      128
#define XB_XCNT(j)  (256  + 64 * (j))
#define XB_XSUB(j)  (1280 + 64 * (j))
#define XB_XGEN(j)  (2304 + 64 * (j))
#define XB_TOP      3328
#define XB_TOPGEN   3392
#define XCD_BAR_WORDS 3456
#define XB_SPIN_CAP (1u << 18)

__device__ __forceinline__ unsigned xb_ld(unsigned* p)              { return __hip_atomic_load(p, __ATOMIC_RELAXED, __HIP_MEMORY_SCOPE_AGENT); }
__device__ __forceinline__ unsigned xb_add(unsigned* p, unsigned v) { return __hip_atomic_fetch_add(p, v, __ATOMIC_RELAXED, __HIP_MEMORY_SCOPE_AGENT); }
__device__ __forceinline__ unsigned xb_xcc_id() { return (unsigned)__builtin_amdgcn_s_getreg((3 << 11) | 20) & 0xFu; }
#define XB_SPIN(cond, bar) do { unsigned _sp = 0; while (cond) { __builtin_amdgcn_s_sleep(1); \
    if ((++_sp & 255u) == 0u) { if (xb_ld(&(bar)[XB_TMO])) break; if (_sp > XB_SPIN_CAP) { atomicAdd(&(bar)[XB_TMO], 1u); break; } } } } while (0)

struct XcdBarrier {
    unsigned* bar; unsigned x;
    volatile LAS unsigned* st;
};
__device__ __forceinline__ XcdBarrier xcd_barrier_post(unsigned* bar, volatile LAS unsigned* st) {
    XcdBarrier b; b.bar = bar; b.x = xb_xcc_id(); b.st = st;
    if (threadIdx.x == 0) (void)xb_add(&bar[XB_XCNT(b.x)], 1u);
    return b;
}
__device__ __forceinline__ void xcd_barrier_complete(unsigned* bar, unsigned x, unsigned& nloc, unsigned& nx) {
    const unsigned G = gridDim.x * gridDim.y * gridDim.z;
    unsigned sum, cnt, mine, sp = 0u;
    for (;;) {
        sum = 0u; cnt = 0u; mine = 0u;
#pragma unroll
        for (unsigned j = 0; j < 16; ++j) { const unsigned c = xb_ld(&bar[XB_XCNT(j)]); sum += c; cnt += (c > 0u) ? 1u : 0u; mine = (j == x) ? c : mine; }
        if (sum == G) break;
        __builtin_amdgcn_s_sleep(1);
        if ((++sp & 255u) == 0u) { if (xb_ld(&bar[XB_TMO])) break; if (sp > XB_SPIN_CAP) { atomicAdd(&bar[XB_TMO], 1u); break; } }
    }
    nloc = mine > 0u ? mine : 1u; nx = cnt > 0u ? cnt : 1u;
}
__device__ __forceinline__ void xcd_barrier(const XcdBarrier& b) {
    asm volatile("s_waitcnt vmcnt(0)" ::: "memory");
    __syncthreads();
    if (threadIdx.x == 0) {
        unsigned* bar = b.bar;
        __builtin_amdgcn_s_waitcnt(0);
        unsigned nloc = b.st[0], nx = b.st[1];
        if (nloc == 0u) { xcd_barrier_complete(bar, b.x, nloc, nx); b.st[0] = nloc; b.st[1] = nx; }
        const unsigned old = xb_add(&bar[XB_XSUB(b.x)], 1u);
        const unsigned gen = old / nloc;
        if (old + 1u == (gen + 1u) * nloc) {
            __builtin_amdgcn_fence(__ATOMIC_RELEASE, "agent");
            asm volatile("s_waitcnt vmcnt(0)" ::: "memory");
            const unsigned og = xb_add(&bar[XB_TOP], 1u);
            const unsigned tg = og / nx;
            if (og + 1u == (tg + 1u) * nx) xb_add(&bar[XB_TOPGEN], 1u);
            else XB_SPIN(xb_ld(&bar[XB_TOPGEN]) == tg, bar);
            __builtin_amdgcn_fence(__ATOMIC_ACQUIRE, "agent");
            xb_add(&bar[XB_XGEN(b.x)], 1u);
            asm volatile("s_waitcnt vmcnt(0)" ::: "memory");
        } else {
            XB_SPIN(xb_ld(&bar[XB_XGEN(b.x)]) == gen, bar);
            __builtin_amdgcn_fence(__ATOMIC_ACQUIRE, "agent");
            asm volatile("s_waitcnt vmcnt(0)" ::: "memory");
        }
    }
    __syncthreads();
}

struct XPart { int start, step, end, grp, ngrp; };
constexpr int XC_LDS = 2 * 2 * 256 * 144 + 3584;
DI XPart xcd_part(const char* ws, const char* smem, int N) {
    const int x = ((const int*)(smem + XC_LDS))[0], r = ((const int*)(smem + XC_LDS))[1];
    const int* xc = (const int*)(ws + OFF_XRANK);
    int pre = 0, mine = 1, G = 0, grp = 0, ngrp = 0;
#pragma unroll
    for (int j = 0; j < 16; ++j) { const int c = xc[j]; if (j < x) { pre += c; grp += c > 0; } if (j == x) mine = c; G += c; ngrp += c > 0; }
    if (mine < 1) mine = 1; if (G < 1) G = 1;
    const long lo = (long)N * pre / G, hi = (long)N * (pre + mine) / G;
    XPart p; p.start = (int)lo + r; p.step = mine; p.end = (int)hi; p.grp = grp; p.ngrp = ngrp; return p;
}

constexpr int GT_B = 256 * LROW;
constexpr int GT_STAGE = 2 * 256 * LROW;
constexpr int SM_EXTRA = 2 * GT_STAGE;
constexpr int SMEM_BYTES = SM_EXTRA + 4096;
#define MK_ONE_LAUNCH 1


constexpr int ATT_ITEMS = 4096;
DI int attn_item_cost(int type, int h, int qb) {
    if (type == 0) { const int win = h == 0 ? 4 : h == 1 ? 13 : h == 2 ? 47 : 1000; const int tiles = min(2 * qb + 2, win + 2); return (tiles * 6) / 4; }
    const int win = h == 0 ? 3 : h == 1 ? 4 : h == 2 ? 7 : h == 3 ? 13 : h == 4 ? 24 : h == 5 ? 47 : h == 6 ? 93 : 1000;
    const int tiles = min(4 * qb + 4, win + 4); return (tiles * 5) / 4;
}
DI int attn_item_code(int i) {
    if (i < 2048) { const int qb = i & 63, h = (i >> 6) & 3, b = i >> 8; return (b << 16) | (h << 8) | qb; }
    const int j = i - 2048; const int qb = j & 31, h = (j >> 5) & 7, b = j >> 8; return (1 << 20) | (b << 16) | (h << 8) | qb;
}
DI void build_attn_items(const Params& P, char* smem) {
    int* hist = (int*)smem;
    int* wsum = hist + 256;
    int* items = (int*)(P.ws + OFF_ITEMS);
    const int tid = threadIdx.x, lane = tid & 63, w = tid >> 6;
    __syncthreads();
    if (tid < 256) hist[tid] = 0;
    __syncthreads();
    for (int i = tid; i < ATT_ITEMS; i += NTH) { const int c = attn_item_code(i); atomicAdd(&hist[255 - min(255, attn_item_cost(c >> 20, (c >> 8) & 255, c & 255))], 1); }
    __syncthreads();
    int n = 0, inc = 0;
    if (tid < 256) {
        n = hist[tid]; inc = n;
#pragma unroll
        for (int d = 1; d < 64; d <<= 1) { const int t = __shfl_up(inc, d); if (lane >= d) inc += t; }
        if (lane == 63) wsum[w] = inc;
    }
    __syncthreads();
    if (tid < 256) {
        int off = 0;
#pragma unroll
        for (int i = 0; i < 4; ++i) if (i < w) off += wsum[i];
        hist[tid] = off + inc - n;
    }
    __syncthreads();
    for (int i = tid; i < ATT_ITEMS; i += NTH) {
        const int c = attn_item_code(i);
        const int pos = atomicAdd(&hist[255 - min(255, attn_item_cost(c >> 20, (c >> 8) & 255, c & 255))], 1);
        items[pos] = c;
    }
    __syncthreads();
}

DI void phase_adaln(const Params& P, char* smem) {
    float* mod = (float*)(P.ws + OFF_MOD);
    float* sc = (float*)smem;
    float* red = sc + 8192;
    const int tid = threadIdx.x;
    if (blockIdx.x == 0) build_attn_items(P, smem);
    __syncthreads();
    for (int i = tid; i < 8192; i += NTH) sc[i] = silu_f(P.c[i]);
    __syncthreads();
    const int kg = tid >> 4, cn = tid & 15;
    for (int it = blockIdx.x; it < 384; it += gridDim.x) {
        const int n = it * 16 + cn;
        float acc[8];
#pragma unroll
        for (int b = 0; b < 8; ++b) acc[b] = 0.f;
#pragma unroll 8
        for (int kk = 0; kk < 32; ++kk) {
            const int k = kg * 32 + kk;
            const float w = P.ada_w[(size_t)k * 6144 + n];
#pragma unroll
            for (int b = 0; b < 8; ++b) acc[b] += sc[b * 1024 + k] * w;
        }
#pragma unroll
        for (int b = 0; b < 8; ++b) red[(kg * 8 + b) * 16 + cn] = acc[b];
        __syncthreads();
        if (tid < 128) {
            const int b = tid >> 4;
            float s = P.ada_b[n];
#pragma unroll
            for (int g = 0; g < 32; ++g) s += red[(g * 8 + b) * 16 + cn];
            mod[b * 6144 + n] = s;
        }
        __syncthreads();
    }
}

DI void phase_norm(const float* __restrict__ xin, const float* __restrict__ g, const float* __restrict__ mod, int sh_off, int sc_off, bf16_t* __restrict__ dst) {
    const int lane = threadIdx.x & 63, w = threadIdx.x >> 6;
    for (int row = blockIdx.x * NW + w; row < NT; row += gridDim.x * NW) {
        const int b = row >> 13;
        const float* xr = xin + (size_t)row * 1024;
        f32x4 v[4]; float ss = 0.f;
#pragma unroll
        for (int i = 0; i < 4; ++i) { v[i] = *(const f32x4*)(xr + 256 * i + 4 * lane); ss += v[i][0] * v[i][0] + v[i][1] * v[i][1] + v[i][2] * v[i][2] + v[i][3] * v[i][3]; }
        ss = wave_sum(ss);
        const float rstd = rsqrtf(ss * (1.f / 1024.f) + EPSF);
#pragma unroll
        for (int i = 0; i < 4; ++i) {
            const int col = 256 * i + 4 * lane;
            const f32x4 gg = *(const f32x4*)(g + col);
            const f32x4 sh = *(const f32x4*)(mod + b * 6144 + sh_off + col);
            const f32x4 sc = *(const f32x4*)(mod + b * 6144 + sc_off + col);
            float o[4];
#pragma unroll
            for (int j = 0; j < 4; ++j) o[j] = v[i][j] * rstd * gg[j] * (1.f + sc[j]) + sh[j];
            u32x2 pk; pk[0] = pk2(o[0], o[1]); pk[1] = pk2(o[2], o[3]);
            *(u32x2*)(dst + (size_t)row * 1024 + col) = pk;
        }
    }
}

DI int gu_row(int f, int is_up) { return (f >> 6) * 128 + (((f >> 5) & 1) * 2 + is_up) * 32 + (f & 31); }
DI void cvt_tile(float* t, const float* __restrict__ src, int ldsrc, int nvalid, int k0, int n0, bf16_t* __restrict__ dst, int ldd, int mode) {
    const int tid = threadIdx.x;
    __syncthreads();
#pragma unroll
    for (int i = 0; i < 8; ++i) {
        const int idx = tid + NTH * i, kk = idx >> 6, nn = idx & 63;
        float v = 0.f;
        if (n0 + nn < nvalid) v = src[(size_t)(k0 + kk) * ldsrc + n0 + nn];
        t[kk * 65 + nn] = v;
    }
    __syncthreads();
    const int nn = tid >> 3, kq = (tid & 7) * 8;
    unsigned pk[4];
#pragma unroll
    for (int j = 0; j < 4; ++j) pk[j] = pk2(t[(kq + 2 * j) * 65 + nn], t[(kq + 2 * j + 1) * 65 + nn]);
    const int n = n0 + nn;
    const int drow = mode == 0 ? n : gu_row(n, mode - 1);
    bf16_t* d = dst + (size_t)drow * ldd + k0 + kq;
    *(u32x4*)(d) = (u32x4){pk[0], pk[1], pk[2], pk[3]};
}
constexpr int CVT_WIN = 16 * (NPAD / 64);
constexpr int CVT_SMALL = CVT_WIN + 256 + 64;
constexpr int CVT_ITEMS = CVT_SMALL + NEXP1 * 192;
DI void phase_convert(const Params& P, char* smem) {
    float* t = (float*)smem;
    bf16_t* win = (bf16_t*)(P.ws + OFF_WIN); bf16_t* wout = (bf16_t*)(P.ws + OFF_WOUT); bf16_t* wrt = (bf16_t*)(P.ws + OFF_WRT);
    bf16_t* wgu = (bf16_t*)(P.ws + OFF_WGU); bf16_t* wd = (bf16_t*)(P.ws + OFF_WD);
    for (int it = blockIdx.x; it < CVT_ITEMS; it += gridDim.x) {
        if (it < CVT_WIN) { cvt_tile(t, P.w_in, IN_COLS, IN_COLS, (it & 15) * 64, (it >> 4) * 64, win, 1024, 0); }
        else if (it < CVT_WIN + 256) { const int r = it - CVT_WIN; cvt_tile(t, P.w_out, 1024, 1024, (r & 15) * 64, (r >> 4) * 64, wout, 1024, 0); }
        else if (it < CVT_SMALL) { const int r = it - CVT_WIN - 256; cvt_tile(t, P.router_w, 256, 256, (r & 15) * 64, (r >> 4) * 64, wrt, 1024, 0); }
        else {
            const int r = it - CVT_SMALL, e = r / 192, sub = r % 192;
            if (sub < 128) {
                const int up = sub >> 6, s2 = sub & 63;
                const float* src = e < NEXP ? (up ? P.ew_up : P.ew_gate) + (size_t)e * 1024 * 256 : (up ? P.sw_up : P.sw_gate);
                cvt_tile(t, src, 256, 256, (s2 & 15) * 64, (s2 >> 4) * 64, wgu + (size_t)e * 512 * 1024, 1024, 1 + up);
            } else {
                const int s2 = sub - 128;
                const float* src = e < NEXP ? P.ew_down + (size_t)e * 256 * 1024 : P.sw_down;
                cvt_tile(t, src, 1024, 1024, (s2 & 3) * 64, (s2 >> 2) * 64, wd + (size_t)e * 1024 * 256, 256, 0);
            }
        }
    }
}

template <int BM> struct GemmGeo { static constexpr int NI = BM == 256 ? 4 : 2, WN = BM == 256 ? 2 : 4, AP = BM / 64; };
template <bool SWAP, int BM, class AFn, class Epi>
DI void gemm_stream(char* lds, AFn arow, const bf16_t* __restrict__ Bt, int ldb, int nksh, int nsub, Epi epi) {
    constexpr int NI = GemmGeo<BM>::NI, WN = GemmGeo<BM>::WN, AP = GemmGeo<BM>::AP;
    const int tid = threadIdx.x, lane = tid & 63, w = tid >> 6, wm = w / WN, wn = w % WN, l31 = lane & 31, hf = lane >> 5;
    const int nk = 1 << nksh, total = nsub << nksh;
    const int lrow = tid >> 3, lch = tid & 7;
    const bf16_t* ap[AP];
#pragma unroll
    for (int i = 0; i < AP; ++i) { const bf16_t* a = arow(lrow + 64 * i); ap[i] = a ? a + lch * 8 : nullptr; }
    const int so = lofs(lrow, lch);
    const bf16_t* bp = Bt + (size_t)lrow * ldb + lch * 8;
    const size_t bsub = (size_t)256 * ldb, brow64 = (size_t)64 * ldb;
    f32x16 acc[2][NI];
#pragma unroll
    for (int mi = 0; mi < 2; ++mi)
#pragma unroll
        for (int ni = 0; ni < NI; ++ni)
#pragma unroll
            for (int i = 0; i < 16; ++i) acc[mi][ni][i] = 0.f;
    u32x4 ra[AP], rb[4];
    const u32x4 z4 = {0u, 0u, 0u, 0u};
    auto load_part = [&](int s, int part) {
        const int t = s >> nksh, k0 = (s & (nk - 1)) * 64;
        const bf16_t* b0 = bp + t * bsub + k0;
        if (AP == 4) {
            if (part < 2) {
#pragma unroll
                for (int i = 0; i < 2; ++i) { const int q = 2 * part + i; ra[q] = ap[q] ? *(const u32x4*)(ap[q] + k0) : z4; }
            } else {
#pragma unroll
                for (int i = 0; i < 2; ++i) { const int q = 2 * (part - 2) + i; rb[q] = *(const u32x4*)(b0 + q * brow64); }
            }
        } else {
            if (part == 0) {
#pragma unroll
                for (int i = 0; i < AP; ++i) ra[i] = ap[i] ? *(const u32x4*)(ap[i] + k0) : z4;
            } else if (part < 3) {
#pragma unroll
                for (int i = 0; i < 2; ++i) { const int q = 2 * (part - 1) + i; rb[q] = *(const u32x4*)(b0 + q * brow64); }
            }
        }
    };
    auto store = [&](char* stg) {
#pragma unroll
        for (int i = 0; i < AP; ++i) *(u32x4*)(stg + so + i * 64 * LROW) = ra[i];
#pragma unroll
        for (int i = 0; i < 4; ++i) *(u32x4*)(stg + GT_B + so + i * 64 * LROW) = rb[i];
    };
    auto compute = [&](const char* cur, int snext) {
        const char* abase = cur + (64 * wm + l31) * LROW + hf * 16;
        const char* bbase = cur + GT_B + (32 * NI * wn + l31) * LROW + hf * 16;
#pragma unroll
        for (int ks = 0; ks < 4; ++ks) {
            bf16x8 af[2];
#pragma unroll
            for (int mi = 0; mi < 2; ++mi) af[mi] = *(const bf16x8*)(abase + mi * 32 * LROW + ks * 32);
#pragma unroll
            for (int nh = 0; nh < NI / 2; ++nh) {
                bf16x8 bfr[2];
#pragma unroll
                for (int n2 = 0; n2 < 2; ++n2) bfr[n2] = *(const bf16x8*)(bbase + (2 * nh + n2) * 32 * LROW + ks * 32);
#pragma unroll
                for (int mi = 0; mi < 2; ++mi)
#pragma unroll
                    for (int n2 = 0; n2 < 2; ++n2)
                        acc[mi][2 * nh + n2] = SWAP ? MFMA32(bfr[n2], af[mi], acc[mi][2 * nh + n2]) : MFMA32(af[mi], bfr[n2], acc[mi][2 * nh + n2]);
                if (NI == 4 && nh == 0) __builtin_amdgcn_sched_barrier(0);
            }
            __builtin_amdgcn_sched_barrier(0);
            load_part(snext, ks);
            __builtin_amdgcn_sched_barrier(0);
        }
    };
#pragma unroll
    for (int part = 0; part < 4; ++part) load_part(0, part);
    __syncthreads();
    store(lds);
    __syncthreads();
    for (int s = 0; s < total; ++s) {
        char* cur = lds + (s & 1) * GT_STAGE;
        char* nxt = lds + ((s & 1) ^ 1) * GT_STAGE;
        compute(cur, min(s + 1, total - 1));
        if ((s & (nk - 1)) == nk - 1) {
            epi(s >> nksh, acc);
#pragma unroll
            for (int mi = 0; mi < 2; ++mi)
#pragma unroll
                for (int ni = 0; ni < NI; ++ni)
#pragma unroll
                    for (int i = 0; i < 16; ++i) acc[mi][ni][i] = 0.f;
        }
        store(nxt);
        __syncthreads();
    }
}

constexpr int DS_B = 256 * 64, DS_STAGE = 512 * 64;
constexpr int EP_SCR = 112640, EP_WAVE = 32 * 136;
template <bool PERM16 = false, class XF, class RowPtrFn>
DI void stage_store_chunk(char* smem, const f32x16& a0, const f32x16& a1, XF xf, RowPtrFn rowptr) {
    const int lane = threadIdx.x & 63, w = threadIdx.x >> 6, l31 = lane & 31, hf = lane >> 5;
    LAS char* scr = (LAS char*)smem + EP_SCR + w * EP_WAVE;
#pragma unroll
    for (int n2 = 0; n2 < 2; ++n2)
#pragma unroll
        for (int q4 = 0; q4 < 4; ++q4) {
            const f32x16& a = n2 ? a1 : a0;
            u32x2 pk; pk[0] = pk2(xf(n2, 4 * q4, a[4 * q4]), xf(n2, 4 * q4 + 1, a[4 * q4 + 1])); pk[1] = pk2(xf(n2, 4 * q4 + 2, a[4 * q4 + 2]), xf(n2, 4 * q4 + 3, a[4 * q4 + 3]));
            const int col = PERM16 ? 32 * n2 + 16 * (q4 >> 1) + 8 * hf + 4 * (q4 & 1) : 32 * n2 + 8 * q4 + 4 * hf;
            *(LAS u32x2*)(scr + l31 * 136 + col * 2) = pk;
        }
    const int rr = lane >> 4, c = lane & 15;
#pragma unroll
    for (int i = 0; i < 8; ++i) {
        const int r = rr + 4 * i;
        const u32x2 d = *(const LAS u32x2*)(scr + r * 136 + c * 8);
        bf16_t* g = rowptr(r);
        if (g) *(u32x2*)(g + c * 4) = d;
    }
}

template <bool SWAP, int BM, class AFn, class Epi>
DI void gemm_dma(char* lds_generic, AFn arow, const bf16_t* __restrict__ Bt, int ldb, int nksh, int nsub, const bf16_t* zrow, Epi epi) {
    constexpr int NI = GemmGeo<BM>::NI, WN = GemmGeo<BM>::WN, NA = BM / 128;
    constexpr int STG = (BM + 256) * 64, BOFF = BM * 64, NST = BM == 256 ? 3 : 4;
    LAS char* lds = (LAS char*)lds_generic;
    const int tid = threadIdx.x, lane = tid & 63, w = tid >> 6, wm = w / WN, wn = w % WN, l31 = lane & 31, hf = lane >> 5;
    const int nh = 2 << nksh, total = nsub * nh;
    const bf16_t* asrc[NA]; const bf16_t* bsrc[2];
#pragma unroll
    for (int i = 0; i < NA; ++i) {
        const int row = 16 * (w + 8 * i) + (lane >> 2), c = (lane & 3) ^ ((row >> 2) & 3);
        const bf16_t* a = arow(row);
        asrc[i] = (a ? a : zrow) + c * 8;
    }
#pragma unroll
    for (int i = 0; i < 2; ++i) {
        const int row = 16 * (w + 8 * i) + (lane >> 2), c = (lane & 3) ^ ((row >> 2) & 3);
        bsrc[i] = Bt + (size_t)row * ldb + c * 8;
    }
    const size_t bsub = (size_t)256 * ldb;
    auto dma = [&](int hs, int stage) {
        const int t = hs / nh, k0 = (hs - t * nh) * 32;
        LAS char* stg = lds + stage * STG;
#pragma unroll
        for (int i = 0; i < NA; ++i)
            __builtin_amdgcn_global_load_lds((const unsigned*)(asrc[i] + k0), (LAS unsigned*)(stg + (w + 8 * i) * 1024), 16, 0, 0);
#pragma unroll
        for (int i = 0; i < 2; ++i)
            __builtin_amdgcn_global_load_lds((const unsigned*)(bsrc[i] + t * bsub + k0), (LAS unsigned*)(stg + BOFF + (w + 8 * i) * 1024), 16, 0, 0);
    };
    const int f = (l31 >> 2) & 3;
    const int lbase = l31 * 64 + ((hf ^ (f & 1)) << 4);
    const int o0 = lbase + (((f >> 1) & 1) << 5), o1 = lbase + ((((f >> 1) & 1) ^ 1) << 5);
    f32x16 acc[2][NI];
#pragma unroll
    for (int mi = 0; mi < 2; ++mi)
#pragma unroll
        for (int ni = 0; ni < NI; ++ni)
#pragma unroll
            for (int i = 0; i < 16; ++i) acc[mi][ni][i] = 0.f;
    asm volatile("s_waitcnt vmcnt(0) lgkmcnt(0)" ::: "memory");
    __builtin_amdgcn_s_barrier();
    dma(0, 0); dma(1, 1); if constexpr (NST == 4) dma(2, 2);
    constexpr int NDMA = NA + 2;
    for (int hs = 0; hs < total; ++hs) {
        if constexpr (BM == 256) asm volatile("s_waitcnt vmcnt(4)" ::: "memory"); else asm volatile("s_waitcnt vmcnt(6)" ::: "memory");
        asm volatile("s_waitcnt lgkmcnt(0)" ::: "memory");
        __builtin_amdgcn_s_barrier();
        const int hs_n = min(hs + NST - 1, total - 1), st_n = (hs + NST - 1) % NST;
        const int t_n = hs_n / nh, k0_n = (hs_n - t_n * nh) * 32;
        LAS char* stgn = lds + st_n * STG;
        const LAS char* stg = lds + (hs % NST) * STG;
        const LAS char* abase = stg + (64 * wm) * 64;
        const LAS char* bbase = stg + BOFF + (32 * NI * wn) * 64;
#pragma unroll
        for (int ks = 0; ks < 2; ++ks) {
            const int o = ks ? o1 : o0;
            bf16x8 af[2], bfr[NI];
#pragma unroll
            for (int mi = 0; mi < 2; ++mi) af[mi] = *(const LAS bf16x8*)(abase + mi * 2048 + o);
#pragma unroll
            for (int ni = 0; ni < NI; ++ni) bfr[ni] = *(const LAS bf16x8*)(bbase + ni * 2048 + o);
#pragma unroll
            for (int mi = 0; mi < 2; ++mi)
#pragma unroll
                for (int ni = 0; ni < NI; ++ni)
                    acc[mi][ni] = SWAP ? MFMA32(bfr[ni], af[mi], acc[mi][ni]) : MFMA32(af[mi], bfr[ni], acc[mi][ni]);
            __builtin_amdgcn_sched_barrier(0);
            if (ks == 0) {
#pragma unroll
                for (int i = 0; i < NA; ++i)
                    __builtin_amdgcn_global_load_lds((const unsigned*)(asrc[i] + k0_n), (LAS unsigned*)(stgn + (w + 8 * i) * 1024), 16, 0, 0);
            } else {
#pragma unroll
                for (int i = 0; i < 2; ++i)
                    __builtin_amdgcn_global_load_lds((const unsigned*)(bsrc[i] + t_n * bsub + k0_n), (LAS unsigned*)(stgn + BOFF + (w + 8 * (i)) * 1024), 16, 0, 0);
            }
            __builtin_amdgcn_sched_barrier(0);
        }
        if ((hs % nh) == nh - 1) {
            epi(hs / nh, acc);
#pragma unroll
            for (int mi = 0; mi < 2; ++mi)
#pragma unroll
                for (int ni = 0; ni < NI; ++ni)
#pragma unroll
                    for (int i = 0; i < 16; ++i) acc[mi][ni][i] = 0.f;
        }
    }
    asm volatile("s_waitcnt vmcnt(0) lgkmcnt(0)" ::: "memory");
    __builtin_amdgcn_s_barrier();
}

struct DenseRows { static constexpr bool kDense = true; const bf16_t* base; int ld; DI const bf16_t* operator()(int r) const { return base + (size_t)r * ld; } };

DI void epi_rows_bf16(char* smem, const f32x16 (&acc)[2][4], int row0, bf16_t* __restrict__ dst, int ldo, int cb, const float* gain, bool do_norm) {
    const int lane = threadIdx.x & 63, w = threadIdx.x >> 6, wm = w >> 1, wn = w & 1, hf = lane >> 5;
#pragma unroll
    for (int mi = 0; mi < 2; ++mi)
#pragma unroll
        for (int pr = 0; pr < 2; ++pr) {
            float rstd = 1.f;
            if (do_norm) {
                float ss = 0.f;
#pragma unroll
                for (int n2 = 0; n2 < 2; ++n2)
#pragma unroll
                    for (int i = 0; i < 16; ++i) ss += acc[mi][2 * pr + n2][i] * acc[mi][2 * pr + n2][i];
                ss += __shfl_xor(ss, 32);
                rstd = rsqrtf(ss * (1.f / 64.f) + EPSF);
            }
            bf16_t* base = dst + (size_t)(row0 + 64 * wm + 32 * mi) * ldo + cb + 128 * wn + 64 * pr;
            int zo = 0; asm volatile("" : "+v"(zo));
            const float* gch = gain + zo;
            stage_store_chunk(smem, acc[mi][2 * pr], acc[mi][2 * pr + 1],
                              [&](int n2, int i, float x) { float o = x * rstd; if (do_norm) o *= gch[32 * n2 + crow(i, hf)]; return o; },
                              [&](int r) { return base + (size_t)r * ldo; });
        }
}
DI void epi_vt(char* smem, const f32x16 (&acc)[2][4], int row0, bf16_t* __restrict__ vt, int dv, int nheads, int colbase  ) {
    const int w = threadIdx.x >> 6, wm = w >> 1, wn = w & 1;
    const int b = row0 >> 13, s0 = row0 & (NS - 1);
#pragma unroll
    for (int ni = 0; ni < 4; ++ni) {
        const int c0 = colbase + 128 * wn + 32 * ni;
        bf16_t* base = vt + ((size_t)b * 512 + c0) * NS + s0 + 64 * wm;
        stage_store_chunk<true>(smem, acc[0][ni], acc[1][ni], [](int, int, float x) { return x; }, [&](int r) { return base + (size_t)r * NS; });
    }
}
DI void phase_inproj(const Params& P, char* smem) {
    const bf16_t* zrow = (const bf16_t*)(P.ws + OFF_ZROW);
    const bf16_t* h = (const bf16_t*)(P.ws + OFF_H);
    const bf16_t* win = (const bf16_t*)(P.ws + OFF_WIN);
    float* gl = (float*)(smem + SM_EXTRA);
    __syncthreads();
    {
        const int v = threadIdx.x >> 6, i = threadIdx.x & 63;
        if (v == 0) gl[i] = P.dq_g[i];
        else if (v == 1) gl[64 + i] = P.dk_g[i];
        else if (v == 2) gl[128 + i] = P.sq_g[i];
        else if (v == 3) gl[192 + i] = P.sk_g[i];
        else if (v == 4) gl[256 + i] = P.ik_g[i];
    }
    __syncthreads();
    const XPart xp1 = xcd_part(P.ws, smem, (NT / 256) * 10);
    for (int it = xp1.start; it < xp1.end; it += xp1.step) {
        const int jj = it % 10, mt = it / 10;
        const int j = jj < 4 ? jj : jj < 8 ? jj + 2 : jj + 4;
        const int row0 = mt * 256, grp = j >> 1, cb = (j & 1) * 256;
        DenseRows ar{h + (size_t)row0 * 1024, 1024};
        bf16_t* dst = (bf16_t*)(P.ws + (grp == 0 ? OFF_QD : grp == 1 ? OFF_KD : grp == 3 ? OFF_QS : grp == 4 ? OFF_KS : OFF_IQ));
        const float* gain = gl + 64 * (grp == 0 ? 0 : grp == 1 ? 1 : grp == 3 ? 2 : 3);
        const bool do_norm = grp != 6;
#ifdef XP_DUPEPI
        gemm_dma<true, 256>(smem, ar, win + (size_t)j * 256 * 1024, 1024, 4, 1, zrow, [&](int, const f32x16 (&acc)[2][4]) { epi_rows_bf16(smem, acc, row0, dst, 512, cb, gain, do_norm); asm volatile("" ::: "memory"); epi_rows_bf16(smem, acc, row0, dst, 512, cb, gain, do_norm); });
#else
        gemm_dma<true, 256>(smem, ar, win + (size_t)j * 256 * 1024, 1024, 4, 1, zrow, [&](int, const f32x16 (&acc)[2][4]) { epi_rows_bf16(smem, acc, row0, dst, 512, cb, gain, do_norm); });
#endif
    }
    const XPart xp2 = xcd_part(P.ws, smem, (NT / 256) * 4);
    for (int it = xp2.start; it < xp2.end; it += xp2.step) {
        const int jj = it & 3, mt = it >> 2;
        const int j = jj < 2 ? 4 + jj : 8 + jj;
        const int row0 = mt * 256, cb = (j & 1) * 256;
        DenseRows ar{h + (size_t)row0 * 1024, 1024};
        bf16_t* vt = (bf16_t*)(P.ws + (jj < 2 ? OFF_VDT : OFF_VST));
        const int dv = jj < 2 ? 128 : 64, nh = jj < 2 ? 4 : 8;
        gemm_dma<false, 256>(smem, ar, win + (size_t)j * 256 * 1024, 1024, 4, 1, zrow, [&](int, const f32x16 (&acc)[2][4]) { epi_vt(smem, acc, row0, vt, dv, nh, cb); });
    }
    for (int mt = blockIdx.x; mt < NT / 256; mt += gridDim.x) {
        const int row0 = mt * 256;
        DenseRows ar{h + (size_t)row0 * 1024, 1024};
        gemm_dma<true, 256>(smem, ar, win + (size_t)14 * 256 * 1024, 1024, 4, 1, zrow, [&](int, const f32x16 (&acc)[2][4]) {
            const int lane = threadIdx.x & 63, w = threadIdx.x >> 6, wm = w >> 1, wn = w & 1, l31 = lane & 31, hf = lane >> 5;
            if (wn == 0) {
                bf16_t* ik = (bf16_t*)(P.ws + OFF_IK);
                float* iw = (float*)(P.ws + OFF_IW);
                const float s = 0.35355339059327373f * 0.125f;
#pragma unroll
                for (int mi = 0; mi < 2; ++mi) {
                    const int tok = row0 + 64 * wm + 32 * mi + l31;
                    float ss = 0.f;
#pragma unroll
                    for (int ni = 0; ni < 2; ++ni)
#pragma unroll
                        for (int i = 0; i < 16; ++i) ss += acc[mi][ni][i] * acc[mi][ni][i];
                    ss += __shfl_xor(ss, 32);
                    const float rstd = rsqrtf(ss * (1.f / 64.f) + EPSF);
#pragma unroll
                    for (int ni = 0; ni < 2; ++ni)
#pragma unroll
                        for (int q4 = 0; q4 < 4; ++q4) {
                            const int f = 32 * ni + 8 * q4 + 4 * hf;
                            float o[4];
#pragma unroll
                            for (int r = 0; r < 4; ++r) o[r] = acc[mi][ni][4 * q4 + r] * rstd * gl[256 + f + r];
                            u32x2 pk; pk[0] = pk2(o[0], o[1]); pk[1] = pk2(o[2], o[3]);
                            *(u32x2*)(ik + ((((size_t)(tok >> 5) * 4 + (2 * ni + (q4 >> 1))) * 64 + 32 * (q4 & 1) + (tok & 31)) * 8 + 4 * hf)) = pk;
                        }
                    f32x4 o = {acc[mi][2][0] * s, acc[mi][2][1] * s, acc[mi][2][2] * s, acc[mi][2][3] * s};
                    *(f32x4*)(iw + (size_t)tok * 8 + 4 * hf) = o;
                }
            }
        });
    }
}

constexpr int TK_CAP = 512, TK_HI = 448;
template <int NPASS>
DI unsigned topk_prune(volatile LAS unsigned* buf, volatile LAS unsigned* hist, int cnt, int& kept) {
    const int lane = threadIdx.x & 63;
    unsigned e[8];
#pragma unroll
    for (int i = 0; i < 8; ++i) { const int idx = lane + 64 * i; e[i] = idx < cnt ? buf[idx] : 0u; }
    unsigned prefix = 0u, want = 256u;
#pragma unroll
    for (int p = 3; p >= 4 - NPASS; --p) {
        const int sh = 8 * p;
#pragma unroll
        for (int j = 0; j < 4; ++j) hist[4 * lane + j] = 0u;
        asm volatile("" ::: "memory");
#pragma unroll
        for (int i = 0; i < 8; ++i) {
            const bool m = (e[i] != 0u) && (p == 3 || (e[i] >> (sh + 8)) == prefix);
            if (m) __hip_atomic_fetch_add((LAS unsigned*)&hist[(e[i] >> sh) & 255u], 1u, __ATOMIC_RELAXED, __HIP_MEMORY_SCOPE_WORKGROUP);
        }
        asm volatile("" ::: "memory");
        const unsigned h0 = hist[4 * lane], h1 = hist[4 * lane + 1], h2 = hist[4 * lane + 2], h3 = hist[4 * lane + 3];
        const unsigned s4 = h0 + h1 + h2 + h3;
        int suf_i = (int)s4;
        suf_i += __builtin_amdgcn_update_dpp(0, suf_i, 0x101, 0xf, 0xf, true);
        suf_i += __builtin_amdgcn_update_dpp(0, suf_i, 0x102, 0xf, 0xf, true);
        suf_i += __builtin_amdgcn_update_dpp(0, suf_i, 0x104, 0xf, 0xf, true);
        suf_i += __builtin_amdgcn_update_dpp(0, suf_i, 0x108, 0xf, 0xf, true);
        const int t1 = __builtin_amdgcn_readlane(suf_i, 16), t2 = __builtin_amdgcn_readlane(suf_i, 32), t3 = __builtin_amdgcn_readlane(suf_i, 48);
        const int row = lane >> 4;
        const unsigned suf = (unsigned)(suf_i + (row == 0 ? t1 + t2 + t3 : row == 1 ? t2 + t3 : row == 2 ? t3 : 0));
        const unsigned above = suf - s4;
        const bool own = (above < want) && (want <= suf);
        unsigned bsel = 0u, cum = above;
        if (cum + h3 >= want) bsel = 3u;
        else { cum += h3; if (cum + h2 >= want) bsel = 2u; else { cum += h2; if (cum + h1 >= want) bsel = 1u; else { cum += h1; bsel = 0u; } } }
        const u64 om = __builtin_amdgcn_ballot_w64(own);
        const int ol = om ? (int)__builtin_ctzll(om) : 0;
        const unsigned bin = (unsigned)__builtin_amdgcn_readlane((int)(4u * lane + bsel), ol);
        const unsigned cm = (unsigned)__builtin_amdgcn_readlane((int)cum, ol);
        prefix = (prefix << 8) | bin; want -= cm;
    }
    const unsigned V = NPASS == 4 ? prefix : (prefix << 16);
    int base = 0;
#pragma unroll
    for (int i = 0; i < 8; ++i) {
        const bool keep = (e[i] != 0u) && (e[i] >= V);
        const u64 mk = __ballot(keep);
        const int pos = base + __builtin_popcountll(mk & ((1ull << lane) - 1ull));
        if (keep) buf[pos] = e[i];
        base += __builtin_popcountll(mk);
    }
    asm volatile("" ::: "memory");
    kept = base;
    return NPASS == 4 ? V : (V ? V - 1u : 0u);
}

DI void indexer_item(const Params& P, char* smem, int b, int q0) {
    const int lane = threadIdx.x & 63, w = __builtin_amdgcn_readfirstlane(threadIdx.x >> 6), l31 = lane & 31, hf = lane >> 5;
    const int qbase = q0 + 8 * w;
    const bf16_t* IQ = (const bf16_t*)(P.ws + OFF_IQ);
    const bf16_t* IK = (const bf16_t*)(P.ws + OFF_IK);
    const float* IW = (const float*)(P.ws + OFF_IW);
    volatile LAS unsigned* buf = (volatile LAS unsigned*)(LAS char*)(smem + w * 8 * 2048);
    volatile LAS unsigned* hist = (volatile LAS unsigned*)(LAS char*)(smem + 131072 + w * 1024);
    bf16x8 af[2][4];
    {
        const int m = l31, qs = 2 * ((m >> 2) & 1) + (m >> 4), head = 4 * ((m >> 3) & 1) + (m & 3);
#pragma unroll
        for (int mt = 0; mt < 2; ++mt) {
            const size_t tok = (size_t)b * NS + qbase + 4 * mt + qs;
#pragma unroll
            for (int ks = 0; ks < 4; ++ks) af[mt][ks] = *(const bf16x8*)(IQ + tok * 512 + head * 64 + ks * 16 + hf * 8);
        }
    }
    float iwv[2][2][8]; int qpos[2][2]; unsigned tau[2][2]; int cnt[2][2];
#pragma unroll
    for (int mt = 0; mt < 2; ++mt)
#pragma unroll
        for (int j = 0; j < 2; ++j) {
            qpos[mt][j] = qbase + 4 * mt + 2 * hf + j; tau[mt][j] = 0u; cnt[mt][j] = 0;
            const float* p = IW + ((size_t)b * NS + qpos[mt][j]) * 8;
            const f32x4 a = *(const f32x4*)p, c = *(const f32x4*)(p + 4);
#pragma unroll
            for (int r = 0; r < 4; ++r) { iwv[mt][j][r] = a[r]; iwv[mt][j][4 + r] = c[r]; }
        }
    const int nkt = ((qbase + 7) >> 6) + 1;
    const bf16_t* ikb = IK + (size_t)b * NS * 64 + (size_t)lane * 8;
    bf16x8 bfr[2][4];
#pragma unroll
    for (int sb = 0; sb < 2; ++sb)
#pragma unroll
        for (int ks = 0; ks < 4; ++ks) bfr[sb][ks] = *(const bf16x8*)(ikb + (size_t)(sb * 4 + ks) * 512);
#pragma unroll 2
    for (int kt = 0; kt < nkt; ++kt) {
        bf16x8 bn[2][4];
        {
            const int kn = min(kt + 1, nkt - 1) * 64;
#ifdef XP_DUPIKLOAD
#pragma unroll
            for (int sb = 0; sb < 2; ++sb)
#pragma unroll
                for (int ks = 0; ks < 4; ++ks) { bf16x8 t = __builtin_nontemporal_load((const bf16x8*)(ikb + (size_t)kn * 64 + (size_t)(sb * 4 + ks) * 512)); asm volatile("" : "+v"(t)); }
#endif
#pragma unroll
            for (int sb = 0; sb < 2; ++sb)
#pragma unroll
                for (int ks = 0; ks < 4; ++ks) bn[sb][ks] = *(const bf16x8*)(ikb + (size_t)kn * 64 + (size_t)(sb * 4 + ks) * 512);
        }
#pragma unroll
        for (int sb = 0; sb < 2; ++sb) {
            const int k0 = kt * 64 + 32 * sb;
            if (k0 > qbase + 7) continue;
            const bool needcausal = k0 + 31 > qbase;
            f32x16 acc[2];
#pragma unroll
            for (int mt = 0; mt < 2; ++mt) {
#pragma unroll
                for (int i = 0; i < 16; ++i) acc[mt][i] = 0.f;
#pragma unroll
                for (int ks = 0; ks < 4; ++ks) acc[mt] = MFMA32(af[mt][ks], bfr[sb][ks], acc[mt]);
#ifdef XP_DUPIDXMFMA
                { f32x16 z; for (int i = 0; i < 16; ++i) z[i] = 0.f;
                  for (int ks = 0; ks < 4; ++ks) z = MFMA32(af[mt][ks], bfr[sb][ks], z);
                  asm volatile("" : "+v"(z)); }
#endif
            }
            const int kidx = k0 + l31;
#pragma unroll
            for (int mt = 0; mt < 2; ++mt)
#pragma unroll
                for (int j = 0; j < 2; ++j) {
                    float s = 0.f;
#ifdef XP_DUPSCORE
                    { float s2 = 0.f;
#pragma unroll
                      for (int t = 0; t < 8; ++t) s2 = __builtin_fmaf(iwv[mt][j][t], __int_as_float(max(__float_as_int(acc[mt][8 * j + t]), 0)), s2);
                      asm volatile("" : "+v"(s2)); s = s2 * 0.f; }
#endif
#pragma unroll
                    for (int t = 0; t < 8; ++t)
                        s = __builtin_fmaf(iwv[mt][j][t], __int_as_float(max(__float_as_int(acc[mt][8 * j + t]), 0)), s);
                    const int si = __float_as_int(s);
                    const unsigned ord = (unsigned)si ^ ((unsigned)(si >> 31) | 0x80000000u);
                    const unsigned pk = (ord & 0xFFFFE000u) | (unsigned)(8191 - kidx);
                    const bool pass = needcausal ? ((kidx <= qpos[mt][j]) && (pk > tau[mt][j])) : (pk > tau[mt][j]);
                    const u64 mk = __builtin_amdgcn_ballot_w64(pass);
                    const unsigned hm = hf ? (unsigned)(mk >> 32) : (unsigned)mk;
                    const int pos = cnt[mt][j] + __builtin_popcount(hm & ((1u << l31) - 1u));
                    { const int widx = pass ? (4 * mt + 2 * hf + j) * TK_CAP + pos : (int)(hist - buf) + lane; buf[widx] = pk; }
#ifdef XP_DUPAPPEND
                    {
                        unsigned pk2v = pk; asm volatile("" : "+v"(pk2v));
                        const bool pass2 = needcausal ? ((kidx <= qpos[mt][j]) && (pk2v > tau[mt][j])) : (pk2v > tau[mt][j]);
                        const u64 mk2 = __builtin_amdgcn_ballot_w64(pass2);
                        const unsigned hm2 = hf ? (unsigned)(mk2 >> 32) : (unsigned)mk2;
                        const int pos2 = cnt[mt][j] + __builtin_popcount(hm2 & ((1u << l31) - 1u));
                        if (pass2) buf[(4 * mt + 2 * hf + j) * TK_CAP + pos2] = pk2v;
                    }
#endif
                    cnt[mt][j] += __builtin_popcount(hm);
                }
        }
        const bool anyhi = cnt[0][0] > TK_HI || cnt[0][1] > TK_HI || cnt[1][0] > TK_HI || cnt[1][1] > TK_HI;
        if (__ballot(anyhi) != 0ull) {
#pragma unroll 1
            for (int s8 = 0; s8 < 8; ++s8) {
                const int mt = s8 >> 2, j = (s8 >> 1) & 1, h2 = s8 & 1;
                const int cv = mt ? (j ? cnt[1][1] : cnt[1][0]) : (j ? cnt[0][1] : cnt[0][0]);
                const int c = __builtin_amdgcn_readlane(cv, 32 * h2);
                if (c > TK_HI) {
                    volatile LAS unsigned* qb = buf + (4 * mt + 2 * h2 + j) * TK_CAP;
                    int nk = 0;
                    unsigned V = topk_prune<2>(qb, hist, c, nk);
#ifdef XP_DUPPRUNE
                    V = topk_prune<2>(qb, hist, nk, nk);
#endif
                    if (nk > TK_HI - 64) V = topk_prune<4>(qb, hist, nk, nk);
#pragma unroll
                    for (int a = 0; a < 2; ++a)
#pragma unroll
                        for (int d = 0; d < 2; ++d)
                            if (hf == h2 && a == mt && d == j) { tau[a][d] = V; cnt[a][d] = nk; }
                }
            }
        }
#pragma unroll
        for (int sb = 0; sb < 2; ++sb)
#pragma unroll
            for (int ks = 0; ks < 4; ++ks) bfr[sb][ks] = bn[sb][ks];
    }
#pragma unroll 1
    for (int s8 = 0; s8 < 8; ++s8) {
        const int mt = s8 >> 2, j = (s8 >> 1) & 1, h2 = s8 & 1;
        const int cv = mt ? (j ? cnt[1][1] : cnt[1][0]) : (j ? cnt[0][1] : cnt[0][0]);
        int c = __builtin_amdgcn_readlane(cv, 32 * h2);
        volatile LAS unsigned* qb = buf + (4 * mt + 2 * h2 + j) * TK_CAP;
        if (c > 256) { int nk = 0; (void)topk_prune<4>(qb, hist, c, nk); c = nk; }
#pragma unroll
        for (int t = 0; t < 4; ++t) qb[256 + 4 * lane + t] = 0u;
        asm volatile("" ::: "memory");
#pragma unroll
        for (int t = 0; t < 4; ++t) {
            const int idx = lane + 64 * t;
            if (idx < c) {
                const unsigned e = qb[idx]; const unsigned kk = 8191u - (e & 8191u);
                __hip_atomic_fetch_or((LAS unsigned*)&qb[256 + (kk >> 5)], 1u << (kk & 31u), __ATOMIC_RELAXED, __HIP_MEMORY_SCOPE_WORKGROUP);
            }
        }
        asm volatile("" ::: "memory");
    }
    u64* mask = (u64*)(P.ws + OFF_MASK);
    const int ktmax = (q0 | 255) >> 6;
    const int qi = lane & 7;
#pragma unroll 1
    for (int it = 0; it < 16; ++it) {
        const int kt = it * 8 + (lane >> 3);
        if (kt <= ktmax) {
            const unsigned lo = buf[qi * TK_CAP + 256 + 2 * kt], hi = buf[qi * TK_CAP + 256 + 2 * kt + 1];
            mask[((size_t)(b * 128 + kt)) * NS + qbase + qi] = ((u64)hi << 32) | lo;
        }
    }
}

constexpr int AT_K = 64 * LROW;
constexpr int AT_DSTAGE = 4 * AT_K;
template <int NDB, bool BM>
DI void attn_tile(const LAS char* Kt, const LAS char* Vt, const bf16x8 (&qf)[4], f32x16 (&o)[NDB], float off, float& mlow, float& lrun,
                  int qpos, int k0, float c1, float c2, bool diag, bool scan, u64 mword) {
    const int lane = threadIdx.x & 63, l31 = lane & 31, hf = lane >> 5;
    const int lanex = ((((l31 >> 1) & 7) ^ hf) << 4);
    const LAS char* kbase = Kt + l31 * 128;
    const LAS char* vbase = Vt + l31 * 128;
    const float bias0 = -c2 * (float)(qpos - k0 - 4 * hf) - off;
#pragma unroll 1
    for (int kbi = 0; kbi < 2; ++kbi) {
        const int kb = 1 - kbi;
        f32x16 st;
#pragma unroll
        for (int i = 0; i < 16; ++i) st[i] = 0.f;
#pragma unroll
        for (int ks = 0; ks < 4; ++ks) {
            const bf16x8 kf = *(const LAS bf16x8*)(kbase + kb * 4096 + (lanex ^ (ks << 5)));
            st = MFMA32(kf, qf[ks], st);
        }
        const unsigned mw = BM ? (unsigned)((kb ? (unsigned)(mword >> 32) : (unsigned)mword) >> (4 * hf)) : 0u;
        const float noff = bias0 + c2 * (float)(32 * kb);
        float ls = 0.f, mx = -INFINITY;
#pragma unroll
        for (int i = 0; i < 16; ++i) {
            const int ko = (i & 3) + 8 * (i >> 2);
            const float v = __builtin_fmaf(st[i], c1, __builtin_fmaf(c2, (float)ko, noff));
            bool ok = true;
            if (BM) ok = (mw >> ko) & 1u;
            if (diag) ok = ok && (k0 + 32 * kb + ko + 4 * hf <= qpos);
            float p = __builtin_amdgcn_exp2f(v);
            if (BM || diag) p = ok ? p : 0.f;
            if (scan) mx = fmaxf(mx, (BM || diag) ? (ok ? v : -INFINITY) : v);
            st[i] = p; ls += p;
        }
#ifdef XP_DUPSOFTMAX
        {
            float ls2 = 0.f;
#pragma unroll
            for (int i = 0; i < 16; ++i) {
                const int ko = (i & 3) + 8 * (i >> 2);
                float x = st[i]; asm volatile("" : "+v"(x));
                const float v = __builtin_fmaf(x, c1, __builtin_fmaf(c2, (float)ko, noff));
                ls2 += __builtin_amdgcn_exp2f(v);
            }
            asm volatile("" : "+v"(ls2));
            ls += ls2 * 0.f;
        }
#endif
        lrun += ls;
        if (scan) { mx = fmaxf(mx, __shfl_xor(mx, 32)); mlow = fmaxf(mlow, mx + off); }
        const int vx = lanex ^ (kb << 6);
#pragma unroll
        for (int s = 0; s < 2; ++s) {
            u32x4 pp;
#pragma unroll
            for (int t = 0; t < 4; ++t) pp[t] = pk2(st[8 * s + 2 * t], st[8 * s + 2 * t + 1]);
            const bf16x8 pf = __builtin_bit_cast(bf16x8, pp);
#pragma unroll
            for (int db = 0; db < NDB; ++db) {
                const bf16x8 vf = *(const LAS bf16x8*)(vbase + db * 4096 + (vx ^ (s << 5)));
                o[db] = MFMA32(vf, pf, o[db]);
#ifdef XP_DUPMFMA
                { f32x16 z; for (int i = 0; i < 16; ++i) z[i] = 0.f; z = MFMA32(vf, pf, z); asm volatile("" : "+v"(z)); }
#endif
            }
        }
    }
}

constexpr int AT_NST = 4;

DI void diffattn_item(const Params& P, char* smem, int b, int h, int qb) {
    const int tid = threadIdx.x, lane = tid & 63, w = __builtin_amdgcn_readfirstlane(tid >> 6), l31 = lane & 31, hf = lane >> 5;
    const int map = w & 1, qsub = w >> 1;
    const int q0 = qb * 128;
    LAS char* lds = (LAS char*)smem;
    const bf16_t* Qd = (const bf16_t*)(P.ws + OFF_QD);
    const bf16_t* Kd = (const bf16_t*)(P.ws + OFF_KD);
    const bf16_t* VdT = (const bf16_t*)(P.ws + OFF_VDT);
    const int qpos = q0 + 32 * qsub + l31;
    bf16x8 qf[4];
#pragma unroll
    for (int ks = 0; ks < 4; ++ks) qf[ks] = *(const bf16x8*)(Qd + ((size_t)b * NS + qpos) * 512 + h * 128 + map * 64 + ks * 16 + hf * 8);
    const float slope = exp2f(-2.f * (float)(h + 1));
    const float c1 = 0.125f * LOG2E, c2 = slope * LOG2E;
    float gq = fabsf(P.dq_g[lane]), gk = fabsf(P.dk_g[lane]);
#pragma unroll
    for (int d = 32; d >= 1; d >>= 1) { gq = fmaxf(gq, __shfl_xor(gq, d)); gk = fmaxf(gk, __shfl_xor(gk, d)); }
    const float B2 = 64.f * gq * gk * 1.008f * c1;
    int* flags = (int*)(smem + SM_EXTRA + 3072);
    int par = 0;
    f32x16 o[4];
#pragma unroll
    for (int db = 0; db < 4; ++db)
#pragma unroll
        for (int i = 0; i < 16; ++i) o[db][i] = 0.f;
    float mlow = -INFINITY, lrun = 0.f;
    int ndone = 0;
    const int drow = 8 * w + (lane >> 3), dch = (lane & 7) ^ ((drow >> 1) & 7);
    const bf16_t* ksrc = Kd + ((size_t)b * NS + drow) * 512 + h * 128 + dch * 8;
    const bf16_t* vsrc = VdT + ((size_t)(b * 4 + h) * 128 + drow) * NS + dch * 8;
    auto dma = [&](int kt, int stage) {
        LAS char* stg = lds + stage * 32768;
        const size_t k0 = (size_t)kt * 64;
        __builtin_amdgcn_global_load_lds((const unsigned*)(ksrc + k0 * 512), (LAS unsigned*)(stg + w * 1024), 16, 0, 0);
        __builtin_amdgcn_global_load_lds((const unsigned*)(ksrc + k0 * 512 + 64), (LAS unsigned*)(stg + 8192 + w * 1024), 16, 0, 0);
        __builtin_amdgcn_global_load_lds((const unsigned*)(vsrc + k0), (LAS unsigned*)(stg + 16384 + w * 1024), 16, 0, 0);
        __builtin_amdgcn_global_load_lds((const unsigned*)(vsrc + (size_t)64 * NS + k0), (LAS unsigned*)(stg + 16384 + 8192 + w * 1024), 16, 0, 0);
    };
    const int ktd = 2 * qb + 1;
    const int qwmax = q0 + 32 * qsub + 31, qwmin = q0 + 32 * qsub;
    asm volatile("s_waitcnt vmcnt(0) lgkmcnt(0)" ::: "memory");
    __builtin_amdgcn_s_barrier();
    dma(max(ktd, 0), 0); dma(max(ktd - 1, 0), 1); dma(max(ktd - 2, 0), 2);
    for (int j = 0; j <= ktd; ++j) {
        const int kt = ktd - j, k0 = kt * 64;
        asm volatile("s_waitcnt vmcnt(8)" ::: "memory");
        asm volatile("s_waitcnt lgkmcnt(0)" ::: "memory");
        __builtin_amdgcn_s_barrier();
        int allstop = 0;
        if (j > 0) { allstop = 1;
#pragma unroll
            for (int i = 0; i < 8; ++i) allstop &= flags[(par ^ 1) * 8 + i]; }
        if (allstop) break;
#ifdef XP_STAGGER
        if (w >= 4) __builtin_amdgcn_s_sleep(XP_STAGGER);
#endif
        dma(max(kt - 3, 0), (j + 3) & 3);
        const LAS char* cur = lds + (j & 3) * 32768;
        if (k0 <= qwmax) {
            attn_tile<4, false>(cur + map * 8192, cur + 16384, qf, o, B2, mlow, lrun, qpos, k0, c1, c2, k0 + 63 > qwmin, ndone < 2, 0ull);
            ++ndone;
        }
        {
            const float ub = B2 - c2 * (float)(qpos - (k0 - 1));
            const bool stop = __all(ub < mlow - 40.f);
            if (lane == 0) flags[par * 8 + w] = stop ? 1 : 0;
        }
        par ^= 1;
    }
    asm volatile("s_waitcnt vmcnt(0) lgkmcnt(0)" ::: "memory");
    __builtin_amdgcn_s_barrier();
    const float ltot = lrun + __shfl_xor(lrun, 32);
    const float inv = 1.f / ltot;
    float la, lb;
    { const float a = P.lq1[lane] * P.lk1[lane], c = P.lq2[lane] * P.lk2[lane]; la = wave_sum(a); lb = wave_sum(c); }
    const float lam = __expf(la) - __expf(lb) + 0.2f;
    float* X = (float*)smem;
    if (map == 1) {
#pragma unroll
        for (int db = 0; db < 4; ++db)
#pragma unroll
            for (int q4 = 0; q4 < 4; ++q4) {
                f32x4 v;
#pragma unroll
                for (int r = 0; r < 4; ++r) v[r] = o[db][4 * q4 + r] * inv * lam;
                *(f32x4*)(X + (qsub * 32 + l31) * 132 + 32 * db + 8 * q4 + 4 * hf) = v;
            }
    }
    __syncthreads();
    if (map == 0) {
        float ss = 0.f;
#pragma unroll
        for (int db = 0; db < 4; ++db)
#pragma unroll
            for (int q4 = 0; q4 < 4; ++q4) {
                const f32x4 v2 = *(const f32x4*)(X + (qsub * 32 + l31) * 132 + 32 * db + 8 * q4 + 4 * hf);
#pragma unroll
                for (int r = 0; r < 4; ++r) { const float v = o[db][4 * q4 + r] * inv - v2[r]; o[db][4 * q4 + r] = v; ss += v * v; }
            }
        ss += __shfl_xor(ss, 32);
        const float rstd = rsqrtf(ss * (1.f / 128.f) + EPSF) * 0.8f;
        bf16_t* ao = (bf16_t*)(P.ws + OFF_H) + ((size_t)b * NS + qpos) * 1024 + h * 128;
#pragma unroll
        for (int db = 0; db < 4; ++db)
#pragma unroll
            for (int q4 = 0; q4 < 4; ++q4) {
                const int d = 32 * db + 8 * q4 + 4 * hf;
                const f32x4 g = *(const f32x4*)((const float*)(smem + SM_EXTRA + 1024) + d);
                u32x2 pk; pk[0] = pk2(o[db][4 * q4] * rstd * g[0], o[db][4 * q4 + 1] * rstd * g[1]); pk[1] = pk2(o[db][4 * q4 + 2] * rstd * g[2], o[db][4 * q4 + 3] * rstd * g[3]);
                *(u32x2*)(ao + d) = pk;
            }
    }
    __syncthreads();
}

DI void dsa_item(const Params& P, char* smem, int b, int h, int qb) {
    const int tid = threadIdx.x, lane = tid & 63, w = __builtin_amdgcn_readfirstlane(tid >> 6), l31 = lane & 31, hf = lane >> 5;
    const int q0 = qb * 256;
    LAS char* lds = (LAS char*)smem;
    const bf16_t* Qs = (const bf16_t*)(P.ws + OFF_QS);
    const bf16_t* Ks = (const bf16_t*)(P.ws + OFF_KS);
    const bf16_t* VsT = (const bf16_t*)(P.ws + OFF_VST);
    const u64* mask = (const u64*)(P.ws + OFF_MASK);
    const int qpos = q0 + 32 * w + l31;
    bf16x8 qf[4];
#pragma unroll
    for (int ks = 0; ks < 4; ++ks) qf[ks] = *(const bf16x8*)(Qs + ((size_t)b * NS + qpos) * 512 + h * 64 + ks * 16 + hf * 8);
    const float slope = exp2f(-(float)(h + 1));
    const float c1 = 0.125f * LOG2E, c2 = slope * LOG2E;
    float gq = fabsf(P.sq_g[lane]), gk = fabsf(P.sk_g[lane]);
#pragma unroll
    for (int d = 32; d >= 1; d >>= 1) { gq = fmaxf(gq, __shfl_xor(gq, d)); gk = fmaxf(gk, __shfl_xor(gk, d)); }
    const float B2 = 64.f * gq * gk * 1.008f * c1;
    int* flags = (int*)(smem + SM_EXTRA + 3072);
    int par = 0;
    f32x16 o[2];
#pragma unroll
    for (int db = 0; db < 2; ++db)
#pragma unroll
        for (int i = 0; i < 16; ++i) o[db][i] = 0.f;
    float mlow = -INFINITY, lrun = 0.f, off = 0.f;
    bool offset_set = false;
    const int drow = 8 * w + (lane >> 3), dch = (lane & 7) ^ ((drow >> 1) & 7);
    const bf16_t* ksrc = Ks + ((size_t)b * NS + drow) * 512 + h * 64 + dch * 8;
    const bf16_t* vsrc = VsT + ((size_t)(b * 8 + h) * 64 + drow) * NS + dch * 8;
    const u64* msrc = mask + (size_t)b * 128 * NS + q0 + (w & 1) * 128 + lane * 2;
    auto dma = [&](int kt, int stage) {
        LAS char* stg = lds + stage * 18432;
        const size_t k0 = (size_t)kt * 64;
        __builtin_amdgcn_global_load_lds((const unsigned*)(ksrc + k0 * 512), (LAS unsigned*)(stg + w * 1024), 16, 0, 0);
        __builtin_amdgcn_global_load_lds((const unsigned*)(vsrc + k0), (LAS unsigned*)(stg + 8192 + w * 1024), 16, 0, 0);
        if (w < 2) __builtin_amdgcn_global_load_lds((const unsigned*)(msrc + (size_t)kt * NS), (LAS unsigned*)(stg + 16384 + w * 1024), 16, 0, 0);
    };
    const int ktd = 4 * qb + 3;
    const int qwmax = q0 + 32 * w + 31;
    asm volatile("s_waitcnt vmcnt(0) lgkmcnt(0)" ::: "memory");
    __builtin_amdgcn_s_barrier();
    dma(max(ktd, 0), 0); dma(max(ktd - 1, 0), 1); dma(max(ktd - 2, 0), 2);
    for (int j = 0; j <= ktd; ++j) {
        const int kt = ktd - j, k0 = kt * 64;
        if (w < 2) asm volatile("s_waitcnt vmcnt(6)" ::: "memory"); else asm volatile("s_waitcnt vmcnt(4)" ::: "memory");
        asm volatile("s_waitcnt lgkmcnt(0)" ::: "memory");
        __builtin_amdgcn_s_barrier();
        int allstop = 0;
        if (j > 0) { allstop = 1;
#pragma unroll
            for (int i = 0; i < 8; ++i) allstop &= flags[(par ^ 1) * 8 + i]; }
        if (allstop) break;
#ifdef XP_STAGGER
        if (w >= 4) __builtin_amdgcn_s_sleep(XP_STAGGER);
#endif
        dma(max(kt - 3, 0), (j + 3) & 3);
        const LAS char* cur = lds + (j & 3) * 18432;
        u64 mword = 0ull;
        if (k0 <= qwmax) mword = *(const LAS u64*)(cur + 16384 + (32 * w + l31) * 8);
        if (k0 <= qwmax && __ballot(mword != 0ull) != 0ull) {
            if (!offset_set && mword != 0ull) { off = B2 - c2 * (float)max(qpos - (k0 + 63), 0); offset_set = true; }
            attn_tile<2, true>(cur, cur + 8192, qf, o, off, mlow, lrun, qpos, k0, c1, c2, false, __any(mlow == -INFINITY), mword);
        }
        {
            const float ub = B2 - c2 * (float)(qpos - (k0 - 1));
            const bool stop = __all(ub < mlow - 40.f);
            if (lane == 0) flags[par * 8 + w] = stop ? 1 : 0;
        }
        par ^= 1;
    }
    asm volatile("s_waitcnt vmcnt(0) lgkmcnt(0)" ::: "memory");
    __builtin_amdgcn_s_barrier();
    const float ltot = lrun + __shfl_xor(lrun, 32);
    const float inv = 1.f / ltot;
    bf16_t* ao = (bf16_t*)(P.ws + OFF_H) + ((size_t)b * NS + qpos) * 1024 + 512 + h * 64;
#pragma unroll
    for (int db = 0; db < 2; ++db)
#pragma unroll
        for (int q4 = 0; q4 < 4; ++q4) {
            const int d = 32 * db + 8 * q4 + 4 * hf;
            u32x2 pk; pk[0] = pk2(o[db][4 * q4] * inv, o[db][4 * q4 + 1] * inv); pk[1] = pk2(o[db][4 * q4 + 2] * inv, o[db][4 * q4 + 3] * inv);
            *(u32x2*)(ao + d) = pk;
        }
}

constexpr int P3_ITEMS = 128 * 8;
DI void phase_indexer(const Params& P, char* smem) {
    const XPart xp = xcd_part(P.ws, smem, P3_ITEMS);
    const int lo = xp.start - (xp.start % 1 ? 0 : 0);
    const int step = xp.step;
    const int rank = ((const int*)(smem + XC_LDS))[1];
    const int base = xp.start - rank;
    for (int k = 0; base + k * step < xp.end; ++k) {
        const int i = base + k * step + ((k & 1) ? step - 1 - rank : rank);
        if (i >= xp.end) continue;
        const int b = i >> 7, g = 127 - (i & 127);
        __syncthreads();
        indexer_item(P, smem, b, g * 64);
    }
    __syncthreads();
    (void)lo;
}
DI void phase_attn(const Params& P, char* smem, int qidx) {
    int* qctr = (int*)(P.ws + OFF_Q) + qidx;
    const int* items = (const int*)(P.ws + OFF_ITEMS);
    volatile int* s_it = (volatile int*)(smem + SM_EXTRA + 3200);
    __syncthreads();
    if (threadIdx.x < 128) ((float*)(smem + SM_EXTRA + 1024))[threadIdx.x] = P.subln_g[threadIdx.x];
    __syncthreads();
    for (;;) {
        __syncthreads();
        if (threadIdx.x == 0) *s_it = atomicAdd(qctr, 1);
        __syncthreads();
        const int it = *s_it;
        if (it >= ATT_ITEMS) break;
        const int code = items[it];
        const int b = (code >> 16) & 15, h = (code >> 8) & 255, qb = code & 255;
        if ((code >> 20) == 0) diffattn_item(P, smem, b, h, qb);
        else dsa_item(P, smem, b, h, qb);
    }
}

constexpr int OUTPROJ_ITEMS = (NT / 256) * 4;
DI void phase_outproj(const Params& P, char* smem) {
    const bf16_t* zrow = (const bf16_t*)(P.ws + OFF_ZROW);
    const bf16_t* ao = (const bf16_t*)(P.ws + OFF_H);
    const bf16_t* wout = (const bf16_t*)(P.ws + OFF_WOUT);
    bf16_t* mix = (bf16_t*)(P.ws + OFF_QD);
    const int lane = threadIdx.x & 63, w = threadIdx.x >> 6, wm = w >> 1, wn = w & 1, l31 = lane & 31, hf = lane >> 5;
    const XPart xp = xcd_part(P.ws, smem, OUTPROJ_ITEMS);
    for (int it = xp.start; it < xp.end; it += xp.step) {
        const int mt = it >> 2, j = it & 3;
        const int row0 = mt * 256;
        DenseRows ar{ao + (size_t)row0 * 1024, 1024};
        gemm_dma<true, 256>(smem, ar, wout + (size_t)j * 256 * 1024, 1024, 4, 1, zrow, [&](int, const f32x16 (&acc)[2][4]) {
#pragma unroll
            for (int mi = 0; mi < 2; ++mi)
#pragma unroll
                for (int pr = 0; pr < 2; ++pr) {
                    bf16_t* base = mix + ((size_t)row0 + 64 * wm + 32 * mi) * 1024 + 256 * j + 128 * wn + 64 * pr;
                    stage_store_chunk(smem, acc[mi][2 * pr], acc[mi][2 * pr + 1], [](int, int, float x) { return x; }, [&](int r) { return base + (size_t)r * 1024; });
                }
        });
    }
}
DI void phase_resnorm2(const Params& P) {
    const bf16_t* mix = (const bf16_t*)(P.ws + OFF_QD);
    const float* mod = (const float*)(P.ws + OFF_MOD);
    bf16_t* h2 = (bf16_t*)(P.ws + OFF_H2);
    const int lane = threadIdx.x & 63, w = threadIdx.x >> 6;
    for (int row = blockIdx.x * NW + w; row < NT; row += gridDim.x * NW) {
        const int b = row >> 13;
        const float* mb = mod + b * 6144;
        f32x4 v[4]; float ss = 0.f;
#pragma unroll
        for (int i = 0; i < 4; ++i) {
            const int col = 256 * i + 4 * lane;
            const f32x4 xv = *(const f32x4*)(P.x + (size_t)row * 1024 + col);
            const u32x2 mv = *(const u32x2*)(mix + (size_t)row * 1024 + col);
            const f32x4 g1 = *(const f32x4*)(mb + 2048 + col);
            v[i][0] = xv[0] + g1[0] * bflo(mv[0]); v[i][1] = xv[1] + g1[1] * bfhi(mv[0]);
            v[i][2] = xv[2] + g1[2] * bflo(mv[1]); v[i][3] = xv[3] + g1[3] * bfhi(mv[1]);
            *(f32x4*)(P.out + (size_t)row * 1024 + col) = v[i];
            ss += v[i][0] * v[i][0] + v[i][1] * v[i][1] + v[i][2] * v[i][2] + v[i][3] * v[i][3];
        }
        ss = wave_sum(ss);
        const float rstd = rsqrtf(ss * (1.f / 1024.f) + EPSF);
#pragma unroll
        for (int i = 0; i < 4; ++i) {
            const int col = 256 * i + 4 * lane;
            const f32x4 gg = *(const f32x4*)(P.norm2_g + col);
            const f32x4 sh = *(const f32x4*)(mb + 3072 + col);
            const f32x4 sc = *(const f32x4*)(mb + 4096 + col);
            float o[4];
#pragma unroll
            for (int j = 0; j < 4; ++j) o[j] = v[i][j] * rstd * gg[j] * (1.f + sc[j]) + sh[j];
            u32x2 pk; pk[0] = pk2(o[0], o[1]); pk[1] = pk2(o[2], o[3]);
            *(u32x2*)(h2 + (size_t)row * 1024 + col) = pk;
        }
    }
}

constexpr int ROUTER_ITEMS = NT / 256;
DI void phase_router(const Params& P, char* smem) {
    const bf16_t* zrow = (const bf16_t*)(P.ws + OFF_ZROW);
    const bf16_t* h2 = (const bf16_t*)(P.ws + OFF_H2);
    const bf16_t* wrt = (const bf16_t*)(P.ws + OFF_WRT);
    float* logits = (float*)(P.ws + OFF_Y);
    const int lane = threadIdx.x & 63, w = threadIdx.x >> 6, wm = w >> 1, wn = w & 1, l31 = lane & 31, hf = lane >> 5;
    for (int it = blockIdx.x; it < ROUTER_ITEMS; it += gridDim.x) {
        const int row0 = it * 256;
        DenseRows ar{h2 + (size_t)row0 * 1024, 1024};
        gemm_dma<true, 256>(smem, ar, wrt, 1024, 4, 1, zrow, [&](int, const f32x16 (&acc)[2][4]) {
#pragma unroll
            for (int mi = 0; mi < 2; ++mi) {
                const size_t tok = (size_t)row0 + 64 * wm + 32 * mi + l31;
#pragma unroll
                for (int ni = 0; ni < 4; ++ni)
#pragma unroll
                    for (int q4 = 0; q4 < 4; ++q4) {
                        const int n = 128 * wn + 32 * ni + 8 * q4 + 4 * hf;
                        f32x4 ov = {acc[mi][ni][4 * q4], acc[mi][ni][4 * q4 + 1], acc[mi][ni][4 * q4 + 2], acc[mi][ni][4 * q4 + 3]};
                        *(f32x4*)(logits + tok * 256 + n) = ov;
                    }
            }
        });
    }
}

DI void phase_route(const Params& P) {
    const float* logits = (const float*)(P.ws + OFF_Y);
    int* cnt = (int*)(P.ws + OFF_CNT);
    int* list = (int*)(P.ws + OFF_LIST);
    int* eidx = (int*)(P.ws + OFF_EIDX);
    float* gates = (float*)(P.ws + OFF_GATE);
    const int lane = threadIdx.x & 63, w = threadIdx.x >> 6;
    const f32x4 bias = *(const f32x4*)(P.router_b + 4 * lane);
    for (int t = blockIdx.x * NW + w; t < NT; t += gridDim.x * NW) {
        const f32x4 lg = *(const f32x4*)(logits + (size_t)t * 256 + 4 * lane);
        float sc[4], cand[4];
#pragma unroll
        for (int i = 0; i < 4; ++i) { sc[i] = 1.f / (1.f + __expf(-lg[i])); cand[i] = sc[i] + bias[i]; }
        float t1 = fmaxf(cand[0], cand[1]), t2 = fminf(cand[0], cand[1]);
#pragma unroll
        for (int i = 2; i < 4; ++i) { const float v = cand[i]; t2 = fmaxf(t2, fminf(t1, v)); t1 = fmaxf(t1, v); }
#pragma unroll
        for (int d = 1; d < 8; d <<= 1) {
            const float o1 = __shfl_xor(t1, d), o2 = __shfl_xor(t2, d);
            const float n1 = fmaxf(t1, o1), n2 = fmaxf(fminf(t1, o1), fmaxf(t2, o2));
            t1 = n1; t2 = n2;
        }
        const float gs = t1 + t2;
        const int myg = lane >> 3;
        int rank = 0;
#pragma unroll
        for (int g = 0; g < 8; ++g) { const float sg = __shfl(gs, 8 * g); rank += (sg > gs || (sg == gs && g < myg)) ? 1 : 0; }
        if (rank >= 4) {
#pragma unroll
            for (int i = 0; i < 4; ++i) cand[i] = -INFINITY;
        }
        int sel[8]; float wv[8]; float wsum = 0.f;
#pragma unroll
        for (int k = 0; k < 8; ++k) {
            float bv = cand[0]; int bi = 0;
#pragma unroll
            for (int i = 1; i < 4; ++i) if (cand[i] > bv) { bv = cand[i]; bi = i; }
            int be = 4 * lane + bi;
#pragma unroll
            for (int d = 32; d >= 1; d >>= 1) {
                const float ov = __shfl_xor(bv, d); const int oe = __shfl_xor(be, d);
                if (ov > bv || (ov == bv && oe < be)) { bv = ov; be = oe; }
            }
            const int ol = be >> 2, oi = be & 3;
            float mys = (oi == 0) ? sc[0] : (oi == 1) ? sc[1] : (oi == 2) ? sc[2] : sc[3];
            const float ws_ = __shfl(mys, ol);
            if (lane == ol) {
#pragma unroll
                for (int i = 0; i < 4; ++i) if (i == oi) cand[i] = -INFINITY;
            }
            sel[k] = be; wv[k] = ws_; wsum += ws_;
        }
        const float rs = 2.5f / wsum;
        int my_e = 256; float my_g = 1.f;
#pragma unroll
        for (int k = 0; k < 8; ++k) if (lane == k) { my_e = sel[k]; my_g = wv[k] * rs; }
        const int c = t >> 14, tl = t & (CHUNK_T - 1);
        if (lane < 8) {
            eidx[(size_t)t * 8 + lane] = my_e; gates[(size_t)t * 8 + lane] = my_g;
            const int pos = atomicAdd(&cnt[c * NEXP1 + my_e], 1);
            list[((size_t)c * NEXP1 + my_e) * CHUNK_T + pos] = tl * NPAIR + lane;
        } else if (lane == 8) {
            list[((size_t)c * NEXP1 + 256) * CHUNK_T + tl] = tl * NPAIR + 8;
        }
    }
}

#ifndef MOE_BM
#define MOE_BM 256
#endif
constexpr int MOE_SH = MOE_BM == 256 ? 8 : 7;
DI int moe_build_tiles(const Params& P, char* smem, int c) {
    int* tstart = (int*)(smem + SM_EXTRA);
    int* wsum = (int*)(smem + SM_EXTRA + 1040);
    const int* cnt = (const int*)(P.ws + OFF_CNT) + c * NEXP1;
    const int e = threadIdx.x, lane = e & 63, w = e >> 6;
    __syncthreads();
    int n = 0, inc = 0;
    if (e < 256) {
        n = (cnt[e] + MOE_BM - 1) >> MOE_SH; inc = n;
#pragma unroll
        for (int d = 1; d < 64; d <<= 1) { const int t = __shfl_up(inc, d); if (lane >= d) inc += t; }
        if (lane == 63) wsum[w] = inc;
    }
    __syncthreads();
    if (e < 256) {
        int off = 0;
#pragma unroll
        for (int i = 0; i < 4; ++i) if (i < w) off += wsum[i];
        tstart[e] = off + inc - n;
        if (e == 255) { tstart[256] = off + inc; tstart[257] = off + inc + CHUNK_T / MOE_BM; }
    }
    __syncthreads();
    return tstart[NEXP1];
}
DI int moe_find_expert(const int* tstart, int tile) {
    int lo = 0, hi = NEXP1;
    while (hi - lo > 1) { const int mid = (lo + hi) >> 1; if (tstart[mid] <= tile) lo = mid; else hi = mid; }
    return lo;
}
struct GatherRows {
    static constexpr bool kDense = false;
    const bf16_t* base; int ld; const int* pid; int div;
    DI const bf16_t* operator()(int r) const { const int p = pid[r]; return p < 0 ? nullptr : base + (size_t)(p / div) * ld; }
};
DI int moe_wm(int w) { return MOE_BM == 256 ? (w >> 1) : (w >> 2); }
DI int moe_wn(int w) { return MOE_BM == 256 ? (w & 1) : (w & 3); }
DI void phase_moe_g1(const Params& P, char* smem, int c) {
    const bf16_t* zrow = (const bf16_t*)(P.ws + OFF_ZROW);
    const int total = moe_build_tiles(P, smem, c);
    const int* tstart = (const int*)(smem + SM_EXTRA);
    int* pid = (int*)(smem + SM_EXTRA + 1088);
    const int* cnt = (const int*)(P.ws + OFF_CNT) + c * NEXP1;
    const int* list = (const int*)(P.ws + OFF_LIST) + (size_t)c * NEXP1 * CHUNK_T;
    const bf16_t* h2 = (const bf16_t*)(P.ws + OFF_H2) + (size_t)c * CHUNK_T * 1024;
    const bf16_t* wgu = (const bf16_t*)(P.ws + OFF_WGU);
    bf16_t* act = (bf16_t*)(P.ws + OFF_ACT + (size_t)(c & 1) * ACT_BYTES);
    const int lane = threadIdx.x & 63, w = threadIdx.x >> 6, wm = moe_wm(w), wn = moe_wn(w), l31 = lane & 31, hf = lane >> 5;
    const XPart xp = xcd_part(P.ws, smem, total * 2);
    for (int it = xp.start; it < xp.end; it += xp.step) {
        const int tile = it >> 1, half = it & 1;
        const int e = moe_find_expert(tstart, tile), ti = tile - tstart[e];
        const int n = e < NEXP ? cnt[e] : CHUNK_T;
        __syncthreads();
        if (threadIdx.x < MOE_BM) { const int li = ti * MOE_BM + threadIdx.x; pid[threadIdx.x] = li < n ? list[(size_t)e * CHUNK_T + li] : -1; }
        __syncthreads();
        GatherRows ar{h2, 1024, pid, NPAIR};
#if MOE_BM == 256
        gemm_dma<true, 256>(smem, ar, wgu + ((size_t)e * 512 + half * 256) * 1024, 1024, 4, 1, zrow, [&](int, const f32x16 (&acc)[2][4]) {
#pragma unroll
            for (int mi = 0; mi < 2; ++mi) {
                f32x16 t0, t1;
#pragma unroll
                for (int i = 0; i < 16; ++i) { t0[i] = silu_f(acc[mi][0][i]) * acc[mi][1][i]; t1[i] = silu_f(acc[mi][2][i]) * acc[mi][3][i]; }
                const int* prow = pid + 64 * wm + 32 * mi;
                bf16_t* abase = act + 128 * half + 64 * wn;
                stage_store_chunk(smem, t0, t1, [](int, int, float x) { return x; }, [&](int r) { const int pp = prow[r]; return pp >= 0 ? abase + (size_t)pp * 256 : (bf16_t*)nullptr; });
            }
        });
#else
        gemm_dma<true, 128>(smem, ar, wgu + ((size_t)e * 512 + half * 256) * 1024, 1024, 4, 1, zrow, [&](int, const f32x16 (&acc)[2][2]) {
#pragma unroll
            for (int mi = 0; mi < 2; ++mi) {
                const int p = pid[64 * wm + 32 * mi + l31];
                if (p >= 0) {
                    bf16_t* arow_ = act + (size_t)p * 256 + 128 * half + 32 * wn;
#pragma unroll
                    for (int q4 = 0; q4 < 4; ++q4) {
                        float o[4];
#pragma unroll
                        for (int r = 0; r < 4; ++r) { const float g = acc[mi][0][4 * q4 + r], u = acc[mi][1][4 * q4 + r]; o[r] = silu_f(g) * u; }
                        u32x2 pk; pk[0] = pk2(o[0], o[1]); pk[1] = pk2(o[2], o[3]);
                        *(u32x2*)(arow_ + 8 * q4 + 4 * hf) = pk;
                    }
                }
            }
        });
#endif
    }
}
#ifdef G2_FULLROW
#define G2_NSUB 4
#else
#define G2_NSUB 2
#endif
DI void phase_moe_g2(const Params& P, char* smem, int c) {
    const bf16_t* zrow = (const bf16_t*)(P.ws + OFF_ZROW);
    const int total = moe_build_tiles(P, smem, c);
    const int* tstart = (const int*)(smem + SM_EXTRA);
    int* pid = (int*)(smem + SM_EXTRA + 1088);
    float* gsm = (float*)(smem + SM_EXTRA + 2112);
    const int* cnt = (const int*)(P.ws + OFF_CNT) + c * NEXP1;
    const int* list = (const int*)(P.ws + OFF_LIST) + (size_t)c * NEXP1 * CHUNK_T;
    const float* gates = (const float*)(P.ws + OFF_GATE) + (size_t)c * CHUNK_T * 8;
    const bf16_t* wd = (const bf16_t*)(P.ws + OFF_WD);
    const bf16_t* act = (const bf16_t*)(P.ws + OFF_ACT + (size_t)(c & 1) * ACT_BYTES);
    bf16_t* y = (bf16_t*)(P.ws + OFF_Y);
    const int lane = threadIdx.x & 63, w = threadIdx.x >> 6, wm = moe_wm(w), wn = moe_wn(w), l31 = lane & 31;
#ifdef G2_FULLROW
    const XPart xp = xcd_part(P.ws, smem, total);
    for (int it = xp.start; it < xp.end; it += xp.step) {
        const int tile = it, half = 0;
#else
    const XPart xp = xcd_part(P.ws, smem, total * 2);
    for (int it = xp.start; it < xp.end; it += xp.step) {
        const int tile = it >> 1, half = it & 1;
#endif
        const int e = moe_find_expert(tstart, tile), ti = tile - tstart[e];
        const int n = e < NEXP ? cnt[e] : CHUNK_T;
        __syncthreads();
        if (threadIdx.x < MOE_BM) {
            const int li = ti * MOE_BM + threadIdx.x; const int pp = li < n ? list[(size_t)e * CHUNK_T + li] : -1;
            pid[threadIdx.x] = pp;
            float g = 1.f;
            if (pp >= 0 && (pp % NPAIR) < 8) g = gates[(size_t)(pp / NPAIR) * 8 + (pp % NPAIR)];
            gsm[threadIdx.x] = g;
        }
        __syncthreads();
        GatherRows ar{act, 256, pid, 1};
#if MOE_BM == 256
        gemm_dma<true, 256>(smem, ar, wd + ((size_t)e * 1024 + half * 512) * 256, 256, 2, G2_NSUB, zrow, [&](int t, const f32x16 (&acc)[2][4]) {
#pragma unroll
            for (int mi = 0; mi < 2; ++mi) {
                const float g = gsm[64 * wm + 32 * mi + l31];
                const int* prow = pid + 64 * wm + 32 * mi;
#pragma unroll
                for (int pr = 0; pr < 2; ++pr) {
                    const int cb = half * 512 + t * 256 + 128 * wn + 64 * pr;
                    stage_store_chunk(smem, acc[mi][2 * pr], acc[mi][2 * pr + 1], [&](int, int, float x) { return x * g; }, [&](int r) { const int pp = prow[r]; return pp >= 0 ? y + (size_t)pp * 1024 + cb : (bf16_t*)nullptr; });
                }
            }
        });
#else
        gemm_dma<true, 128>(smem, ar, wd + ((size_t)e * 1024 + half * 512) * 256, 256, 2, 2, zrow, [&](int t, const f32x16 (&acc)[2][2]) {
            const int cb = half * 512 + t * 256 + 64 * wn;
#pragma unroll
            for (int mi = 0; mi < 2; ++mi) {
                const float g = gsm[64 * wm + 32 * mi + l31];
                const int* prow = pid + 64 * wm + 32 * mi;
                stage_store_chunk(smem, acc[mi][0], acc[mi][1], [&](int, int, float x) { return x * g; }, [&](int r) { const int pp = prow[r]; return pp >= 0 ? y + (size_t)pp * 1024 + cb : (bf16_t*)nullptr; });
            }
        });
#endif
    }
}
DI void phase_moe_combine(const Params& P, int c) {
    const bf16_t* y = (const bf16_t*)(P.ws + OFF_Y);
    const float* mod = (const float*)(P.ws + OFF_MOD);
    const int lane = threadIdx.x & 63, w = threadIdx.x >> 6;
    for (int tl = blockIdx.x * NW + w; tl < CHUNK_T; tl += gridDim.x * NW) {
        const size_t t = (size_t)c * CHUNK_T + tl;
        const int b = (int)(t >> 13);
        const float* g2 = mod + b * 6144 + 5120;
#pragma unroll
        for (int i = 0; i < 4; ++i) {
            const int col = 256 * i + 4 * lane;
            float s[4] = {0.f, 0.f, 0.f, 0.f};
#pragma unroll
            for (int k = 0; k < NPAIR; ++k) {
                const u32x2 v = *(const u32x2*)(y + ((size_t)tl * NPAIR + k) * 1024 + col);
                s[0] += bflo(v[0]); s[1] += bfhi(v[0]); s[2] += bflo(v[1]); s[3] += bfhi(v[1]);
            }
            const f32x4 xv = *(const f32x4*)(P.out + t * 1024 + col);
            const f32x4 gv = *(const f32x4*)(g2 + col);
            f32x4 ov;
#pragma unroll
            for (int r = 0; r < 4; ++r) ov[r] = xv[r] + gv[r] * s[r];
            *(f32x4*)(P.out + t * 1024 + col) = ov;
        }
    }
}

constexpr int NPHASE = 18;
template <int PH, int REP = 0> DI void run_phase(const Params& Pin, char* smem) {
    Params P = Pin;
    { typedef __attribute__((address_space(1))) char gchar; gchar* g = (gchar*)Pin.ws; asm volatile("" : "+s"(g)); P.ws = (char*)g; }
    float* mod = (float*)(P.ws + OFF_MOD);
    if constexpr (PH == 0) phase_adaln(P, smem);
    else if constexpr (PH == 1) { phase_norm(P.x, P.norm1_g, mod, 0, 1024, (bf16_t*)(P.ws + OFF_H)); phase_convert(P, smem); }
    else if constexpr (PH == 2) phase_inproj(P, smem);
    else if constexpr (PH == 3) phase_indexer(P, smem);
    else if constexpr (PH == 4) phase_attn(P, smem, REP);
    else if constexpr (PH == 5) phase_outproj(P, smem);
    else if constexpr (PH == 6) phase_resnorm2(P);
    else if constexpr (PH == 7) phase_router(P, smem);
    else if constexpr (PH == 8) phase_route(P);
    else if constexpr (PH == 9) phase_moe_g1(P, smem, 0);
    else if constexpr (PH == 10) { phase_moe_g2(P, smem, 0); phase_moe_g1(P, smem, 1); }
    else if constexpr (PH == 11) phase_moe_combine(P, 0);
    else if constexpr (PH == 12) { phase_moe_g2(P, smem, 1); phase_moe_g1(P, smem, 2); }
    else if constexpr (PH == 13) phase_moe_combine(P, 1);
    else if constexpr (PH == 14) { phase_moe_g2(P, smem, 2); phase_moe_g1(P, smem, 3); }
    else if constexpr (PH == 15) phase_moe_combine(P, 2);
    else if constexpr (PH == 16) phase_moe_g2(P, smem, 3);
    else if constexpr (PH == 17) phase_moe_combine(P, 3);
}
#ifndef DUP_PHASE
#define DUP_PHASE -1
#endif
#ifndef PROBE_PHASE
#define PROBE_PHASE -1
#endif
#ifndef PROBE_SCALE
#define PROBE_SCALE 0.1f
#endif
#define MK_RUN(PH) if constexpr (P0 <= PH && PH < P1) { \
    unsigned long long t0_ = 0; if constexpr (PH == PROBE_PHASE) t0_ = __builtin_amdgcn_s_memrealtime(); \
    run_phase<PH>(P, smem); if constexpr (PH == DUP_PHASE) { xcd_barrier(bar); run_phase<PH, 1>(P, smem); } \
    if constexpr (PH + 1 < P1 || PH == PROBE_PHASE) xcd_barrier(bar); \
    if constexpr (PH == PROBE_PHASE) { if (blockIdx.x == 0 && threadIdx.x == 0) *(volatile unsigned*)(P.ws + OFF_ERR + 512) = (unsigned)(__builtin_amdgcn_s_memrealtime() - t0_); } }
template <int P0, int P1>
__global__ void __launch_bounds__(NTH, 2) mk_kernel(Params P) {
    __shared__ __attribute__((aligned(16))) char smem[SMEM_BYTES + 16];
    if (threadIdx.x == 0) {
        *(uint4*)(smem + SMEM_BYTES) = make_uint4(0u, 0u, 0u, 0u);
        const int x = (int)xb_xcc_id();
        ((int*)(smem + XC_LDS))[0] = x;
        ((int*)(smem + XC_LDS))[1] = atomicAdd((int*)(P.ws + OFF_XRANK) + x, 1);
    }
    __syncthreads();
    XcdBarrier bar;
    if constexpr (P1 - P0 > 1 || PROBE_PHASE >= 0) bar = xcd_barrier_post((unsigned*)(P.ws + OFF_BAR), (volatile LAS unsigned*)(LAS char*)(smem + SMEM_BYTES));
    MK_RUN(0) MK_RUN(1) MK_RUN(2) MK_RUN(3) MK_RUN(4) MK_RUN(5) MK_RUN(6) MK_RUN(7) MK_RUN(8)
    MK_RUN(9) MK_RUN(10) MK_RUN(11) MK_RUN(12) MK_RUN(13) MK_RUN(14) MK_RUN(15) MK_RUN(16) MK_RUN(17)
    if constexpr (PROBE_PHASE >= 0) {
        xcd_barrier(bar);
        const float us = (float)(*(volatile unsigned*)(P.ws + OFF_ERR + 512)) * 0.01f;
        const float cval = sqrtf(us * PROBE_SCALE);
        for (size_t i = (size_t)blockIdx.x * NTH + threadIdx.x; i < (size_t)NT * 1024 / 4; i += (size_t)gridDim.x * NTH) ((f32x4*)P.out)[i] = (f32x4){cval, cval, cval, cval};
    }
}

template <int P0, int P1> static void launch_range(const Params& p, hipStream_t stream) {
    static int grid = 0;
    if (!grid) {
        int dev = 0, cus = 0, per_cu = 0;
        (void)hipGetDevice(&dev);
        (void)hipDeviceGetAttribute(&cus, hipDeviceAttributeMultiprocessorCount, dev);
        (void)(void)hipOccupancyMaxActiveBlocksPerMultiprocessor(&per_cu, mk_kernel<P0, P1>, NTH, 0);
        if (cus <= 0) cus = 256;
        if (per_cu < 1) per_cu = 1;
        grid = cus * (per_cu < 1 ? 1 : 1);
    }
    mk_kernel<P0, P1><<<dim3(grid), dim3(NTH), 0, stream>>>(p);
}

extern "C" void kernel_launch(void* const* d_in, const int* in_sizes, int n_in, void* d_out, int out_size, void* d_ws, size_t ws_size, hipStream_t stream) {
    if (ws_size < WS_NEED) return;
    if (ws_size < WS_NEED) return;
    Params p{};
    const float** f = (const float**)&p;
    for (int i = 0; i < 26; ++i) f[i] = (const float*)d_in[i];
    p.out = (float*)d_out;
    p.ws = (char*)d_ws;
    (void)hipMemsetAsync(d_ws, 0, ZERO_BYTES, stream);
#if MK_ONE_LAUNCH
    launch_range<0, NPHASE>(p, stream);
#else
    launch_range<0, 1>(p, stream); launch_range<1, 2>(p, stream); launch_range<2, 3>(p, stream); launch_range<3, 4>(p, stream);
    launch_range<4, 5>(p, stream); launch_range<5, 6>(p, stream); launch_range<6, 7>(p, stream); launch_range<7, 8>(p, stream);
    launch_range<8, 9>(p, stream); launch_range<9, 10>(p, stream); launch_range<10, 11>(p, stream); launch_range<11, 12>(p, stream);
    launch_range<12, 13>(p, stream); launch_range<13, 14>(p, stream); launch_range<14, 15>(p, stream); launch_range<15, 16>(p, stream);
    launch_range<16, 17>(p, stream); launch_range<17, 18>(p, stream);
#endif
}
```

```cpp
#include <hip/hip_runtime.h>
#include <stdint.h>

#define DI __device__ __forceinline__
#define LAS __attribute__((address_space(3)))
typedef unsigned short bf16_t;
typedef short bf16x8 __attribute__((ext_vector_type(8)));
typedef short s16x4 __attribute__((ext_vector_type(4)));
typedef float f32x16 __attribute__((ext_vector_type(16)));
typedef float f32x4 __attribute__((ext_vector_type(4)));
typedef float f32x2 __attribute__((ext_vector_type(2)));
typedef __bf16 bf16v2 __attribute__((ext_vector_type(2)));
typedef unsigned u32x4 __attribute__((ext_vector_type(4)));
typedef unsigned u32x2 __attribute__((ext_vector_type(2)));
typedef unsigned long long u64;
#define MFMA32(a, b, c) __builtin_amdgcn_mfma_f32_32x32x16_bf16((a), (b), (c), 0, 0, 0)

constexpr int NB = 8, NS = 8192, ND = 1024, NT = NB * NS;
constexpr int IN_COLS = 3656, NPAD = 3840;
constexpr int NTH = 512, NW = 8;
constexpr int NEXP = 256, NEXP1 = 257;
constexpr int NCHUNK = 4, CHUNK_T = NT / NCHUNK;
constexpr int NPAIR = 9;
constexpr float EPSF = 1e-6f;
constexpr float LOG2E = 1.4426950408889634f;

constexpr size_t MiB = 1048576;
constexpr size_t OFF_BAR = 0;
constexpr size_t OFF_MOD = 16384;
constexpr size_t OFF_CNT = OFF_MOD + 196608;
constexpr size_t OFF_ERR = OFF_CNT + 8192;
constexpr size_t OFF_Q = OFF_ERR;
constexpr size_t OFF_XRANK = OFF_ERR + 128;
constexpr size_t OFF_XQ = OFF_ERR + 256;
constexpr size_t OFF_ITEMS = OFF_ERR + 1024;
constexpr size_t OFF_ZROW = 245760;
constexpr size_t ZERO_BYTES = 262144;
constexpr size_t OFF_WIN = 1 * MiB;
constexpr size_t OFF_WOUT = OFF_WIN + (size_t)NPAD * 1024 * 2;
constexpr size_t OFF_WRT = OFF_WOUT + 2 * MiB;
constexpr size_t OFF_WGU = 12 * MiB;
constexpr size_t OFF_WD = OFF_WGU + (size_t)NEXP1 * 512 * 1024 * 2;
constexpr size_t OFF_R1 = OFF_WD + (size_t)NEXP1 * 1024 * 256 * 2;
constexpr size_t OFF_H = OFF_R1;
constexpr size_t OFF_QD = OFF_H + 128 * MiB;
constexpr size_t OFF_KD = OFF_QD + 64 * MiB;
constexpr size_t OFF_VDT = OFF_KD + 64 * MiB;
constexpr size_t OFF_QS = OFF_VDT + 64 * MiB;
constexpr size_t OFF_KS = OFF_QS + 64 * MiB;
constexpr size_t OFF_VST = OFF_KS + 64 * MiB;
constexpr size_t OFF_IQ = OFF_VST + 64 * MiB;
constexpr size_t OFF_IK = OFF_IQ + 64 * MiB;
constexpr size_t OFF_IW = OFF_IK + 8 * MiB;
constexpr size_t OFF_MASK = OFF_IW + 2 * MiB;
constexpr size_t END_A = OFF_MASK + 64 * MiB;
constexpr size_t OFF_H2 = OFF_R1;
constexpr size_t OFF_LIST = OFF_H2 + 128 * MiB;
constexpr size_t OFF_EIDX = OFF_LIST + (size_t)NCHUNK * NEXP1 * CHUNK_T * 4;
constexpr size_t OFF_GATE = OFF_EIDX + 2 * MiB;
constexpr size_t OFF_ACT = OFF_GATE + 2 * MiB;
constexpr size_t ACT_BYTES = (size_t)CHUNK_T * NPAIR * 256 * 2;
constexpr size_t OFF_Y = OFF_ACT + 2 * ACT_BYTES;
constexpr size_t END_B = OFF_Y + (size_t)CHUNK_T * NPAIR * 1024 * 2;
constexpr size_t WS_NEED = END_A > END_B ? END_A : END_B;

struct Params {
    const float *x, *c, *ada_w, *ada_b, *norm1_g, *norm2_g, *w_in, *dq_g, *dk_g, *lq1, *lk1, *lq2, *lk2, *subln_g, *sq_g, *sk_g, *ik_g,
        *w_out, *router_w, *router_b, *ew_gate, *ew_up, *ew_down, *sw_gate, *sw_up, *sw_down;
    float* out;
    char* ws;
};

DI unsigned pk2(float a, float b) { f32x2 f = {a, b}; bf16v2 r = __builtin_convertvector(f, bf16v2); return __builtin_bit_cast(unsigned, r); }
DI float bf2f(bf16_t v) { return __uint_as_float(((unsigned)v) << 16); }
DI float bflo(unsigned u) { return __uint_as_float(u << 16); }
DI float bfhi(unsigned u) { return __uint_as_float(u & 0xffff0000u); }
DI int crow(int i, int hf) { return (i & 3) + 8 * (i >> 2) + 4 * hf; }
constexpr int LROW = 144;
DI int lofs(int row, int chunk) { return row * LROW + chunk * 16; }
DI float wave_sum(float v) {
#pragma unroll
    for (int d = 32; d >= 1; d >>= 1) v += __shfl_xor(v, d);
    return v;
}
DI float silu_f(float v) { return v / (1.f + __expf(-v)); }

#define XB_TMO      128
#define XB_XCNT(j)  (256  + 64 * (j))
#define XB_XSUB(j)  (1280 + 64 * (j))
#define XB_XGEN(j)  (2304 + 64 * (j))
#define XB_TOP      3328
#define XB_TOPGEN   3392
#define XCD_BAR_WORDS 3456
#define XB_SPIN_CAP (1u << 18)

__device__ __forceinline__ unsigned xb_ld(unsigned* p)              { return __hip_atomic_load(p, __ATOMIC_RELAXED, __HIP_MEMORY_SCOPE_AGENT); }
__device__ __forceinline__ unsigned xb_add(unsigned* p, unsigned v) { return __hip_atomic_fetch_add(p, v, __ATOMIC_RELAXED, __HIP_MEMORY_SCOPE_AGENT); }
__device__ __forceinline__ unsigned xb_xcc_id() { return (unsigned)__builtin_amdgcn_s_getreg((3 << 11) | 20) & 0xFu; }
#define XB_SPIN(cond, bar) do { unsigned _sp = 0; while (cond) { __builtin_amdgcn_s_sleep(1); \
    if ((++_sp & 255u) == 0u) { if (xb_ld(&(bar)[XB_TMO])) break; if (_sp > XB_SPIN_CAP) { atomicAdd(&(bar)[XB_TMO], 1u); break; } } } } while (0)

struct XcdBarrier {
    unsigned* bar; unsigned x;
    volatile LAS unsigned* st;
};
__device__ __forceinline__ XcdBarrier xcd_barrier_post(unsigned* bar, volatile LAS unsigned* st) {
    XcdBarrier b; b.bar = bar; b.x = xb_xcc_id(); b.st = st;
    if (threadIdx.x == 0) (void)xb_add(&bar[XB_XCNT(b.x)], 1u);
    return b;
}
__device__ __forceinline__ void xcd_barrier_complete(unsigned* bar, unsigned x, unsigned& nloc, unsigned& nx) {
    const unsigned G = gridDim.x * gridDim.y * gridDim.z;
    unsigned sum, cnt, mine, sp = 0u;
    for (;;) {
        sum = 0u; cnt = 0u; mine = 0u;
#pragma unroll
        for (unsigned j = 0; j < 16; ++j) { const unsigned c = xb_ld(&bar[XB_XCNT(j)]); sum += c; cnt += (c > 0u) ? 1u : 0u; mine = (j == x) ? c : mine; }
        if (sum == G) break;
        __builtin_amdgcn_s_sleep(1);
        if ((++sp & 255u) == 0u) { if (xb_ld(&bar[XB_TMO])) break; if (sp > XB_SPIN_CAP) { atomicAdd(&bar[XB_TMO], 1u); break; } }
    }
    nloc = mine > 0u ? mine : 1u; nx = cnt > 0u ? cnt : 1u;
}
__device__ __forceinline__ void xcd_barrier(const XcdBarrier& b) {
    asm volatile("s_waitcnt vmcnt(0)" ::: "memory");
    __syncthreads();
    if (threadIdx.x == 0) {
        unsigned* bar = b.bar;
        __builtin_amdgcn_s_waitcnt(0);
        unsigned nloc = b.st[0], nx = b.st[1];
        if (nloc == 0u) { xcd_barrier_complete(bar, b.x, nloc, nx); b.st[0] = nloc; b.st[1] = nx; }
        const unsigned old = xb_add(&bar[XB_XSUB(b.x)], 1u);
        const unsigned gen = old / nloc;
        if (old + 1u == (gen + 1u) * nloc) {
            __builtin_amdgcn_fence(__ATOMIC_RELEASE, "agent");
            asm volatile("s_waitcnt vmcnt(0)" ::: "memory");
            const unsigned og = xb_add(&bar[XB_TOP], 1u);
            const unsigned tg = og / nx;
            if (og + 1u == (tg + 1u) * nx) xb_add(&bar[XB_TOPGEN], 1u);
            else XB_SPIN(xb_ld(&bar[XB_TOPGEN]) == tg, bar);
            __builtin_amdgcn_fence(__ATOMIC_ACQUIRE, "agent");
            xb_add(&bar[XB_XGEN(b.x)], 1u);
            asm volatile("s_waitcnt vmcnt(0)" ::: "memory");
        } else {
            XB_SPIN(xb_ld(&bar[XB_XGEN(b.x)]) == gen, bar);
            __builtin_amdgcn_fence(__ATOMIC_ACQUIRE, "agent");
            asm volatile("s_waitcnt vmcnt(0)" ::: "memory");
        }
    }
    __syncthreads();
}

struct XPart { int start, step, end, grp, ngrp; };
constexpr int XC_LDS = 2 * 2 * 256 * 144 + 3584;
DI XPart xcd_part(const char* ws, const char* smem, int N) {
    const int x = ((const int*)(smem + XC_LDS))[0], r = ((const int*)(smem + XC_LDS))[1];
    const int* xc = (const int*)(ws + OFF_XRANK);
    int pre = 0, mine = 1, G = 0, grp = 0, ngrp = 0;
#pragma unroll
    for (int j = 0; j < 16; ++j) { const int c = xc[j]; if (j < x) { pre += c; grp += c > 0; } if (j == x) mine = c; G += c; ngrp += c > 0; }
    if (mine < 1) mine = 1; if (G < 1) G = 1;
    const long lo = (long)N * pre / G, hi = (long)N * (pre + mine) / G;
    XPart p; p.start = (int)lo + r; p.step = mine; p.end = (int)hi; p.grp = grp; p.ngrp = ngrp; return p;
}

constexpr int GT_B = 256 * LROW;
constexpr int GT_STAGE = 2 * 256 * LROW;
constexpr int SM_EXTRA = 2 * GT_STAGE;
constexpr int SMEM_BYTES = SM_EXTRA + 4096;
#define MK_ONE_LAUNCH 1


constexpr int ATT_ITEMS = 4096;
DI int attn_item_cost(int type, int h, int qb) {
    if (type == 0) { const int win = h == 0 ? 2 : h == 1 ? 7 : h == 2 ? 28 : 109; const int tiles = min(2 * qb + 2, win + 2); return (tiles * 6) / 4; }
    const int win = h == 0 ? 1 : h == 1 ? 2 : h == 2 ? 4 : h == 3 ? 7 : h == 4 ? 14 : h == 5 ? 28 : h == 6 ? 55 : 109;
    const int tiles = min(4 * qb + 4, win + 4); return (tiles * 5) / 4;
}
DI int attn_item_code(int i) {
    if (i < 2048) { const int qb = i & 63, h = (i >> 6) & 3, b = i >> 8; return (b << 16) | (h << 8) | qb; }
    const int j = i - 2048; const int qb = j & 31, h = (j >> 5) & 7, b = j >> 8; return (1 << 20) | (b << 16) | (h << 8) | qb;
}
DI void build_attn_items(const Params& P, char* smem) {
    int* hist = (int*)smem;
    int* wsum = hist + 256;
    int* items = (int*)(P.ws + OFF_ITEMS);
    const int tid = threadIdx.x, lane = tid & 63, w = tid >> 6;
    __syncthreads();
    if (tid < 256) hist[tid] = 0;
    __syncthreads();
    for (int i = tid; i < ATT_ITEMS; i += NTH) { const int c = attn_item_code(i); atomicAdd(&hist[255 - min(255, attn_item_cost(c >> 20, (c >> 8) & 255, c & 255))], 1); }
    __syncthreads();
    int n = 0, inc = 0;
    if (tid < 256) {
        n = hist[tid]; inc = n;
#pragma unroll
        for (int d = 1; d < 64; d <<= 1) { const int t = __shfl_up(inc, d); if (lane >= d) inc += t; }
        if (lane == 63) wsum[w] = inc;
    }
    __syncthreads();
    if (tid < 256) {
        int off = 0;
#pragma unroll
        for (int i = 0; i < 4; ++i) if (i < w) off += wsum[i];
        hist[tid] = off + inc - n;
    }
    __syncthreads();
    for (int i = tid; i < ATT_ITEMS; i += NTH) {
        const int c = attn_item_code(i);
        const int pos = atomicAdd(&hist[255 - min(255, attn_item_cost(c >> 20, (c >> 8) & 255, c & 255))], 1);
        items[pos] = c;
    }
    __syncthreads();
}

DI void phase_adaln(const Params& P, char* smem) {
    float* mod = (float*)(P.ws + OFF_MOD);
    float* sc = (float*)smem;
    float* red = sc + 8192;
    const int tid = threadIdx.x;
    if (blockIdx.x == 0) build_attn_items(P, smem);
    __syncthreads();
    for (int i = tid; i < 8192; i += NTH) sc[i] = silu_f(P.c[i]);
    __syncthreads();
    const int kg = tid >> 4, cn = tid & 15;
    for (int it = blockIdx.x; it < 384; it += gridDim.x) {
        const int n = it * 16 + cn;
        float acc[8];
#pragma unroll
        for (int b = 0; b < 8; ++b) acc[b] = 0.f;
#pragma unroll 8
        for (int kk = 0; kk < 32; ++kk) {
            const int k = kg * 32 + kk;
            const float w = P.ada_w[(size_t)k * 6144 + n];
#pragma unroll
            for (int b = 0; b < 8; ++b) acc[b] += sc[b * 1024 + k] * w;
        }
#pragma unroll
        for (int b = 0; b < 8; ++b) red[(kg * 8 + b) * 16 + cn] = acc[b];
        __syncthreads();
        if (tid < 128) {
            const int b = tid >> 4;
            float s = P.ada_b[n];
#pragma unroll
            for (int g = 0; g < 32; ++g) s += red[(g * 8 + b) * 16 + cn];
            mod[b * 6144 + n] = s;
        }
        __syncthreads();
    }
}

DI void phase_norm(const float* __restrict__ xin, const float* __restrict__ g, const float* __restrict__ mod, int sh_off, int sc_off, bf16_t* __restrict__ dst) {
    const int lane = threadIdx.x & 63, w = threadIdx.x >> 6;
    for (int row = blockIdx.x * NW + w; row < NT; row += gridDim.x * NW) {
        const int b = row >> 13;
        const float* xr = xin + (size_t)row * 1024;
        f32x4 v[4]; float ss = 0.f;
#pragma unroll
        for (int i = 0; i < 4; ++i) { v[i] = *(const f32x4*)(xr + 256 * i + 4 * lane); ss += v[i][0] * v[i][0] + v[i][1] * v[i][1] + v[i][2] * v[i][2] + v[i][3] * v[i][3]; }
        ss = wave_sum(ss);
        const float rstd = rsqrtf(ss * (1.f / 1024.f) + EPSF);
#pragma unroll
        for (int i = 0; i < 4; ++i) {
            const int col = 256 * i + 4 * lane;
            const f32x4 gg = *(const f32x4*)(g + col);
            const f32x4 sh = *(const f32x4*)(mod + b * 6144 + sh_off + col);
            const f32x4 sc = *(const f32x4*)(mod + b * 6144 + sc_off + col);
            float o[4];
#pragma unroll
            for (int j = 0; j < 4; ++j) o[j] = v[i][j] * rstd * gg[j] * (1.f + sc[j]) + sh[j];
            u32x2 pk; pk[0] = pk2(o[0], o[1]); pk[1] = pk2(o[2], o[3]);
            *(u32x2*)(dst + (size_t)row * 1024 + col) = pk;
        }
    }
}

DI int gu_row(int f, int is_up) { return (f >> 6) * 128 + (((f >> 5) & 1) * 2 + is_up) * 32 + (f & 31); }
struct CvtDesc { const float* src; bf16_t* dst; int ldsrc, nvalid, k0, n0, ldd, mode; };
constexpr int CVT_WIN = 16 * (NPAD / 64);
constexpr int CVT_SMALL = CVT_WIN + 256 + 64;
constexpr int CVT_ITEMS = CVT_SMALL + NEXP1 * 192;
DI CvtDesc cvt_desc(const Params& P, int it) {
    CvtDesc d;
    if (it < CVT_WIN) { d.src = P.w_in; d.ldsrc = IN_COLS; d.nvalid = IN_COLS; d.k0 = (it & 15) * 64; d.n0 = (it >> 4) * 64; d.dst = (bf16_t*)(P.ws + OFF_WIN); d.ldd = 1024; d.mode = 0; }
    else if (it < CVT_WIN + 256) { const int r = it - CVT_WIN; d.src = P.w_out; d.ldsrc = 1024; d.nvalid = 1024; d.k0 = (r & 15) * 64; d.n0 = (r >> 4) * 64; d.dst = (bf16_t*)(P.ws + OFF_WOUT); d.ldd = 1024; d.mode = 0; }
    else if (it < CVT_SMALL) { const int r = it - CVT_WIN - 256; d.src = P.router_w; d.ldsrc = 256; d.nvalid = 256; d.k0 = (r & 15) * 64; d.n0 = (r >> 4) * 64; d.dst = (bf16_t*)(P.ws + OFF_WRT); d.ldd = 1024; d.mode = 0; }
    else {
        const int r = it - CVT_SMALL, e = r / 192, sub = r % 192;
        if (sub < 128) {
            const int up = sub >> 6, s2 = sub & 63;
            d.src = e < NEXP ? (up ? P.ew_up : P.ew_gate) + (size_t)e * 1024 * 256 : (up ? P.sw_up : P.sw_gate);
            d.ldsrc = 256; d.nvalid = 256; d.k0 = (s2 & 15) * 64; d.n0 = (s2 >> 4) * 64; d.dst = (bf16_t*)(P.ws + OFF_WGU) + (size_t)e * 512 * 1024; d.ldd = 1024; d.mode = 1 + up;
        } else {
            const int s2 = sub - 128;
            d.src = e < NEXP ? P.ew_down + (size_t)e * 256 * 1024 : P.sw_down;
            d.ldsrc = 1024; d.nvalid = 1024; d.k0 = (s2 & 3) * 64; d.n0 = (s2 >> 2) * 64; d.dst = (bf16_t*)(P.ws + OFF_WD) + (size_t)e * 1024 * 256; d.ldd = 256; d.mode = 0;
        }
    }
    return d;
}
DI void phase_convert(const Params& P, char* smem) {
    float* t = (float*)smem;
    const int tid = threadIdx.x, G = gridDim.x;
    for (int it0 = blockIdx.x; it0 < CVT_ITEMS; it0 += 4 * G) {
        float v[4][8];
#pragma unroll
        for (int r = 0; r < 4; ++r) {
            const int it = it0 + r * G;
            if (it < CVT_ITEMS) {
                const CvtDesc d = cvt_desc(P, it);
#pragma unroll
                for (int i = 0; i < 8; ++i) {
                    const int idx = tid + NTH * i, kk = idx >> 6, nn = idx & 63;
                    v[r][i] = (d.n0 + nn < d.nvalid) ? d.src[(size_t)(d.k0 + kk) * d.ldsrc + d.n0 + nn] : 0.f;
                }
            } else {
#pragma unroll
                for (int i = 0; i < 8; ++i) v[r][i] = 0.f;
            }
        }
        __syncthreads();
#pragma unroll
        for (int r = 0; r < 4; ++r)
#pragma unroll
            for (int i = 0; i < 8; ++i) { const int idx = tid + NTH * i; t[r * 4160 + (idx >> 6) * 65 + (idx & 63)] = v[r][i]; }
        __syncthreads();
        const int nn = tid >> 3, kq = (tid & 7) * 8;
#pragma unroll
        for (int r = 0; r < 4; ++r) {
            const int it = it0 + r * G;
            if (it < CVT_ITEMS) {
                const CvtDesc d = cvt_desc(P, it);
                unsigned pk[4];
#pragma unroll
                for (int j = 0; j < 4; ++j) pk[j] = pk2(t[r * 4160 + (kq + 2 * j) * 65 + nn], t[r * 4160 + (kq + 2 * j + 1) * 65 + nn]);
                const int n = d.n0 + nn;
                const int drow = d.mode == 0 ? n : gu_row(n, d.mode - 1);
                *(u32x4*)(d.dst + (size_t)drow * d.ldd + d.k0 + kq) = (u32x4){pk[0], pk[1], pk[2], pk[3]};
            }
        }
    }
}

template <int BM> struct GemmGeo { static constexpr int NI = BM == 256 ? 4 : 2, WN = BM == 256 ? 2 : 4, AP = BM / 64; };
template <bool SWAP, int BM, class AFn, class Epi>
DI void gemm_stream(char* lds, AFn arow, const bf16_t* __restrict__ Bt, int ldb, int nksh, int nsub, Epi epi) {
    constexpr int NI = GemmGeo<BM>::NI, WN = GemmGeo<BM>::WN, AP = GemmGeo<BM>::AP;
    const int tid = threadIdx.x, lane = tid & 63, w = tid >> 6, wm = w / WN, wn = w % WN, l31 = lane & 31, hf = lane >> 5;
    const int nk = 1 << nksh, total = nsub << nksh;
    const int lrow = tid >> 3, lch = tid & 7;
    const bf16_t* ap[AP];
#pragma unroll
    for (int i = 0; i < AP; ++i) { const bf16_t* a = arow(lrow + 64 * i); ap[i] = a ? a + lch * 8 : nullptr; }
    const int so = lofs(lrow, lch);
    const bf16_t* bp = Bt + (size_t)lrow * ldb + lch * 8;
    const size_t bsub = (size_t)256 * ldb, brow64 = (size_t)64 * ldb;
    f32x16 acc[2][NI];
#pragma unroll
    for (int mi = 0; mi < 2; ++mi)
#pragma unroll
        for (int ni = 0; ni < NI; ++ni)
#pragma unroll
            for (int i = 0; i < 16; ++i) acc[mi][ni][i] = 0.f;
    u32x4 ra[AP], rb[4];
    const u32x4 z4 = {0u, 0u, 0u, 0u};
    auto load_part = [&](int s, int part) {
        const int t = s >> nksh, k0 = (s & (nk - 1)) * 64;
        const bf16_t* b0 = bp + t * bsub + k0;
        if (AP == 4) {
            if (part < 2) {
#pragma unroll
                for (int i = 0; i < 2; ++i) { const int q = 2 * part + i; ra[q] = ap[q] ? *(const u32x4*)(ap[q] + k0) : z4; }
            } else {
#pragma unroll
                for (int i = 0; i < 2; ++i) { const int q = 2 * (part - 2) + i; rb[q] = *(const u32x4*)(b0 + q * brow64); }
            }
        } else {
            if (part == 0) {
#pragma unroll
                for (int i = 0; i < AP; ++i) ra[i] = ap[i] ? *(const u32x4*)(ap[i] + k0) : z4;
            } else if (part < 3) {
#pragma unroll
                for (int i = 0; i < 2; ++i) { const int q = 2 * (part - 1) + i; rb[q] = *(const u32x4*)(b0 + q * brow64); }
            }
        }
    };
    auto store = [&](char* stg) {
#pragma unroll
        for (int i = 0; i < AP; ++i) *(u32x4*)(stg + so + i * 64 * LROW) = ra[i];
#pragma unroll
        for (int i = 0; i < 4; ++i) *(u32x4*)(stg + GT_B + so + i * 64 * LROW) = rb[i];
    };
    auto compute = [&](const char* cur, int snext) {
        const char* abase = cur + (64 * wm + l31) * LROW + hf * 16;
        const char* bbase = cur + GT_B + (32 * NI * wn + l31) * LROW + hf * 16;
#pragma unroll
        for (int ks = 0; ks < 4; ++ks) {
            bf16x8 af[2];
#pragma unroll
            for (int mi = 0; mi < 2; ++mi) af[mi] = *(const bf16x8*)(abase + mi * 32 * LROW + ks * 32);
#pragma unroll
            for (int nh = 0; nh < NI / 2; ++nh) {
                bf16x8 bfr[2];
#pragma unroll
                for (int n2 = 0; n2 < 2; ++n2) bfr[n2] = *(const bf16x8*)(bbase + (2 * nh + n2) * 32 * LROW + ks * 32);
#pragma unroll
                for (int mi = 0; mi < 2; ++mi)
#pragma unroll
                    for (int n2 = 0; n2 < 2; ++n2)
                        acc[mi][2 * nh + n2] = SWAP ? MFMA32(bfr[n2], af[mi], acc[mi][2 * nh + n2]) : MFMA32(af[mi], bfr[n2], acc[mi][2 * nh + n2]);
                if (NI == 4 && nh == 0) __builtin_amdgcn_sched_barrier(0);
            }
            __builtin_amdgcn_sched_barrier(0);
            load_part(snext, ks);
            __builtin_amdgcn_sched_barrier(0);
        }
    };
#pragma unroll
    for (int part = 0; part < 4; ++part) load_part(0, part);
    __syncthreads();
    store(lds);
    __syncthreads();
    for (int s = 0; s < total; ++s) {
        char* cur = lds + (s & 1) * GT_STAGE;
        char* nxt = lds + ((s & 1) ^ 1) * GT_STAGE;
        compute(cur, min(s + 1, total - 1));
        if ((s & (nk - 1)) == nk - 1) {
            epi(s >> nksh, acc);
#pragma unroll
            for (int mi = 0; mi < 2; ++mi)
#pragma unroll
                for (int ni = 0; ni < NI; ++ni)
#pragma unroll
                    for (int i = 0; i < 16; ++i) acc[mi][ni][i] = 0.f;
        }
        store(nxt);
        __syncthreads();
    }
}

constexpr int DS_B = 256 * 64, DS_STAGE = 512 * 64;
constexpr int EP_SCR = 112640, EP_WAVE = 32 * 136;
template <bool PERM16 = false, class XF, class RowPtrFn>
DI void stage_store_chunk(char* smem, const f32x16& a0, const f32x16& a1, XF xf, RowPtrFn rowptr) {
    const int lane = threadIdx.x & 63, w = threadIdx.x >> 6, l31 = lane & 31, hf = lane >> 5;
    LAS char* scr = (LAS char*)smem + EP_SCR + w * EP_WAVE;
#pragma unroll
    for (int n2 = 0; n2 < 2; ++n2)
#pragma unroll
        for (int q4 = 0; q4 < 4; ++q4) {
            const f32x16& a = n2 ? a1 : a0;
            u32x2 pk; pk[0] = pk2(xf(n2, 4 * q4, a[4 * q4]), xf(n2, 4 * q4 + 1, a[4 * q4 + 1])); pk[1] = pk2(xf(n2, 4 * q4 + 2, a[4 * q4 + 2]), xf(n2, 4 * q4 + 3, a[4 * q4 + 3]));
            const int col = PERM16 ? 32 * n2 + 16 * (q4 >> 1) + 8 * hf + 4 * (q4 & 1) : 32 * n2 + 8 * q4 + 4 * hf;
            *(LAS u32x2*)(scr + l31 * 136 + col * 2) = pk;
        }
    const int rr = lane >> 4, c = lane & 15;
#pragma unroll
    for (int i = 0; i < 8; ++i) {
        const int r = rr + 4 * i;
        const u32x2 d = *(const LAS u32x2*)(scr + r * 136 + c * 8);
        bf16_t* g = rowptr(r);
        if (g) *(u32x2*)(g + c * 4) = d;
    }
}

template <bool SWAP, int BM, class AFn, class Epi>
DI void gemm_dma(char* lds_generic, AFn arow, const bf16_t* __restrict__ Bt, int ldb, int nksh, int nsub, const bf16_t* zrow, Epi epi) {
    constexpr int NI = GemmGeo<BM>::NI, WN = GemmGeo<BM>::WN, NA = BM / 128;
    constexpr int STG = (BM + 256) * 64, BOFF = BM * 64, NST = BM == 256 ? 3 : 4;
    LAS char* lds = (LAS char*)lds_generic;
    const int tid = threadIdx.x, lane = tid & 63, w = tid >> 6, wm = w / WN, wn = w % WN, l31 = lane & 31, hf = lane >> 5;
    const int nh = 2 << nksh, total = nsub * nh;
    const bf16_t* asrc[NA]; const bf16_t* bsrc[2];
#pragma unroll
    for (int i = 0; i < NA; ++i) {
        const int row = 16 * (w + 8 * i) + (lane >> 2), c = (lane & 3) ^ ((row >> 2) & 3);
        const bf16_t* a = arow(row);
        asrc[i] = (a ? a : zrow) + c * 8;
    }
#pragma unroll
    for (int i = 0; i < 2; ++i) {
        const int row = 16 * (w + 8 * i) + (lane >> 2), c = (lane & 3) ^ ((row >> 2) & 3);
        bsrc[i] = Bt + (size_t)row * ldb + c * 8;
    }
    const size_t bsub = (size_t)256 * ldb;
    auto dma = [&](int hs, int stage) {
        const int t = hs / nh, k0 = (hs - t * nh) * 32;
        LAS char* stg = lds + stage * STG;
#pragma unroll
        for (int i = 0; i < NA; ++i)
            __builtin_amdgcn_global_load_lds((const unsigned*)(asrc[i] + k0), (LAS unsigned*)(stg + (w + 8 * i) * 1024), 16, 0, 0);
#pragma unroll
        for (int i = 0; i < 2; ++i)
            __builtin_amdgcn_global_load_lds((const unsigned*)(bsrc[i] + t * bsub + k0), (LAS unsigned*)(stg + BOFF + (w + 8 * i) * 1024), 16, 0, 0);
    };
    const int f = (l31 >> 2) & 3;
    const int lbase = l31 * 64 + ((hf ^ (f & 1)) << 4);
    const int o0 = lbase + (((f >> 1) & 1) << 5), o1 = lbase + ((((f >> 1) & 1) ^ 1) << 5);
    f32x16 acc[2][NI];
#pragma unroll
    for (int mi = 0; mi < 2; ++mi)
#pragma unroll
        for (int ni = 0; ni < NI; ++ni)
#pragma unroll
            for (int i = 0; i < 16; ++i) acc[mi][ni][i] = 0.f;
    asm volatile("s_waitcnt vmcnt(0) lgkmcnt(0)" ::: "memory");
    __builtin_amdgcn_s_barrier();
    dma(0, 0); dma(1, 1); if constexpr (NST == 4) dma(2, 2);
    constexpr int NDMA = NA + 2;
    for (int hs = 0; hs < total; ++hs) {
        if constexpr (BM == 256) asm volatile("s_waitcnt vmcnt(4)" ::: "memory"); else asm volatile("s_waitcnt vmcnt(6)" ::: "memory");
        asm volatile("s_waitcnt lgkmcnt(0)" ::: "memory");
        __builtin_amdgcn_s_barrier();
        const int hs_n = min(hs + NST - 1, total - 1), st_n = (hs + NST - 1) % NST;
        const int t_n = hs_n / nh, k0_n = (hs_n - t_n * nh) * 32;
        LAS char* stgn = lds + st_n * STG;
        const LAS char* stg = lds + (hs % NST) * STG;
        const LAS char* abase = stg + (64 * wm) * 64;
        const LAS char* bbase = stg + BOFF + (32 * NI * wn) * 64;
#pragma unroll
        for (int ks = 0; ks < 2; ++ks) {
            const int o = ks ? o1 : o0;
            bf16x8 af[2], bfr[NI];
#pragma unroll
            for (int mi = 0; mi < 2; ++mi) af[mi] = *(const LAS bf16x8*)(abase + mi * 2048 + o);
#pragma unroll
            for (int ni = 0; ni < NI; ++ni) bfr[ni] = *(const LAS bf16x8*)(bbase + ni * 2048 + o);
#pragma unroll
            for (int mi = 0; mi < 2; ++mi)
#pragma unroll
                for (int ni = 0; ni < NI; ++ni)
                    acc[mi][ni] = SWAP ? MFMA32(bfr[ni], af[mi], acc[mi][ni]) : MFMA32(af[mi], bfr[ni], acc[mi][ni]);
            __builtin_amdgcn_sched_barrier(0);
            if (ks == 0) {
#pragma unroll
                for (int i = 0; i < NA; ++i)
                    __builtin_amdgcn_global_load_lds((const unsigned*)(asrc[i] + k0_n), (LAS unsigned*)(stgn + (w + 8 * i) * 1024), 16, 0, 0);
            } else {
#pragma unroll
                for (int i = 0; i < 2; ++i)
                    __builtin_amdgcn_global_load_lds((const unsigned*)(bsrc[i] + t_n * bsub + k0_n), (LAS unsigned*)(stgn + BOFF + (w + 8 * (i)) * 1024), 16, 0, 0);
            }
            __builtin_amdgcn_sched_barrier(0);
        }
        if ((hs % nh) == nh - 1) {
            epi(hs / nh, acc);
#pragma unroll
            for (int mi = 0; mi < 2; ++mi)
#pragma unroll
                for (int ni = 0; ni < NI; ++ni)
#pragma unroll
                    for (int i = 0; i < 16; ++i) acc[mi][ni][i] = 0.f;
        }
    }
    asm volatile("s_waitcnt vmcnt(0) lgkmcnt(0)" ::: "memory");
    __builtin_amdgcn_s_barrier();
}

struct DenseRows { static constexpr bool kDense = true; const bf16_t* base; int ld; DI const bf16_t* operator()(int r) const { return base + (size_t)r * ld; } };

DI void epi_rows_bf16(char* smem, const f32x16 (&acc)[2][4], int row0, bf16_t* __restrict__ dst, int ldo, int cb, const float* gain, bool do_norm) {
    const int lane = threadIdx.x & 63, w = threadIdx.x >> 6, wm = w >> 1, wn = w & 1, hf = lane >> 5;
#pragma unroll
    for (int mi = 0; mi < 2; ++mi)
#pragma unroll
        for (int pr = 0; pr < 2; ++pr) {
            float rstd = 1.f;
            if (do_norm) {
                float ss = 0.f;
#pragma unroll
                for (int n2 = 0; n2 < 2; ++n2)
#pragma unroll
                    for (int i = 0; i < 16; ++i) ss += acc[mi][2 * pr + n2][i] * acc[mi][2 * pr + n2][i];
                ss += __shfl_xor(ss, 32);
                rstd = rsqrtf(ss * (1.f / 64.f) + EPSF);
            }
            bf16_t* base = dst + (size_t)(row0 + 64 * wm + 32 * mi) * ldo + cb + 128 * wn + 64 * pr;
            int zo = 0; asm volatile("" : "+v"(zo));
            const float* gch = gain + zo;
            stage_store_chunk(smem, acc[mi][2 * pr], acc[mi][2 * pr + 1],
                              [&](int n2, int i, float x) { float o = x * rstd; if (do_norm) o *= gch[32 * n2 + crow(i, hf)]; return o; },
                              [&](int r) { return base + (size_t)r * ldo; });
        }
}
DI void epi_vt(char* smem, const f32x16 (&acc)[2][4], int row0, bf16_t* __restrict__ vt, int dv, int nheads, int colbase  ) {
    const int w = threadIdx.x >> 6, wm = w >> 1, wn = w & 1;
    const int b = row0 >> 13, s0 = row0 & (NS - 1);
#pragma unroll
    for (int ni = 0; ni < 4; ++ni) {
        const int c0 = colbase + 128 * wn + 32 * ni;
        bf16_t* base = vt + ((size_t)b * 512 + c0) * NS + s0 + 64 * wm;
        stage_store_chunk<true>(smem, acc[0][ni], acc[1][ni], [](int, int, float x) { return x; }, [&](int r) { return base + (size_t)r * NS; });
    }
}
DI void phase_inproj(const Params& P, char* smem) {
    const bf16_t* zrow = (const bf16_t*)(P.ws + OFF_ZROW);
    const bf16_t* h = (const bf16_t*)(P.ws + OFF_H);
    const bf16_t* win = (const bf16_t*)(P.ws + OFF_WIN);
    float* gl = (float*)(smem + SM_EXTRA);
    __syncthreads();
    {
        const int v = threadIdx.x >> 6, i = threadIdx.x & 63;
        if (v == 0) gl[i] = P.dq_g[i];
        else if (v == 1) gl[64 + i] = P.dk_g[i];
        else if (v == 2) gl[128 + i] = P.sq_g[i];
        else if (v == 3) gl[192 + i] = P.sk_g[i];
        else if (v == 4) gl[256 + i] = P.ik_g[i];
    }
    __syncthreads();
    const XPart xp1 = xcd_part(P.ws, smem, (NT / 256) * 10);
    for (int it = xp1.start; it < xp1.end; it += xp1.step) {
        const int jj = it % 10, mt = it / 10;
        const int j = jj < 4 ? jj : jj < 8 ? jj + 2 : jj + 4;
        const int row0 = mt * 256, grp = j >> 1, cb = (j & 1) * 256;
        DenseRows ar{h + (size_t)row0 * 1024, 1024};
        bf16_t* dst = (bf16_t*)(P.ws + (grp == 0 ? OFF_QD : grp == 1 ? OFF_KD : grp == 3 ? OFF_QS : grp == 4 ? OFF_KS : OFF_IQ));
        const float* gain = gl + 64 * (grp == 0 ? 0 : grp == 1 ? 1 : grp == 3 ? 2 : 3);
        const bool do_norm = grp != 6;
#ifdef XP_DUPEPI
        gemm_dma<true, 256>(smem, ar, win + (size_t)j * 256 * 1024, 1024, 4, 1, zrow, [&](int, const f32x16 (&acc)[2][4]) { epi_rows_bf16(smem, acc, row0, dst, 512, cb, gain, do_norm); asm volatile("" ::: "memory"); epi_rows_bf16(smem, acc, row0, dst, 512, cb, gain, do_norm); });
#else
        gemm_dma<true, 256>(smem, ar, win + (size_t)j * 256 * 1024, 1024, 4, 1, zrow, [&](int, const f32x16 (&acc)[2][4]) { epi_rows_bf16(smem, acc, row0, dst, 512, cb, gain, do_norm); });
#endif
    }
    const XPart xp2 = xcd_part(P.ws, smem, (NT / 256) * 4);
    for (int it = xp2.start; it < xp2.end; it += xp2.step) {
        const int jj = it & 3, mt = it >> 2;
        const int j = jj < 2 ? 4 + jj : 8 + jj;
        const int row0 = mt * 256, cb = (j & 1) * 256;
        DenseRows ar{h + (size_t)row0 * 1024, 1024};
        bf16_t* vt = (bf16_t*)(P.ws + (jj < 2 ? OFF_VDT : OFF_VST));
        const int dv = jj < 2 ? 128 : 64, nh = jj < 2 ? 4 : 8;
        gemm_dma<false, 256>(smem, ar, win + (size_t)j * 256 * 1024, 1024, 4, 1, zrow, [&](int, const f32x16 (&acc)[2][4]) { epi_vt(smem, acc, row0, vt, dv, nh, cb); });
    }
    for (int mt = blockIdx.x; mt < NT / 256; mt += gridDim.x) {
        const int row0 = mt * 256;
        DenseRows ar{h + (size_t)row0 * 1024, 1024};
        gemm_dma<true, 256>(smem, ar, win + (size_t)14 * 256 * 1024, 1024, 4, 1, zrow, [&](int, const f32x16 (&acc)[2][4]) {
            const int lane = threadIdx.x & 63, w = threadIdx.x >> 6, wm = w >> 1, wn = w & 1, l31 = lane & 31, hf = lane >> 5;
            if (wn == 0) {
                bf16_t* ik = (bf16_t*)(P.ws + OFF_IK);
                float* iw = (float*)(P.ws + OFF_IW);
                const float s = 0.35355339059327373f * 0.125f;
#pragma unroll
                for (int mi = 0; mi < 2; ++mi) {
                    const int tok = row0 + 64 * wm + 32 * mi + l31;
                    float ss = 0.f;
#pragma unroll
                    for (int ni = 0; ni < 2; ++ni)
#pragma unroll
                        for (int i = 0; i < 16; ++i) ss += acc[mi][ni][i] * acc[mi][ni][i];
                    ss += __shfl_xor(ss, 32);
                    const float rstd = rsqrtf(ss * (1.f / 64.f) + EPSF);
#pragma unroll
                    for (int ni = 0; ni < 2; ++ni)
#pragma unroll
                        for (int q4 = 0; q4 < 4; ++q4) {
                            const int f = 32 * ni + 8 * q4 + 4 * hf;
                            float o[4];
#pragma unroll
                            for (int r = 0; r < 4; ++r) o[r] = acc[mi][ni][4 * q4 + r] * rstd * gl[256 + f + r];
                            u32x2 pk; pk[0] = pk2(o[0], o[1]); pk[1] = pk2(o[2], o[3]);
                            *(u32x2*)(ik + ((((size_t)(tok >> 5) * 4 + (2 * ni + (q4 >> 1))) * 64 + 32 * (q4 & 1) + (tok & 31)) * 8 + 4 * hf)) = pk;
                        }
                    f32x4 o = {acc[mi][2][0] * s, acc[mi][2][1] * s, acc[mi][2][2] * s, acc[mi][2][3] * s};
                    *(f32x4*)(iw + (size_t)tok * 8 + 4 * hf) = o;
                }
            }
        });
    }
}

constexpr int TK_CAP = 512, TK_HI = 448;
template <int NPASS>
DI unsigned topk_prune(volatile LAS unsigned* buf, volatile LAS unsigned* hist, int cnt, int& kept) {
    const int lane = threadIdx.x & 63;
    unsigned e[8];
#pragma unroll
    for (int i = 0; i < 8; ++i) { const int idx = lane + 64 * i; e[i] = idx < cnt ? buf[idx] : 0u; }
    unsigned prefix = 0u, want = 256u;
#pragma unroll
    for (int p = 3; p >= 4 - NPASS; --p) {
        const int sh = 8 * p;
#pragma unroll
        for (int j = 0; j < 4; ++j) hist[4 * lane + j] = 0u;
        asm volatile("" ::: "memory");
#pragma unroll
        for (int i = 0; i < 8; ++i) {
            const bool m = (e[i] != 0u) && (p == 3 || (e[i] >> (sh + 8)) == prefix);
            if (m) __hip_atomic_fetch_add((LAS unsigned*)&hist[(e[i] >> sh) & 255u], 1u, __ATOMIC_RELAXED, __HIP_MEMORY_SCOPE_WORKGROUP);
        }
        asm volatile("" ::: "memory");
        const unsigned h0 = hist[4 * lane], h1 = hist[4 * lane + 1], h2 = hist[4 * lane + 2], h3 = hist[4 * lane + 3];
        const unsigned s4 = h0 + h1 + h2 + h3;
        int suf_i = (int)s4;
        suf_i += __builtin_amdgcn_update_dpp(0, suf_i, 0x101, 0xf, 0xf, true);
        suf_i += __builtin_amdgcn_update_dpp(0, suf_i, 0x102, 0xf, 0xf, true);
        suf_i += __builtin_amdgcn_update_dpp(0, suf_i, 0x104, 0xf, 0xf, true);
        suf_i += __builtin_amdgcn_update_dpp(0, suf_i, 0x108, 0xf, 0xf, true);
        const int t1 = __builtin_amdgcn_readlane(suf_i, 16), t2 = __builtin_amdgcn_readlane(suf_i, 32), t3 = __builtin_amdgcn_readlane(suf_i, 48);
        const int row = lane >> 4;
        const unsigned suf = (unsigned)(suf_i + (row == 0 ? t1 + t2 + t3 : row == 1 ? t2 + t3 : row == 2 ? t3 : 0));
        const unsigned above = suf - s4;
        const bool own = (above < want) && (want <= suf);
        unsigned bsel = 0u, cum = above;
        if (cum + h3 >= want) bsel = 3u;
        else { cum += h3; if (cum + h2 >= want) bsel = 2u; else { cum += h2; if (cum + h1 >= want) bsel = 1u; else { cum += h1; bsel = 0u; } } }
        const u64 om = __builtin_amdgcn_ballot_w64(own);
        const int ol = om ? (int)__builtin_ctzll(om) : 0;
        const unsigned bin = (unsigned)__builtin_amdgcn_readlane((int)(4u * lane + bsel), ol);
        const unsigned cm = (unsigned)__builtin_amdgcn_readlane((int)cum, ol);
        prefix = (prefix << 8) | bin; want -= cm;
    }
    const unsigned V = NPASS == 4 ? prefix : (prefix << 16);
    int base = 0;
#pragma unroll
    for (int i = 0; i < 8; ++i) {
        const bool keep = (e[i] != 0u) && (e[i] >= V);
        const u64 mk = __ballot(keep);
        const int pos = base + __builtin_popcountll(mk & ((1ull << lane) - 1ull));
        if (keep) buf[pos] = e[i];
        base += __builtin_popcountll(mk);
    }
    asm volatile("" ::: "memory");
    kept = base;
    return NPASS == 4 ? V : (V ? V - 1u : 0u);
}

DI void indexer_item(const Params& P, char* smem, int b, int q0) {
    const int lane = threadIdx.x & 63, w = __builtin_amdgcn_readfirstlane(threadIdx.x >> 6), l31 = lane & 31, hf = lane >> 5;
    const int qbase = q0 + 8 * w;
    const bf16_t* IQ = (const bf16_t*)(P.ws + OFF_IQ);
    const bf16_t* IK = (const bf16_t*)(P.ws + OFF_IK);
    const float* IW = (const float*)(P.ws + OFF_IW);
    volatile LAS unsigned* buf = (volatile LAS unsigned*)(LAS char*)(smem + w * 8 * 2048);
    volatile LAS unsigned* hist = (volatile LAS unsigned*)(LAS char*)(smem + 131072 + w * 1024);
    bf16x8 af[2][4];
    {
        const int m = l31, qs = 2 * ((m >> 2) & 1) + (m >> 4), head = 4 * ((m >> 3) & 1) + (m & 3);
#pragma unroll
        for (int mt = 0; mt < 2; ++mt) {
            const size_t tok = (size_t)b * NS + qbase + 4 * mt + qs;
#pragma unroll
            for (int ks = 0; ks < 4; ++ks) af[mt][ks] = *(const bf16x8*)(IQ + tok * 512 + head * 64 + ks * 16 + hf * 8);
        }
    }
    float iwv[2][2][8]; int qpos[2][2]; unsigned tau[2][2]; int cnt[2][2];
#pragma unroll
    for (int mt = 0; mt < 2; ++mt)
#pragma unroll
        for (int j = 0; j < 2; ++j) {
            qpos[mt][j] = qbase + 4 * mt + 2 * hf + j; tau[mt][j] = 0u; cnt[mt][j] = 0;
            const float* p = IW + ((size_t)b * NS + qpos[mt][j]) * 8;
            const f32x4 a = *(const f32x4*)p, c = *(const f32x4*)(p + 4);
#pragma unroll
            for (int r = 0; r < 4; ++r) { iwv[mt][j][r] = a[r]; iwv[mt][j][4 + r] = c[r]; }
        }
    const int nkt = ((qbase + 7) >> 6) + 1;
    const bf16_t* ikb = IK + (size_t)b * NS * 64 + (size_t)lane * 8;
    bf16x8 bfr[2][4];
#pragma unroll
    for (int sb = 0; sb < 2; ++sb)
#pragma unroll
        for (int ks = 0; ks < 4; ++ks) bfr[sb][ks] = *(const bf16x8*)(ikb + (size_t)(sb * 4 + ks) * 512);
#pragma unroll 2
    for (int kt = 0; kt < nkt; ++kt) {
        bf16x8 bn[2][4];
        {
            const int kn = min(kt + 1, nkt - 1) * 64;
#ifdef XP_DUPIKLOAD
#pragma unroll
            for (int sb = 0; sb < 2; ++sb)
#pragma unroll
                for (int ks = 0; ks < 4; ++ks) { bf16x8 t = __builtin_nontemporal_load((const bf16x8*)(ikb + (size_t)kn * 64 + (size_t)(sb * 4 + ks) * 512)); asm volatile("" : "+v"(t)); }
#endif
#pragma unroll
            for (int sb = 0; sb < 2; ++sb)
#pragma unroll
                for (int ks = 0; ks < 4; ++ks) bn[sb][ks] = *(const bf16x8*)(ikb + (size_t)kn * 64 + (size_t)(sb * 4 + ks) * 512);
        }
#pragma unroll
        for (int sb = 0; sb < 2; ++sb) {
            const int k0 = kt * 64 + 32 * sb;
            if (k0 > qbase + 7) continue;
            const bool needcausal = k0 + 31 > qbase;
            f32x16 acc[2];
#pragma unroll
            for (int mt = 0; mt < 2; ++mt) {
#pragma unroll
                for (int i = 0; i < 16; ++i) acc[mt][i] = 0.f;
#pragma unroll
                for (int ks = 0; ks < 4; ++ks) acc[mt] = MFMA32(af[mt][ks], bfr[sb][ks], acc[mt]);
#ifdef XP_DUPIDXMFMA
                { f32x16 z; for (int i = 0; i < 16; ++i) z[i] = 0.f;
                  for (int ks = 0; ks < 4; ++ks) z = MFMA32(af[mt][ks], bfr[sb][ks], z);
                  asm volatile("" : "+v"(z)); }
#endif
            }
            const int kidx = k0 + l31;
#pragma unroll
            for (int mt = 0; mt < 2; ++mt)
#pragma unroll
                for (int j = 0; j < 2; ++j) {
                    float s = 0.f;
#ifdef XP_DUPSCORE
                    { float s2 = 0.f;
#pragma unroll
                      for (int t = 0; t < 8; ++t) s2 = __builtin_fmaf(iwv[mt][j][t], __int_as_float(max(__float_as_int(acc[mt][8 * j + t]), 0)), s2);
                      asm volatile("" : "+v"(s2)); s = s2 * 0.f; }
#endif
#pragma unroll
                    for (int t = 0; t < 8; ++t)
                        s = __builtin_fmaf(iwv[mt][j][t], __int_as_float(max(__float_as_int(acc[mt][8 * j + t]), 0)), s);
                    const int si = __float_as_int(s);
                    const unsigned ord = (unsigned)si ^ ((unsigned)(si >> 31) | 0x80000000u);
                    const unsigned pk = (ord & 0xFFFFE000u) | (unsigned)(8191 - kidx);
                    const bool pass = needcausal ? ((kidx <= qpos[mt][j]) && (pk > tau[mt][j])) : (pk > tau[mt][j]);
                    const u64 mk = __builtin_amdgcn_ballot_w64(pass);
                    const unsigned hm = hf ? (unsigned)(mk >> 32) : (unsigned)mk;
                    const int pos = cnt[mt][j] + __builtin_popcount(hm & ((1u << l31) - 1u));
                    { const int widx = pass ? (4 * mt + 2 * hf + j) * TK_CAP + pos : (int)(hist - buf) + lane; buf[widx] = pk; }
#ifdef XP_DUPAPPEND
                    {
                        unsigned pk2v = pk; asm volatile("" : "+v"(pk2v));
                        const bool pass2 = needcausal ? ((kidx <= qpos[mt][j]) && (pk2v > tau[mt][j])) : (pk2v > tau[mt][j]);
                        const u64 mk2 = __builtin_amdgcn_ballot_w64(pass2);
                        const unsigned hm2 = hf ? (unsigned)(mk2 >> 32) : (unsigned)mk2;
                        const int pos2 = cnt[mt][j] + __builtin_popcount(hm2 & ((1u << l31) - 1u));
                        if (pass2) buf[(4 * mt + 2 * hf + j) * TK_CAP + pos2] = pk2v;
                    }
#endif
                    cnt[mt][j] += __builtin_popcount(hm);
                }
        }
        const bool anyhi = cnt[0][0] > TK_HI || cnt[0][1] > TK_HI || cnt[1][0] > TK_HI || cnt[1][1] > TK_HI;
        if (__ballot(anyhi) != 0ull) {
#pragma unroll 1
            for (int s8 = 0; s8 < 8; ++s8) {
                const int mt = s8 >> 2, j = (s8 >> 1) & 1, h2 = s8 & 1;
                const int cv = mt ? (j ? cnt[1][1] : cnt[1][0]) : (j ? cnt[0][1] : cnt[0][0]);
                const int c = __builtin_amdgcn_readlane(cv, 32 * h2);
                if (c > TK_HI) {
                    volatile LAS unsigned* qb = buf + (4 * mt + 2 * h2 + j) * TK_CAP;
                    int nk = 0;
                    unsigned V = topk_prune<2>(qb, hist, c, nk);
#ifdef XP_DUPPRUNE
                    V = topk_prune<2>(qb, hist, nk, nk);
#endif
                    if (nk > TK_HI - 64) V = topk_prune<4>(qb, hist, nk, nk);
#pragma unroll
                    for (int a = 0; a < 2; ++a)
#pragma unroll
                        for (int d = 0; d < 2; ++d)
                            if (hf == h2 && a == mt && d == j) { tau[a][d] = V; cnt[a][d] = nk; }
                }
            }
        }
#pragma unroll
        for (int sb = 0; sb < 2; ++sb)
#pragma unroll
            for (int ks = 0; ks < 4; ++ks) bfr[sb][ks] = bn[sb][ks];
    }
#pragma unroll 1
    for (int s8 = 0; s8 < 8; ++s8) {
        const int mt = s8 >> 2, j = (s8 >> 1) & 1, h2 = s8 & 1;
        const int cv = mt ? (j ? cnt[1][1] : cnt[1][0]) : (j ? cnt[0][1] : cnt[0][0]);
        int c = __builtin_amdgcn_readlane(cv, 32 * h2);
        volatile LAS unsigned* qb = buf + (4 * mt + 2 * h2 + j) * TK_CAP;
        if (c > 256) { int nk = 0; (void)topk_prune<4>(qb, hist, c, nk); c = nk; }
#pragma unroll
        for (int t = 0; t < 4; ++t) qb[256 + 4 * lane + t] = 0u;
        asm volatile("" ::: "memory");
#pragma unroll
        for (int t = 0; t < 4; ++t) {
            const int idx = lane + 64 * t;
            if (idx < c) {
                const unsigned e = qb[idx]; const unsigned kk = 8191u - (e & 8191u);
                __hip_atomic_fetch_or((LAS unsigned*)&qb[256 + (kk >> 5)], 1u << (kk & 31u), __ATOMIC_RELAXED, __HIP_MEMORY_SCOPE_WORKGROUP);
            }
        }
        asm volatile("" ::: "memory");
    }
    u64* mask = (u64*)(P.ws + OFF_MASK);
    const int ktmax = (q0 | 255) >> 6;
    const int qi = lane & 7;
#pragma unroll 1
    for (int it = 0; it < 16; ++it) {
        const int kt = it * 8 + (lane >> 3);
        if (kt <= ktmax) {
            const unsigned lo = buf[qi * TK_CAP + 256 + 2 * kt], hi = buf[qi * TK_CAP + 256 + 2 * kt + 1];
            mask[((size_t)(b * 128 + kt)) * NS + qbase + qi] = ((u64)hi << 32) | lo;
        }
    }
}

constexpr int AT_K = 64 * LROW;
constexpr int AT_DSTAGE = 4 * AT_K;
template <int NDB, bool BM>
DI void attn_tile(const LAS char* Kt, const LAS char* Vt, const bf16x8 (&qf)[4], f32x16 (&o)[NDB], float off, float& mlow, float& lrun,
                  int qpos, int k0, float c1, float c2, bool diag, bool scan, u64 mword) {
    const int lane = threadIdx.x & 63, l31 = lane & 31, hf = lane >> 5;
    const int lanex = ((((l31 >> 1) & 7) ^ hf) << 4);
    const LAS char* kbase = Kt + l31 * 128;
    const LAS char* vbase = Vt + l31 * 128;
    const float bias0 = -c2 * (float)(qpos - k0 - 4 * hf) - off;
#pragma unroll 1
    for (int kbi = 0; kbi < 2; ++kbi) {
        const int kb = 1 - kbi;
        f32x16 st;
#pragma unroll
        for (int i = 0; i < 16; ++i) st[i] = 0.f;
#pragma unroll
        for (int ks = 0; ks < 4; ++ks) {
            const bf16x8 kf = *(const LAS bf16x8*)(kbase + kb * 4096 + (lanex ^ (ks << 5)));
            st = MFMA32(kf, qf[ks], st);
        }
        const unsigned mw = BM ? (unsigned)((kb ? (unsigned)(mword >> 32) : (unsigned)mword) >> (4 * hf)) : 0u;
        const float noff = bias0 + c2 * (float)(32 * kb);
        float ls = 0.f, mx = -INFINITY;
#pragma unroll
        for (int i = 0; i < 16; ++i) {
            const int ko = (i & 3) + 8 * (i >> 2);
            const float v = __builtin_fmaf(st[i], c1, __builtin_fmaf(c2, (float)ko, noff));
            bool ok = true;
            if (BM) ok = (mw >> ko) & 1u;
            if (diag) ok = ok && (k0 + 32 * kb + ko + 4 * hf <= qpos);
            float p = __builtin_amdgcn_exp2f(v);
            if (BM || diag) p = ok ? p : 0.f;
            if (scan) mx = fmaxf(mx, (BM || diag) ? (ok ? v : -INFINITY) : v);
            st[i] = p; ls += p;
        }
#ifdef XP_DUPSOFTMAX
        {
            float ls2 = 0.f;
#pragma unroll
            for (int i = 0; i < 16; ++i) {
                const int ko = (i & 3) + 8 * (i >> 2);
                float x = st[i]; asm volatile("" : "+v"(x));
                const float v = __builtin_fmaf(x, c1, __builtin_fmaf(c2, (float)ko, noff));
                ls2 += __builtin_amdgcn_exp2f(v);
            }
            asm volatile("" : "+v"(ls2));
            ls += ls2 * 0.f;
        }
#endif
        lrun += ls;
        if (scan) { mx = fmaxf(mx, __shfl_xor(mx, 32)); mlow = fmaxf(mlow, mx + off); }
        const int vx = lanex ^ (kb << 6);
#pragma unroll
        for (int s = 0; s < 2; ++s) {
            u32x4 pp;
#pragma unroll
            for (int t = 0; t < 4; ++t) pp[t] = pk2(st[8 * s + 2 * t], st[8 * s + 2 * t + 1]);
            const bf16x8 pf = __builtin_bit_cast(bf16x8, pp);
#pragma unroll
            for (int db = 0; db < NDB; ++db) {
                const bf16x8 vf = *(const LAS bf16x8*)(vbase + db * 4096 + (vx ^ (s << 5)));
                o[db] = MFMA32(vf, pf, o[db]);
            }
        }
    }
}

constexpr int AT_NST = 4;

DI void diffattn_item(const Params& P, char* smem, int b, int h, int qb) {
    const int tid = threadIdx.x, lane = tid & 63, w = __builtin_amdgcn_readfirstlane(tid >> 6), l31 = lane & 31, hf = lane >> 5;
    const int map = w & 1, qsub = w >> 1;
    const int q0 = qb * 128;
    LAS char* lds = (LAS char*)smem;
    const bf16_t* Qd = (const bf16_t*)(P.ws + OFF_QD);
    const bf16_t* Kd = (const bf16_t*)(P.ws + OFF_KD);
    const bf16_t* VdT = (const bf16_t*)(P.ws + OFF_VDT);
    const int qpos = q0 + 32 * qsub + l31;
    bf16x8 qf[4];
#pragma unroll
    for (int ks = 0; ks < 4; ++ks) qf[ks] = *(const bf16x8*)(Qd + ((size_t)b * NS + qpos) * 512 + h * 128 + map * 64 + ks * 16 + hf * 8);
    const float slope = exp2f(-2.f * (float)(h + 1));
    const float c1 = 0.125f * LOG2E, c2 = slope * LOG2E;
    float gq = fabsf(P.dq_g[lane]), gk = fabsf(P.dk_g[lane]);
#pragma unroll
    for (int d = 32; d >= 1; d >>= 1) { gq = fmaxf(gq, __shfl_xor(gq, d)); gk = fmaxf(gk, __shfl_xor(gk, d)); }
    const float B2 = 64.f * gq * gk * 1.008f * c1;
    int* flags = (int*)(smem + SM_EXTRA + 3072);
    int par = 0;
    f32x16 o[4];
#pragma unroll
    for (int db = 0; db < 4; ++db)
#pragma unroll
        for (int i = 0; i < 16; ++i) o[db][i] = 0.f;
    float mlow = -INFINITY, lrun = 0.f;
    int ndone = 0;
    const int drow = 8 * w + (lane >> 3), dch = (lane & 7) ^ ((drow >> 1) & 7);
    const bf16_t* ksrc = Kd + ((size_t)b * NS + drow) * 512 + h * 128 + dch * 8;
    const bf16_t* vsrc = VdT + ((size_t)(b * 4 + h) * 128 + drow) * NS + dch * 8;
    auto dma = [&](int kt, int stage) {
        LAS char* stg = lds + stage * 32768;
        const size_t k0 = (size_t)kt * 64;
        __builtin_amdgcn_global_load_lds((const unsigned*)(ksrc + k0 * 512), (LAS unsigned*)(stg + w * 1024), 16, 0, 0);
        __builtin_amdgcn_global_load_lds((const unsigned*)(ksrc + k0 * 512 + 64), (LAS unsigned*)(stg + 8192 + w * 1024), 16, 0, 0);
        __builtin_amdgcn_global_load_lds((const unsigned*)(vsrc + k0), (LAS unsigned*)(stg + 16384 + w * 1024), 16, 0, 0);
        __builtin_amdgcn_global_load_lds((const unsigned*)(vsrc + (size_t)64 * NS + k0), (LAS unsigned*)(stg + 16384 + 8192 + w * 1024), 16, 0, 0);
#ifdef XP_DUPDMA
        __builtin_amdgcn_global_load_lds((const unsigned*)(ksrc + k0 * 512), (LAS unsigned*)(stg + w * 1024), 16, 0, 0);
        __builtin_amdgcn_global_load_lds((const unsigned*)(ksrc + k0 * 512 + 64), (LAS unsigned*)(stg + 8192 + w * 1024), 16, 0, 0);
        __builtin_amdgcn_global_load_lds((const unsigned*)(vsrc + k0), (LAS unsigned*)(stg + 16384 + w * 1024), 16, 0, 0);
        __builtin_amdgcn_global_load_lds((const unsigned*)(vsrc + (size_t)64 * NS + k0), (LAS unsigned*)(stg + 16384 + 8192 + w * 1024), 16, 0, 0);
#endif
    };
    const int ktd = 2 * qb + 1;
    const int qwmax = q0 + 32 * qsub + 31, qwmin = q0 + 32 * qsub;
#ifdef XP_DUPLOOP
  for (int rep = 0; rep < 2; ++rep) {
    if (rep) { for (int db = 0; db < 4; ++db) for (int i = 0; i < 16; ++i) o[db][i] = 0.f; mlow = -INFINITY; lrun = 0.f; ndone = 0; par = 0; }
#endif
    asm volatile("s_waitcnt vmcnt(0) lgkmcnt(0)" ::: "memory");
    __builtin_amdgcn_s_barrier();
    dma(max(ktd, 0), 0); dma(max(ktd - 1, 0), 1); dma(max(ktd - 2, 0), 2);
    for (int j = 0; j <= ktd; ++j) {
        const int kt = ktd - j, k0 = kt * 64;
#ifdef XP_DUPDMA
        asm volatile("s_waitcnt vmcnt(16)" ::: "memory");
#else
        asm volatile("s_waitcnt vmcnt(8)" ::: "memory");
#endif
        asm volatile("s_waitcnt lgkmcnt(0)" ::: "memory");
        __builtin_amdgcn_s_barrier();
        int allstop = 0;
        if (j > 0) { allstop = 1;
#pragma unroll
            for (int i = 0; i < 8; ++i) allstop &= flags[(par ^ 1) * 8 + i]; }
        if (allstop) break;
        dma(max(kt - 3, 0), (j + 3) & 3);
        const LAS char* cur = lds + (j & 3) * 32768;
        if (k0 <= qwmax) {
            attn_tile<4, false>(cur + map * 8192, cur + 16384, qf, o, B2, mlow, lrun, qpos, k0, c1, c2, k0 + 63 > qwmin, ndone < 2, 0ull);
            ++ndone;
        }
        {
            const float ub = B2 - c2 * (float)(qpos - (k0 - 1));
            const bool stop = __all(ub < mlow - 30.f);
            if (lane == 0) flags[par * 8 + w] = stop ? 1 : 0;
        }
        par ^= 1;
    }
    asm volatile("s_waitcnt vmcnt(0) lgkmcnt(0)" ::: "memory");
    __builtin_amdgcn_s_barrier();
#ifdef XP_DUPLOOP
  }
#endif
    const float ltot = lrun + __shfl_xor(lrun, 32);
    const float inv = 1.f / ltot;
    float la, lb;
    { const float a = P.lq1[lane] * P.lk1[lane], c = P.lq2[lane] * P.lk2[lane]; la = wave_sum(a); lb = wave_sum(c); }
    const float lam = __expf(la) - __expf(lb) + 0.2f;
    float* X = (float*)smem;
    if (map == 1) {
#pragma unroll
        for (int db = 0; db < 4; ++db)
#pragma unroll
            for (int q4 = 0; q4 < 4; ++q4) {
                f32x4 v;
#pragma unroll
                for (int r = 0; r < 4; ++r) v[r] = o[db][4 * q4 + r] * inv * lam;
                *(f32x4*)(X + (qsub * 32 + l31) * 132 + 32 * db + 8 * q4 + 4 * hf) = v;
            }
    }
    __syncthreads();
    if (map == 0) {
        float ss = 0.f;
#pragma unroll
        for (int db = 0; db < 4; ++db)
#pragma unroll
            for (int q4 = 0; q4 < 4; ++q4) {
                const f32x4 v2 = *(const f32x4*)(X + (qsub * 32 + l31) * 132 + 32 * db + 8 * q4 + 4 * hf);
#pragma unroll
                for (int r = 0; r < 4; ++r) { const float v = o[db][4 * q4 + r] * inv - v2[r]; o[db][4 * q4 + r] = v; ss += v * v; }
            }
        ss += __shfl_xor(ss, 32);
        const float rstd = rsqrtf(ss * (1.f / 128.f) + EPSF) * 0.8f;
        bf16_t* ao = (bf16_t*)(P.ws + OFF_H) + ((size_t)b * NS + qpos) * 1024 + h * 128;
#pragma unroll
        for (int db = 0; db < 4; ++db)
#pragma unroll
            for (int q4 = 0; q4 < 4; ++q4) {
                const int d = 32 * db + 8 * q4 + 4 * hf;
                const f32x4 g = *(const f32x4*)((const float*)(smem + SM_EXTRA + 1024) + d);
                u32x2 pk; pk[0] = pk2(o[db][4 * q4] * rstd * g[0], o[db][4 * q4 + 1] * rstd * g[1]); pk[1] = pk2(o[db][4 * q4 + 2] * rstd * g[2], o[db][4 * q4 + 3] * rstd * g[3]);
                *(u32x2*)(ao + d) = pk;
            }
    }
    __syncthreads();
}

DI void dsa_item(const Params& P, char* smem, int b, int h, int qb) {
    const int tid = threadIdx.x, lane = tid & 63, w = __builtin_amdgcn_readfirstlane(tid >> 6), l31 = lane & 31, hf = lane >> 5;
    const int q0 = qb * 256;
    LAS char* lds = (LAS char*)smem;
    const bf16_t* Qs = (const bf16_t*)(P.ws + OFF_QS);
    const bf16_t* Ks = (const bf16_t*)(P.ws + OFF_KS);
    const bf16_t* VsT = (const bf16_t*)(P.ws + OFF_VST);
    const u64* mask = (const u64*)(P.ws + OFF_MASK);
    const int qpos = q0 + 32 * w + l31;
    bf16x8 qf[4];
#pragma unroll
    for (int ks = 0; ks < 4; ++ks) qf[ks] = *(const bf16x8*)(Qs + ((size_t)b * NS + qpos) * 512 + h * 64 + ks * 16 + hf * 8);
    const float slope = exp2f(-(float)(h + 1));
    const float c1 = 0.125f * LOG2E, c2 = slope * LOG2E;
    float gq = fabsf(P.sq_g[lane]), gk = fabsf(P.sk_g[lane]);
#pragma unroll
    for (int d = 32; d >= 1; d >>= 1) { gq = fmaxf(gq, __shfl_xor(gq, d)); gk = fmaxf(gk, __shfl_xor(gk, d)); }
    const float B2 = 64.f * gq * gk * 1.008f * c1;
    int* flags = (int*)(smem + SM_EXTRA + 3072);
    int par = 0;
    f32x16 o[2];
#pragma unroll
    for (int db = 0; db < 2; ++db)
#pragma unroll
        for (int i = 0; i < 16; ++i) o[db][i] = 0.f;
    float mlow = -INFINITY, lrun = 0.f, off = 0.f;
    bool offset_set = false;
    const int drow = 8 * w + (lane >> 3), dch = (lane & 7) ^ ((drow >> 1) & 7);
    const bf16_t* ksrc = Ks + ((size_t)b * NS + drow) * 512 + h * 64 + dch * 8;
    const bf16_t* vsrc = VsT + ((size_t)(b * 8 + h) * 64 + drow) * NS + dch * 8;
    const u64* msrc = mask + (size_t)b * 128 * NS + q0 + (w & 1) * 128 + lane * 2;
    auto dma = [&](int kt, int stage) {
        LAS char* stg = lds + stage * 18432;
        const size_t k0 = (size_t)kt * 64;
        __builtin_amdgcn_global_load_lds((const unsigned*)(ksrc + k0 * 512), (LAS unsigned*)(stg + w * 1024), 16, 0, 0);
        __builtin_amdgcn_global_load_lds((const unsigned*)(vsrc + k0), (LAS unsigned*)(stg + 8192 + w * 1024), 16, 0, 0);
        if (w < 2) __builtin_amdgcn_global_load_lds((const unsigned*)(msrc + (size_t)kt * NS), (LAS unsigned*)(stg + 16384 + w * 1024), 16, 0, 0);
    };
    const int ktd = 4 * qb + 3;
    const int qwmax = q0 + 32 * w + 31;
#ifdef XP_DUPLOOP
  for (int rep = 0; rep < 2; ++rep) {
    if (rep) { for (int db = 0; db < 2; ++db) for (int i = 0; i < 16; ++i) o[db][i] = 0.f; mlow = -INFINITY; lrun = 0.f; off = 0.f; offset_set = false; par = 0; }
#endif
    asm volatile("s_waitcnt vmcnt(0) lgkmcnt(0)" ::: "memory");
    __builtin_amdgcn_s_barrier();
    dma(max(ktd, 0), 0); dma(max(ktd - 1, 0), 1); dma(max(ktd - 2, 0), 2);
    for (int j = 0; j <= ktd; ++j) {
        const int kt = ktd - j, k0 = kt * 64;
        if (w < 2) asm volatile("s_waitcnt vmcnt(6)" ::: "memory"); else asm volatile("s_waitcnt vmcnt(4)" ::: "memory");
        asm volatile("s_waitcnt lgkmcnt(0)" ::: "memory");
        __builtin_amdgcn_s_barrier();
        int allstop = 0;
        if (j > 0) { allstop = 1;
#pragma unroll
            for (int i = 0; i < 8; ++i) allstop &= flags[(par ^ 1) * 8 + i]; }
        if (allstop) break;
        dma(max(kt - 3, 0), (j + 3) & 3);
        const LAS char* cur = lds + (j & 3) * 18432;
        u64 mword = 0ull;
        if (k0 <= qwmax) mword = *(const LAS u64*)(cur + 16384 + (32 * w + l31) * 8);
        if (k0 <= qwmax && __ballot(mword != 0ull) != 0ull) {
            if (!offset_set && mword != 0ull) { off = B2 - c2 * (float)max(qpos - (k0 + 63), 0); offset_set = true; }
            attn_tile<2, true>(cur, cur + 8192, qf, o, off, mlow, lrun, qpos, k0, c1, c2, false, __any(mlow == -INFINITY), mword);
        }
        {
            const float ub = B2 - c2 * (float)(qpos - (k0 - 1));
            const bool stop = __all(ub < mlow - 30.f);
            if (lane == 0) flags[par * 8 + w] = stop ? 1 : 0;
        }
        par ^= 1;
    }
    asm volatile("s_waitcnt vmcnt(0) lgkmcnt(0)" ::: "memory");
    __builtin_amdgcn_s_barrier();
#ifdef XP_DUPLOOP
  }
#endif
    const float ltot = lrun + __shfl_xor(lrun, 32);
    const float inv = 1.f / ltot;
    bf16_t* ao = (bf16_t*)(P.ws + OFF_H) + ((size_t)b * NS + qpos) * 1024 + 512 + h * 64;
#pragma unroll
    for (int db = 0; db < 2; ++db)
#pragma unroll
        for (int q4 = 0; q4 < 4; ++q4) {
            const int d = 32 * db + 8 * q4 + 4 * hf;
            u32x2 pk; pk[0] = pk2(o[db][4 * q4] * inv, o[db][4 * q4 + 1] * inv); pk[1] = pk2(o[db][4 * q4 + 2] * inv, o[db][4 * q4 + 3] * inv);
            *(u32x2*)(ao + d) = pk;
        }
}

constexpr int P3_ITEMS = 128 * 8;
DI void phase_indexer(const Params& P, char* smem) {
    const XPart xp = xcd_part(P.ws, smem, P3_ITEMS);
    const int lo = xp.start - (xp.start % 1 ? 0 : 0);
    const int step = xp.step;
    const int rank = ((const int*)(smem + XC_LDS))[1];
    const int base = xp.start - rank;
    for (int k = 0; base + k * step < xp.end; ++k) {
        const int i = base + k * step + ((k & 1) ? step - 1 - rank : rank);
        if (i >= xp.end) continue;
        const int b = i >> 7, g = 127 - (i & 127);
        __syncthreads();
        indexer_item(P, smem, b, g * 64);
    }
    __syncthreads();
    (void)lo;
}
DI void phase_attn(const Params& P, char* smem, int qidx) {
    int* qctr = (int*)(P.ws + OFF_Q) + qidx;
    const int* items = (const int*)(P.ws + OFF_ITEMS);
    volatile int* s_it = (volatile int*)(smem + SM_EXTRA + 3200);
    __syncthreads();
    if (threadIdx.x < 128) ((float*)(smem + SM_EXTRA + 1024))[threadIdx.x] = P.subln_g[threadIdx.x];
    __syncthreads();
    for (;;) {
        __syncthreads();
        if (threadIdx.x == 0) *s_it = atomicAdd(qctr, 1);
        __syncthreads();
        const int it = *s_it;
        if (it >= ATT_ITEMS) break;
        const int code = items[it];
        const int b = (code >> 16) & 15, h = (code >> 8) & 255, qb = code & 255;
        if ((code >> 20) == 0) diffattn_item(P, smem, b, h, qb);
        else dsa_item(P, smem, b, h, qb);
    }
}

constexpr int OUTPROJ_ITEMS = (NT / 256) * 4;
DI void phase_outproj(const Params& P, char* smem) {
    const bf16_t* zrow = (const bf16_t*)(P.ws + OFF_ZROW);
    const bf16_t* ao = (const bf16_t*)(P.ws + OFF_H);
    const bf16_t* wout = (const bf16_t*)(P.ws + OFF_WOUT);
    bf16_t* mix = (bf16_t*)(P.ws + OFF_QD);
    const int lane = threadIdx.x & 63, w = threadIdx.x >> 6, wm = w >> 1, wn = w & 1, l31 = lane & 31, hf = lane >> 5;
    const XPart xp = xcd_part(P.ws, smem, OUTPROJ_ITEMS);
    for (int it = xp.start; it < xp.end; it += xp.step) {
        const int mt = it >> 2, j = it & 3;
        const int row0 = mt * 256;
        DenseRows ar{ao + (size_t)row0 * 1024, 1024};
        gemm_dma<true, 256>(smem, ar, wout + (size_t)j * 256 * 1024, 1024, 4, 1, zrow, [&](int, const f32x16 (&acc)[2][4]) {
#pragma unroll
            for (int mi = 0; mi < 2; ++mi)
#pragma unroll
                for (int pr = 0; pr < 2; ++pr) {
                    bf16_t* base = mix + ((size_t)row0 + 64 * wm + 32 * mi) * 1024 + 256 * j + 128 * wn + 64 * pr;
                    stage_store_chunk(smem, acc[mi][2 * pr], acc[mi][2 * pr + 1], [](int, int, float x) { return x; }, [&](int r) { return base + (size_t)r * 1024; });
                }
        });
    }
}
DI void phase_resnorm2(const Params& P) {
    const bf16_t* mix = (const bf16_t*)(P.ws + OFF_QD);
    const float* mod = (const float*)(P.ws + OFF_MOD);
    bf16_t* h2 = (bf16_t*)(P.ws + OFF_H2);
    const int lane = threadIdx.x & 63, w = threadIdx.x >> 6;
    for (int row = blockIdx.x * NW + w; row < NT; row += gridDim.x * NW) {
        const int b = row >> 13;
        const float* mb = mod + b * 6144;
        f32x4 v[4]; float ss = 0.f;
#pragma unroll
        for (int i = 0; i < 4; ++i) {
            const int col = 256 * i + 4 * lane;
            const f32x4 xv = *(const f32x4*)(P.x + (size_t)row * 1024 + col);
            const u32x2 mv = *(const u32x2*)(mix + (size_t)row * 1024 + col);
            const f32x4 g1 = *(const f32x4*)(mb + 2048 + col);
            v[i][0] = xv[0] + g1[0] * bflo(mv[0]); v[i][1] = xv[1] + g1[1] * bfhi(mv[0]);
            v[i][2] = xv[2] + g1[2] * bflo(mv[1]); v[i][3] = xv[3] + g1[3] * bfhi(mv[1]);
            *(f32x4*)(P.out + (size_t)row * 1024 + col) = v[i];
            ss += v[i][0] * v[i][0] + v[i][1] * v[i][1] + v[i][2] * v[i][2] + v[i][3] * v[i][3];
        }
        ss = wave_sum(ss);
        const float rstd = rsqrtf(ss * (1.f / 1024.f) + EPSF);
#pragma unroll
        for (int i = 0; i < 4; ++i) {
            const int col = 256 * i + 4 * lane;
            const f32x4 gg = *(const f32x4*)(P.norm2_g + col);
            const f32x4 sh = *(const f32x4*)(mb + 3072 + col);
            const f32x4 sc = *(const f32x4*)(mb + 4096 + col);
            float o[4];
#pragma unroll
            for (int j = 0; j < 4; ++j) o[j] = v[i][j] * rstd * gg[j] * (1.f + sc[j]) + sh[j];
            u32x2 pk; pk[0] = pk2(o[0], o[1]); pk[1] = pk2(o[2], o[3]);
            *(u32x2*)(h2 + (size_t)row * 1024 + col) = pk;
        }
    }
}

constexpr int ROUTER_ITEMS = NT / 256;
DI void phase_router(const Params& P, char* smem) {
    const bf16_t* zrow = (const bf16_t*)(P.ws + OFF_ZROW);
    const bf16_t* h2 = (const bf16_t*)(P.ws + OFF_H2);
    const bf16_t* wrt = (const bf16_t*)(P.ws + OFF_WRT);
    float* logits = (float*)(P.ws + OFF_Y);
    const int lane = threadIdx.x & 63, w = threadIdx.x >> 6, wm = w >> 1, wn = w & 1, l31 = lane & 31, hf = lane >> 5;
    for (int it = blockIdx.x; it < ROUTER_ITEMS; it += gridDim.x) {
        const int row0 = it * 256;
        DenseRows ar{h2 + (size_t)row0 * 1024, 1024};
        gemm_dma<true, 256>(smem, ar, wrt, 1024, 4, 1, zrow, [&](int, const f32x16 (&acc)[2][4]) {
#pragma unroll
            for (int mi = 0; mi < 2; ++mi) {
                const size_t tok = (size_t)row0 + 64 * wm + 32 * mi + l31;
#pragma unroll
                for (int ni = 0; ni < 4; ++ni)
#pragma unroll
                    for (int q4 = 0; q4 < 4; ++q4) {
                        const int n = 128 * wn + 32 * ni + 8 * q4 + 4 * hf;
                        f32x4 ov = {acc[mi][ni][4 * q4], acc[mi][ni][4 * q4 + 1], acc[mi][ni][4 * q4 + 2], acc[mi][ni][4 * q4 + 3]};
                        *(f32x4*)(logits + tok * 256 + n) = ov;
                    }
            }
        });
    }
}

DI void phase_route(const Params& P) {
    const float* logits = (const float*)(P.ws + OFF_Y);
    int* cnt = (int*)(P.ws + OFF_CNT);
    int* list = (int*)(P.ws + OFF_LIST);
    int* eidx = (int*)(P.ws + OFF_EIDX);
    float* gates = (float*)(P.ws + OFF_GATE);
    const int lane = threadIdx.x & 63, w = threadIdx.x >> 6;
    const f32x4 bias = *(const f32x4*)(P.router_b + 4 * lane);
    for (int t = blockIdx.x * NW + w; t < NT; t += gridDim.x * NW) {
        const f32x4 lg = *(const f32x4*)(logits + (size_t)t * 256 + 4 * lane);
        float sc[4], cand[4];
#pragma unroll
        for (int i = 0; i < 4; ++i) { sc[i] = 1.f / (1.f + __expf(-lg[i])); cand[i] = sc[i] + bias[i]; }
        float t1 = fmaxf(cand[0], cand[1]), t2 = fminf(cand[0], cand[1]);
#pragma unroll
        for (int i = 2; i < 4; ++i) { const float v = cand[i]; t2 = fmaxf(t2, fminf(t1, v)); t1 = fmaxf(t1, v); }
#pragma unroll
        for (int d = 1; d < 8; d <<= 1) {
            const float o1 = __shfl_xor(t1, d), o2 = __shfl_xor(t2, d);
            const float n1 = fmaxf(t1, o1), n2 = fmaxf(fminf(t1, o1), fmaxf(t2, o2));
            t1 = n1; t2 = n2;
        }
        const float gs = t1 + t2;
        const int myg = lane >> 3;
        int rank = 0;
#pragma unroll
        for (int g = 0; g < 8; ++g) { const float sg = __shfl(gs, 8 * g); rank += (sg > gs || (sg == gs && g < myg)) ? 1 : 0; }
        if (rank >= 4) {
#pragma unroll
            for (int i = 0; i < 4; ++i) cand[i] = -INFINITY;
        }
        int sel[8]; float wv[8]; float wsum = 0.f;
#pragma unroll
        for (int k = 0; k < 8; ++k) {
            float bv = cand[0]; int bi = 0;
#pragma unroll
            for (int i = 1; i < 4; ++i) if (cand[i] > bv) { bv = cand[i]; bi = i; }
            int be = 4 * lane + bi;
#pragma unroll
            for (int d = 32; d >= 1; d >>= 1) {
                const float ov = __shfl_xor(bv, d); const int oe = __shfl_xor(be, d);
                if (ov > bv || (ov == bv && oe < be)) { bv = ov; be = oe; }
            }
            const int ol = be >> 2, oi = be & 3;
            float mys = (oi == 0) ? sc[0] : (oi == 1) ? sc[1] : (oi == 2) ? sc[2] : sc[3];
            const float ws_ = __shfl(mys, ol);
            if (lane == ol) {
#pragma unroll
                for (int i = 0; i < 4; ++i) if (i == oi) cand[i] = -INFINITY;
            }
            sel[k] = be; wv[k] = ws_; wsum += ws_;
        }
        const float rs = 2.5f / wsum;
        int my_e = 256; float my_g = 1.f;
#pragma unroll
        for (int k = 0; k < 8; ++k) if (lane == k) { my_e = sel[k]; my_g = wv[k] * rs; }
        const int c = t >> 14, tl = t & (CHUNK_T - 1);
        if (lane < 8) {
            eidx[(size_t)t * 8 + lane] = my_e; gates[(size_t)t * 8 + lane] = my_g;
            const int pos = atomicAdd(&cnt[c * NEXP1 + my_e], 1);
            list[((size_t)c * NEXP1 + my_e) * CHUNK_T + pos] = tl * NPAIR + lane;
        } else if (lane == 8) {
            list[((size_t)c * NEXP1 + 256) * CHUNK_T + tl] = tl * NPAIR + 8;
        }
    }
}

typedef unsigned short u16;
DI void moe_build_tiles(const Params& P, char* smem, int c, int& totalA, int& totalB) {
    u16* tA = (u16*)(smem + SM_EXTRA);
    u16* tB = (u16*)(smem + SM_EXTRA + 528);
    int* wsum = (int*)(smem + SM_EXTRA + 1048);
    const int* cnt = (const int*)(P.ws + OFF_CNT) + c * NEXP1;
    const int e = threadIdx.x, lane = e & 63, w = e >> 6;
    __syncthreads();
    int na = 0, nb = 0, ia = 0, ib = 0;
    if (e < 256) {
        const int n = cnt[e], full = n >> 8, rem = n & 255;
        na = full + (rem > 128 ? 1 : 0); nb = (rem >= 1 && rem <= 128) ? 1 : 0;
        ia = na; ib = nb;
#pragma unroll
        for (int d = 1; d < 64; d <<= 1) { const int t = __shfl_up(ia, d), u = __shfl_up(ib, d); if (lane >= d) { ia += t; ib += u; } }
        if (lane == 63) { wsum[w] = ia; wsum[4 + w] = ib; }
    }
    __syncthreads();
    if (e < 256) {
        int oa = 0, ob = 0;
#pragma unroll
        for (int i = 0; i < 4; ++i) if (i < w) { oa += wsum[i]; ob += wsum[4 + i]; }
        tA[e] = (u16)(oa + ia - na); tB[e] = (u16)(ob + ib - nb);
        if (e == 255) { tA[256] = (u16)(oa + ia); tA[257] = (u16)(oa + ia + CHUNK_T / 256); tB[256] = (u16)(ob + ib); tB[257] = (u16)(ob + ib); }
    }
    __syncthreads();
    totalA = tA[NEXP1]; totalB = tB[NEXP1];
}
DI int moe_find_expert(const u16* tstart, int tile) {
    int lo = 0, hi = NEXP1;
    while (hi - lo > 1) { const int mid = (lo + hi) >> 1; if ((int)tstart[mid] <= tile) lo = mid; else hi = mid; }
    return lo;
}
struct GatherRows {
    static constexpr bool kDense = false;
    const bf16_t* base; int ld; const int* pid; int div;
    DI const bf16_t* operator()(int r) const { const int p = pid[r]; return p < 0 ? nullptr : base + (size_t)(p / div) * ld; }
};
template <int BM>
DI void moe_g1_tiles(const Params& P, char* smem, int c, const u16* tstart, int total) {
    const bf16_t* zrow = (const bf16_t*)(P.ws + OFF_ZROW);
    int* pid = (int*)(smem + SM_EXTRA + 1088);
    const int* cnt = (const int*)(P.ws + OFF_CNT) + c * NEXP1;
    const int* list = (const int*)(P.ws + OFF_LIST) + (size_t)c * NEXP1 * CHUNK_T;
    const bf16_t* h2 = (const bf16_t*)(P.ws + OFF_H2) + (size_t)c * CHUNK_T * 1024;
    const bf16_t* wgu = (const bf16_t*)(P.ws + OFF_WGU);
    bf16_t* act = (bf16_t*)(P.ws + OFF_ACT + (size_t)(c & 1) * ACT_BYTES);
    const int lane = threadIdx.x & 63, w = threadIdx.x >> 6, wm = BM == 256 ? (w >> 1) : (w >> 2), wn = BM == 256 ? (w & 1) : (w & 3), l31 = lane & 31, hf = lane >> 5;
    const XPart xp = xcd_part(P.ws, smem, total * 2);
    for (int it = xp.start; it < xp.end; it += xp.step) {
        const int tile = it >> 1, half = it & 1;
        const int e = moe_find_expert(tstart, tile), ti = tile - tstart[e];
        const int n = e < NEXP ? cnt[e] : CHUNK_T;
        const int li0 = BM == 256 ? ti * 256 : (n >> 8) * 256;
        __syncthreads();
        if (threadIdx.x < BM) { const int li = li0 + threadIdx.x; pid[threadIdx.x] = li < n ? list[(size_t)e * CHUNK_T + li] : -1; }
        __syncthreads();
        GatherRows ar{h2, 1024, pid, NPAIR};
        if constexpr (BM == 256) {
            gemm_dma<true, 256>(smem, ar, wgu + ((size_t)e * 512 + half * 256) * 1024, 1024, 4, 1, zrow, [&](int, const f32x16 (&acc)[2][4]) {
#pragma unroll
                for (int mi = 0; mi < 2; ++mi) {
                    f32x16 t0, t1;
#pragma unroll
                    for (int i = 0; i < 16; ++i) { t0[i] = silu_f(acc[mi][0][i]) * acc[mi][1][i]; t1[i] = silu_f(acc[mi][2][i]) * acc[mi][3][i]; }
                    const int* prow = pid + 64 * wm + 32 * mi;
                    bf16_t* abase = act + 128 * half + 64 * wn;
                    stage_store_chunk(smem, t0, t1, [](int, int, float x) { return x; }, [&](int r) { const int pp = prow[r]; return pp >= 0 ? abase + (size_t)pp * 256 : (bf16_t*)nullptr; });
                }
            });
        } else {
            gemm_dma<true, 128>(smem, ar, wgu + ((size_t)e * 512 + half * 256) * 1024, 1024, 4, 1, zrow, [&](int, const f32x16 (&acc)[2][2]) {
#pragma unroll
                for (int mi = 0; mi < 2; ++mi) {
                    const int p = pid[64 * wm + 32 * mi + l31];
                    if (p >= 0) {
                        bf16_t* arow_ = act + (size_t)p * 256 + 128 * half + 32 * wn;
#pragma unroll
                        for (int q4 = 0; q4 < 4; ++q4) {
                            float o[4];
#pragma unroll
                            for (int r = 0; r < 4; ++r) { const float g = acc[mi][0][4 * q4 + r], u = acc[mi][1][4 * q4 + r]; o[r] = silu_f(g) * u; }
                            u32x2 pk; pk[0] = pk2(o[0], o[1]); pk[1] = pk2(o[2], o[3]);
                            *(u32x2*)(arow_ + 8 * q4 + 4 * hf) = pk;
                        }
                    }
                }
            });
        }
    }
}
DI void phase_moe_g1(const Params& P, char* smem, int c) {
    int totalA, totalB;
    moe_build_tiles(P, smem, c, totalA, totalB);
    moe_g1_tiles<256>(P, smem, c, (const u16*)(smem + SM_EXTRA), totalA);
    moe_g1_tiles<128>(P, smem, c, (const u16*)(smem + SM_EXTRA + 528), totalB);
}
template <int BM>
DI void moe_g2_tiles(const Params& P, char* smem, int c, const u16* tstart, int total) {
    const bf16_t* zrow = (const bf16_t*)(P.ws + OFF_ZROW);
    int* pid = (int*)(smem + SM_EXTRA + 1088);
    float* gsm = (float*)(smem + SM_EXTRA + 2112);
    const int* cnt = (const int*)(P.ws + OFF_CNT) + c * NEXP1;
    const int* list = (const int*)(P.ws + OFF_LIST) + (size_t)c * NEXP1 * CHUNK_T;
    const float* gates = (const float*)(P.ws + OFF_GATE) + (size_t)c * CHUNK_T * 8;
    const bf16_t* wd = (const bf16_t*)(P.ws + OFF_WD);
    const bf16_t* act = (const bf16_t*)(P.ws + OFF_ACT + (size_t)(c & 1) * ACT_BYTES);
    bf16_t* y = (bf16_t*)(P.ws + OFF_Y);
    const int lane = threadIdx.x & 63, w = threadIdx.x >> 6, wm = BM == 256 ? (w >> 1) : (w >> 2), wn = BM == 256 ? (w & 1) : (w & 3), l31 = lane & 31;
    const XPart xp = xcd_part(P.ws, smem, total * 2);
    for (int it = xp.start; it < xp.end; it += xp.step) {
        const int tile = it >> 1, half = it & 1;
        const int e = moe_find_expert(tstart, tile), ti = tile - tstart[e];
        const int n = e < NEXP ? cnt[e] : CHUNK_T;
        const int li0 = BM == 256 ? ti * 256 : (n >> 8) * 256;
        __syncthreads();
        if (threadIdx.x < BM) {
            const int li = li0 + threadIdx.x; const int pp = li < n ? list[(size_t)e * CHUNK_T + li] : -1;
            pid[threadIdx.x] = pp;
            float g = 1.f;
            if (pp >= 0 && (pp % NPAIR) < 8) g = gates[(size_t)(pp / NPAIR) * 8 + (pp % NPAIR)];
            gsm[threadIdx.x] = g;
        }
        __syncthreads();
        GatherRows ar{act, 256, pid, 1};
        if constexpr (BM == 256) {
            gemm_dma<true, 256>(smem, ar, wd + ((size_t)e * 1024 + half * 512) * 256, 256, 2, 2, zrow, [&](int t, const f32x16 (&acc)[2][4]) {
#pragma unroll
                for (int mi = 0; mi < 2; ++mi) {
                    const float g = gsm[64 * wm + 32 * mi + l31];
                    const int* prow = pid + 64 * wm + 32 * mi;
#pragma unroll
                    for (int pr = 0; pr < 2; ++pr) {
                        const int cb = half * 512 + t * 256 + 128 * wn + 64 * pr;
                        stage_store_chunk(smem, acc[mi][2 * pr], acc[mi][2 * pr + 1], [&](int, int, float x) { return x * g; }, [&](int r) { const int pp = prow[r]; return pp >= 0 ? y + (size_t)pp * 1024 + cb : (bf16_t*)nullptr; });
                    }
                }
            });
        } else {
            gemm_dma<true, 128>(smem, ar, wd + ((size_t)e * 1024 + half * 512) * 256, 256, 2, 2, zrow, [&](int t, const f32x16 (&acc)[2][2]) {
                const int cb = half * 512 + t * 256 + 64 * wn;
#pragma unroll
                for (int mi = 0; mi < 2; ++mi) {
                    const float g = gsm[64 * wm + 32 * mi + l31];
                    const int* prow = pid + 64 * wm + 32 * mi;
                    stage_store_chunk(smem, acc[mi][0], acc[mi][1], [&](int, int, float x) { return x * g; }, [&](int r) { const int pp = prow[r]; return pp >= 0 ? y + (size_t)pp * 1024 + cb : (bf16_t*)nullptr; });
                }
            });
        }
    }
}
DI void phase_moe_g2(const Params& P, char* smem, int c) {
    int totalA, totalB;
    moe_build_tiles(P, smem, c, totalA, totalB);
    moe_g2_tiles<256>(P, smem, c, (const u16*)(smem + SM_EXTRA), totalA);
    moe_g2_tiles<128>(P, smem, c, (const u16*)(smem + SM_EXTRA + 528), totalB);
}
DI void phase_moe_combine(const Params& P, int c) {
    const bf16_t* y = (const bf16_t*)(P.ws + OFF_Y);
    const float* mod = (const float*)(P.ws + OFF_MOD);
    const int lane = threadIdx.x & 63, w = threadIdx.x >> 6;
    for (int tl = blockIdx.x * NW + w; tl < CHUNK_T; tl += gridDim.x * NW) {
        const size_t t = (size_t)c * CHUNK_T + tl;
        const int b = (int)(t >> 13);
        const float* g2 = mod + b * 6144 + 5120;
#pragma unroll
        for (int i = 0; i < 4; ++i) {
            const int col = 256 * i + 4 * lane;
            float s[4] = {0.f, 0.f, 0.f, 0.f};
#pragma unroll
            for (int k = 0; k < NPAIR; ++k) {
                const u32x2 v = *(const u32x2*)(y + ((size_t)tl * NPAIR + k) * 1024 + col);
                s[0] += bflo(v[0]); s[1] += bfhi(v[0]); s[2] += bflo(v[1]); s[3] += bfhi(v[1]);
            }
            const f32x4 xv = *(const f32x4*)(P.out + t * 1024 + col);
            const f32x4 gv = *(const f32x4*)(g2 + col);
            f32x4 ov;
#pragma unroll
            for (int r = 0; r < 4; ++r) ov[r] = xv[r] + gv[r] * s[r];
            *(f32x4*)(P.out + t * 1024 + col) = ov;
        }
    }
}

constexpr int NPHASE = 18;
template <int PH, int REP = 0> DI void run_phase(const Params& Pin, char* smem) {
    Params P = Pin;
    { typedef __attribute__((address_space(1))) char gchar; gchar* g = (gchar*)Pin.ws; asm volatile("" : "+s"(g)); P.ws = (char*)g; }
    float* mod = (float*)(P.ws + OFF_MOD);
    if constexpr (PH == 0) phase_adaln(P, smem);
    else if constexpr (PH == 1) { phase_norm(P.x, P.norm1_g, mod, 0, 1024, (bf16_t*)(P.ws + OFF_H)); phase_convert(P, smem); }
    else if constexpr (PH == 2) phase_inproj(P, smem);
    else if constexpr (PH == 3) phase_indexer(P, smem);
    else if constexpr (PH == 4) phase_attn(P, smem, REP);
    else if constexpr (PH == 5) phase_outproj(P, smem);
    else if constexpr (PH == 6) phase_resnorm2(P);
    else if constexpr (PH == 7) phase_router(P, smem);
    else if constexpr (PH == 8) phase_route(P);
    else if constexpr (PH == 9) phase_moe_g1(P, smem, 0);
    else if constexpr (PH == 10) { phase_moe_g2(P, smem, 0); phase_moe_g1(P, smem, 1); }
    else if constexpr (PH == 11) phase_moe_combine(P, 0);
    else if constexpr (PH == 12) { phase_moe_g2(P, smem, 1); phase_moe_g1(P, smem, 2); }
    else if constexpr (PH == 13) phase_moe_combine(P, 1);
    else if constexpr (PH == 14) { phase_moe_g2(P, smem, 2); phase_moe_g1(P, smem, 3); }
    else if constexpr (PH == 15) phase_moe_combine(P, 2);
    else if constexpr (PH == 16) phase_moe_g2(P, smem, 3);
    else if constexpr (PH == 17) phase_moe_combine(P, 3);
}
#ifndef DUP_PHASE
#define DUP_PHASE -1
#endif
#ifndef PROBE_PHASE
#define PROBE_PHASE -1
#endif
#ifndef PROBE_SCALE
#define PROBE_SCALE 0.1f
#endif
#define MK_RUN(PH) if constexpr (P0 <= PH && PH < P1) { \
    unsigned long long t0_ = 0; if constexpr (PH == PROBE_PHASE) t0_ = __builtin_amdgcn_s_memrealtime(); \
    run_phase<PH>(P, smem); if constexpr (PH == DUP_PHASE) { xcd_barrier(bar); run_phase<PH, 1>(P, smem); } \
    if constexpr (PH + 1 < P1 || PH == PROBE_PHASE) xcd_barrier(bar); \
    if constexpr (PH == PROBE_PHASE) { if (blockIdx.x == 0 && threadIdx.x == 0) *(volatile unsigned*)(P.ws + OFF_ERR + 512) = (unsigned)(__builtin_amdgcn_s_memrealtime() - t0_); } }
template <int P0, int P1>
__global__ void __launch_bounds__(NTH, 2) mk_kernel(Params P) {
    __shared__ __attribute__((aligned(16))) char smem[SMEM_BYTES + 16];
    if (threadIdx.x == 0) {
        *(uint4*)(smem + SMEM_BYTES) = make_uint4(0u, 0u, 0u, 0u);
        const int x = (int)xb_xcc_id();
        ((int*)(smem + XC_LDS))[0] = x;
        ((int*)(smem + XC_LDS))[1] = atomicAdd((int*)(P.ws + OFF_XRANK) + x, 1);
    }
    __syncthreads();
    XcdBarrier bar;
    if constexpr (P1 - P0 > 1 || PROBE_PHASE >= 0) bar = xcd_barrier_post((unsigned*)(P.ws + OFF_BAR), (volatile LAS unsigned*)(LAS char*)(smem + SMEM_BYTES));
    MK_RUN(0) MK_RUN(1) MK_RUN(2) MK_RUN(3) MK_RUN(4) MK_RUN(5) MK_RUN(6) MK_RUN(7) MK_RUN(8)
    MK_RUN(9) MK_RUN(10) MK_RUN(11) MK_RUN(12) MK_RUN(13) MK_RUN(14) MK_RUN(15) MK_RUN(16) MK_RUN(17)
    if constexpr (PROBE_PHASE >= 0) {
        xcd_barrier(bar);
        const float us = (float)(*(volatile unsigned*)(P.ws + OFF_ERR + 512)) * 0.01f;
        const float cval = sqrtf(us * PROBE_SCALE);
        for (size_t i = (size_t)blockIdx.x * NTH + threadIdx.x; i < (size_t)NT * 1024 / 4; i += (size_t)gridDim.x * NTH) ((f32x4*)P.out)[i] = (f32x4){cval, cval, cval, cval};
    }
}

template <int P0, int P1> static void launch_range(const Params& p, hipStream_t stream) {
    static int grid = 0;
    if (!grid) {
        int dev = 0, cus = 0, per_cu = 0;
        (void)hipGetDevice(&dev);
        (void)hipDeviceGetAttribute(&cus, hipDeviceAttributeMultiprocessorCount, dev);
        (void)(void)hipOccupancyMaxActiveBlocksPerMultiprocessor(&per_cu, mk_kernel<P0, P1>, NTH, 0);
        if (cus <= 0) cus = 256;
        if (per_cu < 1) per_cu = 1;
        grid = cus * (per_cu < 1 ? 1 : 1);
    }
    mk_kernel<P0, P1><<<dim3(grid), dim3(NTH), 0, stream>>>(p);
}

extern "C" void kernel_launch(void* const* d_in, const int* in_sizes, int n_in, void* d_out, int out_size, void* d_ws, size_t ws_size, hipStream_t stream) {
    if (ws_size < WS_NEED) return;
    if (ws_size < WS_NEED) return;
    Params p{};
    const float** f = (const float**)&p;
    for (int i = 0; i < 26; ++i) f[i] = (const float*)d_in[i];
    p.out = (float*)d_out;
    p.ws = (char*)d_ws;
    (void)hipMemsetAsync(d_ws, 0, ZERO_BYTES, stream);
#if MK_ONE_LAUNCH
    launch_range<0, NPHASE>(p, stream);
#else
    launch_range<0, 1>(p, stream); launch_range<1, 2>(p, stream); launch_range<2, 3>(p, stream); launch_range<3, 4>(p, stream);
    launch_range<4, 5>(p, stream); launch_range<5, 6>(p, stream); launch_range<6, 7>(p, stream); launch_range<7, 8>(p, stream);
    launch_range<8, 9>(p, stream); launch_range<9, 10>(p, stream); launch_range<10, 11>(p, stream); launch_range<11, 12>(p, stream);
    launch_range<12, 13>(p, stream); launch_range<13, 14>(p, stream); launch_range<14, 15>(p, stream); launch_range<15, 16>(p, stream);
    launch_range<16, 17>(p, stream); launch_range<17, 18>(p, stream);
#endif
}
```

```cpp
#include <hip/hip_runtime.h>
#include <stdint.h>

#define DI __device__ __forceinline__
#define LAS __attribute__((address_space(3)))
typedef unsigned short bf16_t;
typedef short bf16x8 __attribute__((ext_vector_type(8)));
typedef short s16x4 __attribute__((ext_vector_type(4)));
typedef float f32x16 __attribute__((ext_vector_type(16)));
typedef float f32x4 __attribute__((ext_vector_type(4)));
typedef float f32x2 __attribute__((ext_vector_type(2)));
typedef __bf16 bf16v2 __attribute__((ext_vector_type(2)));
typedef unsigned u32x4 __attribute__((ext_vector_type(4)));
typedef unsigned u32x2 __attribute__((ext_vector_type(2)));
typedef unsigned long long u64;
#define MFMA32(a, b, c) __builtin_amdgcn_mfma_f32_32x32x16_bf16((a), (b), (c), 0, 0, 0)

constexpr int NB = 8, NS = 8192, ND = 1024, NT = NB * NS;
constexpr int IN_COLS = 3656, NPAD = 3840;
constexpr int NTH = 512, NW = 8;
constexpr int NEXP = 256, NEXP1 = 257;
constexpr int NCHUNK = 4, CHUNK_T = NT / NCHUNK;
constexpr int NPAIR = 9;
constexpr float EPSF = 1e-6f;
constexpr float LOG2E = 1.4426950408889634f;

constexpr size_t MiB = 1048576;
constexpr size_t OFF_BAR = 0;
constexpr size_t OFF_MOD = 16384;
constexpr size_t OFF_CNT = OFF_MOD + 196608;
constexpr size_t OFF_ERR = OFF_CNT + 8192;
constexpr size_t OFF_Q = OFF_ERR;
constexpr size_t OFF_XRANK = OFF_ERR + 128;
constexpr size_t OFF_XQ = OFF_ERR + 256;
constexpr size_t OFF_ITEMS = OFF_ERR + 1024;
constexpr size_t OFF_ZROW = 245760;
constexpr size_t ZERO_BYTES = 262144;
constexpr size_t OFF_WIN = 1 * MiB;
constexpr size_t OFF_WOUT = OFF_WIN + (size_t)NPAD * 1024 * 2;
constexpr size_t OFF_WRT = OFF_WOUT + 2 * MiB;
constexpr size_t OFF_WGU = 12 * MiB;
constexpr size_t OFF_WD = OFF_WGU + (size_t)NEXP1 * 512 * 1024 * 2;
constexpr size_t OFF_R1 = OFF_WD + (size_t)NEXP1 * 1024 * 256 * 2;
constexpr size_t OFF_H = OFF_R1;
constexpr size_t OFF_QD = OFF_H + 128 * MiB;
constexpr size_t OFF_KD = OFF_QD + 64 * MiB;
constexpr size_t OFF_VDT = OFF_KD + 64 * MiB;
constexpr size_t OFF_QS = OFF_VDT + 64 * MiB;
constexpr size_t OFF_KS = OFF_QS + 64 * MiB;
constexpr size_t OFF_VST = OFF_KS + 64 * MiB;
constexpr size_t OFF_IQ = OFF_VST + 64 * MiB;
constexpr size_t OFF_IK = OFF_IQ + 64 * MiB;
constexpr size_t OFF_IW = OFF_IK + 8 * MiB;
constexpr size_t OFF_MASK = OFF_IW + 2 * MiB;
constexpr size_t END_A = OFF_MASK + 64 * MiB;
constexpr size_t OFF_H2 = OFF_R1;
constexpr size_t OFF_LIST = OFF_H2 + 128 * MiB;
constexpr size_t OFF_EIDX = OFF_LIST + (size_t)NCHUNK * NEXP1 * CHUNK_T * 4;
constexpr size_t OFF_GATE = OFF_EIDX + 2 * MiB;
constexpr size_t OFF_ACT = OFF_GATE + 2 * MiB;
constexpr size_t ACT_BYTES = (size_t)CHUNK_T * NPAIR * 256 * 2;
constexpr size_t OFF_Y = OFF_ACT + 2 * ACT_BYTES;
constexpr size_t END_B = OFF_Y + (size_t)CHUNK_T * NPAIR * 1024 * 2;
constexpr size_t WS_NEED = END_A > END_B ? END_A : END_B;

struct Params {
    const float *x, *c, *ada_w, *ada_b, *norm1_g, *norm2_g, *w_in, *dq_g, *dk_g, *lq1, *lk1, *lq2, *lk2, *subln_g, *sq_g, *sk_g, *ik_g,
        *w_out, *router_w, *router_b, *ew_gate, *ew_up, *ew_down, *sw_gate, *sw_up, *sw_down;
    float* out;
    char* ws;
};

DI unsigned pk2(float a, float b) { f32x2 f = {a, b}; bf16v2 r = __builtin_convertvector(f, bf16v2); return __builtin_bit_cast(unsigned, r); }
DI float bf2f(bf16_t v) { return __uint_as_float(((unsigned)v) << 16); }
DI float bflo(unsigned u) { return __uint_as_float(u << 16); }
DI float bfhi(unsigned u) { return __uint_as_float(u & 0xffff0000u); }
DI int crow(int i, int hf) { return (i & 3) + 8 * (i >> 2) + 4 * hf; }
constexpr int LROW = 144;
DI int lofs(int row, int chunk) { return row * LROW + chunk * 16; }
DI float wave_sum(float v) {
#pragma unroll
    for (int d = 32; d >= 1; d >>= 1) v += __shfl_xor(v, d);
    return v;
}
DI float silu_f(float v) { return v / (1.f + __expf(-v)); }

#define XB_TMO      128
#define XB_XCNT(j)  (256  + 64 * (j))
#define XB_XSUB(j)  (1280 + 64 * (j))
#define XB_XGEN(j)  (2304 + 64 * (j))
#define XB_TOP      3328
#define XB_TOPGEN   3392
#define XCD_BAR_WORDS 3456
#define XB_SPIN_CAP (1u << 18)

__device__ __forceinline__ unsigned xb_ld(unsigned* p)              { return __hip_atomic_load(p, __ATOMIC_RELAXED, __HIP_MEMORY_SCOPE_AGENT); }
__device__ __forceinline__ unsigned xb_add(unsigned* p, unsigned v) { return __hip_atomic_fetch_add(p, v, __ATOMIC_RELAXED, __HIP_MEMORY_SCOPE_AGENT); }
__device__ __forceinline__ unsigned xb_xcc_id() { return (unsigned)__builtin_amdgcn_s_getreg((3 << 11) | 20) & 0xFu; }
#define XB_SPIN(cond, bar) do { unsigned _sp = 0; while (cond) { __builtin_amdgcn_s_sleep(1); \
    if ((++_sp & 255u) == 0u) { if (xb_ld(&(bar)[XB_TMO])) break; if (_sp > XB_SPIN_CAP) { atomicAdd(&(bar)[XB_TMO], 1u); break; } } } } while (0)

struct XcdBarrier {
    unsigned* bar; unsigned x;
    volatile LAS unsigned* st;
};
__device__ __forceinline__ XcdBarrier xcd_barrier_post(unsigned* bar, volatile LAS unsigned* st) {
    XcdBarrier b; b.bar = bar; b.x = xb_xcc_id(); b.st = st;
    if (threadIdx.x == 0) (void)xb_add(&bar[XB_XCNT(b.x)], 1u);
    return b;
}
__device__ __forceinline__ void xcd_barrier_complete(unsigned* bar, unsigned x, unsigned& nloc, unsigned& nx) {
    const unsigned G = gridDim.x * gridDim.y * gridDim.z;
    unsigned sum, cnt, mine, sp = 0u;
    for (;;) {
        sum = 0u; cnt = 0u; mine = 0u;
#pragma unroll
        for (unsigned j = 0; j < 16; ++j) { const unsigned c = xb_ld(&bar[XB_XCNT(j)]); sum += c; cnt += (c > 0u) ? 1u : 0u; mine = (j == x) ? c : mine; }
        if (sum == G) break;
        __builtin_amdgcn_s_sleep(1);
        if ((++sp & 255u) == 0u) { if (xb_ld(&bar[XB_TMO])) break; if (sp > XB_SPIN_CAP) { atomicAdd(&bar[XB_TMO], 1u); break; } }
    }
    nloc = mine > 0u ? mine : 1u; nx = cnt > 0u ? cnt : 1u;
}
__device__ __forceinline__ void xcd_barrier(const XcdBarrier& b) {
    asm volatile("s_waitcnt vmcnt(0)" ::: "memory");
    __syncthreads();
    if (threadIdx.x == 0) {
        unsigned* bar = b.bar;
        __builtin_amdgcn_s_waitcnt(0);
        unsigned nloc = b.st[0], nx = b.st[1];
        if (nloc == 0u) { xcd_barrier_complete(bar, b.x, nloc, nx); b.st[0] = nloc; b.st[1] = nx; }
        const unsigned old = xb_add(&bar[XB_XSUB(b.x)], 1u);
        const unsigned gen = old / nloc;
        if (old + 1u == (gen + 1u) * nloc) {
            __builtin_amdgcn_fence(__ATOMIC_RELEASE, "agent");
            asm volatile("s_waitcnt vmcnt(0)" ::: "memory");
            const unsigned og = xb_add(&bar[XB_TOP], 1u);
            const unsigned tg = og / nx;
            if (og + 1u == (tg + 1u) * nx) xb_add(&bar[XB_TOPGEN], 1u);
            else XB_SPIN(xb_ld(&bar[XB_TOPGEN]) == tg, bar);
            __builtin_amdgcn_fence(__ATOMIC_ACQUIRE, "agent");
            xb_add(&bar[XB_XGEN(b.x)], 1u);
            asm volatile("s_waitcnt vmcnt(0)" ::: "memory");
        } else {
            XB_SPIN(xb_ld(&bar[XB_XGEN(b.x)]) == gen, bar);
            __builtin_amdgcn_fence(__ATOMIC_ACQUIRE, "agent");
            asm volatile("s_waitcnt vmcnt(0)" ::: "memory");
        }
    }
    __syncthreads();
}

struct XPart { int start, step, end, grp, ngrp; };
constexpr int XC_LDS = 2 * 2 * 256 * 144 + 3584;
DI XPart xcd_part(const char* ws, const char* smem, int N) {
    const int x = ((const int*)(smem + XC_LDS))[0], r = ((const int*)(smem + XC_LDS))[1];
    const int* xc = (const int*)(ws + OFF_XRANK);
    int pre = 0, mine = 1, G = 0, grp = 0, ngrp = 0;
#pragma unroll
    for (int j = 0; j < 16; ++j) { const int c = xc[j]; if (j < x) { pre += c; grp += c > 0; } if (j == x) mine = c; G += c; ngrp += c > 0; }
    if (mine < 1) mine = 1; if (G < 1) G = 1;
    const long lo = (long)N * pre / G, hi = (long)N * (pre + mine) / G;
    XPart p; p.start = (int)lo + r; p.step = mine; p.end = (int)hi; p.grp = grp; p.ngrp = ngrp; return p;
}

constexpr int GT_B = 256 * LROW;
constexpr int GT_STAGE = 2 * 256 * LROW;
constexpr int SM_EXTRA = 2 * GT_STAGE;
constexpr int SMEM_BYTES = SM_EXTRA + 4096;
#define MK_ONE_LAUNCH 1


constexpr int ATT_ITEMS = 4096;
DI int attn_item_cost(int type, int h, int qb) {
    if (type == 0) { const int win = h == 0 ? 2 : h == 1 ? 7 : h == 2 ? 28 : 109; const int tiles = min(2 * qb + 2, win + 2); return (tiles * 6) / 4; }
    const int win = h == 0 ? 1 : h == 1 ? 2 : h == 2 ? 4 : h == 3 ? 7 : h == 4 ? 14 : h == 5 ? 28 : h == 6 ? 55 : 109;
    const int tiles = min(4 * qb + 4, win + 4); return (tiles * 5) / 4;
}
DI int attn_item_code(int i) {
    if (i < 2048) { const int qb = i & 63, h = (i >> 6) & 3, b = i >> 8; return (b << 16) | (h << 8) | qb; }
    const int j = i - 2048; const int qb = j & 31, h = (j >> 5) & 7, b = j >> 8; return (1 << 20) | (b << 16) | (h << 8) | qb;
}
DI void build_attn_items(const Params& P, char* smem) {
    int* hist = (int*)smem;
    int* wsum = hist + 256;
    int* items = (int*)(P.ws + OFF_ITEMS);
    const int tid = threadIdx.x, lane = tid & 63, w = tid >> 6;
    __syncthreads();
    if (tid < 256) hist[tid] = 0;
    __syncthreads();
    for (int i = tid; i < ATT_ITEMS; i += NTH) { const int c = attn_item_code(i); atomicAdd(&hist[255 - min(255, attn_item_cost(c >> 20, (c >> 8) & 255, c & 255))], 1); }
    __syncthreads();
    int n = 0, inc = 0;
    if (tid < 256) {
        n = hist[tid]; inc = n;
#pragma unroll
        for (int d = 1; d < 64; d <<= 1) { const int t = __shfl_up(inc, d); if (lane >= d) inc += t; }
        if (lane == 63) wsum[w] = inc;
    }
    __syncthreads();
    if (tid < 256) {
        int off = 0;
#pragma unroll
        for (int i = 0; i < 4; ++i) if (i < w) off += wsum[i];
        hist[tid] = off + inc - n;
    }
    __syncthreads();
    for (int i = tid; i < ATT_ITEMS; i += NTH) {
        const int c = attn_item_code(i);
        const int pos = atomicAdd(&hist[255 - min(255, attn_item_cost(c >> 20, (c >> 8) & 255, c & 255))], 1);
        items[pos] = c;
    }
    __syncthreads();
}

DI void phase_adaln(const Params& P, char* smem) {
    float* mod = (float*)(P.ws + OFF_MOD);
    float* sc = (float*)smem;
    float* red = sc + 8192;
    const int tid = threadIdx.x;
    if (blockIdx.x == 0) build_attn_items(P, smem);
    __syncthreads();
    for (int i = tid; i < 8192; i += NTH) sc[i] = silu_f(P.c[i]);
    __syncthreads();
    const int kg = tid >> 4, cn = tid & 15;
    for (int it = blockIdx.x; it < 384; it += gridDim.x) {
        const int n = it * 16 + cn;
        float acc[8];
#pragma unroll
        for (int b = 0; b < 8; ++b) acc[b] = 0.f;
#pragma unroll 8
        for (int kk = 0; kk < 32; ++kk) {
            const int k = kg * 32 + kk;
            const float w = P.ada_w[(size_t)k * 6144 + n];
#pragma unroll
            for (int b = 0; b < 8; ++b) acc[b] += sc[b * 1024 + k] * w;
        }
#pragma unroll
        for (int b = 0; b < 8; ++b) red[(kg * 8 + b) * 16 + cn] = acc[b];
        __syncthreads();
        if (tid < 128) {
            const int b = tid >> 4;
            float s = P.ada_b[n];
#pragma unroll
            for (int g = 0; g < 32; ++g) s += red[(g * 8 + b) * 16 + cn];
            mod[b * 6144 + n] = s;
        }
        __syncthreads();
    }
}

DI void phase_norm(const float* __restrict__ xin, const float* __restrict__ g, const float* __restrict__ mod, int sh_off, int sc_off, bf16_t* __restrict__ dst) {
    const int lane = threadIdx.x & 63, w = threadIdx.x >> 6;
    for (int row = blockIdx.x * NW + w; row < NT; row += gridDim.x * NW) {
        const int b = row >> 13;
        const float* xr = xin + (size_t)row * 1024;
        f32x4 v[4]; float ss = 0.f;
#pragma unroll
        for (int i = 0; i < 4; ++i) { v[i] = *(const f32x4*)(xr + 256 * i + 4 * lane); ss += v[i][0] * v[i][0] + v[i][1] * v[i][1] + v[i][2] * v[i][2] + v[i][3] * v[i][3]; }
        ss = wave_sum(ss);
        const float rstd = rsqrtf(ss * (1.f / 1024.f) + EPSF);
#pragma unroll
        for (int i = 0; i < 4; ++i) {
            const int col = 256 * i + 4 * lane;
            const f32x4 gg = *(const f32x4*)(g + col);
            const f32x4 sh = *(const f32x4*)(mod + b * 6144 + sh_off + col);
            const f32x4 sc = *(const f32x4*)(mod + b * 6144 + sc_off + col);
            float o[4];
#pragma unroll
            for (int j = 0; j < 4; ++j) o[j] = v[i][j] * rstd * gg[j] * (1.f + sc[j]) + sh[j];
            u32x2 pk; pk[0] = pk2(o[0], o[1]); pk[1] = pk2(o[2], o[3]);
            *(u32x2*)(dst + (size_t)row * 1024 + col) = pk;
        }
    }
}

DI int gu_row(int f, int is_up) { return (f >> 6) * 128 + (((f >> 5) & 1) * 2 + is_up) * 32 + (f & 31); }
struct CvtDesc { const float* src; bf16_t* dst; int ldsrc, nvalid, k0, n0, ldd, mode; };
constexpr int CVT_WIN = 16 * (NPAD / 64);
constexpr int CVT_SMALL = CVT_WIN + 256 + 64;
constexpr int CVT_ITEMS = CVT_SMALL + NEXP1 * 192;
DI CvtDesc cvt_desc(const Params& P, int it) {
    CvtDesc d;
    if (it < CVT_WIN) { d.src = P.w_in; d.ldsrc = IN_COLS; d.nvalid = IN_COLS; d.k0 = (it & 15) * 64; d.n0 = (it >> 4) * 64; d.dst = (bf16_t*)(P.ws + OFF_WIN); d.ldd = 1024; d.mode = 0; }
    else if (it < CVT_WIN + 256) { const int r = it - CVT_WIN; d.src = P.w_out; d.ldsrc = 1024; d.nvalid = 1024; d.k0 = (r & 15) * 64; d.n0 = (r >> 4) * 64; d.dst = (bf16_t*)(P.ws + OFF_WOUT); d.ldd = 1024; d.mode = 0; }
    else if (it < CVT_SMALL) { const int r = it - CVT_WIN - 256; d.src = P.router_w; d.ldsrc = 256; d.nvalid = 256; d.k0 = (r & 15) * 64; d.n0 = (r >> 4) * 64; d.dst = (bf16_t*)(P.ws + OFF_WRT); d.ldd = 1024; d.mode = 0; }
    else {
        const int r = it - CVT_SMALL, e = r / 192, sub = r % 192;
        if (sub < 128) {
            const int up = sub >> 6, s2 = sub & 63;
            d.src = e < NEXP ? (up ? P.ew_up : P.ew_gate) + (size_t)e * 1024 * 256 : (up ? P.sw_up : P.sw_gate);
            d.ldsrc = 256; d.nvalid = 256; d.k0 = (s2 & 15) * 64; d.n0 = (s2 >> 4) * 64; d.dst = (bf16_t*)(P.ws + OFF_WGU) + (size_t)e * 512 * 1024; d.ldd = 1024; d.mode = 1 + up;
        } else {
            const int s2 = sub - 128;
            d.src = e < NEXP ? P.ew_down + (size_t)e * 256 * 1024 : P.sw_down;
            d.ldsrc = 1024; d.nvalid = 1024; d.k0 = (s2 & 3) * 64; d.n0 = (s2 >> 2) * 64; d.dst = (bf16_t*)(P.ws + OFF_WD) + (size_t)e * 1024 * 256; d.ldd = 256; d.mode = 0;
        }
    }
    return d;
}
DI void phase_convert(const Params& P, char* smem) {
    float* t = (float*)smem;
    const int tid = threadIdx.x, G = gridDim.x;
    for (int it0 = blockIdx.x; it0 < CVT_ITEMS; it0 += 4 * G) {
        float v[4][8];
#pragma unroll
        for (int r = 0; r < 4; ++r) {
            const int it = it0 + r * G;
            if (it < CVT_ITEMS) {
                const CvtDesc d = cvt_desc(P, it);
#pragma unroll
                for (int i = 0; i < 8; ++i) {
                    const int idx = tid + NTH * i, kk = idx >> 6, nn = idx & 63;
                    v[r][i] = (d.n0 + nn < d.nvalid) ? d.src[(size_t)(d.k0 + kk) * d.ldsrc + d.n0 + nn] : 0.f;
                }
            } else {
#pragma unroll
                for (int i = 0; i < 8; ++i) v[r][i] = 0.f;
            }
        }
        __syncthreads();
#pragma unroll
        for (int r = 0; r < 4; ++r)
#pragma unroll
            for (int i = 0; i < 8; ++i) { const int idx = tid + NTH * i; t[r * 4160 + (idx >> 6) * 65 + (idx & 63)] = v[r][i]; }
        __syncthreads();
        const int nn = tid >> 3, kq = (tid & 7) * 8;
#pragma unroll
        for (int r = 0; r < 4; ++r) {
            const int it = it0 + r * G;
            if (it < CVT_ITEMS) {
                const CvtDesc d = cvt_desc(P, it);
                unsigned pk[4];
#pragma unroll
                for (int j = 0; j < 4; ++j) pk[j] = pk2(t[r * 4160 + (kq + 2 * j) * 65 + nn], t[r * 4160 + (kq + 2 * j + 1) * 65 + nn]);
                const int n = d.n0 + nn;
                const int drow = d.mode == 0 ? n : gu_row(n, d.mode - 1);
                *(u32x4*)(d.dst + (size_t)drow * d.ldd + d.k0 + kq) = (u32x4){pk[0], pk[1], pk[2], pk[3]};
            }
        }
    }
}

template <int BM> struct GemmGeo { static constexpr int NI = BM == 256 ? 4 : 2, WN = BM == 256 ? 2 : 4, AP = BM / 64; };
template <bool SWAP, int BM, class AFn, class Epi>
DI void gemm_stream(char* lds, AFn arow, const bf16_t* __restrict__ Bt, int ldb, int nksh, int nsub, Epi epi) {
    constexpr int NI = GemmGeo<BM>::NI, WN = GemmGeo<BM>::WN, AP = GemmGeo<BM>::AP;
    const int tid = threadIdx.x, lane = tid & 63, w = tid >> 6, wm = w / WN, wn = w % WN, l31 = lane & 31, hf = lane >> 5;
    const int nk = 1 << nksh, total = nsub << nksh;
    const int lrow = tid >> 3, lch = tid & 7;
    const bf16_t* ap[AP];
#pragma unroll
    for (int i = 0; i < AP; ++i) { const bf16_t* a = arow(lrow + 64 * i); ap[i] = a ? a + lch * 8 : nullptr; }
    const int so = lofs(lrow, lch);
    const bf16_t* bp = Bt + (size_t)lrow * ldb + lch * 8;
    const size_t bsub = (size_t)256 * ldb, brow64 = (size_t)64 * ldb;
    f32x16 acc[2][NI];
#pragma unroll
    for (int mi = 0; mi < 2; ++mi)
#pragma unroll
        for (int ni = 0; ni < NI; ++ni)
#pragma unroll
            for (int i = 0; i < 16; ++i) acc[mi][ni][i] = 0.f;
    u32x4 ra[AP], rb[4];
    const u32x4 z4 = {0u, 0u, 0u, 0u};
    auto load_part = [&](int s, int part) {
        const int t = s >> nksh, k0 = (s & (nk - 1)) * 64;
        const bf16_t* b0 = bp + t * bsub + k0;
        if (AP == 4) {
            if (part < 2) {
#pragma unroll
                for (int i = 0; i < 2; ++i) { const int q = 2 * part + i; ra[q] = ap[q] ? *(const u32x4*)(ap[q] + k0) : z4; }
            } else {
#pragma unroll
                for (int i = 0; i < 2; ++i) { const int q = 2 * (part - 2) + i; rb[q] = *(const u32x4*)(b0 + q * brow64); }
            }
        } else {
            if (part == 0) {
#pragma unroll
                for (int i = 0; i < AP; ++i) ra[i] = ap[i] ? *(const u32x4*)(ap[i] + k0) : z4;
            } else if (part < 3) {
#pragma unroll
                for (int i = 0; i < 2; ++i) { const int q = 2 * (part - 1) + i; rb[q] = *(const u32x4*)(b0 + q * brow64); }
            }
        }
    };
    auto store = [&](char* stg) {
#pragma unroll
        for (int i = 0; i < AP; ++i) *(u32x4*)(stg + so + i * 64 * LROW) = ra[i];
#pragma unroll
        for (int i = 0; i < 4; ++i) *(u32x4*)(stg + GT_B + so + i * 64 * LROW) = rb[i];
    };
    auto compute = [&](const char* cur, int snext) {
        const char* abase = cur + (64 * wm + l31) * LROW + hf * 16;
        const char* bbase = cur + GT_B + (32 * NI * wn + l31) * LROW + hf * 16;
#pragma unroll
        for (int ks = 0; ks < 4; ++ks) {
            bf16x8 af[2];
#pragma unroll
            for (int mi = 0; mi < 2; ++mi) af[mi] = *(const bf16x8*)(abase + mi * 32 * LROW + ks * 32);
#pragma unroll
            for (int nh = 0; nh < NI / 2; ++nh) {
                bf16x8 bfr[2];
#pragma unroll
                for (int n2 = 0; n2 < 2; ++n2) bfr[n2] = *(const bf16x8*)(bbase + (2 * nh + n2) * 32 * LROW + ks * 32);
#pragma unroll
                for (int mi = 0; mi < 2; ++mi)
#pragma unroll
                    for (int n2 = 0; n2 < 2; ++n2)
                        acc[mi][2 * nh + n2] = SWAP ? MFMA32(bfr[n2], af[mi], acc[mi][2 * nh + n2]) : MFMA32(af[mi], bfr[n2], acc[mi][2 * nh + n2]);
                if (NI == 4 && nh == 0) __builtin_amdgcn_sched_barrier(0);
            }
            __builtin_amdgcn_sched_barrier(0);
            load_part(snext, ks);
            __builtin_amdgcn_sched_barrier(0);
        }
    };
#pragma unroll
    for (int part = 0; part < 4; ++part) load_part(0, part);
    __syncthreads();
    store(lds);
    __syncthreads();
    for (int s = 0; s < total; ++s) {
        char* cur = lds + (s & 1) * GT_STAGE;
        char* nxt = lds + ((s & 1) ^ 1) * GT_STAGE;
        compute(cur, min(s + 1, total - 1));
        if ((s & (nk - 1)) == nk - 1) {
            epi(s >> nksh, acc);
#pragma unroll
            for (int mi = 0; mi < 2; ++mi)
#pragma unroll
                for (int ni = 0; ni < NI; ++ni)
#pragma unroll
                    for (int i = 0; i < 16; ++i) acc[mi][ni][i] = 0.f;
        }
        store(nxt);
        __syncthreads();
    }
}

constexpr int DS_B = 256 * 64, DS_STAGE = 512 * 64;
constexpr int EP_SCR = 112640, EP_WAVE = 32 * 136;
DI int opaque_tid() { int t = threadIdx.x; asm volatile("" : "+v"(t)); return t; }
template <bool PERM16 = false, class XF, class RowPtrFn>
DI void stage_store_chunk(char* smem, const f32x16& a0, const f32x16& a1, XF xf, RowPtrFn rowptr) {
    const int otid = opaque_tid(), lane = otid & 63, w = otid >> 6, l31 = lane & 31, hf = lane >> 5;
    LAS char* scr = (LAS char*)smem + EP_SCR + w * EP_WAVE;
#pragma unroll
    for (int n2 = 0; n2 < 2; ++n2)
#pragma unroll
        for (int q4 = 0; q4 < 4; ++q4) {
            const f32x16& a = n2 ? a1 : a0;
            u32x2 pk; pk[0] = pk2(xf(n2, 4 * q4, a[4 * q4]), xf(n2, 4 * q4 + 1, a[4 * q4 + 1])); pk[1] = pk2(xf(n2, 4 * q4 + 2, a[4 * q4 + 2]), xf(n2, 4 * q4 + 3, a[4 * q4 + 3]));
            const int col = PERM16 ? 32 * n2 + 16 * (q4 >> 1) + 8 * hf + 4 * (q4 & 1) : 32 * n2 + 8 * q4 + 4 * hf;
            *(LAS u32x2*)(scr + l31 * 136 + col * 2) = pk;
        }
    const int rr = lane >> 4, c = lane & 15;
#pragma unroll
    for (int i = 0; i < 8; ++i) {
        const int r = rr + 4 * i;
        const u32x2 d = *(const LAS u32x2*)(scr + r * 136 + c * 8);
        bf16_t* g = rowptr(r);
        if (g) *(u32x2*)(g + c * 4) = d;
    }
}

template <bool SWAP, int BM, class AFn, class Epi>
DI void gemm_dma(char* lds_generic, AFn arow, const bf16_t* __restrict__ Bt, int ldb, int nksh, int nsub, const bf16_t* zrow, Epi epi) {
    constexpr int NI = GemmGeo<BM>::NI, WN = GemmGeo<BM>::WN, NA = BM / 128;
    constexpr int STG = (BM + 256) * 64, BOFF = BM * 64, NST = BM == 256 ? 3 : 4;
    LAS char* lds = (LAS char*)lds_generic;
    const int tid = opaque_tid(), lane = tid & 63, w = tid >> 6, wm = w / WN, wn = w % WN, l31 = lane & 31, hf = lane >> 5;
    const int nh = 2 << nksh, total = nsub * nh;
    typedef const __attribute__((address_space(1))) char* gcp_t;
    const char* wsg = (const char*)zrow - OFF_ZROW;
    auto uni = [](const char* p) { const unsigned long long v = (unsigned long long)p; const unsigned lo = __builtin_amdgcn_readfirstlane((unsigned)v), hi = __builtin_amdgcn_readfirstlane((unsigned)(v >> 32)); return (gcp_t)(((unsigned long long)hi << 32) | lo); };
    const gcp_t wsu = uni(wsg), btu = uni((const char*)Bt);
    unsigned aoff[NA], boff[2];
#pragma unroll
    for (int i = 0; i < NA; ++i) {
        const int row = 16 * (w + 8 * i) + (lane >> 2), c = (lane & 3) ^ ((row >> 2) & 3);
        const bf16_t* a = arow(row);
        aoff[i] = (unsigned)((const char*)(a ? a : zrow) - wsg) + c * 16;
    }
#pragma unroll
    for (int i = 0; i < 2; ++i) {
        const int row = 16 * (w + 8 * i) + (lane >> 2), c = (lane & 3) ^ ((row >> 2) & 3);
        boff[i] = (unsigned)(row * ldb * 2 + c * 16);
    }
    const size_t bsub = (size_t)256 * ldb;
    auto dma_a = [&](int k0, LAS char* stg) {
        gcp_t ab = wsu + k0 * 2; asm volatile("" : "+s"(ab));
#pragma unroll
        for (int i = 0; i < NA; ++i)
        {
            unsigned ao = aoff[i]; asm volatile("" : "+v"(ao));
            __builtin_amdgcn_global_load_lds((const __attribute__((address_space(1))) unsigned*)(ab + ao), (LAS unsigned*)(stg + (w + 8 * i) * 1024), 16, 0, 0);
        }
    };
    auto dma_b = [&](int t, int k0, LAS char* stg) {
        gcp_t bb = btu + (t * bsub + k0) * 2; asm volatile("" : "+s"(bb));
#pragma unroll
        for (int i = 0; i < 2; ++i)
        {
            unsigned bo = boff[i]; asm volatile("" : "+v"(bo));
            __builtin_amdgcn_global_load_lds((const __attribute__((address_space(1))) unsigned*)(bb + bo), (LAS unsigned*)(stg + BOFF + (w + 8 * i) * 1024), 16, 0, 0);
        }
    };
    auto dma = [&](int hs, int stage) {
        const int t = hs / nh, k0 = (hs - t * nh) * 32;
        LAS char* stg = lds + stage * STG;
        dma_a(k0, stg); dma_b(t, k0, stg);
    };
    const int f = (l31 >> 2) & 3;
    const int lbase = l31 * 64 + ((hf ^ (f & 1)) << 4);
    const int o0 = lbase + (((f >> 1) & 1) << 5), o1 = lbase + ((((f >> 1) & 1) ^ 1) << 5);
    f32x16 acc[2][NI];
#pragma unroll
    for (int mi = 0; mi < 2; ++mi)
#pragma unroll
        for (int ni = 0; ni < NI; ++ni)
#pragma unroll
            for (int i = 0; i < 16; ++i) acc[mi][ni][i] = 0.f;
    asm volatile("s_waitcnt vmcnt(0) lgkmcnt(0)" ::: "memory");
    __builtin_amdgcn_s_barrier();
    constexpr int NDMA = NA + 2;
    dma(0, 0); dma(1, 1); dma(2, 2); if constexpr (NST == 4) dma(3, 3);
    if constexpr (NST == 3) asm volatile("s_waitcnt vmcnt(8)" ::: "memory"); else asm volatile("s_waitcnt vmcnt(9)" ::: "memory");
    __builtin_amdgcn_s_barrier();
    constexpr int NF = 2 + NI;
    const unsigned aofs = (64 * wm) * 64, bofs = (32 * NI * wn) * 64;
    auto rd = [&](bf16x8 (&a)[2], bf16x8 (&b)[NI], unsigned sbase, unsigned o) {
        const unsigned pa = sbase + aofs + o, pb = sbase + bofs + o;
        asm volatile("ds_read_b128 %0, %1" : "=v"(a[0]) : "v"(pa));
        asm volatile("ds_read_b128 %0, %1 offset:2048" : "=v"(a[1]) : "v"(pa));
        asm volatile("ds_read_b128 %0, %1 offset:%2" : "=v"(b[0]) : "v"(pb), "n"(BOFF));
        asm volatile("ds_read_b128 %0, %1 offset:%2" : "=v"(b[1]) : "v"(pb), "n"(BOFF + 2048));
        if constexpr (NI == 4) {
            asm volatile("ds_read_b128 %0, %1 offset:%2" : "=v"(b[2]) : "v"(pb), "n"(BOFF + 4096));
            asm volatile("ds_read_b128 %0, %1 offset:%2" : "=v"(b[3]) : "v"(pb), "n"(BOFF + 6144));
        }
    };
    auto release = [&](bf16x8 (&a)[2], bf16x8 (&b)[NI], bool all) {
        if constexpr (NI == 4) {
            if (all) asm volatile("s_waitcnt lgkmcnt(0)" : "+v"(a[0]), "+v"(a[1]), "+v"(b[0]), "+v"(b[1]), "+v"(b[2]), "+v"(b[3]) :: "memory");
            else asm volatile("s_waitcnt lgkmcnt(6)" : "+v"(a[0]), "+v"(a[1]), "+v"(b[0]), "+v"(b[1]), "+v"(b[2]), "+v"(b[3]) :: "memory");
        } else {
            if (all) asm volatile("s_waitcnt lgkmcnt(0)" : "+v"(a[0]), "+v"(a[1]), "+v"(b[0]), "+v"(b[1]) :: "memory");
            else asm volatile("s_waitcnt lgkmcnt(4)" : "+v"(a[0]), "+v"(a[1]), "+v"(b[0]), "+v"(b[1]) :: "memory");
        }
    };
    const unsigned lds0 = (unsigned)(size_t)lds;
    bf16x8 a0[2], b0[NI];
    rd(a0, b0, lds0, o0);
    int st = 0;
    for (int hs = 0; hs < total; ++hs) {
        const int hs_n = min(hs + NST, total - 1);
        const int t_n = hs_n / nh, k0_n = (hs_n - t_n * nh) * 32;
        const int stn = st + 1 == NST ? 0 : st + 1;
        LAS char* stg = lds + st * STG;
        bf16x8 a1[2], b1[NI];
        rd(a1, b1, lds0 + st * STG, o1);
        release(a0, b0, false);
        __builtin_amdgcn_sched_barrier(0);
#pragma unroll
        for (int mi = 0; mi < 2; ++mi)
#pragma unroll
            for (int ni = 0; ni < NI; ++ni)
                acc[mi][ni] = SWAP ? MFMA32(b0[ni], a0[mi], acc[mi][ni]) : MFMA32(a0[mi], b0[ni], acc[mi][ni]);
        __builtin_amdgcn_sched_barrier(0);
        if constexpr (BM == 256) asm volatile("s_waitcnt vmcnt(4)" ::: "memory"); else asm volatile("s_waitcnt vmcnt(6)" ::: "memory");
        release(a1, b1, true);
        __builtin_amdgcn_s_barrier();
        dma_a(k0_n, stg);
        rd(a0, b0, lds0 + stn * STG, o0);
        __builtin_amdgcn_sched_barrier(0);
#pragma unroll
        for (int mi = 0; mi < 2; ++mi)
#pragma unroll
            for (int ni = 0; ni < NI; ++ni)
                acc[mi][ni] = SWAP ? MFMA32(b1[ni], a1[mi], acc[mi][ni]) : MFMA32(a1[mi], b1[ni], acc[mi][ni]);
        __builtin_amdgcn_sched_barrier(0);
        dma_b(t_n, k0_n, stg);
        __builtin_amdgcn_sched_barrier(0);
        if ((hs % nh) == nh - 1) {
            epi(hs / nh, acc);
#pragma unroll
            for (int mi = 0; mi < 2; ++mi)
#pragma unroll
                for (int ni = 0; ni < NI; ++ni)
#pragma unroll
                    for (int i = 0; i < 16; ++i) acc[mi][ni][i] = 0.f;
        }
        st = stn;
    }
    release(a0, b0, true);
    asm volatile("s_waitcnt vmcnt(0) lgkmcnt(0)" ::: "memory");
    __builtin_amdgcn_s_barrier();
}

struct DenseRows { static constexpr bool kDense = true; const bf16_t* base; int ld; DI const bf16_t* operator()(int r) const { return base + (size_t)r * ld; } };

DI void epi_rows_bf16(char* smem, const f32x16 (&acc)[2][4], int row0, bf16_t* __restrict__ dst, int ldo, int cb, const float* gain, bool do_norm) {
    const int otid = opaque_tid(), lane = otid & 63, w = otid >> 6, wm = w >> 1, wn = w & 1, hf = lane >> 5;
#pragma unroll
    for (int mi = 0; mi < 2; ++mi)
#pragma unroll
        for (int pr = 0; pr < 2; ++pr) {
            float rstd = 1.f;
            if (do_norm) {
                float ss = 0.f;
#pragma unroll
                for (int n2 = 0; n2 < 2; ++n2)
#pragma unroll
                    for (int i = 0; i < 16; ++i) ss += acc[mi][2 * pr + n2][i] * acc[mi][2 * pr + n2][i];
                ss += __shfl_xor(ss, 32);
                rstd = rsqrtf(ss * (1.f / 64.f) + EPSF);
            }
            bf16_t* base = dst + (size_t)(row0 + 64 * wm + 32 * mi) * ldo + cb + 128 * wn + 64 * pr;
            int zo = 0; asm volatile("" : "+v"(zo));
            const float* gch = gain + zo;
            stage_store_chunk(smem, acc[mi][2 * pr], acc[mi][2 * pr + 1],
                              [&](int n2, int i, float x) { float o = x * rstd; if (do_norm) o *= gch[32 * n2 + crow(i, hf)]; return o; },
                              [&](int r) { return base + (size_t)r * ldo; });
        }
}
DI void epi_vt(char* smem, const f32x16 (&acc)[2][4], int row0, bf16_t* __restrict__ vt, int dv, int nheads, int colbase  ) {
    const int w = opaque_tid() >> 6, wm = w >> 1, wn = w & 1;
    const int b = row0 >> 13, s0 = row0 & (NS - 1);
#pragma unroll
    for (int ni = 0; ni < 4; ++ni) {
        const int c0 = colbase + 128 * wn + 32 * ni;
        bf16_t* base = vt + ((size_t)b * 512 + c0) * NS + s0 + 64 * wm;
        stage_store_chunk<true>(smem, acc[0][ni], acc[1][ni], [](int, int, float x) { return x; }, [&](int r) { return base + (size_t)r * NS; });
    }
}
DI void phase_inproj(const Params& P, char* smem) {
    const bf16_t* zrow = (const bf16_t*)(P.ws + OFF_ZROW);
    const bf16_t* h = (const bf16_t*)(P.ws + OFF_H);
    const bf16_t* win = (const bf16_t*)(P.ws + OFF_WIN);
    float* gl = (float*)(smem + SM_EXTRA);
    __syncthreads();
    {
        const int v = threadIdx.x >> 6, i = threadIdx.x & 63;
        if (v == 0) gl[i] = P.dq_g[i];
        else if (v == 1) gl[64 + i] = P.dk_g[i];
        else if (v == 2) gl[128 + i] = P.sq_g[i];
        else if (v == 3) gl[192 + i] = P.sk_g[i];
        else if (v == 4) gl[256 + i] = P.ik_g[i];
    }
    __syncthreads();
    const XPart xp1 = xcd_part(P.ws, smem, (NT / 256) * 10);
    for (int it = xp1.start; it < xp1.end; it += xp1.step) {
        const int jj = it % 10, mt = it / 10;
        const int j = jj < 4 ? jj : jj < 8 ? jj + 2 : jj + 4;
        const int row0 = mt * 256, grp = j >> 1, cb = (j & 1) * 256;
        DenseRows ar{h + (size_t)row0 * 1024, 1024};
        bf16_t* dst = (bf16_t*)(P.ws + (grp == 0 ? OFF_QD : grp == 1 ? OFF_KD : grp == 3 ? OFF_QS : grp == 4 ? OFF_KS : OFF_IQ));
        const float* gain = gl + 64 * (grp == 0 ? 0 : grp == 1 ? 1 : grp == 3 ? 2 : 3);
        const bool do_norm = grp != 6;
#ifdef XP_DUPEPI
        gemm_dma<true, 256>(smem, ar, win + (size_t)j * 256 * 1024, 1024, 4, 1, zrow, [&](int, const f32x16 (&acc)[2][4]) { epi_rows_bf16(smem, acc, row0, dst, 512, cb, gain, do_norm); asm volatile("" ::: "memory"); epi_rows_bf16(smem, acc, row0, dst, 512, cb, gain, do_norm); });
#else
        gemm_dma<true, 256>(smem, ar, win + (size_t)j * 256 * 1024, 1024, 4, 1, zrow, [&](int, const f32x16 (&acc)[2][4]) { epi_rows_bf16(smem, acc, row0, dst, 512, cb, gain, do_norm); });
#endif
    }
    const XPart xp2 = xcd_part(P.ws, smem, (NT / 256) * 4);
    for (int it = xp2.start; it < xp2.end; it += xp2.step) {
        const int jj = it & 3, mt = it >> 2;
        const int j = jj < 2 ? 4 + jj : 8 + jj;
        const int row0 = mt * 256, cb = (j & 1) * 256;
        DenseRows ar{h + (size_t)row0 * 1024, 1024};
        bf16_t* vt = (bf16_t*)(P.ws + (jj < 2 ? OFF_VDT : OFF_VST));
        const int dv = jj < 2 ? 128 : 64, nh = jj < 2 ? 4 : 8;
        gemm_dma<false, 256>(smem, ar, win + (size_t)j * 256 * 1024, 1024, 4, 1, zrow, [&](int, const f32x16 (&acc)[2][4]) { epi_vt(smem, acc, row0, vt, dv, nh, cb); });
    }
    for (int mt = blockIdx.x; mt < NT / 256; mt += gridDim.x) {
        const int row0 = mt * 256;
        DenseRows ar{h + (size_t)row0 * 1024, 1024};
        gemm_dma<true, 256>(smem, ar, win + (size_t)14 * 256 * 1024, 1024, 4, 1, zrow, [&](int, const f32x16 (&acc)[2][4]) {
            const int otid = opaque_tid(), lane = otid & 63, w = otid >> 6, wm = w >> 1, wn = w & 1, l31 = lane & 31, hf = lane >> 5;
            if (wn == 0) {
                bf16_t* ik = (bf16_t*)(P.ws + OFF_IK);
                float* iw = (float*)(P.ws + OFF_IW);
                const float s = 0.35355339059327373f * 0.125f;
#pragma unroll
                for (int mi = 0; mi < 2; ++mi) {
                    const int tok = row0 + 64 * wm + 32 * mi + l31;
                    float ss = 0.f;
#pragma unroll
                    for (int ni = 0; ni < 2; ++ni)
#pragma unroll
                        for (int i = 0; i < 16; ++i) ss += acc[mi][ni][i] * acc[mi][ni][i];
                    ss += __shfl_xor(ss, 32);
                    const float rstd = rsqrtf(ss * (1.f / 64.f) + EPSF);
#pragma unroll
                    for (int ni = 0; ni < 2; ++ni)
#pragma unroll
                        for (int q4 = 0; q4 < 4; ++q4) {
                            const int f = 32 * ni + 8 * q4 + 4 * hf;
                            float o[4];
#pragma unroll
                            for (int r = 0; r < 4; ++r) o[r] = acc[mi][ni][4 * q4 + r] * rstd * gl[256 + f + r];
                            u32x2 pk; pk[0] = pk2(o[0], o[1]); pk[1] = pk2(o[2], o[3]);
                            *(u32x2*)(ik + ((((size_t)(tok >> 5) * 4 + (2 * ni + (q4 >> 1))) * 64 + 32 * (q4 & 1) + (tok & 31)) * 8 + 4 * hf)) = pk;
                        }
                    f32x4 o = {acc[mi][2][0] * s, acc[mi][2][1] * s, acc[mi][2][2] * s, acc[mi][2][3] * s};
                    *(f32x4*)(iw + (size_t)tok * 8 + 4 * hf) = o;
                }
            }
        });
    }
}

constexpr int TK_CAP = 512, TK_HI = 448;
template <int NPASS>
DI unsigned topk_prune(volatile LAS unsigned* buf, volatile LAS unsigned* hist, int cnt, int& kept) {
    const int lane = threadIdx.x & 63;
    unsigned e[8];
#pragma unroll
    for (int i = 0; i < 8; ++i) { const int idx = lane + 64 * i; e[i] = idx < cnt ? buf[idx] : 0u; }
    unsigned prefix = 0u, want = 256u;
#pragma unroll
    for (int p = 3; p >= 4 - NPASS; --p) {
        const int sh = 8 * p;
#pragma unroll
        for (int j = 0; j < 4; ++j) hist[4 * lane + j] = 0u;
        asm volatile("" ::: "memory");
#pragma unroll
        for (int i = 0; i < 8; ++i) {
            const bool m = (e[i] != 0u) && (p == 3 || (e[i] >> (sh + 8)) == prefix);
            if (m) __hip_atomic_fetch_add((LAS unsigned*)&hist[(e[i] >> sh) & 255u], 1u, __ATOMIC_RELAXED, __HIP_MEMORY_SCOPE_WORKGROUP);
        }
        asm volatile("" ::: "memory");
        const unsigned h0 = hist[4 * lane], h1 = hist[4 * lane + 1], h2 = hist[4 * lane + 2], h3 = hist[4 * lane + 3];
        const unsigned s4 = h0 + h1 + h2 + h3;
        int suf_i = (int)s4;
        suf_i += __builtin_amdgcn_update_dpp(0, suf_i, 0x101, 0xf, 0xf, true);
        suf_i += __builtin_amdgcn_update_dpp(0, suf_i, 0x102, 0xf, 0xf, true);
        suf_i += __builtin_amdgcn_update_dpp(0, suf_i, 0x104, 0xf, 0xf, true);
        suf_i += __builtin_amdgcn_update_dpp(0, suf_i, 0x108, 0xf, 0xf, true);
        const int t1 = __builtin_amdgcn_readlane(suf_i, 16), t2 = __builtin_amdgcn_readlane(suf_i, 32), t3 = __builtin_amdgcn_readlane(suf_i, 48);
        const int row = lane >> 4;
        const unsigned suf = (unsigned)(suf_i + (row == 0 ? t1 + t2 + t3 : row == 1 ? t2 + t3 : row == 2 ? t3 : 0));
        const unsigned above = suf - s4;
        const bool own = (above < want) && (want <= suf);
        unsigned bsel = 0u, cum = above;
        if (cum + h3 >= want) bsel = 3u;
        else { cum += h3; if (cum + h2 >= want) bsel = 2u; else { cum += h2; if (cum + h1 >= want) bsel = 1u; else { cum += h1; bsel = 0u; } } }
        const u64 om = __builtin_amdgcn_ballot_w64(own);
        const int ol = om ? (int)__builtin_ctzll(om) : 0;
        const unsigned bin = (unsigned)__builtin_amdgcn_readlane((int)(4u * lane + bsel), ol);
        const unsigned cm = (unsigned)__builtin_amdgcn_readlane((int)cum, ol);
        prefix = (prefix << 8) | bin; want -= cm;
    }
    const unsigned V = NPASS == 4 ? prefix : (prefix << 16);
    int base = 0;
#pragma unroll
    for (int i = 0; i < 8; ++i) {
        const bool keep = (e[i] != 0u) && (e[i] >= V);
        const u64 mk = __ballot(keep);
        const int pos = base + __builtin_popcountll(mk & ((1ull << lane) - 1ull));
        if (keep) buf[pos] = e[i];
        base += __builtin_popcountll(mk);
    }
    asm volatile("" ::: "memory");
    kept = base;
    return NPASS == 4 ? V : (V ? V - 1u : 0u);
}

DI void indexer_item(const Params& P, char* smem, int b, int q0) {
    const int lane = threadIdx.x & 63, w = __builtin_amdgcn_readfirstlane(threadIdx.x >> 6), l31 = lane & 31, hf = lane >> 5;
    const int qbase = q0 + 8 * w;
    const bf16_t* IQ = (const bf16_t*)(P.ws + OFF_IQ);
    const bf16_t* IK = (const bf16_t*)(P.ws + OFF_IK);
    const float* IW = (const float*)(P.ws + OFF_IW);
    volatile LAS unsigned* buf = (volatile LAS unsigned*)(LAS char*)(smem + w * 8 * 2048);
    volatile LAS unsigned* hist = (volatile LAS unsigned*)(LAS char*)(smem + 131072 + w * 1024);
    bf16x8 af[2][4];
    {
        const int m = l31, qs = 2 * ((m >> 2) & 1) + (m >> 4), head = 4 * ((m >> 3) & 1) + (m & 3);
#pragma unroll
        for (int mt = 0; mt < 2; ++mt) {
            const size_t tok = (size_t)b * NS + qbase + 4 * mt + qs;
#pragma unroll
            for (int ks = 0; ks < 4; ++ks) af[mt][ks] = *(const bf16x8*)(IQ + tok * 512 + head * 64 + ks * 16 + hf * 8);
        }
    }
    float iwv[2][2][8]; int qpos[2][2]; unsigned tau[2][2]; int cnt[2][2];
#pragma unroll
    for (int mt = 0; mt < 2; ++mt)
#pragma unroll
        for (int j = 0; j < 2; ++j) {
            qpos[mt][j] = qbase + 4 * mt + 2 * hf + j; tau[mt][j] = 0u; cnt[mt][j] = 0;
            const float* p = IW + ((size_t)b * NS + qpos[mt][j]) * 8;
            const f32x4 a = *(const f32x4*)p, c = *(const f32x4*)(p + 4);
#pragma unroll
            for (int r = 0; r < 4; ++r) { iwv[mt][j][r] = a[r]; iwv[mt][j][4 + r] = c[r]; }
        }
    const int nkt = ((qbase + 7) >> 6) + 1;
    const bf16_t* ikb = IK + (size_t)b * NS * 64 + (size_t)lane * 8;
    bf16x8 bfr[2][4];
#pragma unroll
    for (int sb = 0; sb < 2; ++sb)
#pragma unroll
        for (int ks = 0; ks < 4; ++ks) bfr[sb][ks] = *(const bf16x8*)(ikb + (size_t)(sb * 4 + ks) * 512);
#pragma unroll 2
    for (int kt = 0; kt < nkt; ++kt) {
        bf16x8 bn[2][4];
        {
            const int kn = min(kt + 1, nkt - 1) * 64;
#ifdef XP_DUPIKLOAD
#pragma unroll
            for (int sb = 0; sb < 2; ++sb)
#pragma unroll
                for (int ks = 0; ks < 4; ++ks) { bf16x8 t = __builtin_nontemporal_load((const bf16x8*)(ikb + (size_t)kn * 64 + (size_t)(sb * 4 + ks) * 512)); asm volatile("" : "+v"(t)); }
#endif
#pragma unroll
            for (int sb = 0; sb < 2; ++sb)
#pragma unroll
                for (int ks = 0; ks < 4; ++ks) bn[sb][ks] = *(const bf16x8*)(ikb + (size_t)kn * 64 + (size_t)(sb * 4 + ks) * 512);
        }
#pragma unroll
        for (int sb = 0; sb < 2; ++sb) {
            const int k0 = kt * 64 + 32 * sb;
            if (k0 > qbase + 7) continue;
            const bool needcausal = k0 + 31 > qbase;
            f32x16 acc[2];
#pragma unroll
            for (int mt = 0; mt < 2; ++mt) {
#pragma unroll
                for (int i = 0; i < 16; ++i) acc[mt][i] = 0.f;
#pragma unroll
                for (int ks = 0; ks < 4; ++ks) acc[mt] = MFMA32(af[mt][ks], bfr[sb][ks], acc[mt]);
#ifdef XP_DUPIDXMFMA
                { f32x16 z; for (int i = 0; i < 16; ++i) z[i] = 0.f;
                  for (int ks = 0; ks < 4; ++ks) z = MFMA32(af[mt][ks], bfr[sb][ks], z);
                  asm volatile("" : "+v"(z)); }
#endif
            }
            const int kidx = k0 + l31;
#pragma unroll
            for (int mt = 0; mt < 2; ++mt)
#pragma unroll
                for (int j = 0; j < 2; ++j) {
                    float s = 0.f;
#ifdef XP_DUPSCORE
                    { float s2 = 0.f;
#pragma unroll
                      for (int t = 0; t < 8; ++t) s2 = __builtin_fmaf(iwv[mt][j][t], __int_as_float(max(__float_as_int(acc[mt][8 * j + t]), 0)), s2);
                      asm volatile("" : "+v"(s2)); s = s2 * 0.f; }
#endif
#pragma unroll
                    for (int t = 0; t < 8; ++t)
                        s = __builtin_fmaf(iwv[mt][j][t], __int_as_float(max(__float_as_int(acc[mt][8 * j + t]), 0)), s);
                    const int si = __float_as_int(s);
                    const unsigned ord = (unsigned)si ^ ((unsigned)(si >> 31) | 0x80000000u);
                    const unsigned pk = (ord & 0xFFFFE000u) | (unsigned)(8191 - kidx);
                    const bool pass = needcausal ? ((kidx <= qpos[mt][j]) && (pk > tau[mt][j])) : (pk > tau[mt][j]);
                    const u64 mk = __builtin_amdgcn_ballot_w64(pass);
                    const unsigned hm = hf ? (unsigned)(mk >> 32) : (unsigned)mk;
                    const int pos = cnt[mt][j] + __builtin_popcount(hm & ((1u << l31) - 1u));
                    { const int widx = pass ? (4 * mt + 2 * hf + j) * TK_CAP + pos : (int)(hist - buf) + lane; buf[widx] = pk; }
#ifdef XP_DUPAPPEND
                    {
                        unsigned pk2v = pk; asm volatile("" : "+v"(pk2v));
                        const bool pass2 = needcausal ? ((kidx <= qpos[mt][j]) && (pk2v > tau[mt][j])) : (pk2v > tau[mt][j]);
                        const u64 mk2 = __builtin_amdgcn_ballot_w64(pass2);
                        const unsigned hm2 = hf ? (unsigned)(mk2 >> 32) : (unsigned)mk2;
                        const int pos2 = cnt[mt][j] + __builtin_popcount(hm2 & ((1u << l31) - 1u));
                        if (pass2) buf[(4 * mt + 2 * hf + j) * TK_CAP + pos2] = pk2v;
                    }
#endif
                    cnt[mt][j] += __builtin_popcount(hm);
                }
        }
        const bool anyhi = cnt[0][0] > TK_HI || cnt[0][1] > TK_HI || cnt[1][0] > TK_HI || cnt[1][1] > TK_HI;
        if (__ballot(anyhi) != 0ull) {
#pragma unroll 1
            for (int s8 = 0; s8 < 8; ++s8) {
                const int mt = s8 >> 2, j = (s8 >> 1) & 1, h2 = s8 & 1;
                const int cv = mt ? (j ? cnt[1][1] : cnt[1][0]) : (j ? cnt[0][1] : cnt[0][0]);
                const int c = __builtin_amdgcn_readlane(cv, 32 * h2);
                if (c > TK_HI) {
                    volatile LAS unsigned* qb = buf + (4 * mt + 2 * h2 + j) * TK_CAP;
                    int nk = 0;
                    unsigned V = topk_prune<2>(qb, hist, c, nk);
#ifdef XP_DUPPRUNE
                    V = topk_prune<2>(qb, hist, nk, nk);
#endif
                    if (nk > TK_HI - 64) V = topk_prune<4>(qb, hist, nk, nk);
#pragma unroll
                    for (int a = 0; a < 2; ++a)
#pragma unroll
                        for (int d = 0; d < 2; ++d)
                            if (hf == h2 && a == mt && d == j) { tau[a][d] = V; cnt[a][d] = nk; }
                }
            }
        }
#pragma unroll
        for (int sb = 0; sb < 2; ++sb)
#pragma unroll
            for (int ks = 0; ks < 4; ++ks) bfr[sb][ks] = bn[sb][ks];
    }
#pragma unroll 1
    for (int s8 = 0; s8 < 8; ++s8) {
        const int mt = s8 >> 2, j = (s8 >> 1) & 1, h2 = s8 & 1;
        const int cv = mt ? (j ? cnt[1][1] : cnt[1][0]) : (j ? cnt[0][1] : cnt[0][0]);
        int c = __builtin_amdgcn_readlane(cv, 32 * h2);
        volatile LAS unsigned* qb = buf + (4 * mt + 2 * h2 + j) * TK_CAP;
        if (c > 256) { int nk = 0; (void)topk_prune<4>(qb, hist, c, nk); c = nk; }
#pragma unroll
        for (int t = 0; t < 4; ++t) qb[256 + 4 * lane + t] = 0u;
        asm volatile("" ::: "memory");
#pragma unroll
        for (int t = 0; t < 4; ++t) {
            const int idx = lane + 64 * t;
            if (idx < c) {
                const unsigned e = qb[idx]; const unsigned kk = 8191u - (e & 8191u);
                __hip_atomic_fetch_or((LAS unsigned*)&qb[256 + (kk >> 5)], 1u << (kk & 31u), __ATOMIC_RELAXED, __HIP_MEMORY_SCOPE_WORKGROUP);
            }
        }
        asm volatile("" ::: "memory");
    }
    u64* mask = (u64*)(P.ws + OFF_MASK);
    const int ktmax = (q0 | 255) >> 6;
    const int qi = lane & 7;
#pragma unroll 1
    for (int it = 0; it < 16; ++it) {
        const int kt = it * 8 + (lane >> 3);
        if (kt <= ktmax) {
            const unsigned lo = buf[qi * TK_CAP + 256 + 2 * kt], hi = buf[qi * TK_CAP + 256 + 2 * kt + 1];
            mask[((size_t)(b * 128 + kt)) * NS + qbase + qi] = ((u64)hi << 32) | lo;
        }
    }
}

constexpr int AT_K = 64 * LROW;
constexpr int AT_DSTAGE = 4 * AT_K;
template <int NDB, bool BM>
DI void attn_tile(const LAS char* Kt, const LAS char* Vt, const bf16x8 (&qf)[4], f32x16 (&o)[NDB], float off, float& mlow, float& lrun,
                  int qpos, int k0, float c1, float c2, bool diag, bool scan, u64 mword) {
    const int lane = threadIdx.x & 63, l31 = lane & 31, hf = lane >> 5;
    const int lanex = ((((l31 >> 1) & 7) ^ hf) << 4);
    const LAS char* kbase = Kt + l31 * 128;
    const LAS char* vbase = Vt + l31 * 128;
    const float bias0 = -c2 * (float)(qpos - k0 - 4 * hf) - off;
#pragma unroll 1
    for (int kbi = 0; kbi < 2; ++kbi) {
        const int kb = 1 - kbi;
        f32x16 st;
#pragma unroll
        for (int i = 0; i < 16; ++i) st[i] = 0.f;
#pragma unroll
        for (int ks = 0; ks < 4; ++ks) {
            const bf16x8 kf = *(const LAS bf16x8*)(kbase + kb * 4096 + (lanex ^ (ks << 5)));
            st = MFMA32(kf, qf[ks], st);
        }
        const unsigned mw = BM ? (unsigned)((kb ? (unsigned)(mword >> 32) : (unsigned)mword) >> (4 * hf)) : 0u;
        const float noff = bias0 + c2 * (float)(32 * kb);
        float ls = 0.f, mx = -INFINITY;
#pragma unroll
        for (int i = 0; i < 16; ++i) {
            const int ko = (i & 3) + 8 * (i >> 2);
            const float v = __builtin_fmaf(st[i], c1, __builtin_fmaf(c2, (float)ko, noff));
            bool ok = true;
            if (BM) ok = (mw >> ko) & 1u;
            if (diag) ok = ok && (k0 + 32 * kb + ko + 4 * hf <= qpos);
            float p = __builtin_amdgcn_exp2f(v);
            if (BM || diag) p = ok ? p : 0.f;
            if (scan) mx = fmaxf(mx, (BM || diag) ? (ok ? v : -INFINITY) : v);
            st[i] = p; ls += p;
        }
#ifdef XP_DUPSOFTMAX
        {
            float ls2 = 0.f;
#pragma unroll
            for (int i = 0; i < 16; ++i) {
                const int ko = (i & 3) + 8 * (i >> 2);
                float x = st[i]; asm volatile("" : "+v"(x));
                const float v = __builtin_fmaf(x, c1, __builtin_fmaf(c2, (float)ko, noff));
                ls2 += __builtin_amdgcn_exp2f(v);
            }
            asm volatile("" : "+v"(ls2));
            ls += ls2 * 0.f;
        }
#endif
        lrun += ls;
        if (scan) { mx = fmaxf(mx, __shfl_xor(mx, 32)); mlow = fmaxf(mlow, mx + off); }
        const int vx = lanex ^ (kb << 6);
#pragma unroll
        for (int s = 0; s < 2; ++s) {
            u32x4 pp;
#pragma unroll
            for (int t = 0; t < 4; ++t) pp[t] = pk2(st[8 * s + 2 * t], st[8 * s + 2 * t + 1]);
            const bf16x8 pf = __builtin_bit_cast(bf16x8, pp);
#pragma unroll
            for (int db = 0; db < NDB; ++db) {
                const bf16x8 vf = *(const LAS bf16x8*)(vbase + db * 4096 + (vx ^ (s << 5)));
                o[db] = MFMA32(vf, pf, o[db]);
            }
        }
    }
}

constexpr int AT_NST = 4;

DI void diffattn_item(const Params& P, char* smem, int b, int h, int qb) {
    const int tid = threadIdx.x, lane = tid & 63, w = __builtin_amdgcn_readfirstlane(tid >> 6), l31 = lane & 31, hf = lane >> 5;
    const int map = w & 1, qsub = w >> 1;
    const int q0 = qb * 128;
    LAS char* lds = (LAS char*)smem;
    const bf16_t* Qd = (const bf16_t*)(P.ws + OFF_QD);
    const bf16_t* Kd = (const bf16_t*)(P.ws + OFF_KD);
    const bf16_t* VdT = (const bf16_t*)(P.ws + OFF_VDT);
    const int qpos = q0 + 32 * qsub + l31;
    bf16x8 qf[4];
#pragma unroll
    for (int ks = 0; ks < 4; ++ks) qf[ks] = *(const bf16x8*)(Qd + ((size_t)b * NS + qpos) * 512 + h * 128 + map * 64 + ks * 16 + hf * 8);
    const float slope = exp2f(-2.f * (float)(h + 1));
    const float c1 = 0.125f * LOG2E, c2 = slope * LOG2E;
    float gq = fabsf(P.dq_g[lane]), gk = fabsf(P.dk_g[lane]);
#pragma unroll
    for (int d = 32; d >= 1; d >>= 1) { gq = fmaxf(gq, __shfl_xor(gq, d)); gk = fmaxf(gk, __shfl_xor(gk, d)); }
    const float B2 = 64.f * gq * gk * 1.008f * c1;
    int* flags = (int*)(smem + SM_EXTRA + 3072);
    int par = 0;
    f32x16 o[4];
#pragma unroll
    for (int db = 0; db < 4; ++db)
#pragma unroll
        for (int i = 0; i < 16; ++i) o[db][i] = 0.f;
    float mlow = -INFINITY, lrun = 0.f;
    int ndone = 0;
    const int drow = 8 * w + (lane >> 3), dch = (lane & 7) ^ ((drow >> 1) & 7);
    const bf16_t* ksrc = Kd + ((size_t)b * NS + drow) * 512 + h * 128 + dch * 8;
    const bf16_t* vsrc = VdT + ((size_t)(b * 4 + h) * 128 + drow) * NS + dch * 8;
    auto dma = [&](int kt, int stage) {
        LAS char* stg = lds + stage * 32768;
        const size_t k0 = (size_t)kt * 64;
        __builtin_amdgcn_global_load_lds((const unsigned*)(ksrc + k0 * 512), (LAS unsigned*)(stg + w * 1024), 16, 0, 0);
        __builtin_amdgcn_global_load_lds((const unsigned*)(ksrc + k0 * 512 + 64), (LAS unsigned*)(stg + 8192 + w * 1024), 16, 0, 0);
        __builtin_amdgcn_global_load_lds((const unsigned*)(vsrc + k0), (LAS unsigned*)(stg + 16384 + w * 1024), 16, 0, 0);
        __builtin_amdgcn_global_load_lds((const unsigned*)(vsrc + (size_t)64 * NS + k0), (LAS unsigned*)(stg + 16384 + 8192 + w * 1024), 16, 0, 0);
#ifdef XP_DUPDMA
        __builtin_amdgcn_global_load_lds((const unsigned*)(ksrc + k0 * 512), (LAS unsigned*)(stg + w * 1024), 16, 0, 0);
        __builtin_amdgcn_global_load_lds((const unsigned*)(ksrc + k0 * 512 + 64), (LAS unsigned*)(stg + 8192 + w * 1024), 16, 0, 0);
        __builtin_amdgcn_global_load_lds((const unsigned*)(vsrc + k0), (LAS unsigned*)(stg + 16384 + w * 1024), 16, 0, 0);
        __builtin_amdgcn_global_load_lds((const unsigned*)(vsrc + (size_t)64 * NS + k0), (LAS unsigned*)(stg + 16384 + 8192 + w * 1024), 16, 0, 0);
#endif
    };
    const int ktd = 2 * qb + 1;
    const int qwmax = q0 + 32 * qsub + 31, qwmin = q0 + 32 * qsub;
#ifdef XP_DUPLOOP
  for (int rep = 0; rep < 2; ++rep) {
    if (rep) { for (int db = 0; db < 4; ++db) for (int i = 0; i < 16; ++i) o[db][i] = 0.f; mlow = -INFINITY; lrun = 0.f; ndone = 0; par = 0; }
#endif
    asm volatile("s_waitcnt vmcnt(0) lgkmcnt(0)" ::: "memory");
    __builtin_amdgcn_s_barrier();
    dma(max(ktd, 0), 0); dma(max(ktd - 1, 0), 1); dma(max(ktd - 2, 0), 2);
    for (int j = 0; j <= ktd; ++j) {
        const int kt = ktd - j, k0 = kt * 64;
#ifdef XP_DUPDMA
        asm volatile("s_waitcnt vmcnt(16)" ::: "memory");
#else
        asm volatile("s_waitcnt vmcnt(8)" ::: "memory");
#endif
        asm volatile("s_waitcnt lgkmcnt(0)" ::: "memory");
        __builtin_amdgcn_s_barrier();
        int allstop = 0;
        if (j > 0) { allstop = 1;
#pragma unroll
            for (int i = 0; i < 8; ++i) allstop &= flags[(par ^ 1) * 8 + i]; }
        if (allstop) break;
        dma(max(kt - 3, 0), (j + 3) & 3);
        const LAS char* cur = lds + (j & 3) * 32768;
        if (k0 <= qwmax) {
            attn_tile<4, false>(cur + map * 8192, cur + 16384, qf, o, B2, mlow, lrun, qpos, k0, c1, c2, k0 + 63 > qwmin, ndone < 2, 0ull);
            ++ndone;
        }
        {
            const float ub = B2 - c2 * (float)(qpos - (k0 - 1));
            const bool stop = __all(ub < mlow - 30.f);
            if (lane == 0) flags[par * 8 + w] = stop ? 1 : 0;
        }
        par ^= 1;
    }
    asm volatile("s_waitcnt vmcnt(0) lgkmcnt(0)" ::: "memory");
    __builtin_amdgcn_s_barrier();
#ifdef XP_DUPLOOP
  }
#endif
    const float ltot = lrun + __shfl_xor(lrun, 32);
    const float inv = 1.f / ltot;
    float la, lb;
    { const float a = P.lq1[lane] * P.lk1[lane], c = P.lq2[lane] * P.lk2[lane]; la = wave_sum(a); lb = wave_sum(c); }
    const float lam = __expf(la) - __expf(lb) + 0.2f;
    float* X = (float*)smem;
    if (map == 1) {
#pragma unroll
        for (int db = 0; db < 4; ++db)
#pragma unroll
            for (int q4 = 0; q4 < 4; ++q4) {
                f32x4 v;
#pragma unroll
                for (int r = 0; r < 4; ++r) v[r] = o[db][4 * q4 + r] * inv * lam;
                *(f32x4*)(X + (qsub * 32 + l31) * 132 + 32 * db + 8 * q4 + 4 * hf) = v;
            }
    }
    __syncthreads();
    if (map == 0) {
        float ss = 0.f;
#pragma unroll
        for (int db = 0; db < 4; ++db)
#pragma unroll
            for (int q4 = 0; q4 < 4; ++q4) {
                const f32x4 v2 = *(const f32x4*)(X + (qsub * 32 + l31) * 132 + 32 * db + 8 * q4 + 4 * hf);
#pragma unroll
                for (int r = 0; r < 4; ++r) { const float v = o[db][4 * q4 + r] * inv - v2[r]; o[db][4 * q4 + r] = v; ss += v * v; }
            }
        ss += __shfl_xor(ss, 32);
        const float rstd = rsqrtf(ss * (1.f / 128.f) + EPSF) * 0.8f;
        bf16_t* ao = (bf16_t*)(P.ws + OFF_H) + ((size_t)b * NS + qpos) * 1024 + h * 128;
#pragma unroll
        for (int db = 0; db < 4; ++db)
#pragma unroll
            for (int q4 = 0; q4 < 4; ++q4) {
                const int d = 32 * db + 8 * q4 + 4 * hf;
                const f32x4 g = *(const f32x4*)((const float*)(smem + SM_EXTRA + 1024) + d);
                u32x2 pk; pk[0] = pk2(o[db][4 * q4] * rstd * g[0], o[db][4 * q4 + 1] * rstd * g[1]); pk[1] = pk2(o[db][4 * q4 + 2] * rstd * g[2], o[db][4 * q4 + 3] * rstd * g[3]);
                *(u32x2*)(ao + d) = pk;
            }
    }
    __syncthreads();
}

DI void dsa_item(const Params& P, char* smem, int b, int h, int qb) {
    const int tid = threadIdx.x, lane = tid & 63, w = __builtin_amdgcn_readfirstlane(tid >> 6), l31 = lane & 31, hf = lane >> 5;
    const int q0 = qb * 256;
    LAS char* lds = (LAS char*)smem;
    const bf16_t* Qs = (const bf16_t*)(P.ws + OFF_QS);
    const bf16_t* Ks = (const bf16_t*)(P.ws + OFF_KS);
    const bf16_t* VsT = (const bf16_t*)(P.ws + OFF_VST);
    const u64* mask = (const u64*)(P.ws + OFF_MASK);
    const int qpos = q0 + 32 * w + l31;
    bf16x8 qf[4];
#pragma unroll
    for (int ks = 0; ks < 4; ++ks) qf[ks] = *(const bf16x8*)(Qs + ((size_t)b * NS + qpos) * 512 + h * 64 + ks * 16 + hf * 8);
    const float slope = exp2f(-(float)(h + 1));
    const float c1 = 0.125f * LOG2E, c2 = slope * LOG2E;
    float gq = fabsf(P.sq_g[lane]), gk = fabsf(P.sk_g[lane]);
#pragma unroll
    for (int d = 32; d >= 1; d >>= 1) { gq = fmaxf(gq, __shfl_xor(gq, d)); gk = fmaxf(gk, __shfl_xor(gk, d)); }
    const float B2 = 64.f * gq * gk * 1.008f * c1;
    int* flags = (int*)(smem + SM_EXTRA + 3072);
    int par = 0;
    f32x16 o[2];
#pragma unroll
    for (int db = 0; db < 2; ++db)
#pragma unroll
        for (int i = 0; i < 16; ++i) o[db][i] = 0.f;
    float mlow = -INFINITY, lrun = 0.f, off = 0.f;
    bool offset_set = false;
    const int drow = 8 * w + (lane >> 3), dch = (lane & 7) ^ ((drow >> 1) & 7);
    const bf16_t* ksrc = Ks + ((size_t)b * NS + drow) * 512 + h * 64 + dch * 8;
    const bf16_t* vsrc = VsT + ((size_t)(b * 8 + h) * 64 + drow) * NS + dch * 8;
    const u64* msrc = mask + (size_t)b * 128 * NS + q0 + (w & 1) * 128 + lane * 2;
    auto dma = [&](int kt, int stage) {
        LAS char* stg = lds + stage * 18432;
        const size_t k0 = (size_t)kt * 64;
        __builtin_amdgcn_global_load_lds((const unsigned*)(ksrc + k0 * 512), (LAS unsigned*)(stg + w * 1024), 16, 0, 0);
        __builtin_amdgcn_global_load_lds((const unsigned*)(vsrc + k0), (LAS unsigned*)(stg + 8192 + w * 1024), 16, 0, 0);
        if (w < 2) __builtin_amdgcn_global_load_lds((const unsigned*)(msrc + (size_t)kt * NS), (LAS unsigned*)(stg + 16384 + w * 1024), 16, 0, 0);
    };
    const int ktd = 4 * qb + 3;
    const int qwmax = q0 + 32 * w + 31;
#ifdef XP_DUPLOOP
  for (int rep = 0; rep < 2; ++rep) {
    if (rep) { for (int db = 0; db < 2; ++db) for (int i = 0; i < 16; ++i) o[db][i] = 0.f; mlow = -INFINITY; lrun = 0.f; off = 0.f; offset_set = false; par = 0; }
#endif
    asm volatile("s_waitcnt vmcnt(0) lgkmcnt(0)" ::: "memory");
    __builtin_amdgcn_s_barrier();
    dma(max(ktd, 0), 0); dma(max(ktd - 1, 0), 1); dma(max(ktd - 2, 0), 2);
    for (int j = 0; j <= ktd; ++j) {
        const int kt = ktd - j, k0 = kt * 64;
        if (w < 2) asm volatile("s_waitcnt vmcnt(6)" ::: "memory"); else asm volatile("s_waitcnt vmcnt(4)" ::: "memory");
        asm volatile("s_waitcnt lgkmcnt(0)" ::: "memory");
        __builtin_amdgcn_s_barrier();
        int allstop = 0;
        if (j > 0) { allstop = 1;
#pragma unroll
            for (int i = 0; i < 8; ++i) allstop &= flags[(par ^ 1) * 8 + i]; }
        if (allstop) break;
        dma(max(kt - 3, 0), (j + 3) & 3);
        const LAS char* cur = lds + (j & 3) * 18432;
        u64 mword = 0ull;
        if (k0 <= qwmax) mword = *(const LAS u64*)(cur + 16384 + (32 * w + l31) * 8);
        if (k0 <= qwmax && __ballot(mword != 0ull) != 0ull) {
            if (!offset_set && mword != 0ull) { off = B2 - c2 * (float)max(qpos - (k0 + 63), 0); offset_set = true; }
            attn_tile<2, true>(cur, cur + 8192, qf, o, off, mlow, lrun, qpos, k0, c1, c2, false, __any(mlow == -INFINITY), mword);
        }
        {
            const float ub = B2 - c2 * (float)(qpos - (k0 - 1));
            const bool stop = __all(ub < mlow - 30.f);
            if (lane == 0) flags[par * 8 + w] = stop ? 1 : 0;
        }
        par ^= 1;
    }
    asm volatile("s_waitcnt vmcnt(0) lgkmcnt(0)" ::: "memory");
    __builtin_amdgcn_s_barrier();
#ifdef XP_DUPLOOP
  }
#endif
    const float ltot = lrun + __shfl_xor(lrun, 32);
    const float inv = 1.f / ltot;
    bf16_t* ao = (bf16_t*)(P.ws + OFF_H) + ((size_t)b * NS + qpos) * 1024 + 512 + h * 64;
#pragma unroll
    for (int db = 0; db < 2; ++db)
#pragma unroll
        for (int q4 = 0; q4 < 4; ++q4) {
            const int d = 32 * db + 8 * q4 + 4 * hf;
            u32x2 pk; pk[0] = pk2(o[db][4 * q4] * inv, o[db][4 * q4 + 1] * inv); pk[1] = pk2(o[db][4 * q4 + 2] * inv, o[db][4 * q4 + 3] * inv);
            *(u32x2*)(ao + d) = pk;
        }
}

constexpr int P3_ITEMS = 128 * 8;
DI void phase_indexer(const Params& P, char* smem) {
    const XPart xp = xcd_part(P.ws, smem, P3_ITEMS);
    const int lo = xp.start - (xp.start % 1 ? 0 : 0);
    const int step = xp.step;
    const int rank = ((const int*)(smem + XC_LDS))[1];
    const int base = xp.start - rank;
    for (int k = 0; base + k * step < xp.end; ++k) {
        const int i = base + k * step + ((k & 1) ? step - 1 - rank : rank);
        if (i >= xp.end) continue;
        const int b = i >> 7, g = 127 - (i & 127);
        __syncthreads();
        indexer_item(P, smem, b, g * 64);
    }
    __syncthreads();
    (void)lo;
}
DI void phase_attn(const Params& P, char* smem, int qidx) {
    int* qctr = (int*)(P.ws + OFF_Q) + qidx;
    const int* items = (const int*)(P.ws + OFF_ITEMS);
    volatile int* s_it = (volatile int*)(smem + SM_EXTRA + 3200);
    __syncthreads();
    if (threadIdx.x < 128) ((float*)(smem + SM_EXTRA + 1024))[threadIdx.x] = P.subln_g[threadIdx.x];
    __syncthreads();
    for (;;) {
        __syncthreads();
        if (threadIdx.x == 0) *s_it = atomicAdd(qctr, 1);
        __syncthreads();
        const int it = *s_it;
        if (it >= ATT_ITEMS) break;
        const int code = items[it];
        const int b = (code >> 16) & 15, h = (code >> 8) & 255, qb = code & 255;
        if ((code >> 20) == 0) diffattn_item(P, smem, b, h, qb);
        else dsa_item(P, smem, b, h, qb);
    }
}

constexpr int OUTPROJ_ITEMS = (NT / 256) * 4;
DI void phase_outproj(const Params& P, char* smem) {
    const bf16_t* zrow = (const bf16_t*)(P.ws + OFF_ZROW);
    const bf16_t* ao = (const bf16_t*)(P.ws + OFF_H);
    const bf16_t* wout = (const bf16_t*)(P.ws + OFF_WOUT);
    bf16_t* mix = (bf16_t*)(P.ws + OFF_QD);
    const int lane = threadIdx.x & 63, w = threadIdx.x >> 6, wm = w >> 1, wn = w & 1, l31 = lane & 31, hf = lane >> 5;
    const XPart xp = xcd_part(P.ws, smem, OUTPROJ_ITEMS);
    for (int it = xp.start; it < xp.end; it += xp.step) {
        const int mt = it >> 2, j = it & 3;
        const int row0 = mt * 256;
        DenseRows ar{ao + (size_t)row0 * 1024, 1024};
        gemm_dma<true, 256>(smem, ar, wout + (size_t)j * 256 * 1024, 1024, 4, 1, zrow, [&](int, const f32x16 (&acc)[2][4]) {
#pragma unroll
            for (int mi = 0; mi < 2; ++mi)
#pragma unroll
                for (int pr = 0; pr < 2; ++pr) {
                    bf16_t* base = mix + ((size_t)row0 + 64 * wm + 32 * mi) * 1024 + 256 * j + 128 * wn + 64 * pr;
                    stage_store_chunk(smem, acc[mi][2 * pr], acc[mi][2 * pr + 1], [](int, int, float x) { return x; }, [&](int r) { return base + (size_t)r * 1024; });
                }
        });
    }
}
DI void phase_resnorm2(const Params& P) {
    const bf16_t* mix = (const bf16_t*)(P.ws + OFF_QD);
    const float* mod = (const float*)(P.ws + OFF_MOD);
    bf16_t* h2 = (bf16_t*)(P.ws + OFF_H2);
    const int lane = threadIdx.x & 63, w = threadIdx.x >> 6;
    for (int row = blockIdx.x * NW + w; row < NT; row += gridDim.x * NW) {
        const int b = row >> 13;
        const float* mb = mod + b * 6144;
        f32x4 v[4]; float ss = 0.f;
#pragma unroll
        for (int i = 0; i < 4; ++i) {
            const int col = 256 * i + 4 * lane;
            const f32x4 xv = *(const f32x4*)(P.x + (size_t)row * 1024 + col);
            const u32x2 mv = *(const u32x2*)(mix + (size_t)row * 1024 + col);
            const f32x4 g1 = *(const f32x4*)(mb + 2048 + col);
            v[i][0] = xv[0] + g1[0] * bflo(mv[0]); v[i][1] = xv[1] + g1[1] * bfhi(mv[0]);
            v[i][2] = xv[2] + g1[2] * bflo(mv[1]); v[i][3] = xv[3] + g1[3] * bfhi(mv[1]);
            *(f32x4*)(P.out + (size_t)row * 1024 + col) = v[i];
            ss += v[i][0] * v[i][0] + v[i][1] * v[i][1] + v[i][2] * v[i][2] + v[i][3] * v[i][3];
        }
        ss = wave_sum(ss);
        const float rstd = rsqrtf(ss * (1.f / 1024.f) + EPSF);
#pragma unroll
        for (int i = 0; i < 4; ++i) {
            const int col = 256 * i + 4 * lane;
            const f32x4 gg = *(const f32x4*)(P.norm2_g + col);
            const f32x4 sh = *(const f32x4*)(mb + 3072 + col);
            const f32x4 sc = *(const f32x4*)(mb + 4096 + col);
            float o[4];
#pragma unroll
            for (int j = 0; j < 4; ++j) o[j] = v[i][j] * rstd * gg[j] * (1.f + sc[j]) + sh[j];
            u32x2 pk; pk[0] = pk2(o[0], o[1]); pk[1] = pk2(o[2], o[3]);
            *(u32x2*)(h2 + (size_t)row * 1024 + col) = pk;
        }
    }
}

constexpr int ROUTER_ITEMS = NT / 256;
DI void phase_router(const Params& P, char* smem) {
    const bf16_t* zrow = (const bf16_t*)(P.ws + OFF_ZROW);
    const bf16_t* h2 = (const bf16_t*)(P.ws + OFF_H2);
    const bf16_t* wrt = (const bf16_t*)(P.ws + OFF_WRT);
    float* logits = (float*)(P.ws + OFF_Y);
    const int lane = threadIdx.x & 63, w = threadIdx.x >> 6, wm = w >> 1, wn = w & 1, l31 = lane & 31, hf = lane >> 5;
    for (int it = blockIdx.x; it < ROUTER_ITEMS; it += gridDim.x) {
        const int row0 = it * 256;
        DenseRows ar{h2 + (size_t)row0 * 1024, 1024};
        gemm_dma<true, 256>(smem, ar, wrt, 1024, 4, 1, zrow, [&](int, const f32x16 (&acc)[2][4]) {
#pragma unroll
            for (int mi = 0; mi < 2; ++mi) {
                const size_t tok = (size_t)row0 + 64 * wm + 32 * mi + l31;
#pragma unroll
                for (int ni = 0; ni < 4; ++ni)
#pragma unroll
                    for (int q4 = 0; q4 < 4; ++q4) {
                        const int n = 128 * wn + 32 * ni + 8 * q4 + 4 * hf;
                        f32x4 ov = {acc[mi][ni][4 * q4], acc[mi][ni][4 * q4 + 1], acc[mi][ni][4 * q4 + 2], acc[mi][ni][4 * q4 + 3]};
                        *(f32x4*)(logits + tok * 256 + n) = ov;
                    }
            }
        });
    }
}

DI void phase_route(const Params& P) {
    const float* logits = (const float*)(P.ws + OFF_Y);
    int* cnt = (int*)(P.ws + OFF_CNT);
    int* list = (int*)(P.ws + OFF_LIST);
    int* eidx = (int*)(P.ws + OFF_EIDX);
    float* gates = (float*)(P.ws + OFF_GATE);
    const int lane = threadIdx.x & 63, w = threadIdx.x >> 6;
    const f32x4 bias = *(const f32x4*)(P.router_b + 4 * lane);
    for (int t = blockIdx.x * NW + w; t < NT; t += gridDim.x * NW) {
        const f32x4 lg = *(const f32x4*)(logits + (size_t)t * 256 + 4 * lane);
        float sc[4], cand[4];
#pragma unroll
        for (int i = 0; i < 4; ++i) { sc[i] = 1.f / (1.f + __expf(-lg[i])); cand[i] = sc[i] + bias[i]; }
        float t1 = fmaxf(cand[0], cand[1]), t2 = fminf(cand[0], cand[1]);
#pragma unroll
        for (int i = 2; i < 4; ++i) { const float v = cand[i]; t2 = fmaxf(t2, fminf(t1, v)); t1 = fmaxf(t1, v); }
#pragma unroll
        for (int d = 1; d < 8; d <<= 1) {
            const float o1 = __shfl_xor(t1, d), o2 = __shfl_xor(t2, d);
            const float n1 = fmaxf(t1, o1), n2 = fmaxf(fminf(t1, o1), fmaxf(t2, o2));
            t1 = n1; t2 = n2;
        }
        const float gs = t1 + t2;
        const int myg = lane >> 3;
        int rank = 0;
#pragma unroll
        for (int g = 0; g < 8; ++g) { const float sg = __shfl(gs, 8 * g); rank += (sg > gs || (sg == gs && g < myg)) ? 1 : 0; }
        if (rank >= 4) {
#pragma unroll
            for (int i = 0; i < 4; ++i) cand[i] = -INFINITY;
        }
        int sel[8]; float wv[8]; float wsum = 0.f;
#pragma unroll
        for (int k = 0; k < 8; ++k) {
            float bv = cand[0]; int bi = 0;
#pragma unroll
            for (int i = 1; i < 4; ++i) if (cand[i] > bv) { bv = cand[i]; bi = i; }
            int be = 4 * lane + bi;
#pragma unroll
            for (int d = 32; d >= 1; d >>= 1) {
                const float ov = __shfl_xor(bv, d); const int oe = __shfl_xor(be, d);
                if (ov > bv || (ov == bv && oe < be)) { bv = ov; be = oe; }
            }
            const int ol = be >> 2, oi = be & 3;
            float mys = (oi == 0) ? sc[0] : (oi == 1) ? sc[1] : (oi == 2) ? sc[2] : sc[3];
            const float ws_ = __shfl(mys, ol);
            if (lane == ol) {
#pragma unroll
                for (int i = 0; i < 4; ++i) if (i == oi) cand[i] = -INFINITY;
            }
            sel[k] = be; wv[k] = ws_; wsum += ws_;
        }
        const float rs = 2.5f / wsum;
        int my_e = 256; float my_g = 1.f;
#pragma unroll
        for (int k = 0; k < 8; ++k) if (lane == k) { my_e = sel[k]; my_g = wv[k] * rs; }
        const int c = t >> 14, tl = t & (CHUNK_T - 1);
        if (lane < 8) {
            eidx[(size_t)t * 8 + lane] = my_e; gates[(size_t)t * 8 + lane] = my_g;
            const int pos = atomicAdd(&cnt[c * NEXP1 + my_e], 1);
            list[((size_t)c * NEXP1 + my_e) * CHUNK_T + pos] = tl * NPAIR + lane;
        } else if (lane == 8) {
            list[((size_t)c * NEXP1 + 256) * CHUNK_T + tl] = tl * NPAIR + 8;
        }
    }
}

typedef unsigned short u16;
DI void moe_build_tiles(const Params& P, char* smem, int c, int& totalA, int& totalB) {
    u16* tA = (u16*)(smem + SM_EXTRA);
    u16* tB = (u16*)(smem + SM_EXTRA + 528);
    int* wsum = (int*)(smem + SM_EXTRA + 1048);
    const int* cnt = (const int*)(P.ws + OFF_CNT) + c * NEXP1;
    const int e = threadIdx.x, lane = e & 63, w = e >> 6;
    __syncthreads();
    int na = 0, nb = 0, ia = 0, ib = 0;
    if (e < 256) {
        const int n = cnt[e], full = n >> 8, rem = n & 255;
        na = full + (rem > 128 ? 1 : 0); nb = (rem >= 1 && rem <= 128) ? 1 : 0;
        ia = na; ib = nb;
#pragma unroll
        for (int d = 1; d < 64; d <<= 1) { const int t = __shfl_up(ia, d), u = __shfl_up(ib, d); if (lane >= d) { ia += t; ib += u; } }
        if (lane == 63) { wsum[w] = ia; wsum[4 + w] = ib; }
    }
    __syncthreads();
    if (e < 256) {
        int oa = 0, ob = 0;
#pragma unroll
        for (int i = 0; i < 4; ++i) if (i < w) { oa += wsum[i]; ob += wsum[4 + i]; }
        tA[e] = (u16)(oa + ia - na); tB[e] = (u16)(ob + ib - nb);
        if (e == 255) { tA[256] = (u16)(oa + ia); tA[257] = (u16)(oa + ia + CHUNK_T / 256); tB[256] = (u16)(ob + ib); tB[257] = (u16)(ob + ib); }
    }
    __syncthreads();
    totalA = tA[NEXP1]; totalB = tB[NEXP1];
}
DI int moe_find_expert(const u16* tstart, int tile) {
    int lo = 0, hi = NEXP1;
    while (hi - lo > 1) { const int mid = (lo + hi) >> 1; if ((int)tstart[mid] <= tile) lo = mid; else hi = mid; }
    return lo;
}
struct GatherRows {
    static constexpr bool kDense = false;
    const bf16_t* base; int ld; const int* pid; int div;
    DI const bf16_t* operator()(int r) const { const int p = pid[r]; return p < 0 ? nullptr : base + (size_t)(p / div) * ld; }
};
template <int BM>
DI void moe_g1_tiles(const Params& P, char* smem, int c, const u16* tstart, int total) {
    const bf16_t* zrow = (const bf16_t*)(P.ws + OFF_ZROW);
    int* pid = (int*)(smem + SM_EXTRA + 1088);
    const int* cnt = (const int*)(P.ws + OFF_CNT) + c * NEXP1;
    const int* list = (const int*)(P.ws + OFF_LIST) + (size_t)c * NEXP1 * CHUNK_T;
    const bf16_t* h2 = (const bf16_t*)(P.ws + OFF_H2) + (size_t)c * CHUNK_T * 1024;
    const bf16_t* wgu = (const bf16_t*)(P.ws + OFF_WGU);
    bf16_t* act = (bf16_t*)(P.ws + OFF_ACT + (size_t)(c & 1) * ACT_BYTES);
    const int lane = threadIdx.x & 63, w = threadIdx.x >> 6, wm = BM == 256 ? (w >> 1) : (w >> 2), wn = BM == 256 ? (w & 1) : (w & 3), l31 = lane & 31, hf = lane >> 5;
    const XPart xp = xcd_part(P.ws, smem, total * 2);
    for (int it = xp.start; it < xp.end; it += xp.step) {
        const int tile = it >> 1, half = it & 1;
        const int e = moe_find_expert(tstart, tile), ti = tile - tstart[e];
        const int n = e < NEXP ? cnt[e] : CHUNK_T;
        const int li0 = BM == 256 ? ti * 256 : (n >> 8) * 256;
        __syncthreads();
        if (threadIdx.x < BM) { const int li = li0 + threadIdx.x; pid[threadIdx.x] = li < n ? list[(size_t)e * CHUNK_T + li] : -1; }
        __syncthreads();
        GatherRows ar{h2, 1024, pid, NPAIR};
        if constexpr (BM == 256) {
            gemm_dma<true, 256>(smem, ar, wgu + ((size_t)e * 512 + half * 256) * 1024, 1024, 4, 1, zrow, [&](int, const f32x16 (&acc)[2][4]) {
#pragma unroll
                for (int mi = 0; mi < 2; ++mi) {
                    f32x16 t0, t1;
#pragma unroll
                    for (int i = 0; i < 16; ++i) { t0[i] = silu_f(acc[mi][0][i]) * acc[mi][1][i]; t1[i] = silu_f(acc[mi][2][i]) * acc[mi][3][i]; }
                    const int* prow = pid + 64 * wm + 32 * mi;
                    bf16_t* abase = act + 128 * half + 64 * wn;
                    stage_store_chunk(smem, t0, t1, [](int, int, float x) { return x; }, [&](int r) { const int pp = prow[r]; return pp >= 0 ? abase + (size_t)pp * 256 : (bf16_t*)nullptr; });
                }
            });
        } else {
            gemm_dma<true, 128>(smem, ar, wgu + ((size_t)e * 512 + half * 256) * 1024, 1024, 4, 1, zrow, [&](int, const f32x16 (&acc)[2][2]) {
#pragma unroll
                for (int mi = 0; mi < 2; ++mi) {
                    const int p = pid[64 * wm + 32 * mi + l31];
                    if (p >= 0) {
                        bf16_t* arow_ = act + (size_t)p * 256 + 128 * half + 32 * wn;
#pragma unroll
                        for (int q4 = 0; q4 < 4; ++q4) {
                            float o[4];
#pragma unroll
                            for (int r = 0; r < 4; ++r) { const float g = acc[mi][0][4 * q4 + r], u = acc[mi][1][4 * q4 + r]; o[r] = silu_f(g) * u; }
                            u32x2 pk; pk[0] = pk2(o[0], o[1]); pk[1] = pk2(o[2], o[3]);
                            *(u32x2*)(arow_ + 8 * q4 + 4 * hf) = pk;
                        }
                    }
                }
            });
        }
    }
}
DI void phase_moe_g1(const Params& P, char* smem, int c) {
    int totalA, totalB;
    moe_build_tiles(P, smem, c, totalA, totalB);
    moe_g1_tiles<256>(P, smem, c, (const u16*)(smem + SM_EXTRA), totalA);
    moe_g1_tiles<128>(P, smem, c, (const u16*)(smem + SM_EXTRA + 528), totalB);
}
template <int BM>
DI void moe_g2_tiles(const Params& P, char* smem, int c, const u16* tstart, int total) {
    const bf16_t* zrow = (const bf16_t*)(P.ws + OFF_ZROW);
    int* pid = (int*)(smem + SM_EXTRA + 1088);
    float* gsm = (float*)(smem + SM_EXTRA + 2112);
    const int* cnt = (const int*)(P.ws + OFF_CNT) + c * NEXP1;
    const int* list = (const int*)(P.ws + OFF_LIST) + (size_t)c * NEXP1 * CHUNK_T;
    const float* gates = (const float*)(P.ws + OFF_GATE) + (size_t)c * CHUNK_T * 8;
    const bf16_t* wd = (const bf16_t*)(P.ws + OFF_WD);
    const bf16_t* act = (const bf16_t*)(P.ws + OFF_ACT + (size_t)(c & 1) * ACT_BYTES);
    bf16_t* y = (bf16_t*)(P.ws + OFF_Y);
    const int lane = threadIdx.x & 63, w = threadIdx.x >> 6, wm = BM == 256 ? (w >> 1) : (w >> 2), wn = BM == 256 ? (w & 1) : (w & 3), l31 = lane & 31;
    const XPart xp = xcd_part(P.ws, smem, total * 2);
    for (int it = xp.start; it < xp.end; it += xp.step) {
        const int tile = it >> 1, half = it & 1;
        const int e = moe_find_expert(tstart, tile), ti = tile - tstart[e];
        const int n = e < NEXP ? cnt[e] : CHUNK_T;
        const int li0 = BM == 256 ? ti * 256 : (n >> 8) * 256;
        __syncthreads();
        if (threadIdx.x < BM) {
            const int li = li0 + threadIdx.x; const int pp = li < n ? list[(size_t)e * CHUNK_T + li] : -1;
            pid[threadIdx.x] = pp;
            float g = 1.f;
            if (pp >= 0 && (pp % NPAIR) < 8) g = gates[(size_t)(pp / NPAIR) * 8 + (pp % NPAIR)];
            gsm[threadIdx.x] = g;
        }
        __syncthreads();
        GatherRows ar{act, 256, pid, 1};
        if constexpr (BM == 256) {
            gemm_dma<true, 256>(smem, ar, wd + ((size_t)e * 1024 + half * 512) * 256, 256, 2, 2, zrow, [&](int t, const f32x16 (&acc)[2][4]) {
#pragma unroll
                for (int mi = 0; mi < 2; ++mi) {
                    const float g = gsm[64 * wm + 32 * mi + l31];
                    const int* prow = pid + 64 * wm + 32 * mi;
#pragma unroll
                    for (int pr = 0; pr < 2; ++pr) {
                        const int cb = half * 512 + t * 256 + 128 * wn + 64 * pr;
                        stage_store_chunk(smem, acc[mi][2 * pr], acc[mi][2 * pr + 1], [&](int, int, float x) { return x * g; }, [&](int r) { const int pp = prow[r]; return pp >= 0 ? y + (size_t)pp * 1024 + cb : (bf16_t*)nullptr; });
                    }
                }
            });
        } else {
            gemm_dma<true, 128>(smem, ar, wd + ((size_t)e * 1024 + half * 512) * 256, 256, 2, 2, zrow, [&](int t, const f32x16 (&acc)[2][2]) {
                const int cb = half * 512 + t * 256 + 64 * wn;
#pragma unroll
                for (int mi = 0; mi < 2; ++mi) {
                    const float g = gsm[64 * wm + 32 * mi + l31];
                    const int* prow = pid + 64 * wm + 32 * mi;
                    stage_store_chunk(smem, acc[mi][0], acc[mi][1], [&](int, int, float x) { return x * g; }, [&](int r) { const int pp = prow[r]; return pp >= 0 ? y + (size_t)pp * 1024 + cb : (bf16_t*)nullptr; });
                }
            });
        }
    }
}
DI void phase_moe_g2(const Params& P, char* smem, int c) {
    int totalA, totalB;
    moe_build_tiles(P, smem, c, totalA, totalB);
    moe_g2_tiles<256>(P, smem, c, (const u16*)(smem + SM_EXTRA), totalA);
    moe_g2_tiles<128>(P, smem, c, (const u16*)(smem + SM_EXTRA + 528), totalB);
}
DI void phase_moe_combine(const Params& P, int c) {
    const bf16_t* y = (const bf16_t*)(P.ws + OFF_Y);
    const float* mod = (const float*)(P.ws + OFF_MOD);
    const int lane = threadIdx.x & 63, w = threadIdx.x >> 6;
    for (int tl = blockIdx.x * NW + w; tl < CHUNK_T; tl += gridDim.x * NW) {
        const size_t t = (size_t)c * CHUNK_T + tl;
        const int b = (int)(t >> 13);
        const float* g2 = mod + b * 6144 + 5120;
#pragma unroll
        for (int i = 0; i < 4; ++i) {
            const int col = 256 * i + 4 * lane;
            float s[4] = {0.f, 0.f, 0.f, 0.f};
#pragma unroll
            for (int k = 0; k < NPAIR; ++k) {
                const u32x2 v = *(const u32x2*)(y + ((size_t)tl * NPAIR + k) * 1024 + col);
                s[0] += bflo(v[0]); s[1] += bfhi(v[0]); s[2] += bflo(v[1]); s[3] += bfhi(v[1]);
            }
            const f32x4 xv = *(const f32x4*)(P.out + t * 1024 + col);
            const f32x4 gv = *(const f32x4*)(g2 + col);
            f32x4 ov;
#pragma unroll
            for (int r = 0; r < 4; ++r) ov[r] = xv[r] + gv[r] * s[r];
            *(f32x4*)(P.out + t * 1024 + col) = ov;
        }
    }
}

constexpr int NPHASE = 18;
template <int PH, int REP = 0> DI void run_phase(const Params& Pin, char* smem) {
    Params P = Pin;
    { typedef __attribute__((address_space(1))) char gchar; gchar* g = (gchar*)Pin.ws; asm volatile("" : "+s"(g)); P.ws = (char*)g; }
    float* mod = (float*)(P.ws + OFF_MOD);
    if constexpr (PH == 0) phase_adaln(P, smem);
    else if constexpr (PH == 1) { phase_norm(P.x, P.norm1_g, mod, 0, 1024, (bf16_t*)(P.ws + OFF_H)); phase_convert(P, smem); }
    else if constexpr (PH == 2) phase_inproj(P, smem);
    else if constexpr (PH == 3) phase_indexer(P, smem);
    else if constexpr (PH == 4) phase_attn(P, smem, REP);
    else if constexpr (PH == 5) phase_outproj(P, smem);
    else if constexpr (PH == 6) phase_resnorm2(P);
    else if constexpr (PH == 7) phase_router(P, smem);
    else if constexpr (PH == 8) phase_route(P);
    else if constexpr (PH == 9) phase_moe_g1(P, smem, 0);
    else if constexpr (PH == 10) { phase_moe_g2(P, smem, 0); phase_moe_g1(P, smem, 1); }
    else if constexpr (PH == 11) phase_moe_combine(P, 0);
    else if constexpr (PH == 12) { phase_moe_g2(P, smem, 1); phase_moe_g1(P, smem, 2); }
    else if constexpr (PH == 13) phase_moe_combine(P, 1);
    else if constexpr (PH == 14) { phase_moe_g2(P, smem, 2); phase_moe_g1(P, smem, 3); }
    else if constexpr (PH == 15) phase_moe_combine(P, 2);
    else if constexpr (PH == 16) phase_moe_g2(P, smem, 3);
    else if constexpr (PH == 17) phase_moe_combine(P, 3);
}
#ifndef DUP_PHASE
#define DUP_PHASE -1
#endif
#ifndef PROBE_PHASE
#define PROBE_PHASE -1
#endif
#ifndef PROBE_SCALE
#define PROBE_SCALE 0.1f
#endif
#define MK_RUN(PH) if constexpr (P0 <= PH && PH < P1) { \
    unsigned long long t0_ = 0; if constexpr (PH == PROBE_PHASE) t0_ = __builtin_amdgcn_s_memrealtime(); \
    run_phase<PH>(P, smem); if constexpr (PH == DUP_PHASE) { xcd_barrier(bar); run_phase<PH, 1>(P, smem); } \
    if constexpr (PH + 1 < P1 || PH == PROBE_PHASE) xcd_barrier(bar); \
    if constexpr (PH == PROBE_PHASE) { if (blockIdx.x == 0 && threadIdx.x == 0) *(volatile unsigned*)(P.ws + OFF_ERR + 512) = (unsigned)(__builtin_amdgcn_s_memrealtime() - t0_); } }
template <int P0, int P1>
__global__ void __launch_bounds__(NTH, 2) mk_kernel(Params P) {
    __shared__ __attribute__((aligned(16))) char smem[SMEM_BYTES + 16];
    if (threadIdx.x == 0) {
        *(uint4*)(smem + SMEM_BYTES) = make_uint4(0u, 0u, 0u, 0u);
        const int x = (int)xb_xcc_id();
        ((int*)(smem + XC_LDS))[0] = x;
        ((int*)(smem + XC_LDS))[1] = atomicAdd((int*)(P.ws + OFF_XRANK) + x, 1);
    }
    __syncthreads();
    XcdBarrier bar;
    if constexpr (P1 - P0 > 1 || PROBE_PHASE >= 0) bar = xcd_barrier_post((unsigned*)(P.ws + OFF_BAR), (volatile LAS unsigned*)(LAS char*)(smem + SMEM_BYTES));
    MK_RUN(0) MK_RUN(1) MK_RUN(2) MK_RUN(3) MK_RUN(4) MK_RUN(5) MK_RUN(6) MK_RUN(7) MK_RUN(8)
    MK_RUN(9) MK_RUN(10) MK_RUN(11) MK_RUN(12) MK_RUN(13) MK_RUN(14) MK_RUN(15) MK_RUN(16) MK_RUN(17)
    if constexpr (PROBE_PHASE >= 0) {
        xcd_barrier(bar);
        const float us = (float)(*(volatile unsigned*)(P.ws + OFF_ERR + 512)) * 0.01f;
        const float cval = sqrtf(us * PROBE_SCALE);
        for (size_t i = (size_t)blockIdx.x * NTH + threadIdx.x; i < (size_t)NT * 1024 / 4; i += (size_t)gridDim.x * NTH) ((f32x4*)P.out)[i] = (f32x4){cval, cval, cval, cval};
    }
}

template <int P0, int P1> static void launch_range(const Params& p, hipStream_t stream) {
    static int grid = 0;
    if (!grid) {
        int dev = 0, cus = 0, per_cu = 0;
        (void)hipGetDevice(&dev);
        (void)hipDeviceGetAttribute(&cus, hipDeviceAttributeMultiprocessorCount, dev);
        (void)(void)hipOccupancyMaxActiveBlocksPerMultiprocessor(&per_cu, mk_kernel<P0, P1>, NTH, 0);
        if (cus <= 0) cus = 256;
        if (per_cu < 1) per_cu = 1;
        grid = cus * (per_cu < 1 ? 1 : 1);
    }
    mk_kernel<P0, P1><<<dim3(grid), dim3(NTH), 0, stream>>>(p);
}

extern "C" void kernel_launch(void* const* d_in, const int* in_sizes, int n_in, void* d_out, int out_size, void* d_ws, size_t ws_size, hipStream_t stream) {
    if (ws_size < WS_NEED) return;
    if (ws_size < WS_NEED) return;
    Params p{};
    const float** f = (const float**)&p;
    for (int i = 0; i < 26; ++i) f[i] = (const float*)d_in[i];
    p.out = (float*)d_out;
    p.ws = (char*)d_ws;
    (void)hipMemsetAsync(d_ws, 0, ZERO_BYTES, stream);
#if MK_ONE_LAUNCH
    launch_range<0, NPHASE>(p, stream);
#else
    launch_range<0, 1>(p, stream); launch_range<1, 2>(p, stream); launch_range<2, 3>(p, stream); launch_range<3, 4>(p, stream);
    launch_range<4, 5>(p, stream); launch_range<5, 6>(p, stream); launch_range<6, 7>(p, stream); launch_range<7, 8>(p, stream);
    launch_range<8, 9>(p, stream); launch_range<9, 10>(p, stream); launch_range<10, 11>(p, stream); launch_range<11, 12>(p, stream);
    launch_range<12, 13>(p, stream); launch_range<13, 14>(p, stream); launch_range<14, 15>(p, stream); launch_range<15, 16>(p, stream);
    launch_range<16, 17>(p, stream); launch_range<17, 18>(p, stream);
#endif
}
```

```cpp
#include <hip/hip_runtime.h>
#include <stdint.h>

#define DI __device__ __forceinline__
#define LAS __attribute__((address_space(3)))
typedef unsigned short bf16_t;
typedef short bf16x8 __attribute__((ext_vector_type(8)));
typedef short s16x4 __attribute__((ext_vector_type(4)));
typedef float f32x16 __attribute__((ext_vector_type(16)));
typedef float f32x4 __attribute__((ext_vector_type(4)));
typedef float f32x2 __attribute__((ext_vector_type(2)));
typedef __bf16 bf16v2 __attribute__((ext_vector_type(2)));
typedef unsigned u32x4 __attribute__((ext_vector_type(4)));
typedef unsigned u32x2 __attribute__((ext_vector_type(2)));
typedef unsigned long long u64;
#define MFMA32(a, b, c) __builtin_amdgcn_mfma_f32_32x32x16_bf16((a), (b), (c), 0, 0, 0)

constexpr int NB = 8, NS = 8192, ND = 1024, NT = NB * NS;
constexpr int IN_COLS = 3656, NPAD = 3840;
constexpr int NTH = 512, NW = 8;
constexpr int NEXP = 256, NEXP1 = 257;
constexpr int NCHUNK = 4, CHUNK_T = NT / NCHUNK;
constexpr int NPAIR = 9;
constexpr float EPSF = 1e-6f;
constexpr float LOG2E = 1.4426950408889634f;

constexpr size_t MiB = 1048576;
constexpr size_t OFF_BAR = 0;
constexpr size_t OFF_MOD = 16384;
constexpr size_t OFF_CNT = OFF_MOD + 196608;
constexpr size_t OFF_ERR = OFF_CNT + 8192;
constexpr size_t OFF_Q = OFF_ERR;
constexpr size_t OFF_XRANK = OFF_ERR + 128;
constexpr size_t OFF_XQ = OFF_ERR + 256;
constexpr size_t OFF_ITEMS = OFF_ERR + 1024;
constexpr size_t OFF_ZROW = 245760;
constexpr size_t ZERO_BYTES = 262144;
constexpr size_t OFF_WIN = 1 * MiB;
constexpr size_t OFF_WOUT = OFF_WIN + (size_t)NPAD * 1024 * 2;
constexpr size_t OFF_WRT = OFF_WOUT + 2 * MiB;
constexpr size_t OFF_WGU = 12 * MiB;
constexpr size_t OFF_WD = OFF_WGU + (size_t)NEXP1 * 512 * 1024 * 2;
constexpr size_t OFF_R1 = OFF_WD + (size_t)NEXP1 * 1024 * 256 * 2;
constexpr size_t OFF_H = OFF_R1;
constexpr size_t OFF_QD = OFF_H + 128 * MiB;
constexpr size_t OFF_KD = OFF_QD + 64 * MiB;
constexpr size_t OFF_VDT = OFF_KD + 64 * MiB;
constexpr size_t OFF_QS = OFF_VDT + 64 * MiB;
constexpr size_t OFF_KS = OFF_QS + 64 * MiB;
constexpr size_t OFF_VST = OFF_KS + 64 * MiB;
constexpr size_t OFF_IQ = OFF_VST + 64 * MiB;
constexpr size_t OFF_IK = OFF_IQ + 64 * MiB;
constexpr size_t OFF_IW = OFF_IK + 8 * MiB;
constexpr size_t OFF_MASK = OFF_IW + 2 * MiB;
constexpr size_t END_A = OFF_MASK + 64 * MiB;
constexpr size_t OFF_H2 = OFF_R1;
constexpr size_t OFF_LIST = OFF_H2 + 128 * MiB;
constexpr size_t OFF_EIDX = OFF_LIST + (size_t)NCHUNK * NEXP1 * CHUNK_T * 4;
constexpr size_t OFF_GATE = OFF_EIDX + 2 * MiB;
constexpr size_t OFF_ACT = OFF_GATE + 2 * MiB;
constexpr size_t ACT_BYTES = (size_t)CHUNK_T * NPAIR * 256 * 2;
constexpr size_t OFF_Y = OFF_ACT + 2 * ACT_BYTES;
constexpr size_t END_B = OFF_Y + (size_t)CHUNK_T * NPAIR * 1024 * 2;
constexpr size_t WS_NEED = END_A > END_B ? END_A : END_B;

struct Params {
    const float *x, *c, *ada_w, *ada_b, *norm1_g, *norm2_g, *w_in, *dq_g, *dk_g, *lq1, *lk1, *lq2, *lk2, *subln_g, *sq_g, *sk_g, *ik_g,
        *w_out, *router_w, *router_b, *ew_gate, *ew_up, *ew_down, *sw_gate, *sw_up, *sw_down;
    float* out;
    char* ws;
};

DI unsigned pk2(float a, float b) { f32x2 f = {a, b}; bf16v2 r = __builtin_convertvector(f, bf16v2); return __builtin_bit_cast(unsigned, r); }
DI float bf2f(bf16_t v) { return __uint_as_float(((unsigned)v) << 16); }
DI float bflo(unsigned u) { return __uint_as_float(u << 16); }
DI float bfhi(unsigned u) { return __uint_as_float(u & 0xffff0000u); }
DI int crow(int i, int hf) { return (i & 3) + 8 * (i >> 2) + 4 * hf; }
constexpr int LROW = 144;
DI int lofs(int row, int chunk) { return row * LROW + chunk * 16; }
DI float wave_sum(float v) {
#pragma unroll
    for (int d = 32; d >= 1; d >>= 1) v += __shfl_xor(v, d);
    return v;
}
DI float silu_f(float v) { return v / (1.f + __expf(-v)); }

#define XB_TMO      128
#define XB_XCNT(j)  (256  + 64 * (j))
#define XB_XSUB(j)  (1280 + 64 * (j))
#define XB_XGEN(j)  (2304 + 64 * (j))
#define XB_TOP      3328
#define XB_TOPGEN   3392
#define XCD_BAR_WORDS 3456
#define XB_SPIN_CAP (1u << 18)

__device__ __forceinline__ unsigned xb_ld(unsigned* p)              { return __hip_atomic_load(p, __ATOMIC_RELAXED, __HIP_MEMORY_SCOPE_AGENT); }
__device__ __forceinline__ unsigned xb_add(unsigned* p, unsigned v) { return __hip_atomic_fetch_add(p, v, __ATOMIC_RELAXED, __HIP_MEMORY_SCOPE_AGENT); }
__device__ __forceinline__ unsigned xb_xcc_id() { return (unsigned)__builtin_amdgcn_s_getreg((3 << 11) | 20) & 0xFu; }
#define XB_SPIN(cond, bar) do { unsigned _sp = 0; while (cond) { __builtin_amdgcn_s_sleep(1); \
    if ((++_sp & 255u) == 0u) { if (xb_ld(&(bar)[XB_TMO])) break; if (_sp > XB_SPIN_CAP) { atomicAdd(&(bar)[XB_TMO], 1u); break; } } } } while (0)

struct XcdBarrier {
    unsigned* bar; unsigned x;
    volatile LAS unsigned* st;
};
__device__ __forceinline__ XcdBarrier xcd_barrier_post(unsigned* bar, volatile LAS unsigned* st) {
    XcdBarrier b; b.bar = bar; b.x = xb_xcc_id(); b.st = st;
    if (threadIdx.x == 0) (void)xb_add(&bar[XB_XCNT(b.x)], 1u);
    return b;
}
__device__ __forceinline__ void xcd_barrier_complete(unsigned* bar, unsigned x, unsigned& nloc, unsigned& nx) {
    const unsigned G = gridDim.x * gridDim.y * gridDim.z;
    unsigned sum, cnt, mine, sp = 0u;
    for (;;) {
        sum = 0u; cnt = 0u; mine = 0u;
#pragma unroll
        for (unsigned j = 0; j < 16; ++j) { const unsigned c = xb_ld(&bar[XB_XCNT(j)]); sum += c; cnt += (c > 0u) ? 1u : 0u; mine = (j == x) ? c : mine; }
        if (sum == G) break;
        __builtin_amdgcn_s_sleep(1);
        if ((++sp & 255u) == 0u) { if (xb_ld(&bar[XB_TMO])) break; if (sp > XB_SPIN_CAP) { atomicAdd(&bar[XB_TMO], 1u); break; } }
    }
    nloc = mine > 0u ? mine : 1u; nx = cnt > 0u ? cnt : 1u;
}
__device__ __forceinline__ void xcd_barrier(const XcdBarrier& b) {
    asm volatile("s_waitcnt vmcnt(0)" ::: "memory");
    __syncthreads();
    if (threadIdx.x == 0) {
        unsigned* bar = b.bar;
        __builtin_amdgcn_s_waitcnt(0);
        unsigned nloc = b.st[0], nx = b.st[1];
        if (nloc == 0u) { xcd_barrier_complete(bar, b.x, nloc, nx); b.st[0] = nloc; b.st[1] = nx; }
        const unsigned old = xb_add(&bar[XB_XSUB(b.x)], 1u);
        const unsigned gen = old / nloc;
        if (old + 1u == (gen + 1u) * nloc) {
            __builtin_amdgcn_fence(__ATOMIC_RELEASE, "agent");
            asm volatile("s_waitcnt vmcnt(0)" ::: "memory");
            const unsigned og = xb_add(&bar[XB_TOP], 1u);
            const unsigned tg = og / nx;
            if (og + 1u == (tg + 1u) * nx) xb_add(&bar[XB_TOPGEN], 1u);
            else XB_SPIN(xb_ld(&bar[XB_TOPGEN]) == tg, bar);
            __builtin_amdgcn_fence(__ATOMIC_ACQUIRE, "agent");
            xb_add(&bar[XB_XGEN(b.x)], 1u);
            asm volatile("s_waitcnt vmcnt(0)" ::: "memory");
        } else {
            XB_SPIN(xb_ld(&bar[XB_XGEN(b.x)]) == gen, bar);
            __builtin_amdgcn_fence(__ATOMIC_ACQUIRE, "agent");
            asm volatile("s_waitcnt vmcnt(0)" ::: "memory");
        }
    }
    __syncthreads();
}

struct XPart { int start, step, end, grp, ngrp; };
constexpr int XC_LDS = 148480 + 3584;
DI XPart xcd_part(const char* ws, const char* smem, int N) {
    const int x = ((const int*)(smem + XC_LDS))[0], r = ((const int*)(smem + XC_LDS))[1];
    const int* xc = (const int*)(ws + OFF_XRANK);
    int pre = 0, mine = 1, G = 0, grp = 0, ngrp = 0;
#pragma unroll
    for (int j = 0; j < 16; ++j) { const int c = xc[j]; if (j < x) { pre += c; grp += c > 0; } if (j == x) mine = c; G += c; ngrp += c > 0; }
    if (mine < 1) mine = 1; if (G < 1) G = 1;
    const long lo = (long)N * pre / G, hi = (long)N * (pre + mine) / G;
    XPart p; p.start = (int)lo + r; p.step = mine; p.end = (int)hi; p.grp = grp; p.ngrp = ngrp; return p;
}

constexpr int GT_B = 256 * LROW;
constexpr int GT_STAGE = 2 * 256 * LROW;
constexpr int SM_EXTRA = 148480;
constexpr int SM_BASE = SM_EXTRA + 4096;
constexpr int SMEM_BYTES = SM_BASE + 1056;
#define MK_ONE_LAUNCH 1


constexpr int ATT_ITEMS = 4096;
DI int attn_item_cost(int type, int h, int qb) {
    if (type == 0) { const int win = h == 0 ? 2 : h == 1 ? 7 : h == 2 ? 28 : 109; const int tiles = min(2 * qb + 2, win + 2); return (tiles * 6) / 4; }
    const int win = h == 0 ? 1 : h == 1 ? 2 : h == 2 ? 4 : h == 3 ? 7 : h == 4 ? 14 : h == 5 ? 28 : h == 6 ? 55 : 109;
    const int tiles = min(4 * qb + 4, win + 4); return (tiles * 5) / 4;
}
DI int attn_item_code(int i) {
    if (i < 2048) { const int qb = i & 63, h = (i >> 6) & 3, b = i >> 8; return (b << 16) | (h << 8) | qb; }
    const int j = i - 2048; const int qb = j & 31, h = (j >> 5) & 7, b = j >> 8; return (1 << 20) | (b << 16) | (h << 8) | qb;
}
DI void build_attn_items(const Params& P, char* smem) {
    int* hist = (int*)smem;
    int* wsum = hist + 256;
    int* items = (int*)(P.ws + OFF_ITEMS);
    const int tid = threadIdx.x, lane = tid & 63, w = tid >> 6;
    __syncthreads();
    if (tid < 256) hist[tid] = 0;
    __syncthreads();
    for (int i = tid; i < ATT_ITEMS; i += NTH) { const int c = attn_item_code(i); atomicAdd(&hist[255 - min(255, attn_item_cost(c >> 20, (c >> 8) & 255, c & 255))], 1); }
    __syncthreads();
    int n = 0, inc = 0;
    if (tid < 256) {
        n = hist[tid]; inc = n;
#pragma unroll
        for (int d = 1; d < 64; d <<= 1) { const int t = __shfl_up(inc, d); if (lane >= d) inc += t; }
        if (lane == 63) wsum[w] = inc;
    }
    __syncthreads();
    if (tid < 256) {
        int off = 0;
#pragma unroll
        for (int i = 0; i < 4; ++i) if (i < w) off += wsum[i];
        hist[tid] = off + inc - n;
    }
    __syncthreads();
    for (int i = tid; i < ATT_ITEMS; i += NTH) {
        const int c = attn_item_code(i);
        const int pos = atomicAdd(&hist[255 - min(255, attn_item_cost(c >> 20, (c >> 8) & 255, c & 255))], 1);
        items[pos] = c;
    }
    __syncthreads();
}

DI void phase_adaln(const Params& P, char* smem) {
    float* mod = (float*)(P.ws + OFF_MOD);
    float* sc = (float*)smem;
    float* red = sc + 8192;
    const int tid = threadIdx.x;
    if (blockIdx.x == 0) build_attn_items(P, smem);
    __syncthreads();
    for (int i = tid; i < 8192; i += NTH) sc[i] = silu_f(P.c[i]);
    __syncthreads();
    const int kg = tid >> 4, cn = tid & 15;
    for (int it = blockIdx.x; it < 384; it += gridDim.x) {
        const int n = it * 16 + cn;
        float acc[8];
#pragma unroll
        for (int b = 0; b < 8; ++b) acc[b] = 0.f;
#pragma unroll 8
        for (int kk = 0; kk < 32; ++kk) {
            const int k = kg * 32 + kk;
            const float w = P.ada_w[(size_t)k * 6144 + n];
#pragma unroll
            for (int b = 0; b < 8; ++b) acc[b] += sc[b * 1024 + k] * w;
        }
#pragma unroll
        for (int b = 0; b < 8; ++b) red[(kg * 8 + b) * 16 + cn] = acc[b];
        __syncthreads();
        if (tid < 128) {
            const int b = tid >> 4;
            float s = P.ada_b[n];
#pragma unroll
            for (int g = 0; g < 32; ++g) s += red[(g * 8 + b) * 16 + cn];
            mod[b * 6144 + n] = s;
        }
        __syncthreads();
    }
}

DI void phase_norm(const float* __restrict__ xin, const float* __restrict__ g, const float* __restrict__ mod, int sh_off, int sc_off, bf16_t* __restrict__ dst) {
    const int lane = threadIdx.x & 63, w = threadIdx.x >> 6;
    for (int row = blockIdx.x * NW + w; row < NT; row += gridDim.x * NW) {
        const int b = row >> 13;
        const float* xr = xin + (size_t)row * 1024;
        f32x4 v[4]; float ss = 0.f;
#pragma unroll
        for (int i = 0; i < 4; ++i) { v[i] = *(const f32x4*)(xr + 256 * i + 4 * lane); ss += v[i][0] * v[i][0] + v[i][1] * v[i][1] + v[i][2] * v[i][2] + v[i][3] * v[i][3]; }
        ss = wave_sum(ss);
        const float rstd = rsqrtf(ss * (1.f / 1024.f) + EPSF);
#pragma unroll
        for (int i = 0; i < 4; ++i) {
            const int col = 256 * i + 4 * lane;
            const f32x4 gg = *(const f32x4*)(g + col);
            const f32x4 sh = *(const f32x4*)(mod + b * 6144 + sh_off + col);
            const f32x4 sc = *(const f32x4*)(mod + b * 6144 + sc_off + col);
            float o[4];
#pragma unroll
            for (int j = 0; j < 4; ++j) o[j] = v[i][j] * rstd * gg[j] * (1.f + sc[j]) + sh[j];
            u32x2 pk; pk[0] = pk2(o[0], o[1]); pk[1] = pk2(o[2], o[3]);
            *(u32x2*)(dst + (size_t)row * 1024 + col) = pk;
        }
    }
}

DI int gu_row(int f, int is_up) { return (f >> 6) * 128 + (((f >> 5) & 1) * 2 + is_up) * 32 + (f & 31); }
struct CvtDesc { const float* src; bf16_t* dst; int ldsrc, nvalid, k0, n0, ldd, mode; };
constexpr int CVT_WIN = 16 * (NPAD / 64);
constexpr int CVT_SMALL = CVT_WIN + 256 + 64;
constexpr int CVT_ITEMS = CVT_SMALL + NEXP1 * 192;
DI CvtDesc cvt_desc(const Params& P, int it) {
    CvtDesc d;
    if (it < CVT_WIN) { d.src = P.w_in; d.ldsrc = IN_COLS; d.nvalid = IN_COLS; d.k0 = (it & 15) * 64; d.n0 = (it >> 4) * 64; d.dst = (bf16_t*)(P.ws + OFF_WIN); d.ldd = 1024; d.mode = 0; }
    else if (it < CVT_WIN + 256) { const int r = it - CVT_WIN; d.src = P.w_out; d.ldsrc = 1024; d.nvalid = 1024; d.k0 = (r & 15) * 64; d.n0 = (r >> 4) * 64; d.dst = (bf16_t*)(P.ws + OFF_WOUT); d.ldd = 1024; d.mode = 0; }
    else if (it < CVT_SMALL) { const int r = it - CVT_WIN - 256; d.src = P.router_w; d.ldsrc = 256; d.nvalid = 256; d.k0 = (r & 15) * 64; d.n0 = (r >> 4) * 64; d.dst = (bf16_t*)(P.ws + OFF_WRT); d.ldd = 1024; d.mode = 0; }
    else {
        const int r = it - CVT_SMALL, e = r / 192, sub = r % 192;
        if (sub < 128) {
            const int up = sub >> 6, s2 = sub & 63;
            d.src = e < NEXP ? (up ? P.ew_up : P.ew_gate) + (size_t)e * 1024 * 256 : (up ? P.sw_up : P.sw_gate);
            d.ldsrc = 256; d.nvalid = 256; d.k0 = (s2 & 15) * 64; d.n0 = (s2 >> 4) * 64; d.dst = (bf16_t*)(P.ws + OFF_WGU) + (size_t)e * 512 * 1024; d.ldd = 1024; d.mode = 1 + up;
        } else {
            const int s2 = sub - 128;
            d.src = e < NEXP ? P.ew_down + (size_t)e * 256 * 1024 : P.sw_down;
            d.ldsrc = 1024; d.nvalid = 1024; d.k0 = (s2 & 3) * 64; d.n0 = (s2 >> 2) * 64; d.dst = (bf16_t*)(P.ws + OFF_WD) + (size_t)e * 1024 * 256; d.ldd = 256; d.mode = 0;
        }
    }
    return d;
}
DI void phase_convert(const Params& P, char* smem) {
    float* t = (float*)smem;
    const int tid = threadIdx.x, G = gridDim.x;
    for (int it0 = blockIdx.x; it0 < CVT_ITEMS; it0 += 4 * G) {
        float v[4][8];
#pragma unroll
        for (int r = 0; r < 4; ++r) {
            const int it = it0 + r * G;
            if (it < CVT_ITEMS) {
                const CvtDesc d = cvt_desc(P, it);
#pragma unroll
                for (int i = 0; i < 8; ++i) {
                    const int idx = tid + NTH * i, kk = idx >> 6, nn = idx & 63;
                    v[r][i] = (d.n0 + nn < d.nvalid) ? d.src[(size_t)(d.k0 + kk) * d.ldsrc + d.n0 + nn] : 0.f;
                }
            } else {
#pragma unroll
                for (int i = 0; i < 8; ++i) v[r][i] = 0.f;
            }
        }
        __syncthreads();
#pragma unroll
        for (int r = 0; r < 4; ++r)
#pragma unroll
            for (int i = 0; i < 8; ++i) { const int idx = tid + NTH * i; t[r * 4160 + (idx >> 6) * 65 + (idx & 63)] = v[r][i]; }
        __syncthreads();
        const int nn = tid >> 3, kq = (tid & 7) * 8;
#pragma unroll
        for (int r = 0; r < 4; ++r) {
            const int it = it0 + r * G;
            if (it < CVT_ITEMS) {
                const CvtDesc d = cvt_desc(P, it);
                unsigned pk[4];
#pragma unroll
                for (int j = 0; j < 4; ++j) pk[j] = pk2(t[r * 4160 + (kq + 2 * j) * 65 + nn], t[r * 4160 + (kq + 2 * j + 1) * 65 + nn]);
                const int n = d.n0 + nn;
                const int drow = d.mode == 0 ? n : gu_row(n, d.mode - 1);
                *(u32x4*)(d.dst + (size_t)drow * d.ldd + d.k0 + kq) = (u32x4){pk[0], pk[1], pk[2], pk[3]};
            }
        }
    }
}

template <int BM> struct GemmGeo { static constexpr int NI = BM == 256 ? 4 : 2, WN = BM == 256 ? 2 : 4, AP = BM / 64; };
template <bool SWAP, int BM, class AFn, class Epi>
DI void gemm_stream(char* lds, AFn arow, const bf16_t* __restrict__ Bt, int ldb, int nksh, int nsub, Epi epi) {
    constexpr int NI = GemmGeo<BM>::NI, WN = GemmGeo<BM>::WN, AP = GemmGeo<BM>::AP;
    const int tid = threadIdx.x, lane = tid & 63, w = tid >> 6, wm = w / WN, wn = w % WN, l31 = lane & 31, hf = lane >> 5;
    const int nk = 1 << nksh, total = nsub << nksh;
    const int lrow = tid >> 3, lch = tid & 7;
    const bf16_t* ap[AP];
#pragma unroll
    for (int i = 0; i < AP; ++i) { const bf16_t* a = arow(lrow + 64 * i); ap[i] = a ? a + lch * 8 : nullptr; }
    const int so = lofs(lrow, lch);
    const bf16_t* bp = Bt + (size_t)lrow * ldb + lch * 8;
    const size_t bsub = (size_t)256 * ldb, brow64 = (size_t)64 * ldb;
    f32x16 acc[2][NI];
#pragma unroll
    for (int mi = 0; mi < 2; ++mi)
#pragma unroll
        for (int ni = 0; ni < NI; ++ni)
#pragma unroll
            for (int i = 0; i < 16; ++i) acc[mi][ni][i] = 0.f;
    u32x4 ra[AP], rb[4];
    const u32x4 z4 = {0u, 0u, 0u, 0u};
    auto load_part = [&](int s, int part) {
        const int t = s >> nksh, k0 = (s & (nk - 1)) * 64;
        const bf16_t* b0 = bp + t * bsub + k0;
        if (AP == 4) {
            if (part < 2) {
#pragma unroll
                for (int i = 0; i < 2; ++i) { const int q = 2 * part + i; ra[q] = ap[q] ? *(const u32x4*)(ap[q] + k0) : z4; }
            } else {
#pragma unroll
                for (int i = 0; i < 2; ++i) { const int q = 2 * (part - 2) + i; rb[q] = *(const u32x4*)(b0 + q * brow64); }
            }
        } else {
            if (part == 0) {
#pragma unroll
                for (int i = 0; i < AP; ++i) ra[i] = ap[i] ? *(const u32x4*)(ap[i] + k0) : z4;
            } else if (part < 3) {
#pragma unroll
                for (int i = 0; i < 2; ++i) { const int q = 2 * (part - 1) + i; rb[q] = *(const u32x4*)(b0 + q * brow64); }
            }
        }
    };
    auto store = [&](char* stg) {
#pragma unroll
        for (int i = 0; i < AP; ++i) *(u32x4*)(stg + so + i * 64 * LROW) = ra[i];
#pragma unroll
        for (int i = 0; i < 4; ++i) *(u32x4*)(stg + GT_B + so + i * 64 * LROW) = rb[i];
    };
    auto compute = [&](const char* cur, int snext) {
        const char* abase = cur + (64 * wm + l31) * LROW + hf * 16;
        const char* bbase = cur + GT_B + (32 * NI * wn + l31) * LROW + hf * 16;
#pragma unroll
        for (int ks = 0; ks < 4; ++ks) {
            bf16x8 af[2];
#pragma unroll
            for (int mi = 0; mi < 2; ++mi) af[mi] = *(const bf16x8*)(abase + mi * 32 * LROW + ks * 32);
#pragma unroll
            for (int nh = 0; nh < NI / 2; ++nh) {
                bf16x8 bfr[2];
#pragma unroll
                for (int n2 = 0; n2 < 2; ++n2) bfr[n2] = *(const bf16x8*)(bbase + (2 * nh + n2) * 32 * LROW + ks * 32);
#pragma unroll
                for (int mi = 0; mi < 2; ++mi)
#pragma unroll
                    for (int n2 = 0; n2 < 2; ++n2)
                        acc[mi][2 * nh + n2] = SWAP ? MFMA32(bfr[n2], af[mi], acc[mi][2 * nh + n2]) : MFMA32(af[mi], bfr[n2], acc[mi][2 * nh + n2]);
                if (NI == 4 && nh == 0) __builtin_amdgcn_sched_barrier(0);
            }
            __builtin_amdgcn_sched_barrier(0);
            load_part(snext, ks);
            __builtin_amdgcn_sched_barrier(0);
        }
    };
#pragma unroll
    for (int part = 0; part < 4; ++part) load_part(0, part);
    __syncthreads();
    store(lds);
    __syncthreads();
    for (int s = 0; s < total; ++s) {
        char* cur = lds + (s & 1) * GT_STAGE;
        char* nxt = lds + ((s & 1) ^ 1) * GT_STAGE;
        compute(cur, min(s + 1, total - 1));
        if ((s & (nk - 1)) == nk - 1) {
            epi(s >> nksh, acc);
#pragma unroll
            for (int mi = 0; mi < 2; ++mi)
#pragma unroll
                for (int ni = 0; ni < NI; ++ni)
#pragma unroll
                    for (int i = 0; i < 16; ++i) acc[mi][ni][i] = 0.f;
        }
        store(nxt);
        __syncthreads();
    }
}

constexpr int EP_SCR = 131072, EP_WAVE = 16 * 136;
static_assert(EP_SCR + 8 * EP_WAVE <= SM_EXTRA, "LDS layout");
DI int opaque_tid() { int t = threadIdx.x; asm volatile("" : "+v"(t)); return t; }
template <bool PERM16 = false, class XF, class RowPtrFn>
DI void stage_store_chunk(char* smem, const f32x16& a0, const f32x16& a1, XF xf, RowPtrFn rowptr) {
    const int otid = opaque_tid(), lane = otid & 63, w = otid >> 6, l31 = lane & 31, hf = lane >> 5;
    LAS char* scr = (LAS char*)smem + EP_SCR + w * EP_WAVE;
    u32x2 pk[2][4];
#pragma unroll
    for (int n2 = 0; n2 < 2; ++n2)
#pragma unroll
        for (int q4 = 0; q4 < 4; ++q4) {
            const f32x16& a = n2 ? a1 : a0;
            pk[n2][q4][0] = pk2(xf(n2, 4 * q4, a[4 * q4]), xf(n2, 4 * q4 + 1, a[4 * q4 + 1])); pk[n2][q4][1] = pk2(xf(n2, 4 * q4 + 2, a[4 * q4 + 2]), xf(n2, 4 * q4 + 3, a[4 * q4 + 3]));
        }
    const int rr = lane >> 4, c = lane & 15;
    u32x2 d[2][4];
#pragma unroll
    for (int ps = 0; ps < 2; ++ps) {
        if ((l31 >> 4) == ps) {
#pragma unroll
            for (int n2 = 0; n2 < 2; ++n2)
#pragma unroll
                for (int q4 = 0; q4 < 4; ++q4) {
                    const int col = PERM16 ? 32 * n2 + 16 * (q4 >> 1) + 8 * hf + 4 * (q4 & 1) : 32 * n2 + 8 * q4 + 4 * hf;
                    *(LAS u32x2*)(scr + (l31 & 15) * 136 + col * 2) = pk[n2][q4];
                }
        }
        asm volatile("" ::: "memory");
#pragma unroll
        for (int i = 0; i < 4; ++i) d[ps][i] = *(const LAS u32x2*)(scr + (rr + 4 * i) * 136 + c * 8);
        asm volatile("" ::: "memory");
    }
    asm volatile("s_waitcnt lgkmcnt(0)" : "+v"(d[0][0]), "+v"(d[0][1]), "+v"(d[0][2]), "+v"(d[0][3]), "+v"(d[1][0]), "+v"(d[1][1]), "+v"(d[1][2]), "+v"(d[1][3]) :: "memory");
#pragma unroll
    for (int ps = 0; ps < 2; ++ps)
#pragma unroll
        for (int i = 0; i < 4; ++i) {
            bf16_t* g = rowptr(16 * ps + rr + 4 * i);
            if (g) *(u32x2*)(g + c * 4) = d[ps][i];
        }
}

template <bool SWAP, int BM, int NSTORE = 0, class AFn, class Epi>
DI void gemm_dma(char* lds_generic, AFn arow, const bf16_t* __restrict__ Bt, int ldb, int nksh, int nsub, const bf16_t* zrow, Epi epi) {
    constexpr int NI = GemmGeo<BM>::NI, WN = GemmGeo<BM>::WN, NA = BM / 64;
    constexpr int STG = (BM + 256) * 128, BOFF = BM * 128;
    LAS char* lds = (LAS char*)lds_generic;
    const int tid = opaque_tid(), lane = tid & 63, w = tid >> 6, wm = w / WN, wn = w % WN, l31 = lane & 31, hf = lane >> 5;
    const int nh = 1 << nksh, total = nsub * nh;
    typedef const __attribute__((address_space(1))) char* gcp_t;
    const char* wsg = (const char*)zrow - OFF_ZROW;
    auto uni = [](const char* p) { const unsigned long long v = (unsigned long long)p; const unsigned lo = __builtin_amdgcn_readfirstlane((unsigned)v), hi = __builtin_amdgcn_readfirstlane((unsigned)(v >> 32)); return (gcp_t)(((unsigned long long)hi << 32) | lo); };
    const gcp_t wsu = uni(wsg), btu = uni((const char*)Bt);
    unsigned aoff[NA], boff[4];
    const int csw = ((lane & 7) ^ ((4 * (w & 1) + (lane >> 4)) & 7)) * 16;
#pragma unroll
    for (int i = 0; i < NA; ++i) {
        const int row = 8 * (w + 8 * i) + (lane >> 3);
        const bf16_t* a = arow(row);
        aoff[i] = (unsigned)((const char*)(a ? a : zrow) - wsg) + csw;
    }
#pragma unroll
    for (int i = 0; i < 4; ++i) {
        const int row = 8 * (w + 8 * i) + (lane >> 3);
        boff[i] = (unsigned)(row * ldb * 2 + csw);
    }
    const size_t bsub = (size_t)256 * ldb;
    auto dma_a = [&](int k0, LAS char* stg) {
        gcp_t ab = wsu + k0 * 2; asm volatile("" : "+s"(ab));
#pragma unroll
        for (int i = 0; i < NA; ++i) {
            unsigned ao = aoff[i]; asm volatile("" : "+v"(ao));
            __builtin_amdgcn_global_load_lds((const __attribute__((address_space(1))) unsigned*)(ab + ao), (LAS unsigned*)(stg + (w + 8 * i) * 1024), 16, 0, 0);
        }
    };
    auto dma_b = [&](int t, int k0, LAS char* stg) {
        gcp_t bb = btu + (t * bsub + k0) * 2; asm volatile("" : "+s"(bb));
#pragma unroll
        for (int i = 0; i < 4; ++i) {
            unsigned bo = boff[i]; asm volatile("" : "+v"(bo));
            __builtin_amdgcn_global_load_lds((const __attribute__((address_space(1))) unsigned*)(bb + bo), (LAS unsigned*)(stg + BOFF + (w + 8 * i) * 1024), 16, 0, 0);
        }
    };
    auto dma = [&](int hs, int stage) {
        const int t = hs >> nksh, k0 = (hs - (t << nksh)) * 64;
        LAS char* stg = lds + stage * STG;
        dma_a(k0, stg); dma_b(t, k0, stg);
    };
    unsigned o[4];
#pragma unroll
    for (int ks = 0; ks < 4; ++ks) o[ks] = l31 * 128 + (((2 * ks + hf) ^ ((l31 >> 1) & 7)) << 4);
    f32x16 acc[2][NI];
#pragma unroll
    for (int mi = 0; mi < 2; ++mi)
#pragma unroll
        for (int ni = 0; ni < NI; ++ni)
#pragma unroll
            for (int i = 0; i < 16; ++i) acc[mi][ni][i] = 0.f;
    asm volatile("s_waitcnt vmcnt(0) lgkmcnt(0)" ::: "memory");
    __builtin_amdgcn_s_barrier();
    dma(0, 0); dma(1, 1);
    if constexpr (BM == 256) asm volatile("s_waitcnt vmcnt(8)" ::: "memory"); else asm volatile("s_waitcnt vmcnt(6)" ::: "memory");
    __builtin_amdgcn_s_barrier();
    constexpr int NF = 2 + NI;
    const unsigned aofs = (64 * wm) * 128, bofs = (32 * NI * wn) * 128;
    auto rd = [&](bf16x8 (&a)[2], bf16x8 (&b)[NI], unsigned sbase, unsigned ok) {
        const unsigned pa = sbase + aofs + ok, pb = sbase + bofs + ok;
        asm volatile("ds_read_b128 %0, %1" : "=v"(a[0]) : "v"(pa));
        asm volatile("ds_read_b128 %0, %1 offset:4096" : "=v"(a[1]) : "v"(pa));
        asm volatile("ds_read_b128 %0, %1 offset:%2" : "=v"(b[0]) : "v"(pb), "n"(BOFF));
        asm volatile("ds_read_b128 %0, %1 offset:%2" : "=v"(b[1]) : "v"(pb), "n"(BOFF + 4096));
        if constexpr (NI == 4) {
            asm volatile("ds_read_b128 %0, %1 offset:%2" : "=v"(b[2]) : "v"(pb), "n"(BOFF + 8192));
            asm volatile("ds_read_b128 %0, %1 offset:%2" : "=v"(b[3]) : "v"(pb), "n"(BOFF + 12288));
        }
    };
    auto release = [&](bf16x8 (&a)[2], bf16x8 (&b)[NI], bool all) {
        if constexpr (NI == 4) {
            if (all) asm volatile("s_waitcnt lgkmcnt(0)" : "+v"(a[0]), "+v"(a[1]), "+v"(b[0]), "+v"(b[1]), "+v"(b[2]), "+v"(b[3]) :: "memory");
            else asm volatile("s_waitcnt lgkmcnt(6)" : "+v"(a[0]), "+v"(a[1]), "+v"(b[0]), "+v"(b[1]), "+v"(b[2]), "+v"(b[3]) :: "memory");
        } else {
            if (all) asm volatile("s_waitcnt lgkmcnt(0)" : "+v"(a[0]), "+v"(a[1]), "+v"(b[0]), "+v"(b[1]) :: "memory");
            else asm volatile("s_waitcnt lgkmcnt(4)" : "+v"(a[0]), "+v"(a[1]), "+v"(b[0]), "+v"(b[1]) :: "memory");
        }
    };
    auto mma = [&](const bf16x8 (&a)[2], const bf16x8 (&b)[NI]) {
        __builtin_amdgcn_sched_barrier(0);
#pragma unroll
        for (int mi = 0; mi < 2; ++mi)
#pragma unroll
            for (int ni = 0; ni < NI; ++ni)
                acc[mi][ni] = SWAP ? MFMA32(b[ni], a[mi], acc[mi][ni]) : MFMA32(a[mi], b[ni], acc[mi][ni]);
        __builtin_amdgcn_sched_barrier(0);
    };
    const unsigned lds0 = (unsigned)(size_t)lds;
    bf16x8 fa0[2], fb0[NI], fa1[2], fb1[NI];
    rd(fa0, fb0, lds0, o[0]);
    int st = 0;
    bool st_pend = false;
    for (int hs = 0; hs < total; ++hs) {
        const int hs_n = min(hs + 2, total - 1);
        const int t_n = hs_n >> nksh, k0_n = (hs_n - (t_n << nksh)) * 64;
        LAS char* stg = lds + st * STG;
        const unsigned sb = lds0 + st * STG, sbn = lds0 + (st ^ 1) * STG;
        rd(fa1, fb1, sb, o[1]); release(fa0, fb0, false); mma(fa0, fb0);
        rd(fa0, fb0, sb, o[2]); release(fa1, fb1, false); mma(fa1, fb1);
        rd(fa1, fb1, sb, o[3]); release(fa0, fb0, false); mma(fa0, fb0);
        if (NSTORE > 0 && st_pend) asm volatile("s_waitcnt vmcnt(%0)" :: "n"(NSTORE) : "memory"); else asm volatile("s_waitcnt vmcnt(0)" ::: "memory");
        st_pend = false;
        release(fa1, fb1, true);
        __builtin_amdgcn_s_barrier();
        dma_a(k0_n, stg);
        const bool last = ((hs + 1) & (nh - 1)) == 0;
        if (!last) rd(fa0, fb0, sbn, o[0]);
        mma(fa1, fb1);
        dma_b(t_n, k0_n, stg);
        __builtin_amdgcn_sched_barrier(0);
        if (last) {
            epi(hs >> nksh, acc);
#ifdef XP_DUPEPI
            asm volatile("" ::: "memory"); epi(hs >> nksh, acc);
#endif
#pragma unroll
            for (int mi = 0; mi < 2; ++mi)
#pragma unroll
                for (int ni = 0; ni < NI; ++ni)
#pragma unroll
                    for (int i = 0; i < 16; ++i) acc[mi][ni][i] = 0.f;
            rd(fa0, fb0, sbn, o[0]);
            st_pend = true;
        }
        st ^= 1;
    }
    release(fa0, fb0, true);
    asm volatile("s_waitcnt vmcnt(0) lgkmcnt(0)" ::: "memory");
    __builtin_amdgcn_s_barrier();
}

struct DenseRows { static constexpr bool kDense = true; const bf16_t* base; int ld; DI const bf16_t* operator()(int r) const { return base + (size_t)r * ld; } };

DI void epi_rows_bf16(char* smem, const f32x16 (&acc)[2][4], int row0, bf16_t* __restrict__ dst, int ldo, int cb, const float* gain, bool do_norm) {
    const int otid = opaque_tid(), lane = otid & 63, w = otid >> 6, wm = w >> 1, wn = w & 1, hf = lane >> 5;
#pragma unroll
    for (int mi = 0; mi < 2; ++mi)
#pragma unroll
        for (int pr = 0; pr < 2; ++pr) {
            float rstd = 1.f;
            if (do_norm) {
                float ss = 0.f;
#pragma unroll
                for (int n2 = 0; n2 < 2; ++n2)
#pragma unroll
                    for (int i = 0; i < 16; ++i) ss += acc[mi][2 * pr + n2][i] * acc[mi][2 * pr + n2][i];
                ss += __shfl_xor(ss, 32);
                rstd = rsqrtf(ss * (1.f / 64.f) + EPSF);
            }
            bf16_t* base = dst + (size_t)(row0 + 64 * wm + 32 * mi) * ldo + cb + 128 * wn + 64 * pr;
            int zo = 0; asm volatile("" : "+v"(zo));
            const float* gch = gain + zo;
            stage_store_chunk(smem, acc[mi][2 * pr], acc[mi][2 * pr + 1],
                              [&](int n2, int i, float x) { float o = x * rstd; if (do_norm) o *= gch[32 * n2 + crow(i, hf)]; return o; },
                              [&](int r) { return base + (size_t)r * ldo; });
        }
}
DI void epi_vt(char* smem, const f32x16 (&acc)[2][4], int row0, bf16_t* __restrict__ vt, int dv, int nheads, int colbase  ) {
    const int w = opaque_tid() >> 6, wm = w >> 1, wn = w & 1;
    const int b = row0 >> 13, s0 = row0 & (NS - 1);
#pragma unroll
    for (int ni = 0; ni < 4; ++ni) {
        const int c0 = colbase + 128 * wn + 32 * ni;
        bf16_t* base = vt + ((size_t)b * 512 + c0) * NS + s0 + 64 * wm;
        stage_store_chunk<true>(smem, acc[0][ni], acc[1][ni], [](int, int, float x) { return x; }, [&](int r) { return base + (size_t)r * NS; });
    }
}
DI void phase_inproj(const Params& P, char* smem) {
    const bf16_t* zrow = (const bf16_t*)(P.ws + OFF_ZROW);
    const bf16_t* h = (const bf16_t*)(P.ws + OFF_H);
    const bf16_t* win = (const bf16_t*)(P.ws + OFF_WIN);
    float* gl = (float*)(smem + SM_EXTRA);
    __syncthreads();
    {
        const int v = threadIdx.x >> 6, i = threadIdx.x & 63;
        if (v == 0) gl[i] = P.dq_g[i];
        else if (v == 1) gl[64 + i] = P.dk_g[i];
        else if (v == 2) gl[128 + i] = P.sq_g[i];
        else if (v == 3) gl[192 + i] = P.sk_g[i];
        else if (v == 4) gl[256 + i] = P.ik_g[i];
    }
    __syncthreads();
    const XPart xp1 = xcd_part(P.ws, smem, (NT / 256) * 10);
    for (int it = xp1.start; it < xp1.end; it += xp1.step) {
        const int jj = it % 10, mt = it / 10;
        const int j = jj < 4 ? jj : jj < 8 ? jj + 2 : jj + 4;
        const int row0 = mt * 256, grp = j >> 1, cb = (j & 1) * 256;
        DenseRows ar{h + (size_t)row0 * 1024, 1024};
        bf16_t* dst = (bf16_t*)(P.ws + (grp == 0 ? OFF_QD : grp == 1 ? OFF_KD : grp == 3 ? OFF_QS : grp == 4 ? OFF_KS : OFF_IQ));
        const float* gain = gl + 64 * (grp == 0 ? 0 : grp == 1 ? 1 : grp == 3 ? 2 : 3);
        const bool do_norm = grp != 6;
#ifdef XP_DUPEPI
        gemm_dma<true, 256>(smem, ar, win + (size_t)j * 256 * 1024, 1024, 4, 1, zrow, [&](int, const f32x16 (&acc)[2][4]) { epi_rows_bf16(smem, acc, row0, dst, 512, cb, gain, do_norm); asm volatile("" ::: "memory"); epi_rows_bf16(smem, acc, row0, dst, 512, cb, gain, do_norm); });
#else
        gemm_dma<true, 256, 32>(smem, ar, win + (size_t)j * 256 * 1024, 1024, 4, 1, zrow, [&](int, const f32x16 (&acc)[2][4]) { epi_rows_bf16(smem, acc, row0, dst, 512, cb, gain, do_norm); });
#endif
    }
    const XPart xp2 = xcd_part(P.ws, smem, (NT / 256) * 4);
    for (int it = xp2.start; it < xp2.end; it += xp2.step) {
        const int jj = it & 3, mt = it >> 2;
        const int j = jj < 2 ? 4 + jj : 8 + jj;
        const int row0 = mt * 256, cb = (j & 1) * 256;
        DenseRows ar{h + (size_t)row0 * 1024, 1024};
        bf16_t* vt = (bf16_t*)(P.ws + (jj < 2 ? OFF_VDT : OFF_VST));
        const int dv = jj < 2 ? 128 : 64, nh = jj < 2 ? 4 : 8;
        gemm_dma<false, 256, 32>(smem, ar, win + (size_t)j * 256 * 1024, 1024, 4, 1, zrow, [&](int, const f32x16 (&acc)[2][4]) { epi_vt(smem, acc, row0, vt, dv, nh, cb); });
    }
    for (int mt = blockIdx.x; mt < NT / 256; mt += gridDim.x) {
        const int row0 = mt * 256;
        DenseRows ar{h + (size_t)row0 * 1024, 1024};
        gemm_dma<true, 256>(smem, ar, win + (size_t)14 * 256 * 1024, 1024, 4, 1, zrow, [&](int, const f32x16 (&acc)[2][4]) {
            const int otid = opaque_tid(), lane = otid & 63, w = otid >> 6, wm = w >> 1, wn = w & 1, l31 = lane & 31, hf = lane >> 5;
            if (wn == 0) {
                bf16_t* ik = (bf16_t*)(P.ws + OFF_IK);
                float* iw = (float*)(P.ws + OFF_IW);
                const float s = 0.35355339059327373f * 0.125f;
#pragma unroll
                for (int mi = 0; mi < 2; ++mi) {
                    const int tok = row0 + 64 * wm + 32 * mi + l31;
                    float ss = 0.f;
#pragma unroll
                    for (int ni = 0; ni < 2; ++ni)
#pragma unroll
                        for (int i = 0; i < 16; ++i) ss += acc[mi][ni][i] * acc[mi][ni][i];
                    ss += __shfl_xor(ss, 32);
                    const float rstd = rsqrtf(ss * (1.f / 64.f) + EPSF);
#pragma unroll
                    for (int ni = 0; ni < 2; ++ni)
#pragma unroll
                        for (int q4 = 0; q4 < 4; ++q4) {
                            const int f = 32 * ni + 8 * q4 + 4 * hf;
                            float o[4];
#pragma unroll
                            for (int r = 0; r < 4; ++r) o[r] = acc[mi][ni][4 * q4 + r] * rstd * gl[256 + f + r];
                            u32x2 pk; pk[0] = pk2(o[0], o[1]); pk[1] = pk2(o[2], o[3]);
                            *(u32x2*)(ik + ((((size_t)(tok >> 5) * 4 + (2 * ni + (q4 >> 1))) * 64 + 32 * (q4 & 1) + (tok & 31)) * 8 + 4 * hf)) = pk;
                        }
                    f32x4 o = {acc[mi][2][0] * s, acc[mi][2][1] * s, acc[mi][2][2] * s, acc[mi][2][3] * s};
                    *(f32x4*)(iw + (size_t)tok * 8 + 4 * hf) = o;
                }
            }
        });
    }
}

constexpr int TK_CAP = 512, TK_HI = 448;
template <int NPASS>
DI unsigned topk_prune(volatile LAS unsigned* buf, volatile LAS unsigned* hist, int cnt, int& kept) {
    const int lane = threadIdx.x & 63;
    unsigned e[8];
#pragma unroll
    for (int i = 0; i < 8; ++i) { const int idx = lane + 64 * i; e[i] = idx < cnt ? buf[idx] : 0u; }
    unsigned prefix = 0u, want = 256u;
#pragma unroll
    for (int p = 3; p >= 4 - NPASS; --p) {
        const int sh = 8 * p;
#pragma unroll
        for (int j = 0; j < 4; ++j) hist[4 * lane + j] = 0u;
        asm volatile("" ::: "memory");
#pragma unroll
        for (int i = 0; i < 8; ++i) {
            const bool m = (e[i] != 0u) && (p == 3 || (e[i] >> (sh + 8)) == prefix);
            if (m) __hip_atomic_fetch_add((LAS unsigned*)&hist[(e[i] >> sh) & 255u], 1u, __ATOMIC_RELAXED, __HIP_MEMORY_SCOPE_WORKGROUP);
        }
        asm volatile("" ::: "memory");
        const unsigned h0 = hist[4 * lane], h1 = hist[4 * lane + 1], h2 = hist[4 * lane + 2], h3 = hist[4 * lane + 3];
        const unsigned s4 = h0 + h1 + h2 + h3;
        int suf_i = (int)s4;
        suf_i += __builtin_amdgcn_update_dpp(0, suf_i, 0x101, 0xf, 0xf, true);
        suf_i += __builtin_amdgcn_update_dpp(0, suf_i, 0x102, 0xf, 0xf, true);
        suf_i += __builtin_amdgcn_update_dpp(0, suf_i, 0x104, 0xf, 0xf, true);
        suf_i += __builtin_amdgcn_update_dpp(0, suf_i, 0x108, 0xf, 0xf, true);
        const int t1 = __builtin_amdgcn_readlane(suf_i, 16), t2 = __builtin_amdgcn_readlane(suf_i, 32), t3 = __builtin_amdgcn_readlane(suf_i, 48);
        const int row = lane >> 4;
        const unsigned suf = (unsigned)(suf_i + (row == 0 ? t1 + t2 + t3 : row == 1 ? t2 + t3 : row == 2 ? t3 : 0));
        const unsigned above = suf - s4;
        const bool own = (above < want) && (want <= suf);
        unsigned bsel = 0u, cum = above;
        if (cum + h3 >= want) bsel = 3u;
        else { cum += h3; if (cum + h2 >= want) bsel = 2u; else { cum += h2; if (cum + h1 >= want) bsel = 1u; else { cum += h1; bsel = 0u; } } }
        const u64 om = __builtin_amdgcn_ballot_w64(own);
        const int ol = om ? (int)__builtin_ctzll(om) : 0;
        const unsigned bin = (unsigned)__builtin_amdgcn_readlane((int)(4u * lane + bsel), ol);
        const unsigned cm = (unsigned)__builtin_amdgcn_readlane((int)cum, ol);
        prefix = (prefix << 8) | bin; want -= cm;
    }
    const unsigned V = NPASS == 4 ? prefix : (prefix << 16);
    int base = 0;
#pragma unroll
    for (int i = 0; i < 8; ++i) {
        const bool keep = (e[i] != 0u) && (e[i] >= V);
        const u64 mk = __ballot(keep);
        const int pos = base + __builtin_popcountll(mk & ((1ull << lane) - 1ull));
        if (keep) buf[pos] = e[i];
        base += __builtin_popcountll(mk);
    }
    asm volatile("" ::: "memory");
    kept = base;
    return NPASS == 4 ? V : (V ? V - 1u : 0u);
}

DI void indexer_item(const Params& P, char* smem, int b, int q0) {
    const int lane = threadIdx.x & 63, w = __builtin_amdgcn_readfirstlane(threadIdx.x >> 6), l31 = lane & 31, hf = lane >> 5;
    const int qbase = q0 + 8 * w;
    const bf16_t* IQ = (const bf16_t*)(P.ws + OFF_IQ);
    const bf16_t* IK = (const bf16_t*)(P.ws + OFF_IK);
    const float* IW = (const float*)(P.ws + OFF_IW);
    volatile LAS unsigned* buf = (volatile LAS unsigned*)(LAS char*)(smem + w * 8 * 2048);
    volatile LAS unsigned* hist = (volatile LAS unsigned*)(LAS char*)(smem + 131072 + w * 1024);
    bf16x8 af[2][4];
    {
        const int m = l31, qs = 2 * ((m >> 2) & 1) + (m >> 4), head = 4 * ((m >> 3) & 1) + (m & 3);
#pragma unroll
        for (int mt = 0; mt < 2; ++mt) {
            const size_t tok = (size_t)b * NS + qbase + 4 * mt + qs;
#pragma unroll
            for (int ks = 0; ks < 4; ++ks) af[mt][ks] = *(const bf16x8*)(IQ + tok * 512 + head * 64 + ks * 16 + hf * 8);
        }
    }
    float iwv[2][2][8]; int qpos[2][2]; unsigned tau[2][2]; int cnt[2][2];
#pragma unroll
    for (int mt = 0; mt < 2; ++mt)
#pragma unroll
        for (int j = 0; j < 2; ++j) {
            qpos[mt][j] = qbase + 4 * mt + 2 * hf + j; tau[mt][j] = 0u; cnt[mt][j] = 0;
            const float* p = IW + ((size_t)b * NS + qpos[mt][j]) * 8;
            const f32x4 a = *(const f32x4*)p, c = *(const f32x4*)(p + 4);
#pragma unroll
            for (int r = 0; r < 4; ++r) { iwv[mt][j][r] = a[r]; iwv[mt][j][4 + r] = c[r]; }
        }
    const int nkt = ((qbase + 7) >> 6) + 1;
    const bf16_t* ikb = IK + (size_t)b * NS * 64 + (size_t)lane * 8;
    bf16x8 bfr[2][4];
#pragma unroll
    for (int sb = 0; sb < 2; ++sb)
#pragma unroll
        for (int ks = 0; ks < 4; ++ks) bfr[sb][ks] = *(const bf16x8*)(ikb + (size_t)(sb * 4 + ks) * 512);
#pragma unroll 2
    for (int kt = 0; kt < nkt; ++kt) {
        bf16x8 bn[2][4];
        {
            const int kn = min(kt + 1, nkt - 1) * 64;
#ifdef XP_DUPIKLOAD
#pragma unroll
            for (int sb = 0; sb < 2; ++sb)
#pragma unroll
                for (int ks = 0; ks < 4; ++ks) { bf16x8 t = __builtin_nontemporal_load((const bf16x8*)(ikb + (size_t)kn * 64 + (size_t)(sb * 4 + ks) * 512)); asm volatile("" : "+v"(t)); }
#endif
#pragma unroll
            for (int sb = 0; sb < 2; ++sb)
#pragma unroll
                for (int ks = 0; ks < 4; ++ks) bn[sb][ks] = *(const bf16x8*)(ikb + (size_t)kn * 64 + (size_t)(sb * 4 + ks) * 512);
        }
#pragma unroll
        for (int sb = 0; sb < 2; ++sb) {
            const int k0 = kt * 64 + 32 * sb;
            if (k0 > qbase + 7) continue;
            const bool needcausal = k0 + 31 > qbase;
            f32x16 acc[2];
#pragma unroll
            for (int mt = 0; mt < 2; ++mt) {
#pragma unroll
                for (int i = 0; i < 16; ++i) acc[mt][i] = 0.f;
#pragma unroll
                for (int ks = 0; ks < 4; ++ks) acc[mt] = MFMA32(af[mt][ks], bfr[sb][ks], acc[mt]);
#ifdef XP_DUPIDXMFMA
                { f32x16 z; for (int i = 0; i < 16; ++i) z[i] = 0.f;
                  for (int ks = 0; ks < 4; ++ks) z = MFMA32(af[mt][ks], bfr[sb][ks], z);
                  asm volatile("" : "+v"(z)); }
#endif
            }
            const int kidx = k0 + l31;
#pragma unroll
            for (int mt = 0; mt < 2; ++mt)
#pragma unroll
                for (int j = 0; j < 2; ++j) {
                    float s = 0.f;
#ifdef XP_DUPSCORE
                    { float s2 = 0.f;
#pragma unroll
                      for (int t = 0; t < 8; ++t) s2 = __builtin_fmaf(iwv[mt][j][t], __int_as_float(max(__float_as_int(acc[mt][8 * j + t]), 0)), s2);
                      asm volatile("" : "+v"(s2)); s = s2 * 0.f; }
#endif
#pragma unroll
                    for (int t = 0; t < 8; ++t)
                        s = __builtin_fmaf(iwv[mt][j][t], __int_as_float(max(__float_as_int(acc[mt][8 * j + t]), 0)), s);
                    const int si = __float_as_int(s);
                    const unsigned ord = (unsigned)si ^ ((unsigned)(si >> 31) | 0x80000000u);
                    const unsigned pk = (ord & 0xFFFFE000u) | (unsigned)(8191 - kidx);
                    const bool pass = needcausal ? ((kidx <= qpos[mt][j]) && (pk > tau[mt][j])) : (pk > tau[mt][j]);
                    const u64 mk = __builtin_amdgcn_ballot_w64(pass);
                    const unsigned hm = hf ? (unsigned)(mk >> 32) : (unsigned)mk;
                    const int pos = cnt[mt][j] + __builtin_popcount(hm & ((1u << l31) - 1u));
                    { const int widx = pass ? (4 * mt + 2 * hf + j) * TK_CAP + pos : (int)(hist - buf) + lane; buf[widx] = pk; }
#ifdef XP_DUPAPPEND
                    {
                        unsigned pk2v = pk; asm volatile("" : "+v"(pk2v));
                        const bool pass2 = needcausal ? ((kidx <= qpos[mt][j]) && (pk2v > tau[mt][j])) : (pk2v > tau[mt][j]);
                        const u64 mk2 = __builtin_amdgcn_ballot_w64(pass2);
                        const unsigned hm2 = hf ? (unsigned)(mk2 >> 32) : (unsigned)mk2;
                        const int pos2 = cnt[mt][j] + __builtin_popcount(hm2 & ((1u << l31) - 1u));
                        if (pass2) buf[(4 * mt + 2 * hf + j) * TK_CAP + pos2] = pk2v;
                    }
#endif
                    cnt[mt][j] += __builtin_popcount(hm);
                }
        }
        const bool anyhi = cnt[0][0] > TK_HI || cnt[0][1] > TK_HI || cnt[1][0] > TK_HI || cnt[1][1] > TK_HI;
        if (__ballot(anyhi) != 0ull) {
#pragma unroll 1
            for (int s8 = 0; s8 < 8; ++s8) {
                const int mt = s8 >> 2, j = (s8 >> 1) & 1, h2 = s8 & 1;
                const int cv = mt ? (j ? cnt[1][1] : cnt[1][0]) : (j ? cnt[0][1] : cnt[0][0]);
                const int c = __builtin_amdgcn_readlane(cv, 32 * h2);
                if (c > TK_HI) {
                    volatile LAS unsigned* qb = buf + (4 * mt + 2 * h2 + j) * TK_CAP;
                    int nk = 0;
                    unsigned V = topk_prune<2>(qb, hist, c, nk);
#ifdef XP_DUPPRUNE
                    V = topk_prune<2>(qb, hist, nk, nk);
#endif
                    if (nk > TK_HI - 64) V = topk_prune<4>(qb, hist, nk, nk);
#pragma unroll
                    for (int a = 0; a < 2; ++a)
#pragma unroll
                        for (int d = 0; d < 2; ++d)
                            if (hf == h2 && a == mt && d == j) { tau[a][d] = V; cnt[a][d] = nk; }
                }
            }
        }
#pragma unroll
        for (int sb = 0; sb < 2; ++sb)
#pragma unroll
            for (int ks = 0; ks < 4; ++ks) bfr[sb][ks] = bn[sb][ks];
    }
#pragma unroll 1
    for (int s8 = 0; s8 < 8; ++s8) {
        const int mt = s8 >> 2, j = (s8 >> 1) & 1, h2 = s8 & 1;
        const int cv = mt ? (j ? cnt[1][1] : cnt[1][0]) : (j ? cnt[0][1] : cnt[0][0]);
        int c = __builtin_amdgcn_readlane(cv, 32 * h2);
        volatile LAS unsigned* qb = buf + (4 * mt + 2 * h2 + j) * TK_CAP;
        if (c > 256) { int nk = 0; (void)topk_prune<4>(qb, hist, c, nk); c = nk; }
#pragma unroll
        for (int t = 0; t < 4; ++t) qb[256 + 4 * lane + t] = 0u;
        asm volatile("" ::: "memory");
#pragma unroll
        for (int t = 0; t < 4; ++t) {
            const int idx = lane + 64 * t;
            if (idx < c) {
                const unsigned e = qb[idx]; const unsigned kk = 8191u - (e & 8191u);
                __hip_atomic_fetch_or((LAS unsigned*)&qb[256 + (kk >> 5)], 1u << (kk & 31u), __ATOMIC_RELAXED, __HIP_MEMORY_SCOPE_WORKGROUP);
            }
        }
        asm volatile("" ::: "memory");
    }
    u64* mask = (u64*)(P.ws + OFF_MASK);
    const int ktmax = (q0 | 255) >> 6;
    const int qi = lane & 7;
#pragma unroll 1
    for (int it = 0; it < 16; ++it) {
        const int kt = it * 8 + (lane >> 3);
        if (kt <= ktmax) {
            const unsigned lo = buf[qi * TK_CAP + 256 + 2 * kt], hi = buf[qi * TK_CAP + 256 + 2 * kt + 1];
            mask[((size_t)(b * 128 + kt)) * NS + qbase + qi] = ((u64)hi << 32) | lo;
        }
    }
}

constexpr int AT_K = 64 * LROW;
constexpr int AT_DSTAGE = 4 * AT_K;
template <int NDB, bool BM>
DI void attn_tile(const LAS char* Kt, const LAS char* Vt, const bf16x8 (&qf)[4], f32x16 (&o)[NDB], float off, float& mlow, float& lrun,
                  int qpos, int k0, float c1, float c2, bool diag, bool scan, u64 mword) {
    const int lane = threadIdx.x & 63, l31 = lane & 31, hf = lane >> 5;
    const int lanex = ((((l31 >> 1) & 7) ^ hf) << 4);
    const LAS char* kbase = Kt + l31 * 128;
    const LAS char* vbase = Vt + l31 * 128;
    const float bias0 = -c2 * (float)(qpos - k0 - 4 * hf) - off;
#pragma unroll 1
    for (int kbi = 0; kbi < 2; ++kbi) {
        const int kb = 1 - kbi;
        f32x16 st;
#pragma unroll
        for (int i = 0; i < 16; ++i) st[i] = 0.f;
#pragma unroll
        for (int ks = 0; ks < 4; ++ks) {
            const bf16x8 kf = *(const LAS bf16x8*)(kbase + kb * 4096 + (lanex ^ (ks << 5)));
            st = MFMA32(kf, qf[ks], st);
        }
        const unsigned mw = BM ? (unsigned)((kb ? (unsigned)(mword >> 32) : (unsigned)mword) >> (4 * hf)) : 0u;
        const float noff = bias0 + c2 * (float)(32 * kb);
        float ls = 0.f, mx = -INFINITY;
#pragma unroll
        for (int i = 0; i < 16; ++i) {
            const int ko = (i & 3) + 8 * (i >> 2);
            const float v = __builtin_fmaf(st[i], c1, __builtin_fmaf(c2, (float)ko, noff));
            bool ok = true;
            if (BM) ok = (mw >> ko) & 1u;
            if (diag) ok = ok && (k0 + 32 * kb + ko + 4 * hf <= qpos);
            float p = __builtin_amdgcn_exp2f(v);
            if (BM || diag) p = ok ? p : 0.f;
            if (scan) mx = fmaxf(mx, (BM || diag) ? (ok ? v : -INFINITY) : v);
            st[i] = p; ls += p;
        }
#ifdef XP_DUPSOFTMAX
        {
            float ls2 = 0.f;
#pragma unroll
            for (int i = 0; i < 16; ++i) {
                const int ko = (i & 3) + 8 * (i >> 2);
                float x = st[i]; asm volatile("" : "+v"(x));
                const float v = __builtin_fmaf(x, c1, __builtin_fmaf(c2, (float)ko, noff));
                ls2 += __builtin_amdgcn_exp2f(v);
            }
            asm volatile("" : "+v"(ls2));
            ls += ls2 * 0.f;
        }
#endif
        lrun += ls;
        if (scan) { mx = fmaxf(mx, __shfl_xor(mx, 32)); mlow = fmaxf(mlow, mx + off); }
        const int vx = lanex ^ (kb << 6);
#pragma unroll
        for (int s = 0; s < 2; ++s) {
            u32x4 pp;
#pragma unroll
            for (int t = 0; t < 4; ++t) pp[t] = pk2(st[8 * s + 2 * t], st[8 * s + 2 * t + 1]);
            const bf16x8 pf = __builtin_bit_cast(bf16x8, pp);
#pragma unroll
            for (int db = 0; db < NDB; ++db) {
                const bf16x8 vf = *(const LAS bf16x8*)(vbase + db * 4096 + (vx ^ (s << 5)));
                o[db] = MFMA32(vf, pf, o[db]);
            }
        }
    }
}

constexpr int AT_NST = 4;

DI void diffattn_item(const Params& P, char* smem, int b, int h, int qb) {
    const int tid = threadIdx.x, lane = tid & 63, w = __builtin_amdgcn_readfirstlane(tid >> 6), l31 = lane & 31, hf = lane >> 5;
    const int map = w & 1, qsub = w >> 1;
    const int q0 = qb * 128;
    LAS char* lds = (LAS char*)smem;
    const bf16_t* Qd = (const bf16_t*)(P.ws + OFF_QD);
    const bf16_t* Kd = (const bf16_t*)(P.ws + OFF_KD);
    const bf16_t* VdT = (const bf16_t*)(P.ws + OFF_VDT);
    const int qpos = q0 + 32 * qsub + l31;
    bf16x8 qf[4];
#pragma unroll
    for (int ks = 0; ks < 4; ++ks) qf[ks] = *(const bf16x8*)(Qd + ((size_t)b * NS + qpos) * 512 + h * 128 + map * 64 + ks * 16 + hf * 8);
    const float slope = exp2f(-2.f * (float)(h + 1));
    const float c1 = 0.125f * LOG2E, c2 = slope * LOG2E;
    float gq = fabsf(P.dq_g[lane]), gk = fabsf(P.dk_g[lane]);
#pragma unroll
    for (int d = 32; d >= 1; d >>= 1) { gq = fmaxf(gq, __shfl_xor(gq, d)); gk = fmaxf(gk, __shfl_xor(gk, d)); }
    const float B2 = 64.f * gq * gk * 1.008f * c1;
    int* flags = (int*)(smem + SM_EXTRA + 3072);
    int par = 0;
    f32x16 o[4];
#pragma unroll
    for (int db = 0; db < 4; ++db)
#pragma unroll
        for (int i = 0; i < 16; ++i) o[db][i] = 0.f;
    float mlow = -INFINITY, lrun = 0.f;
    int ndone = 0;
    const int drow = 8 * w + (lane >> 3), dch = (lane & 7) ^ ((drow >> 1) & 7);
    const bf16_t* ksrc = Kd + ((size_t)b * NS + drow) * 512 + h * 128 + dch * 8;
    const bf16_t* vsrc = VdT + ((size_t)(b * 4 + h) * 128 + drow) * NS + dch * 8;
    auto dma = [&](int kt, int stage) {
        LAS char* stg = lds + stage * 32768;
        const size_t k0 = (size_t)kt * 64;
        __builtin_amdgcn_global_load_lds((const unsigned*)(ksrc + k0 * 512), (LAS unsigned*)(stg + w * 1024), 16, 0, 0);
        __builtin_amdgcn_global_load_lds((const unsigned*)(ksrc + k0 * 512 + 64), (LAS unsigned*)(stg + 8192 + w * 1024), 16, 0, 0);
        __builtin_amdgcn_global_load_lds((const unsigned*)(vsrc + k0), (LAS unsigned*)(stg + 16384 + w * 1024), 16, 0, 0);
        __builtin_amdgcn_global_load_lds((const unsigned*)(vsrc + (size_t)64 * NS + k0), (LAS unsigned*)(stg + 16384 + 8192 + w * 1024), 16, 0, 0);
#ifdef XP_DUPDMA
        __builtin_amdgcn_global_load_lds((const unsigned*)(ksrc + k0 * 512), (LAS unsigned*)(stg + w * 1024), 16, 0, 0);
        __builtin_amdgcn_global_load_lds((const unsigned*)(ksrc + k0 * 512 + 64), (LAS unsigned*)(stg + 8192 + w * 1024), 16, 0, 0);
        __builtin_amdgcn_global_load_lds((const unsigned*)(vsrc + k0), (LAS unsigned*)(stg + 16384 + w * 1024), 16, 0, 0);
        __builtin_amdgcn_global_load_lds((const unsigned*)(vsrc + (size_t)64 * NS + k0), (LAS unsigned*)(stg + 16384 + 8192 + w * 1024), 16, 0, 0);
#endif
    };
    const int ktd = 2 * qb + 1;
    const int qwmax = q0 + 32 * qsub + 31, qwmin = q0 + 32 * qsub;
#ifdef XP_DUPLOOP
  for (int rep = 0; rep < 2; ++rep) {
    if (rep) { for (int db = 0; db < 4; ++db) for (int i = 0; i < 16; ++i) o[db][i] = 0.f; mlow = -INFINITY; lrun = 0.f; ndone = 0; par = 0; }
#endif
    asm volatile("s_waitcnt vmcnt(0) lgkmcnt(0)" ::: "memory");
    __builtin_amdgcn_s_barrier();
    dma(max(ktd, 0), 0); dma(max(ktd - 1, 0), 1); dma(max(ktd - 2, 0), 2);
    for (int j = 0; j <= ktd; ++j) {
        const int kt = ktd - j, k0 = kt * 64;
#ifdef XP_DUPDMA
        asm volatile("s_waitcnt vmcnt(16)" ::: "memory");
#else
        asm volatile("s_waitcnt vmcnt(8)" ::: "memory");
#endif
        asm volatile("s_waitcnt lgkmcnt(0)" ::: "memory");
        __builtin_amdgcn_s_barrier();
        int allstop = 0;
        if (j > 0) { allstop = 1;
#pragma unroll
            for (int i = 0; i < 8; ++i) allstop &= flags[(par ^ 1) * 8 + i]; }
        if (allstop) break;
        dma(max(kt - 3, 0), (j + 3) & 3);
        const LAS char* cur = lds + (j & 3) * 32768;
        if (k0 <= qwmax) {
            attn_tile<4, false>(cur + map * 8192, cur + 16384, qf, o, B2, mlow, lrun, qpos, k0, c1, c2, k0 + 63 > qwmin, ndone < 2, 0ull);
            ++ndone;
        }
        {
            const float ub = B2 - c2 * (float)(qpos - (k0 - 1));
            const bool stop = __all(ub < mlow - 30.f);
            if (lane == 0) flags[par * 8 + w] = stop ? 1 : 0;
        }
        par ^= 1;
    }
    asm volatile("s_waitcnt vmcnt(0) lgkmcnt(0)" ::: "memory");
    __builtin_amdgcn_s_barrier();
#ifdef XP_DUPLOOP
  }
#endif
    const float ltot = lrun + __shfl_xor(lrun, 32);
    const float inv = 1.f / ltot;
    float la, lb;
    { const float a = P.lq1[lane] * P.lk1[lane], c = P.lq2[lane] * P.lk2[lane]; la = wave_sum(a); lb = wave_sum(c); }
    const float lam = __expf(la) - __expf(lb) + 0.2f;
    float* X = (float*)smem;
    if (map == 1) {
#pragma unroll
        for (int db = 0; db < 4; ++db)
#pragma unroll
            for (int q4 = 0; q4 < 4; ++q4) {
                f32x4 v;
#pragma unroll
                for (int r = 0; r < 4; ++r) v[r] = o[db][4 * q4 + r] * inv * lam;
                *(f32x4*)(X + (qsub * 32 + l31) * 132 + 32 * db + 8 * q4 + 4 * hf) = v;
            }
    }
    __syncthreads();
    if (map == 0) {
        float ss = 0.f;
#pragma unroll
        for (int db = 0; db < 4; ++db)
#pragma unroll
            for (int q4 = 0; q4 < 4; ++q4) {
                const f32x4 v2 = *(const f32x4*)(X + (qsub * 32 + l31) * 132 + 32 * db + 8 * q4 + 4 * hf);
#pragma unroll
                for (int r = 0; r < 4; ++r) { const float v = o[db][4 * q4 + r] * inv - v2[r]; o[db][4 * q4 + r] = v; ss += v * v; }
            }
        ss += __shfl_xor(ss, 32);
        const float rstd = rsqrtf(ss * (1.f / 128.f) + EPSF) * 0.8f;
        bf16_t* ao = (bf16_t*)(P.ws + OFF_H) + ((size_t)b * NS + qpos) * 1024 + h * 128;
#pragma unroll
        for (int db = 0; db < 4; ++db)
#pragma unroll
            for (int q4 = 0; q4 < 4; ++q4) {
                const int d = 32 * db + 8 * q4 + 4 * hf;
                const f32x4 g = *(const f32x4*)((const float*)(smem + SM_EXTRA + 1024) + d);
                u32x2 pk; pk[0] = pk2(o[db][4 * q4] * rstd * g[0], o[db][4 * q4 + 1] * rstd * g[1]); pk[1] = pk2(o[db][4 * q4 + 2] * rstd * g[2], o[db][4 * q4 + 3] * rstd * g[3]);
                *(u32x2*)(ao + d) = pk;
            }
    }
    __syncthreads();
}

DI void dsa_item(const Params& P, char* smem, int b, int h, int qb) {
    const int tid = threadIdx.x, lane = tid & 63, w = __builtin_amdgcn_readfirstlane(tid >> 6), l31 = lane & 31, hf = lane >> 5;
    const int q0 = qb * 256;
    LAS char* lds = (LAS char*)smem;
    const bf16_t* Qs = (const bf16_t*)(P.ws + OFF_QS);
    const bf16_t* Ks = (const bf16_t*)(P.ws + OFF_KS);
    const bf16_t* VsT = (const bf16_t*)(P.ws + OFF_VST);
    const u64* mask = (const u64*)(P.ws + OFF_MASK);
    const int qpos = q0 + 32 * w + l31;
    bf16x8 qf[4];
#pragma unroll
    for (int ks = 0; ks < 4; ++ks) qf[ks] = *(const bf16x8*)(Qs + ((size_t)b * NS + qpos) * 512 + h * 64 + ks * 16 + hf * 8);
    const float slope = exp2f(-(float)(h + 1));
    const float c1 = 0.125f * LOG2E, c2 = slope * LOG2E;
    float gq = fabsf(P.sq_g[lane]), gk = fabsf(P.sk_g[lane]);
#pragma unroll
    for (int d = 32; d >= 1; d >>= 1) { gq = fmaxf(gq, __shfl_xor(gq, d)); gk = fmaxf(gk, __shfl_xor(gk, d)); }
    const float B2 = 64.f * gq * gk * 1.008f * c1;
    int* flags = (int*)(smem + SM_EXTRA + 3072);
    int par = 0;
    f32x16 o[2];
#pragma unroll
    for (int db = 0; db < 2; ++db)
#pragma unroll
        for (int i = 0; i < 16; ++i) o[db][i] = 0.f;
    float mlow = -INFINITY, lrun = 0.f, off = 0.f;
    bool offset_set = false;
    const int drow = 8 * w + (lane >> 3), dch = (lane & 7) ^ ((drow >> 1) & 7);
    const bf16_t* ksrc = Ks + ((size_t)b * NS + drow) * 512 + h * 64 + dch * 8;
    const bf16_t* vsrc = VsT + ((size_t)(b * 8 + h) * 64 + drow) * NS + dch * 8;
    const u64* msrc = mask + (size_t)b * 128 * NS + q0 + (w & 1) * 128 + lane * 2;
    auto dma = [&](int kt, int stage) {
        LAS char* stg = lds + stage * 18432;
        const size_t k0 = (size_t)kt * 64;
        __builtin_amdgcn_global_load_lds((const unsigned*)(ksrc + k0 * 512), (LAS unsigned*)(stg + w * 1024), 16, 0, 0);
        __builtin_amdgcn_global_load_lds((const unsigned*)(vsrc + k0), (LAS unsigned*)(stg + 8192 + w * 1024), 16, 0, 0);
        if (w < 2) __builtin_amdgcn_global_load_lds((const unsigned*)(msrc + (size_t)kt * NS), (LAS unsigned*)(stg + 16384 + w * 1024), 16, 0, 0);
    };
    const int ktd = 4 * qb + 3;
    const int qwmax = q0 + 32 * w + 31;
#ifdef XP_DUPLOOP
  for (int rep = 0; rep < 2; ++rep) {
    if (rep) { for (int db = 0; db < 2; ++db) for (int i = 0; i < 16; ++i) o[db][i] = 0.f; mlow = -INFINITY; lrun = 0.f; off = 0.f; offset_set = false; par = 0; }
#endif
    asm volatile("s_waitcnt vmcnt(0) lgkmcnt(0)" ::: "memory");
    __builtin_amdgcn_s_barrier();
    dma(max(ktd, 0), 0); dma(max(ktd - 1, 0), 1); dma(max(ktd - 2, 0), 2);
    for (int j = 0; j <= ktd; ++j) {
        const int kt = ktd - j, k0 = kt * 64;
        if (w < 2) asm volatile("s_waitcnt vmcnt(6)" ::: "memory"); else asm volatile("s_waitcnt vmcnt(4)" ::: "memory");
        asm volatile("s_waitcnt lgkmcnt(0)" ::: "memory");
        __builtin_amdgcn_s_barrier();
        int allstop = 0;
        if (j > 0) { allstop = 1;
#pragma unroll
            for (int i = 0; i < 8; ++i) allstop &= flags[(par ^ 1) * 8 + i]; }
        if (allstop) break;
        dma(max(kt - 3, 0), (j + 3) & 3);
        const LAS char* cur = lds + (j & 3) * 18432;
        u64 mword = 0ull;
        if (k0 <= qwmax) mword = *(const LAS u64*)(cur + 16384 + (32 * w + l31) * 8);
        if (k0 <= qwmax && __ballot(mword != 0ull) != 0ull) {
            if (!offset_set && mword != 0ull) { off = B2 - c2 * (float)max(qpos - (k0 + 63), 0); offset_set = true; }
            attn_tile<2, true>(cur, cur + 8192, qf, o, off, mlow, lrun, qpos, k0, c1, c2, false, __any(mlow == -INFINITY), mword);
        }
        {
            const float ub = B2 - c2 * (float)(qpos - (k0 - 1));
            const bool stop = __all(ub < mlow - 30.f);
            if (lane == 0) flags[par * 8 + w] = stop ? 1 : 0;
        }
        par ^= 1;
    }
    asm volatile("s_waitcnt vmcnt(0) lgkmcnt(0)" ::: "memory");
    __builtin_amdgcn_s_barrier();
#ifdef XP_DUPLOOP
  }
#endif
    const float ltot = lrun + __shfl_xor(lrun, 32);
    const float inv = 1.f / ltot;
    bf16_t* ao = (bf16_t*)(P.ws + OFF_H) + ((size_t)b * NS + qpos) * 1024 + 512 + h * 64;
#pragma unroll
    for (int db = 0; db < 2; ++db)
#pragma unroll
        for (int q4 = 0; q4 < 4; ++q4) {
            const int d = 32 * db + 8 * q4 + 4 * hf;
            u32x2 pk; pk[0] = pk2(o[db][4 * q4] * inv, o[db][4 * q4 + 1] * inv); pk[1] = pk2(o[db][4 * q4 + 2] * inv, o[db][4 * q4 + 3] * inv);
            *(u32x2*)(ao + d) = pk;
        }
}

constexpr int P3_ITEMS = 128 * 8;
DI void phase_indexer(const Params& P, char* smem) {
    const XPart xp = xcd_part(P.ws, smem, P3_ITEMS);
    const int lo = xp.start - (xp.start % 1 ? 0 : 0);
    const int step = xp.step;
    const int rank = ((const int*)(smem + XC_LDS))[1];
    const int base = xp.start - rank;
    for (int k = 0; base + k * step < xp.end; ++k) {
        const int i = base + k * step + ((k & 1) ? step - 1 - rank : rank);
        if (i >= xp.end) continue;
        const int b = i >> 7, g = 127 - (i & 127);
        __syncthreads();
        indexer_item(P, smem, b, g * 64);
    }
    __syncthreads();
    (void)lo;
}
DI void phase_attn(const Params& P, char* smem, int qidx) {
    int* qctr = (int*)(P.ws + OFF_Q) + qidx;
    const int* items = (const int*)(P.ws + OFF_ITEMS);
    volatile int* s_it = (volatile int*)(smem + SM_EXTRA + 3200);
    __syncthreads();
    if (threadIdx.x < 128) ((float*)(smem + SM_EXTRA + 1024))[threadIdx.x] = P.subln_g[threadIdx.x];
    __syncthreads();
    for (;;) {
        __syncthreads();
        if (threadIdx.x == 0) *s_it = atomicAdd(qctr, 1);
        __syncthreads();
        const int it = *s_it;
        if (it >= ATT_ITEMS) break;
        const int code = items[it];
        const int b = (code >> 16) & 15, h = (code >> 8) & 255, qb = code & 255;
        if ((code >> 20) == 0) diffattn_item(P, smem, b, h, qb);
        else dsa_item(P, smem, b, h, qb);
    }
}

constexpr int OUTPROJ_ITEMS = (NT / 256) * 4;
DI void phase_outproj(const Params& P, char* smem) {
    const bf16_t* zrow = (const bf16_t*)(P.ws + OFF_ZROW);
    const bf16_t* ao = (const bf16_t*)(P.ws + OFF_H);
    const bf16_t* wout = (const bf16_t*)(P.ws + OFF_WOUT);
    bf16_t* mix = (bf16_t*)(P.ws + OFF_QD);
    const int lane = threadIdx.x & 63, w = threadIdx.x >> 6, wm = w >> 1, wn = w & 1, l31 = lane & 31, hf = lane >> 5;
    const XPart xp = xcd_part(P.ws, smem, OUTPROJ_ITEMS);
    for (int it = xp.start; it < xp.end; it += xp.step) {
        const int mt = it >> 2, j = it & 3;
        const int row0 = mt * 256;
        DenseRows ar{ao + (size_t)row0 * 1024, 1024};
        gemm_dma<true, 256>(smem, ar, wout + (size_t)j * 256 * 1024, 1024, 4, 1, zrow, [&](int, const f32x16 (&acc)[2][4]) {
#pragma unroll
            for (int mi = 0; mi < 2; ++mi)
#pragma unroll
                for (int pr = 0; pr < 2; ++pr) {
                    bf16_t* base = mix + ((size_t)row0 + 64 * wm + 32 * mi) * 1024 + 256 * j + 128 * wn + 64 * pr;
                    stage_store_chunk(smem, acc[mi][2 * pr], acc[mi][2 * pr + 1], [](int, int, float x) { return x; }, [&](int r) { return base + (size_t)r * 1024; });
                }
        });
    }
}
DI void phase_resnorm2(const Params& P) {
    const bf16_t* mix = (const bf16_t*)(P.ws + OFF_QD);
    const float* mod = (const float*)(P.ws + OFF_MOD);
    bf16_t* h2 = (bf16_t*)(P.ws + OFF_H2);
    const int lane = threadIdx.x & 63, w = threadIdx.x >> 6;
    for (int row = blockIdx.x * NW + w; row < NT; row += gridDim.x * NW) {
        const int b = row >> 13;
        const float* mb = mod + b * 6144;
        f32x4 v[4]; float ss = 0.f;
#pragma unroll
        for (int i = 0; i < 4; ++i) {
            const int col = 256 * i + 4 * lane;
            const f32x4 xv = *(const f32x4*)(P.x + (size_t)row * 1024 + col);
            const u32x2 mv = *(const u32x2*)(mix + (size_t)row * 1024 + col);
            const f32x4 g1 = *(const f32x4*)(mb + 2048 + col);
            v[i][0] = xv[0] + g1[0] * bflo(mv[0]); v[i][1] = xv[1] + g1[1] * bfhi(mv[0]);
            v[i][2] = xv[2] + g1[2] * bflo(mv[1]); v[i][3] = xv[3] + g1[3] * bfhi(mv[1]);
            *(f32x4*)(P.out + (size_t)row * 1024 + col) = v[i];
            ss += v[i][0] * v[i][0] + v[i][1] * v[i][1] + v[i][2] * v[i][2] + v[i][3] * v[i][3];
        }
        ss = wave_sum(ss);
        const float rstd = rsqrtf(ss * (1.f / 1024.f) + EPSF);
#pragma unroll
        for (int i = 0; i < 4; ++i) {
            const int col = 256 * i + 4 * lane;
            const f32x4 gg = *(const f32x4*)(P.norm2_g + col);
            const f32x4 sh = *(const f32x4*)(mb + 3072 + col);
            const f32x4 sc = *(const f32x4*)(mb + 4096 + col);
            float o[4];
#pragma unroll
            for (int j = 0; j < 4; ++j) o[j] = v[i][j] * rstd * gg[j] * (1.f + sc[j]) + sh[j];
            u32x2 pk; pk[0] = pk2(o[0], o[1]); pk[1] = pk2(o[2], o[3]);
            *(u32x2*)(h2 + (size_t)row * 1024 + col) = pk;
        }
    }
}

constexpr int ROUTER_ITEMS = NT / 256;
DI void phase_router(const Params& P, char* smem) {
    const bf16_t* zrow = (const bf16_t*)(P.ws + OFF_ZROW);
    const bf16_t* h2 = (const bf16_t*)(P.ws + OFF_H2);
    const bf16_t* wrt = (const bf16_t*)(P.ws + OFF_WRT);
    float* logits = (float*)(P.ws + OFF_Y);
    const int lane = threadIdx.x & 63, w = threadIdx.x >> 6, wm = w >> 1, wn = w & 1, l31 = lane & 31, hf = lane >> 5;
    for (int it = blockIdx.x; it < ROUTER_ITEMS; it += gridDim.x) {
        const int row0 = it * 256;
        DenseRows ar{h2 + (size_t)row0 * 1024, 1024};
        gemm_dma<true, 256>(smem, ar, wrt, 1024, 4, 1, zrow, [&](int, const f32x16 (&acc)[2][4]) {
#pragma unroll
            for (int mi = 0; mi < 2; ++mi) {
                const size_t tok = (size_t)row0 + 64 * wm + 32 * mi + l31;
#pragma unroll
                for (int ni = 0; ni < 4; ++ni)
#pragma unroll
                    for (int q4 = 0; q4 < 4; ++q4) {
                        const int n = 128 * wn + 32 * ni + 8 * q4 + 4 * hf;
                        f32x4 ov = {acc[mi][ni][4 * q4], acc[mi][ni][4 * q4 + 1], acc[mi][ni][4 * q4 + 2], acc[mi][ni][4 * q4 + 3]};
                        *(f32x4*)(logits + tok * 256 + n) = ov;
                    }
            }
        });
    }
}

DI void phase_route(const Params& P) {
    const float* logits = (const float*)(P.ws + OFF_Y);
    int* cnt = (int*)(P.ws + OFF_CNT);
    int* list = (int*)(P.ws + OFF_LIST);
    int* eidx = (int*)(P.ws + OFF_EIDX);
    float* gates = (float*)(P.ws + OFF_GATE);
    const int lane = threadIdx.x & 63, w = threadIdx.x >> 6;
    const f32x4 bias = *(const f32x4*)(P.router_b + 4 * lane);
    for (int t = blockIdx.x * NW + w; t < NT; t += gridDim.x * NW) {
        const f32x4 lg = *(const f32x4*)(logits + (size_t)t * 256 + 4 * lane);
        float sc[4], cand[4];
#pragma unroll
        for (int i = 0; i < 4; ++i) { sc[i] = 1.f / (1.f + __expf(-lg[i])); cand[i] = sc[i] + bias[i]; }
        float t1 = fmaxf(cand[0], cand[1]), t2 = fminf(cand[0], cand[1]);
#pragma unroll
        for (int i = 2; i < 4; ++i) { const float v = cand[i]; t2 = fmaxf(t2, fminf(t1, v)); t1 = fmaxf(t1, v); }
#pragma unroll
        for (int d = 1; d < 8; d <<= 1) {
            const float o1 = __shfl_xor(t1, d), o2 = __shfl_xor(t2, d);
            const float n1 = fmaxf(t1, o1), n2 = fmaxf(fminf(t1, o1), fmaxf(t2, o2));
            t1 = n1; t2 = n2;
        }
        const float gs = t1 + t2;
        const int myg = lane >> 3;
        int rank = 0;
#pragma unroll
        for (int g = 0; g < 8; ++g) { const float sg = __shfl(gs, 8 * g); rank += (sg > gs || (sg == gs && g < myg)) ? 1 : 0; }
        if (rank >= 4) {
#pragma unroll
            for (int i = 0; i < 4; ++i) cand[i] = -INFINITY;
        }
        int sel[8]; float wv[8]; float wsum = 0.f;
#pragma unroll
        for (int k = 0; k < 8; ++k) {
            float bv = cand[0]; int bi = 0;
#pragma unroll
            for (int i = 1; i < 4; ++i) if (cand[i] > bv) { bv = cand[i]; bi = i; }
            int be = 4 * lane + bi;
#pragma unroll
            for (int d = 32; d >= 1; d >>= 1) {
                const float ov = __shfl_xor(bv, d); const int oe = __shfl_xor(be, d);
                if (ov > bv || (ov == bv && oe < be)) { bv = ov; be = oe; }
            }
            const int ol = be >> 2, oi = be & 3;
            float mys = (oi == 0) ? sc[0] : (oi == 1) ? sc[1] : (oi == 2) ? sc[2] : sc[3];
            const float ws_ = __shfl(mys, ol);
            if (lane == ol) {
#pragma unroll
                for (int i = 0; i < 4; ++i) if (i == oi) cand[i] = -INFINITY;
            }
            sel[k] = be; wv[k] = ws_; wsum += ws_;
        }
        const float rs = 2.5f / wsum;
        int my_e = 256; float my_g = 1.f;
#pragma unroll
        for (int k = 0; k < 8; ++k) if (lane == k) { my_e = sel[k]; my_g = wv[k] * rs; }
        const int c = t >> 14, tl = t & (CHUNK_T - 1);
        if (lane < 8) {
            gates[(size_t)t * 8 + lane] = my_g;
            const int pos = atomicAdd(&cnt[c * NEXP1 + my_e], 1);
            eidx[(size_t)t * 8 + lane] = my_e | (pos << 9);
            list[((size_t)c * NEXP1 + my_e) * CHUNK_T + pos] = tl * NPAIR + lane;
        } else if (lane == 8) {
            list[((size_t)c * NEXP1 + 256) * CHUNK_T + tl] = tl * NPAIR + 8;
        }
    }
}

typedef unsigned short u16;
DI void moe_build_base(const Params& P, char* smem, int c) {
    int* bs = (int*)(smem + SM_BASE);
    const int* cnt = (const int*)(P.ws + OFF_CNT) + c * NEXP1;
    const int e = threadIdx.x, lane = e & 63, w = e >> 6;
    __syncthreads();
    int n = 0, in = 0;
    if (e < 256) {
        n = cnt[e]; in = n;
#pragma unroll
        for (int d = 1; d < 64; d <<= 1) { const int t = __shfl_up(in, d); if (lane >= d) in += t; }
        if (lane == 63) bs[258 + w] = in;
    }
    __syncthreads();
    if (e < 256) {
        int o = 0;
#pragma unroll
        for (int i = 0; i < 4; ++i) if (i < w) o += bs[258 + i];
        bs[e] = o + in - n;
        if (e == 255) bs[256] = o + in;
    }
    __syncthreads();
}
DI void moe_build_tiles(const Params& P, char* smem, int c, int& totalA, int& totalB) {
    u16* tA = (u16*)(smem + SM_EXTRA);
    u16* tB = (u16*)(smem + SM_EXTRA + 528);
    int* wsum = (int*)(smem + SM_EXTRA + 1048);
    const int* cnt = (const int*)(P.ws + OFF_CNT) + c * NEXP1;
    moe_build_base(P, smem, c);
    const int e = threadIdx.x, lane = e & 63, w = e >> 6;
    __syncthreads();
    int na = 0, nb = 0, ia = 0, ib = 0;
    if (e < 256) {
        const int n = cnt[e], full = n >> 8, rem = n & 255;
        na = full + (rem > 128 ? 1 : 0); nb = (rem >= 1 && rem <= 128) ? 1 : 0;
        ia = na; ib = nb;
#pragma unroll
        for (int d = 1; d < 64; d <<= 1) { const int t = __shfl_up(ia, d), u = __shfl_up(ib, d); if (lane >= d) { ia += t; ib += u; } }
        if (lane == 63) { wsum[w] = ia; wsum[4 + w] = ib; }
    }
    __syncthreads();
    if (e < 256) {
        int oa = 0, ob = 0;
#pragma unroll
        for (int i = 0; i < 4; ++i) if (i < w) { oa += wsum[i]; ob += wsum[4 + i]; }
        tA[e] = (u16)(oa + ia - na); tB[e] = (u16)(ob + ib - nb);
        if (e == 255) { tA[256] = (u16)(oa + ia); tA[257] = (u16)(oa + ia + CHUNK_T / 256); tB[256] = (u16)(ob + ib); tB[257] = (u16)(ob + ib); }
    }
    __syncthreads();
    totalA = tA[NEXP1]; totalB = tB[NEXP1];
}
DI int moe_find_expert(const u16* tstart, int tile) {
    int lo = 0, hi = NEXP1;
    while (hi - lo > 1) { const int mid = (lo + hi) >> 1; if ((int)tstart[mid] <= tile) lo = mid; else hi = mid; }
    return lo;
}
struct GatherRows {
    static constexpr bool kDense = false;
    const bf16_t* base; int ld; const int* pid; int div;
    DI const bf16_t* operator()(int r) const { const int p = pid[r]; return p < 0 ? nullptr : base + (size_t)(p / div) * ld; }
};
template <int BM>
DI void moe_g1_tiles(const Params& P, char* smem, int c, const u16* tstart, int total) {
    const bf16_t* zrow = (const bf16_t*)(P.ws + OFF_ZROW);
    int* pid = (int*)(smem + SM_EXTRA + 1088);
    const int* cnt = (const int*)(P.ws + OFF_CNT) + c * NEXP1;
    const int* list = (const int*)(P.ws + OFF_LIST) + (size_t)c * NEXP1 * CHUNK_T;
    const bf16_t* h2 = (const bf16_t*)(P.ws + OFF_H2) + (size_t)c * CHUNK_T * 1024;
    const bf16_t* wgu = (const bf16_t*)(P.ws + OFF_WGU);
    bf16_t* act = (bf16_t*)(P.ws + OFF_ACT + (size_t)(c & 1) * ACT_BYTES);
    const int lane = threadIdx.x & 63, w = threadIdx.x >> 6, wm = BM == 256 ? (w >> 1) : (w >> 2), wn = BM == 256 ? (w & 1) : (w & 3), l31 = lane & 31, hf = lane >> 5;
    const XPart xp = xcd_part(P.ws, smem, total * 2);
    for (int it = xp.start; it < xp.end; it += xp.step) {
        const int tile = it >> 1, half = it & 1;
        const int e = moe_find_expert(tstart, tile), ti = tile - tstart[e];
        const int n = e < NEXP ? cnt[e] : CHUNK_T;
        const int li0 = BM == 256 ? ti * 256 : (n >> 8) * 256;
        const int srow0 = ((const int*)(smem + SM_BASE))[e] + li0, nvalid = n - li0;
        __syncthreads();
        if (threadIdx.x < BM) { const int li = li0 + threadIdx.x; pid[threadIdx.x] = li < n ? list[(size_t)e * CHUNK_T + li] : -1; }
        __syncthreads();
        GatherRows ar{h2, 1024, pid, NPAIR};
        if constexpr (BM == 256) {
            gemm_dma<true, 256>(smem, ar, wgu + ((size_t)e * 512 + half * 256) * 1024, 1024, 4, 1, zrow, [&](int, const f32x16 (&acc)[2][4]) {
#pragma unroll
                for (int mi = 0; mi < 2; ++mi) {
                    f32x16 t0, t1;
#pragma unroll
                    for (int i = 0; i < 16; ++i) { t0[i] = silu_f(acc[mi][0][i]) * acc[mi][1][i]; t1[i] = silu_f(acc[mi][2][i]) * acc[mi][3][i]; }
                    const int rb = 64 * wm + 32 * mi;
                    bf16_t* abase = act + (size_t)(srow0 + rb) * 256 + 128 * half + 64 * wn;
                    stage_store_chunk(smem, t0, t1, [](int, int, float x) { return x; }, [&](int r) { return rb + r < nvalid ? abase + (size_t)r * 256 : (bf16_t*)nullptr; });
                }
            });
        } else {
            gemm_dma<true, 128>(smem, ar, wgu + ((size_t)e * 512 + half * 256) * 1024, 1024, 4, 1, zrow, [&](int, const f32x16 (&acc)[2][2]) {
#pragma unroll
                for (int mi = 0; mi < 2; ++mi) {
                    const int rw = 64 * wm + 32 * mi + l31;
                    if (rw < nvalid) {
                        bf16_t* arow_ = act + (size_t)(srow0 + rw) * 256 + 128 * half + 32 * wn;
#pragma unroll
                        for (int q4 = 0; q4 < 4; ++q4) {
                            float o[4];
#pragma unroll
                            for (int r = 0; r < 4; ++r) { const float g = acc[mi][0][4 * q4 + r], u = acc[mi][1][4 * q4 + r]; o[r] = silu_f(g) * u; }
                            u32x2 pk; pk[0] = pk2(o[0], o[1]); pk[1] = pk2(o[2], o[3]);
                            *(u32x2*)(arow_ + 8 * q4 + 4 * hf) = pk;
                        }
                    }
                }
            });
        }
    }
}
DI void phase_moe_g1(const Params& P, char* smem, int c) {
    int totalA, totalB;
    moe_build_tiles(P, smem, c, totalA, totalB);
    moe_g1_tiles<256>(P, smem, c, (const u16*)(smem + SM_EXTRA), totalA);
    moe_g1_tiles<128>(P, smem, c, (const u16*)(smem + SM_EXTRA + 528), totalB);
}
template <int BM>
DI void moe_g2_tiles(const Params& P, char* smem, int c, const u16* tstart, int total) {
    const bf16_t* zrow = (const bf16_t*)(P.ws + OFF_ZROW);
    int* pid = (int*)(smem + SM_EXTRA + 1088);
    float* gsm = (float*)(smem + SM_EXTRA + 2112);
    const int* cnt = (const int*)(P.ws + OFF_CNT) + c * NEXP1;
    const int* list = (const int*)(P.ws + OFF_LIST) + (size_t)c * NEXP1 * CHUNK_T;
    const float* gates = (const float*)(P.ws + OFF_GATE) + (size_t)c * CHUNK_T * 8;
    const bf16_t* wd = (const bf16_t*)(P.ws + OFF_WD);
    const bf16_t* act = (const bf16_t*)(P.ws + OFF_ACT + (size_t)(c & 1) * ACT_BYTES);
    bf16_t* y = (bf16_t*)(P.ws + OFF_Y);
    const int lane = threadIdx.x & 63, w = threadIdx.x >> 6, wm = BM == 256 ? (w >> 1) : (w >> 2), wn = BM == 256 ? (w & 1) : (w & 3), l31 = lane & 31;
    const XPart xp = xcd_part(P.ws, smem, total * 2);
    for (int it = xp.start; it < xp.end; it += xp.step) {
        const int tile = it >> 1, half = it & 1;
        const int e = moe_find_expert(tstart, tile), ti = tile - tstart[e];
        const int n = e < NEXP ? cnt[e] : CHUNK_T;
        const int li0 = BM == 256 ? ti * 256 : (n >> 8) * 256;
        const int srow0 = ((const int*)(smem + SM_BASE))[e] + li0, nvalid = n - li0;
        __syncthreads();
        if (threadIdx.x < BM) {
            const int li = li0 + threadIdx.x; const int pp = li < n ? list[(size_t)e * CHUNK_T + li] : -1;
            float g = 1.f;
            if (pp >= 0 && (pp % NPAIR) < 8) g = gates[(size_t)(pp / NPAIR) * 8 + (pp % NPAIR)];
            gsm[threadIdx.x] = g;
        }
        __syncthreads();
        DenseRows ar{act + (size_t)srow0 * 256, 256};
        if constexpr (BM == 256) {
            gemm_dma<true, 256>(smem, ar, wd + ((size_t)e * 1024 + half * 512) * 256, 256, 2, 2, zrow, [&](int t, const f32x16 (&acc)[2][4]) {
#pragma unroll
                for (int mi = 0; mi < 2; ++mi) {
                    const float g = gsm[64 * wm + 32 * mi + l31];
                    const int rb = 64 * wm + 32 * mi;
#pragma unroll
                    for (int pr = 0; pr < 2; ++pr) {
                        const int cb = half * 512 + t * 256 + 128 * wn + 64 * pr;
                        bf16_t* yb = y + (size_t)(srow0 + rb) * 1024 + cb;
                        stage_store_chunk(smem, acc[mi][2 * pr], acc[mi][2 * pr + 1], [&](int, int, float x) { return x * g; }, [&](int r) { return rb + r < nvalid ? yb + (size_t)r * 1024 : (bf16_t*)nullptr; });
                    }
                }
            });
        } else {
            gemm_dma<true, 128>(smem, ar, wd + ((size_t)e * 1024 + half * 512) * 256, 256, 2, 2, zrow, [&](int t, const f32x16 (&acc)[2][2]) {
                const int cb = half * 512 + t * 256 + 64 * wn;
#pragma unroll
                for (int mi = 0; mi < 2; ++mi) {
                    const float g = gsm[64 * wm + 32 * mi + l31];
                    const int rb = 64 * wm + 32 * mi;
                    bf16_t* yb = y + (size_t)(srow0 + rb) * 1024 + cb;
                    stage_store_chunk(smem, acc[mi][0], acc[mi][1], [&](int, int, float x) { return x * g; }, [&](int r) { return rb + r < nvalid ? yb + (size_t)r * 1024 : (bf16_t*)nullptr; });
                }
            });
        }
    }
}
DI void phase_moe_g2(const Params& P, char* smem, int c) {
    int totalA, totalB;
    moe_build_tiles(P, smem, c, totalA, totalB);
    moe_g2_tiles<256>(P, smem, c, (const u16*)(smem + SM_EXTRA), totalA);
    moe_g2_tiles<128>(P, smem, c, (const u16*)(smem + SM_EXTRA + 528), totalB);
}
DI void phase_moe_combine(const Params& P, char* smem, int c) {
    const bf16_t* y = (const bf16_t*)(P.ws + OFF_Y);
    const float* mod = (const float*)(P.ws + OFF_MOD);
    const int* eidx = (const int*)(P.ws + OFF_EIDX);
    const int lane = threadIdx.x & 63, w = threadIdx.x >> 6;
    moe_build_base(P, smem, c);
    const int* bs = (const int*)(smem + SM_BASE);
    for (int tl = blockIdx.x * NW + w; tl < CHUNK_T; tl += gridDim.x * NW) {
        const size_t t = (size_t)c * CHUNK_T + tl;
        const int b = (int)(t >> 13);
        const float* g2 = mod + b * 6144 + 5120;
        int myrow = bs[256] + tl;
        if (lane < 8) { const int ev = eidx[t * 8 + lane]; myrow = bs[ev & 511] + (ev >> 9); }
        const bf16_t* yr[NPAIR];
#pragma unroll
        for (int k = 0; k < NPAIR; ++k) yr[k] = y + (size_t)__builtin_amdgcn_readlane(myrow, k) * 1024;
#pragma unroll
        for (int i = 0; i < 4; ++i) {
            const int col = 256 * i + 4 * lane;
            float s[4] = {0.f, 0.f, 0.f, 0.f};
#pragma unroll
            for (int k = 0; k < NPAIR; ++k) {
                const u32x2 v = *(const u32x2*)(yr[k] + col);
                s[0] += bflo(v[0]); s[1] += bfhi(v[0]); s[2] += bflo(v[1]); s[3] += bfhi(v[1]);
            }
            const f32x4 xv = *(const f32x4*)(P.out + t * 1024 + col);
            const f32x4 gv = *(const f32x4*)(g2 + col);
            f32x4 ov;
#pragma unroll
            for (int r = 0; r < 4; ++r) ov[r] = xv[r] + gv[r] * s[r];
            *(f32x4*)(P.out + t * 1024 + col) = ov;
        }
    }
}

constexpr int NPHASE = 18;
template <int PH, int REP = 0> DI void run_phase(const Params& Pin, char* smem) {
    Params P = Pin;
    { typedef __attribute__((address_space(1))) char gchar; gchar* g = (gchar*)Pin.ws; asm volatile("" : "+s"(g)); P.ws = (char*)g; }
    float* mod = (float*)(P.ws + OFF_MOD);
    if constexpr (PH == 0) phase_adaln(P, smem);
    else if constexpr (PH == 1) { phase_norm(P.x, P.norm1_g, mod, 0, 1024, (bf16_t*)(P.ws + OFF_H)); phase_convert(P, smem); }
    else if constexpr (PH == 2) phase_inproj(P, smem);
    else if constexpr (PH == 3) phase_indexer(P, smem);
    else if constexpr (PH == 4) phase_attn(P, smem, REP);
    else if constexpr (PH == 5) phase_outproj(P, smem);
    else if constexpr (PH == 6) phase_resnorm2(P);
    else if constexpr (PH == 7) phase_router(P, smem);
    else if constexpr (PH == 8) phase_route(P);
    else if constexpr (PH == 9) phase_moe_g1(P, smem, 0);
    else if constexpr (PH == 10) { phase_moe_g2(P, smem, 0); phase_moe_g1(P, smem, 1); }
    else if constexpr (PH == 11) phase_moe_combine(P, smem, 0);
    else if constexpr (PH == 12) { phase_moe_g2(P, smem, 1); phase_moe_g1(P, smem, 2); }
    else if constexpr (PH == 13) phase_moe_combine(P, smem, 1);
    else if constexpr (PH == 14) { phase_moe_g2(P, smem, 2); phase_moe_g1(P, smem, 3); }
    else if constexpr (PH == 15) phase_moe_combine(P, smem, 2);
    else if constexpr (PH == 16) phase_moe_g2(P, smem, 3);
    else if constexpr (PH == 17) phase_moe_combine(P, smem, 3);
}
#ifndef DUP_PHASE
#define DUP_PHASE -1
#endif
#ifndef PROBE_PHASE
#define PROBE_PHASE -1
#endif
#ifndef PROBE_SCALE
#define PROBE_SCALE 0.1f
#endif
#define MK_RUN(PH) if constexpr (P0 <= PH && PH < P1) { \
    unsigned long long t0_ = 0; if constexpr (PH == PROBE_PHASE) t0_ = __builtin_amdgcn_s_memrealtime(); \
    run_phase<PH>(P, smem); if constexpr (PH == DUP_PHASE) { xcd_barrier(bar); run_phase<PH, 1>(P, smem); } \
    if constexpr (PH + 1 < P1 || PH == PROBE_PHASE) xcd_barrier(bar); \
    if constexpr (PH == PROBE_PHASE) { if (blockIdx.x == 0 && threadIdx.x == 0) *(volatile unsigned*)(P.ws + OFF_ERR + 512) = (unsigned)(__builtin_amdgcn_s_memrealtime() - t0_); } }
template <int P0, int P1>
__global__ void __launch_bounds__(NTH, 2) mk_kernel(Params P) {
    __shared__ __attribute__((aligned(16))) char smem[SMEM_BYTES + 16];
    if (threadIdx.x == 0) {
        *(uint4*)(smem + SMEM_BYTES) = make_uint4(0u, 0u, 0u, 0u);
        const int x = (int)xb_xcc_id();
        ((int*)(smem + XC_LDS))[0] = x;
        ((int*)(smem + XC_LDS))[1] = atomicAdd((int*)(P.ws + OFF_XRANK) + x, 1);
    }
    __syncthreads();
    XcdBarrier bar;
    if constexpr (P1 - P0 > 1 || PROBE_PHASE >= 0) bar = xcd_barrier_post((unsigned*)(P.ws + OFF_BAR), (volatile LAS unsigned*)(LAS char*)(smem + SMEM_BYTES));
    MK_RUN(0) MK_RUN(1) MK_RUN(2) MK_RUN(3) MK_RUN(4) MK_RUN(5) MK_RUN(6) MK_RUN(7) MK_RUN(8)
    MK_RUN(9) MK_RUN(10) MK_RUN(11) MK_RUN(12) MK_RUN(13) MK_RUN(14) MK_RUN(15) MK_RUN(16) MK_RUN(17)
    if constexpr (PROBE_PHASE >= 0) {
        xcd_barrier(bar);
        const float us = (float)(*(volatile unsigned*)(P.ws + OFF_ERR + 512)) * 0.01f;
        const float cval = sqrtf(us * PROBE_SCALE);
        for (size_t i = (size_t)blockIdx.x * NTH + threadIdx.x; i < (size_t)NT * 1024 / 4; i += (size_t)gridDim.x * NTH) ((f32x4*)P.out)[i] = (f32x4){cval, cval, cval, cval};
    }
}

template <int P0, int P1> static void launch_range(const Params& p, hipStream_t stream) {
    static int grid = 0;
    if (!grid) {
        int dev = 0, cus = 0, per_cu = 0;
        (void)hipGetDevice(&dev);
        (void)hipDeviceGetAttribute(&cus, hipDeviceAttributeMultiprocessorCount, dev);
        (void)(void)hipOccupancyMaxActiveBlocksPerMultiprocessor(&per_cu, mk_kernel<P0, P1>, NTH, 0);
        if (cus <= 0) cus = 256;
        if (per_cu < 1) per_cu = 1;
        grid = cus * (per_cu < 1 ? 1 : 1);
    }
    mk_kernel<P0, P1><<<dim3(grid), dim3(NTH), 0, stream>>>(p);
}

extern "C" void kernel_launch(void* const* d_in, const int* in_sizes, int n_in, void* d_out, int out_size, void* d_ws, size_t ws_size, hipStream_t stream) {
    if (ws_size < WS_NEED) return;
    if (ws_size < WS_NEED) return;
    Params p{};
    const float** f = (const float**)&p;
    for (int i = 0; i < 26; ++i) f[i] = (const float*)d_in[i];
    p.out = (float*)d_out;
    p.ws = (char*)d_ws;
    (void)hipMemsetAsync(d_ws, 0, ZERO_BYTES, stream);
#if MK_ONE_LAUNCH
    launch_range<0, NPHASE>(p, stream);
#else
    launch_range<0, 1>(p, stream); launch_range<1, 2>(p, stream); launch_range<2, 3>(p, stream); launch_range<3, 4>(p, stream);
    launch_range<4, 5>(p, stream); launch_range<5, 6>(p, stream); launch_range<6, 7>(p, stream); launch_range<7, 8>(p, stream);
    launch_range<8, 9>(p, stream); launch_range<9, 10>(p, stream); launch_range<10, 11>(p, stream); launch_range<11, 12>(p, stream);
    launch_range<12, 13>(p, stream); launch_range<13, 14>(p, stream); launch_range<14, 15>(p, stream); launch_range<15, 16>(p, stream);
    launch_range<16, 17>(p, stream); launch_range<17, 18>(p, stream);
#endif
}
```

```cpp
#include <hip/hip_runtime.h>
#include <stdint.h>

#define DI __device__ __forceinline__
#define LAS __attribute__((address_space(3)))
typedef unsigned short bf16_t;
typedef short bf16x8 __attribute__((ext_vector_type(8)));
typedef short s16x4 __attribute__((ext_vector_type(4)));
typedef float f32x16 __attribute__((ext_vector_type(16)));
typedef float f32x4 __attribute__((ext_vector_type(4)));
typedef float f32x2 __attribute__((ext_vector_type(2)));
typedef __bf16 bf16v2 __attribute__((ext_vector_type(2)));
typedef unsigned u32x4 __attribute__((ext_vector_type(4)));
typedef unsigned u32x2 __attribute__((ext_vector_type(2)));
typedef unsigned long long u64;
#define MFMA32(a, b, c) __builtin_amdgcn_mfma_f32_32x32x16_bf16((a), (b), (c), 0, 0, 0)

constexpr int NB = 8, NS = 8192, ND = 1024, NT = NB * NS;
constexpr int IN_COLS = 3656, NPAD = 3840;
constexpr int NTH = 512, NW = 8;
constexpr int NEXP = 256, NEXP1 = 257;
constexpr int NCHUNK = 4, CHUNK_T = NT / NCHUNK;
constexpr int NPAIR = 9;
constexpr float EPSF = 1e-6f;
constexpr float LOG2E = 1.4426950408889634f;

constexpr size_t MiB = 1048576;
constexpr size_t OFF_BAR = 0;
constexpr size_t OFF_MOD = 16384;
constexpr size_t OFF_CNT = OFF_MOD + 196608;
constexpr size_t OFF_ERR = OFF_CNT + 8192;
constexpr size_t OFF_Q = OFF_ERR;
constexpr size_t OFF_XRANK = OFF_ERR + 128;
constexpr size_t OFF_XQ = OFF_ERR + 256;
constexpr size_t OFF_ITEMS = OFF_ERR + 1024;
constexpr size_t OFF_ZROW = 245760;
constexpr size_t ZERO_BYTES = 262144;
constexpr size_t OFF_WIN = 1 * MiB;
constexpr size_t OFF_WOUT = OFF_WIN + (size_t)NPAD * 1024 * 2;
constexpr size_t OFF_WRT = OFF_WOUT + 2 * MiB;
constexpr size_t OFF_WGU = 12 * MiB;
constexpr size_t OFF_WD = OFF_WGU + (size_t)NEXP1 * 512 * 1024 * 2;
constexpr size_t OFF_R1 = OFF_WD + (size_t)NEXP1 * 1024 * 256 * 2;
constexpr size_t OFF_H = OFF_R1;
constexpr size_t OFF_QD = OFF_H + 128 * MiB;
constexpr size_t OFF_KD = OFF_QD + 64 * MiB;
constexpr size_t OFF_VDT = OFF_KD + 64 * MiB;
constexpr size_t OFF_QS = OFF_VDT + 64 * MiB;
constexpr size_t OFF_KS = OFF_QS + 64 * MiB;
constexpr size_t OFF_VST = OFF_KS + 64 * MiB;
constexpr size_t OFF_IQ = OFF_VST + 64 * MiB;
constexpr size_t OFF_IK = OFF_IQ + 64 * MiB;
constexpr size_t OFF_IW = OFF_IK + 8 * MiB;
constexpr size_t OFF_MASK = OFF_IW + 2 * MiB;
constexpr size_t END_A = OFF_MASK + 64 * MiB;
constexpr size_t OFF_H2 = OFF_R1;
constexpr size_t OFF_LIST = OFF_H2 + 128 * MiB;
constexpr size_t OFF_EIDX = OFF_LIST + (size_t)NCHUNK * NEXP1 * CHUNK_T * 4;
constexpr size_t OFF_GATE = OFF_EIDX + 2 * MiB;
constexpr size_t OFF_ACT = OFF_GATE + 2 * MiB;
constexpr size_t ACT_BYTES = (size_t)CHUNK_T * NPAIR * 256 * 2;
constexpr size_t OFF_Y = OFF_ACT + 2 * ACT_BYTES;
constexpr size_t END_B = OFF_Y + (size_t)CHUNK_T * NPAIR * 1024 * 2;
constexpr size_t WS_NEED = END_A > END_B ? END_A : END_B;

struct Params {
    const float *x, *c, *ada_w, *ada_b, *norm1_g, *norm2_g, *w_in, *dq_g, *dk_g, *lq1, *lk1, *lq2, *lk2, *subln_g, *sq_g, *sk_g, *ik_g,
        *w_out, *router_w, *router_b, *ew_gate, *ew_up, *ew_down, *sw_gate, *sw_up, *sw_down;
    float* out;
    char* ws;
};

DI unsigned pk2(float a, float b) { f32x2 f = {a, b}; bf16v2 r = __builtin_convertvector(f, bf16v2); return __builtin_bit_cast(unsigned, r); }
DI float bf2f(bf16_t v) { return __uint_as_float(((unsigned)v) << 16); }
DI float bflo(unsigned u) { return __uint_as_float(u << 16); }
DI float bfhi(unsigned u) { return __uint_as_float(u & 0xffff0000u); }
DI int crow(int i, int hf) { return (i & 3) + 8 * (i >> 2) + 4 * hf; }
constexpr int LROW = 144;
DI int lofs(int row, int chunk) { return row * LROW + chunk * 16; }
DI float wave_sum(float v) {
#pragma unroll
    for (int d = 32; d >= 1; d >>= 1) v += __shfl_xor(v, d);
    return v;
}
DI float silu_f(float v) { return v / (1.f + __expf(-v)); }

#define XB_TMO      128
#define XB_XCNT(j)  (256  + 64 * (j))
#define XB_XSUB(j)  (1280 + 64 * (j))
#define XB_XGEN(j)  (2304 + 64 * (j))
#define XB_TOP      3328
#define XB_TOPGEN   3392
#define XCD_BAR_WORDS 3456
#define XB_SPIN_CAP (1u << 18)

__device__ __forceinline__ unsigned xb_ld(unsigned* p)              { return __hip_atomic_load(p, __ATOMIC_RELAXED, __HIP_MEMORY_SCOPE_AGENT); }
__device__ __forceinline__ unsigned xb_add(unsigned* p, unsigned v) { return __hip_atomic_fetch_add(p, v, __ATOMIC_RELAXED, __HIP_MEMORY_SCOPE_AGENT); }
__device__ __forceinline__ unsigned xb_xcc_id() { return (unsigned)__builtin_amdgcn_s_getreg((3 << 11) | 20) & 0xFu; }
#define XB_SPIN(cond, bar) do { unsigned _sp = 0; while (cond) { __builtin_amdgcn_s_sleep(1); \
    if ((++_sp & 255u) == 0u) { if (xb_ld(&(bar)[XB_TMO])) break; if (_sp > XB_SPIN_CAP) { atomicAdd(&(bar)[XB_TMO], 1u); break; } } } } while (0)

struct XcdBarrier {
    unsigned* bar; unsigned x;
    volatile LAS unsigned* st;
};
__device__ __forceinline__ XcdBarrier xcd_barrier_post(unsigned* bar, volatile LAS unsigned* st) {
    XcdBarrier b; b.bar = bar; b.x = xb_xcc_id(); b.st = st;
    if (threadIdx.x == 0) (void)xb_add(&bar[XB_XCNT(b.x)], 1u);
    return b;
}
__device__ __forceinline__ void xcd_barrier_complete(unsigned* bar, unsigned x, unsigned& nloc, unsigned& nx) {
    const unsigned G = gridDim.x * gridDim.y * gridDim.z;
    unsigned sum, cnt, mine, sp = 0u;
    for (;;) {
        sum = 0u; cnt = 0u; mine = 0u;
#pragma unroll
        for (unsigned j = 0; j < 16; ++j) { const unsigned c = xb_ld(&bar[XB_XCNT(j)]); sum += c; cnt += (c > 0u) ? 1u : 0u; mine = (j == x) ? c : mine; }
        if (sum == G) break;
        __builtin_amdgcn_s_sleep(1);
        if ((++sp & 255u) == 0u) { if (xb_ld(&bar[XB_TMO])) break; if (sp > XB_SPIN_CAP) { atomicAdd(&bar[XB_TMO], 1u); break; } }
    }
    nloc = mine > 0u ? mine : 1u; nx = cnt > 0u ? cnt : 1u;
}
__device__ __forceinline__ void xcd_barrier(const XcdBarrier& b) {
    asm volatile("s_waitcnt vmcnt(0)" ::: "memory");
    __syncthreads();
    if (threadIdx.x == 0) {
        unsigned* bar = b.bar;
        __builtin_amdgcn_s_waitcnt(0);
        unsigned nloc = b.st[0], nx = b.st[1];
        if (nloc == 0u) { xcd_barrier_complete(bar, b.x, nloc, nx); b.st[0] = nloc; b.st[1] = nx; }
        const unsigned old = xb_add(&bar[XB_XSUB(b.x)], 1u);
        const unsigned gen = old / nloc;
        if (old + 1u == (gen + 1u) * nloc) {
            __builtin_amdgcn_fence(__ATOMIC_RELEASE, "agent");
            asm volatile("s_waitcnt vmcnt(0)" ::: "memory");
            const unsigned og = xb_add(&bar[XB_TOP], 1u);
            const unsigned tg = og / nx;
            if (og + 1u == (tg + 1u) * nx) xb_add(&bar[XB_TOPGEN], 1u);
            else XB_SPIN(xb_ld(&bar[XB_TOPGEN]) == tg, bar);
            __builtin_amdgcn_fence(__ATOMIC_ACQUIRE, "agent");
            xb_add(&bar[XB_XGEN(b.x)], 1u);
            asm volatile("s_waitcnt vmcnt(0)" ::: "memory");
        } else {
            XB_SPIN(xb_ld(&bar[XB_XGEN(b.x)]) == gen, bar);
            __builtin_amdgcn_fence(__ATOMIC_ACQUIRE, "agent");
            asm volatile("s_waitcnt vmcnt(0)" ::: "memory");
        }
    }
    __syncthreads();
}

struct XPart { int start, step, end, grp, ngrp; };
constexpr int XC_LDS = 148480 + 3584;
DI XPart xcd_part(const char* ws, const char* smem, int N) {
    const int x = ((const int*)(smem + XC_LDS))[0], r = ((const int*)(smem + XC_LDS))[1];
    const int* xc = (const int*)(ws + OFF_XRANK);
    int pre = 0, mine = 1, G = 0, grp = 0, ngrp = 0;
#pragma unroll
    for (int j = 0; j < 16; ++j) { const int c = xc[j]; if (j < x) { pre += c; grp += c > 0; } if (j == x) mine = c; G += c; ngrp += c > 0; }
    if (mine < 1) mine = 1; if (G < 1) G = 1;
    const long lo = (long)N * pre / G, hi = (long)N * (pre + mine) / G;
    XPart p; p.start = (int)lo + r; p.step = mine; p.end = (int)hi; p.grp = grp; p.ngrp = ngrp; return p;
}

constexpr int GT_B = 256 * LROW;
constexpr int GT_STAGE = 2 * 256 * LROW;
constexpr int SM_EXTRA = 148480;
constexpr int SM_BASE = SM_EXTRA + 4096;
constexpr int SMEM_BYTES = SM_BASE + 1056;
#define MK_ONE_LAUNCH 1


constexpr int ATT_ITEMS = 4096;
DI int attn_item_cost(int type, int h, int qb) {
    if (type == 0) { const int win = h == 0 ? 2 : h == 1 ? 7 : h == 2 ? 28 : 109; const int tiles = min(2 * qb + 2, win + 2); return (tiles * 6) / 4; }
    const int win = h == 0 ? 1 : h == 1 ? 2 : h == 2 ? 4 : h == 3 ? 7 : h == 4 ? 14 : h == 5 ? 28 : h == 6 ? 55 : 109;
    const int tiles = min(4 * qb + 4, win + 4); return (tiles * 5) / 4;
}
DI int attn_item_code(int i) {
    if (i < 2048) { const int qb = i & 63, h = (i >> 6) & 3, b = i >> 8; return (b << 16) | (h << 8) | qb; }
    const int j = i - 2048; const int qb = j & 31, h = (j >> 5) & 7, b = j >> 8; return (1 << 20) | (b << 16) | (h << 8) | qb;
}
DI void build_attn_items(const Params& P, char* smem) {
    int* hist = (int*)smem;
    int* wsum = hist + 256;
    int* items = (int*)(P.ws + OFF_ITEMS);
    const int tid = threadIdx.x, lane = tid & 63, w = tid >> 6;
    __syncthreads();
    if (tid < 256) hist[tid] = 0;
    __syncthreads();
    for (int i = tid; i < ATT_ITEMS; i += NTH) { const int c = attn_item_code(i); atomicAdd(&hist[255 - min(255, attn_item_cost(c >> 20, (c >> 8) & 255, c & 255))], 1); }
    __syncthreads();
    int n = 0, inc = 0;
    if (tid < 256) {
        n = hist[tid]; inc = n;
#pragma unroll
        for (int d = 1; d < 64; d <<= 1) { const int t = __shfl_up(inc, d); if (lane >= d) inc += t; }
        if (lane == 63) wsum[w] = inc;
    }
    __syncthreads();
    if (tid < 256) {
        int off = 0;
#pragma unroll
        for (int i = 0; i < 4; ++i) if (i < w) off += wsum[i];
        hist[tid] = off + inc - n;
    }
    __syncthreads();
    for (int i = tid; i < ATT_ITEMS; i += NTH) {
        const int c = attn_item_code(i);
        const int pos = atomicAdd(&hist[255 - min(255, attn_item_cost(c >> 20, (c >> 8) & 255, c & 255))], 1);
        items[pos] = c;
    }
    __syncthreads();
}

DI void phase_adaln(const Params& P, char* smem) {
    float* mod = (float*)(P.ws + OFF_MOD);
    float* sc = (float*)smem;
    float* red = sc + 8192;
    const int tid = threadIdx.x;
    if (blockIdx.x == 0) build_attn_items(P, smem);
    __syncthreads();
    for (int i = tid; i < 8192; i += NTH) sc[i] = silu_f(P.c[i]);
    __syncthreads();
    const int kg = tid >> 4, cn = tid & 15;
    for (int it = blockIdx.x; it < 384; it += gridDim.x) {
        const int n = it * 16 + cn;
        float acc[8];
#pragma unroll
        for (int b = 0; b < 8; ++b) acc[b] = 0.f;
#pragma unroll 8
        for (int kk = 0; kk < 32; ++kk) {
            const int k = kg * 32 + kk;
            const float w = P.ada_w[(size_t)k * 6144 + n];
#pragma unroll
            for (int b = 0; b < 8; ++b) acc[b] += sc[b * 1024 + k] * w;
        }
#pragma unroll
        for (int b = 0; b < 8; ++b) red[(kg * 8 + b) * 16 + cn] = acc[b];
        __syncthreads();
        if (tid < 128) {
            const int b = tid >> 4;
            float s = P.ada_b[n];
#pragma unroll
            for (int g = 0; g < 32; ++g) s += red[(g * 8 + b) * 16 + cn];
            mod[b * 6144 + n] = s;
        }
        __syncthreads();
    }
}

DI void phase_norm(const float* __restrict__ xin, const float* __restrict__ g, const float* __restrict__ mod, int sh_off, int sc_off, bf16_t* __restrict__ dst) {
    const int lane = threadIdx.x & 63, w = threadIdx.x >> 6, stride = gridDim.x * NW;
    f32x4 ggv[4], shv[4], scv[4], xa[4];
#pragma unroll
    for (int i = 0; i < 4; ++i) ggv[i] = *(const f32x4*)(g + 256 * i + 4 * lane);
    int row = blockIdx.x * NW + w, bcur = -1;
    if (row < NT) {
#pragma unroll
        for (int i = 0; i < 4; ++i) xa[i] = *(const f32x4*)(xin + (size_t)row * 1024 + 256 * i + 4 * lane);
    }
    for (; row < NT; row += stride) {
        const int b = row >> 13;
        if (b != bcur) {
#pragma unroll
            for (int i = 0; i < 4; ++i) { const int col = 256 * i + 4 * lane; shv[i] = *(const f32x4*)(mod + b * 6144 + sh_off + col); scv[i] = *(const f32x4*)(mod + b * 6144 + sc_off + col); }
            bcur = b;
        }
        f32x4 xb[4];
        const int prow = row + stride < NT ? row + stride : row;
#pragma unroll
        for (int i = 0; i < 4; ++i) xb[i] = *(const f32x4*)(xin + (size_t)prow * 1024 + 256 * i + 4 * lane);
        float ss = 0.f;
#pragma unroll
        for (int i = 0; i < 4; ++i) ss += xa[i][0] * xa[i][0] + xa[i][1] * xa[i][1] + xa[i][2] * xa[i][2] + xa[i][3] * xa[i][3];
        ss = wave_sum(ss);
        const float rstd = rsqrtf(ss * (1.f / 1024.f) + EPSF);
#pragma unroll
        for (int i = 0; i < 4; ++i) {
            const int col = 256 * i + 4 * lane;
            float o[4];
#pragma unroll
            for (int j = 0; j < 4; ++j) o[j] = xa[i][j] * rstd * ggv[i][j] * (1.f + scv[i][j]) + shv[i][j];
            u32x2 pk; pk[0] = pk2(o[0], o[1]); pk[1] = pk2(o[2], o[3]);
            *(u32x2*)(dst + (size_t)row * 1024 + col) = pk;
        }
#pragma unroll
        for (int i = 0; i < 4; ++i) xa[i] = xb[i];
    }
}

DI int gu_row(int f, int is_up) { return (f >> 6) * 128 + (((f >> 5) & 1) * 2 + is_up) * 32 + (f & 31); }
struct CvtDesc { const float* src; bf16_t* dst; int ldsrc, nvalid, k0, n0, ldd, mode; };
constexpr int CVT_WIN = 16 * (NPAD / 64);
constexpr int CVT_SMALL = CVT_WIN + 256 + 64;
constexpr int CVT_ITEMS = CVT_SMALL + NEXP1 * 192;
DI CvtDesc cvt_desc(const Params& P, int it) {
    CvtDesc d;
    if (it < CVT_WIN) { d.src = P.w_in; d.ldsrc = IN_COLS; d.nvalid = IN_COLS; d.k0 = (it & 15) * 64; d.n0 = (it >> 4) * 64; d.dst = (bf16_t*)(P.ws + OFF_WIN); d.ldd = 1024; d.mode = 0; }
    else if (it < CVT_WIN + 256) { const int r = it - CVT_WIN; d.src = P.w_out; d.ldsrc = 1024; d.nvalid = 1024; d.k0 = (r & 15) * 64; d.n0 = (r >> 4) * 64; d.dst = (bf16_t*)(P.ws + OFF_WOUT); d.ldd = 1024; d.mode = 0; }
    else if (it < CVT_SMALL) { const int r = it - CVT_WIN - 256; d.src = P.router_w; d.ldsrc = 256; d.nvalid = 256; d.k0 = (r & 15) * 64; d.n0 = (r >> 4) * 64; d.dst = (bf16_t*)(P.ws + OFF_WRT); d.ldd = 1024; d.mode = 0; }
    else {
        const int r = it - CVT_SMALL, e = r / 192, sub = r % 192;
        if (sub < 128) {
            const int up = sub >> 6, s2 = sub & 63;
            d.src = e < NEXP ? (up ? P.ew_up : P.ew_gate) + (size_t)e * 1024 * 256 : (up ? P.sw_up : P.sw_gate);
            d.ldsrc = 256; d.nvalid = 256; d.k0 = (s2 & 15) * 64; d.n0 = (s2 >> 4) * 64; d.dst = (bf16_t*)(P.ws + OFF_WGU) + (size_t)e * 512 * 1024; d.ldd = 1024; d.mode = 1 + up;
        } else {
            const int s2 = sub - 128;
            d.src = e < NEXP ? P.ew_down + (size_t)e * 256 * 1024 : P.sw_down;
            d.ldsrc = 1024; d.nvalid = 1024; d.k0 = (s2 & 3) * 64; d.n0 = (s2 >> 2) * 64; d.dst = (bf16_t*)(P.ws + OFF_WD) + (size_t)e * 1024 * 256; d.ldd = 256; d.mode = 0;
        }
    }
    return d;
}
DI void phase_convert(const Params& P, char* smem) {
    float* t = (float*)smem;
    const int tid = threadIdx.x, G = gridDim.x;
    for (int it0 = blockIdx.x; it0 < CVT_ITEMS; it0 += 4 * G) {
        float v[4][8];
#pragma unroll
        for (int r = 0; r < 4; ++r) {
            const int it = it0 + r * G;
            if (it < CVT_ITEMS) {
                const CvtDesc d = cvt_desc(P, it);
#pragma unroll
                for (int i = 0; i < 8; ++i) {
                    const int idx = tid + NTH * i, kk = idx >> 6, nn = idx & 63;
                    v[r][i] = (d.n0 + nn < d.nvalid) ? d.src[(size_t)(d.k0 + kk) * d.ldsrc + d.n0 + nn] : 0.f;
                }
            } else {
#pragma unroll
                for (int i = 0; i < 8; ++i) v[r][i] = 0.f;
            }
        }
        __syncthreads();
#pragma unroll
        for (int r = 0; r < 4; ++r)
#pragma unroll
            for (int i = 0; i < 8; ++i) { const int idx = tid + NTH * i; t[r * 4160 + (idx >> 6) * 65 + (idx & 63)] = v[r][i]; }
        __syncthreads();
        const int nn = tid >> 3, kq = (tid & 7) * 8;
#pragma unroll
        for (int r = 0; r < 4; ++r) {
            const int it = it0 + r * G;
            if (it < CVT_ITEMS) {
                const CvtDesc d = cvt_desc(P, it);
                unsigned pk[4];
#pragma unroll
                for (int j = 0; j < 4; ++j) pk[j] = pk2(t[r * 4160 + (kq + 2 * j) * 65 + nn], t[r * 4160 + (kq + 2 * j + 1) * 65 + nn]);
                const int n = d.n0 + nn;
                const int drow = d.mode == 0 ? n : gu_row(n, d.mode - 1);
                *(u32x4*)(d.dst + (size_t)drow * d.ldd + d.k0 + kq) = (u32x4){pk[0], pk[1], pk[2], pk[3]};
            }
        }
    }
}

template <int BM> struct GemmGeo { static constexpr int NI = BM == 256 ? 4 : 2, WN = BM == 256 ? 2 : 4, AP = BM / 64; };
template <bool SWAP, int BM, class AFn, class Epi>
DI void gemm_stream(char* lds, AFn arow, const bf16_t* __restrict__ Bt, int ldb, int nksh, int nsub, Epi epi) {
    constexpr int NI = GemmGeo<BM>::NI, WN = GemmGeo<BM>::WN, AP = GemmGeo<BM>::AP;
    const int tid = threadIdx.x, lane = tid & 63, w = tid >> 6, wm = w / WN, wn = w % WN, l31 = lane & 31, hf = lane >> 5;
    const int nk = 1 << nksh, total = nsub << nksh;
    const int lrow = tid >> 3, lch = tid & 7;
    const bf16_t* ap[AP];
#pragma unroll
    for (int i = 0; i < AP; ++i) { const bf16_t* a = arow(lrow + 64 * i); ap[i] = a ? a + lch * 8 : nullptr; }
    const int so = lofs(lrow, lch);
    const bf16_t* bp = Bt + (size_t)lrow * ldb + lch * 8;
    const size_t bsub = (size_t)256 * ldb, brow64 = (size_t)64 * ldb;
    f32x16 acc[2][NI];
#pragma unroll
    for (int mi = 0; mi < 2; ++mi)
#pragma unroll
        for (int ni = 0; ni < NI; ++ni)
#pragma unroll
            for (int i = 0; i < 16; ++i) acc[mi][ni][i] = 0.f;
    u32x4 ra[AP], rb[4];
    const u32x4 z4 = {0u, 0u, 0u, 0u};
    auto load_part = [&](int s, int part) {
        const int t = s >> nksh, k0 = (s & (nk - 1)) * 64;
        const bf16_t* b0 = bp + t * bsub + k0;
        if (AP == 4) {
            if (part < 2) {
#pragma unroll
                for (int i = 0; i < 2; ++i) { const int q = 2 * part + i; ra[q] = ap[q] ? *(const u32x4*)(ap[q] + k0) : z4; }
            } else {
#pragma unroll
                for (int i = 0; i < 2; ++i) { const int q = 2 * (part - 2) + i; rb[q] = *(const u32x4*)(b0 + q * brow64); }
            }
        } else {
            if (part == 0) {
#pragma unroll
                for (int i = 0; i < AP; ++i) ra[i] = ap[i] ? *(const u32x4*)(ap[i] + k0) : z4;
            } else if (part < 3) {
#pragma unroll
                for (int i = 0; i < 2; ++i) { const int q = 2 * (part - 1) + i; rb[q] = *(const u32x4*)(b0 + q * brow64); }
            }
        }
    };
    auto store = [&](char* stg) {
#pragma unroll
        for (int i = 0; i < AP; ++i) *(u32x4*)(stg + so + i * 64 * LROW) = ra[i];
#pragma unroll
        for (int i = 0; i < 4; ++i) *(u32x4*)(stg + GT_B + so + i * 64 * LROW) = rb[i];
    };
    auto compute = [&](const char* cur, int snext) {
        const char* abase = cur + (64 * wm + l31) * LROW + hf * 16;
        const char* bbase = cur + GT_B + (32 * NI * wn + l31) * LROW + hf * 16;
#pragma unroll
        for (int ks = 0; ks < 4; ++ks) {
            bf16x8 af[2];
#pragma unroll
            for (int mi = 0; mi < 2; ++mi) af[mi] = *(const bf16x8*)(abase + mi * 32 * LROW + ks * 32);
#pragma unroll
            for (int nh = 0; nh < NI / 2; ++nh) {
                bf16x8 bfr[2];
#pragma unroll
                for (int n2 = 0; n2 < 2; ++n2) bfr[n2] = *(const bf16x8*)(bbase + (2 * nh + n2) * 32 * LROW + ks * 32);
#pragma unroll
                for (int mi = 0; mi < 2; ++mi)
#pragma unroll
                    for (int n2 = 0; n2 < 2; ++n2)
                        acc[mi][2 * nh + n2] = SWAP ? MFMA32(bfr[n2], af[mi], acc[mi][2 * nh + n2]) : MFMA32(af[mi], bfr[n2], acc[mi][2 * nh + n2]);
                if (NI == 4 && nh == 0) __builtin_amdgcn_sched_barrier(0);
            }
            __builtin_amdgcn_sched_barrier(0);
            load_part(snext, ks);
            __builtin_amdgcn_sched_barrier(0);
        }
    };
#pragma unroll
    for (int part = 0; part < 4; ++part) load_part(0, part);
    __syncthreads();
    store(lds);
    __syncthreads();
    for (int s = 0; s < total; ++s) {
        char* cur = lds + (s & 1) * GT_STAGE;
        char* nxt = lds + ((s & 1) ^ 1) * GT_STAGE;
        compute(cur, min(s + 1, total - 1));
        if ((s & (nk - 1)) == nk - 1) {
            epi(s >> nksh, acc);
#pragma unroll
            for (int mi = 0; mi < 2; ++mi)
#pragma unroll
                for (int ni = 0; ni < NI; ++ni)
#pragma unroll
                    for (int i = 0; i < 16; ++i) acc[mi][ni][i] = 0.f;
        }
        store(nxt);
        __syncthreads();
    }
}

constexpr int EP_SCR = 131072, EP_WAVE = 16 * 136;
static_assert(EP_SCR + 8 * EP_WAVE <= SM_EXTRA, "LDS layout");
DI int opaque_tid() { int t = threadIdx.x; asm volatile("" : "+v"(t)); return t; }
template <bool PERM16 = false, class XF, class RowPtrFn>
DI void stage_store_chunk(char* smem, const f32x16& a0, const f32x16& a1, XF xf, RowPtrFn rowptr) {
    const int otid = opaque_tid(), lane = otid & 63, w = otid >> 6, l31 = lane & 31, hf = lane >> 5;
    LAS char* scr = (LAS char*)smem + EP_SCR + w * EP_WAVE;
    u32x2 pk[2][4];
#pragma unroll
    for (int n2 = 0; n2 < 2; ++n2)
#pragma unroll
        for (int q4 = 0; q4 < 4; ++q4) {
            const f32x16& a = n2 ? a1 : a0;
            pk[n2][q4][0] = pk2(xf(n2, 4 * q4, a[4 * q4]), xf(n2, 4 * q4 + 1, a[4 * q4 + 1])); pk[n2][q4][1] = pk2(xf(n2, 4 * q4 + 2, a[4 * q4 + 2]), xf(n2, 4 * q4 + 3, a[4 * q4 + 3]));
        }
    const int rr = lane >> 4, c = lane & 15;
    u32x2 d[2][4];
#pragma unroll
    for (int ps = 0; ps < 2; ++ps) {
        if ((l31 >> 4) == ps) {
#pragma unroll
            for (int n2 = 0; n2 < 2; ++n2)
#pragma unroll
                for (int q4 = 0; q4 < 4; ++q4) {
                    const int col = PERM16 ? 32 * n2 + 16 * (q4 >> 1) + 8 * hf + 4 * (q4 & 1) : 32 * n2 + 8 * q4 + 4 * hf;
                    *(LAS u32x2*)(scr + (l31 & 15) * 136 + col * 2) = pk[n2][q4];
                }
        }
        asm volatile("" ::: "memory");
#pragma unroll
        for (int i = 0; i < 4; ++i) d[ps][i] = *(const LAS u32x2*)(scr + (rr + 4 * i) * 136 + c * 8);
        asm volatile("" ::: "memory");
    }
    asm volatile("s_waitcnt lgkmcnt(0)" : "+v"(d[0][0]), "+v"(d[0][1]), "+v"(d[0][2]), "+v"(d[0][3]), "+v"(d[1][0]), "+v"(d[1][1]), "+v"(d[1][2]), "+v"(d[1][3]) :: "memory");
#pragma unroll
    for (int ps = 0; ps < 2; ++ps)
#pragma unroll
        for (int i = 0; i < 4; ++i) {
            bf16_t* g = rowptr(16 * ps + rr + 4 * i);
            if (g) *(u32x2*)(g + c * 4) = d[ps][i];
        }
}

template <bool SWAP, int BM, int NSTORE = 0, class AFn, class Epi>
DI void gemm_dma(char* lds_generic, AFn arow, const bf16_t* __restrict__ Bt, int ldb, int nksh, int nsub, const bf16_t* zrow, Epi epi) {
    constexpr int NI = GemmGeo<BM>::NI, WN = GemmGeo<BM>::WN, NA = BM / 64;
    constexpr int STG = (BM + 256) * 128, BOFF = BM * 128;
    LAS char* lds = (LAS char*)lds_generic;
    const int tid = opaque_tid(), lane = tid & 63, w = tid >> 6, wm = w / WN, wn = w % WN, l31 = lane & 31, hf = lane >> 5;
    const int nh = 1 << nksh, total = nsub * nh;
    typedef const __attribute__((address_space(1))) char* gcp_t;
    const char* wsg = (const char*)zrow - OFF_ZROW;
    auto uni = [](const char* p) { const unsigned long long v = (unsigned long long)p; const unsigned lo = __builtin_amdgcn_readfirstlane((unsigned)v), hi = __builtin_amdgcn_readfirstlane((unsigned)(v >> 32)); return (gcp_t)(((unsigned long long)hi << 32) | lo); };
    const gcp_t wsu = uni(wsg), btu = uni((const char*)Bt);
    unsigned aoff[NA], boff[4];
    const int csw = ((lane & 7) ^ ((4 * (w & 1) + (lane >> 4)) & 7)) * 16;
#pragma unroll
    for (int i = 0; i < NA; ++i) {
        const int row = 8 * (w + 8 * i) + (lane >> 3);
        const bf16_t* a = arow(row);
        aoff[i] = (unsigned)((const char*)(a ? a : zrow) - wsg) + csw;
    }
#pragma unroll
    for (int i = 0; i < 4; ++i) {
        const int row = 8 * (w + 8 * i) + (lane >> 3);
        boff[i] = (unsigned)(row * ldb * 2 + csw);
    }
    const size_t bsub = (size_t)256 * ldb;
    auto dma_a = [&](int k0, LAS char* stg) {
        gcp_t ab = wsu + k0 * 2; asm volatile("" : "+s"(ab));
#pragma unroll
        for (int i = 0; i < NA; ++i) {
            unsigned ao = aoff[i]; asm volatile("" : "+v"(ao));
            __builtin_amdgcn_global_load_lds((const __attribute__((address_space(1))) unsigned*)(ab + ao), (LAS unsigned*)(stg + (w + 8 * i) * 1024), 16, 0, 0);
        }
    };
    auto dma_b = [&](int t, int k0, LAS char* stg) {
        gcp_t bb = btu + (t * bsub + k0) * 2; asm volatile("" : "+s"(bb));
#pragma unroll
        for (int i = 0; i < 4; ++i) {
            unsigned bo = boff[i]; asm volatile("" : "+v"(bo));
            __builtin_amdgcn_global_load_lds((const __attribute__((address_space(1))) unsigned*)(bb + bo), (LAS unsigned*)(stg + BOFF + (w + 8 * i) * 1024), 16, 0, 0);
        }
    };
    auto dma = [&](int hs, int stage) {
        const int t = hs >> nksh, k0 = (hs - (t << nksh)) * 64;
        LAS char* stg = lds + stage * STG;
        dma_a(k0, stg); dma_b(t, k0, stg);
    };
    unsigned o[4];
#pragma unroll
    for (int ks = 0; ks < 4; ++ks) o[ks] = l31 * 128 + (((2 * ks + hf) ^ ((l31 >> 1) & 7)) << 4);
    f32x16 acc[2][NI];
#pragma unroll
    for (int mi = 0; mi < 2; ++mi)
#pragma unroll
        for (int ni = 0; ni < NI; ++ni)
#pragma unroll
            for (int i = 0; i < 16; ++i) acc[mi][ni][i] = 0.f;
    asm volatile("s_waitcnt vmcnt(0) lgkmcnt(0)" ::: "memory");
    __builtin_amdgcn_s_barrier();
    dma(0, 0); dma(1, 1);
    if constexpr (BM == 256) asm volatile("s_waitcnt vmcnt(8)" ::: "memory"); else asm volatile("s_waitcnt vmcnt(6)" ::: "memory");
    __builtin_amdgcn_s_barrier();
    constexpr int NF = 2 + NI;
    const unsigned aofs = (64 * wm) * 128, bofs = (32 * NI * wn) * 128;
    auto rd = [&](bf16x8 (&a)[2], bf16x8 (&b)[NI], unsigned sbase, unsigned ok) {
        const unsigned pa = sbase + aofs + ok, pb = sbase + bofs + ok;
        asm volatile("ds_read_b128 %0, %1" : "=v"(a[0]) : "v"(pa));
        asm volatile("ds_read_b128 %0, %1 offset:4096" : "=v"(a[1]) : "v"(pa));
        asm volatile("ds_read_b128 %0, %1 offset:%2" : "=v"(b[0]) : "v"(pb), "n"(BOFF));
        asm volatile("ds_read_b128 %0, %1 offset:%2" : "=v"(b[1]) : "v"(pb), "n"(BOFF + 4096));
        if constexpr (NI == 4) {
            asm volatile("ds_read_b128 %0, %1 offset:%2" : "=v"(b[2]) : "v"(pb), "n"(BOFF + 8192));
            asm volatile("ds_read_b128 %0, %1 offset:%2" : "=v"(b[3]) : "v"(pb), "n"(BOFF + 12288));
        }
    };
    auto release = [&](bf16x8 (&a)[2], bf16x8 (&b)[NI], bool all) {
        if constexpr (NI == 4) {
            if (all) asm volatile("s_waitcnt lgkmcnt(0)" : "+v"(a[0]), "+v"(a[1]), "+v"(b[0]), "+v"(b[1]), "+v"(b[2]), "+v"(b[3]) :: "memory");
            else asm volatile("s_waitcnt lgkmcnt(6)" : "+v"(a[0]), "+v"(a[1]), "+v"(b[0]), "+v"(b[1]), "+v"(b[2]), "+v"(b[3]) :: "memory");
        } else {
            if (all) asm volatile("s_waitcnt lgkmcnt(0)" : "+v"(a[0]), "+v"(a[1]), "+v"(b[0]), "+v"(b[1]) :: "memory");
            else asm volatile("s_waitcnt lgkmcnt(4)" : "+v"(a[0]), "+v"(a[1]), "+v"(b[0]), "+v"(b[1]) :: "memory");
        }
    };
    auto mma = [&](const bf16x8 (&a)[2], const bf16x8 (&b)[NI]) {
        __builtin_amdgcn_sched_barrier(0);
#pragma unroll
        for (int mi = 0; mi < 2; ++mi)
#pragma unroll
            for (int ni = 0; ni < NI; ++ni)
                acc[mi][ni] = SWAP ? MFMA32(b[ni], a[mi], acc[mi][ni]) : MFMA32(a[mi], b[ni], acc[mi][ni]);
        __builtin_amdgcn_sched_barrier(0);
    };
    const unsigned lds0 = (unsigned)(size_t)lds;
    bf16x8 fa0[2], fb0[NI], fa1[2], fb1[NI];
    rd(fa0, fb0, lds0, o[0]);
    int st = 0;
    bool st_pend = false;
    for (int hs = 0; hs < total; ++hs) {
        const int hs_n = min(hs + 2, total - 1);
        const int t_n = hs_n >> nksh, k0_n = (hs_n - (t_n << nksh)) * 64;
        LAS char* stg = lds + st * STG;
        const unsigned sb = lds0 + st * STG, sbn = lds0 + (st ^ 1) * STG;
        rd(fa1, fb1, sb, o[1]); release(fa0, fb0, false); mma(fa0, fb0);
        rd(fa0, fb0, sb, o[2]); release(fa1, fb1, false); mma(fa1, fb1);
        rd(fa1, fb1, sb, o[3]); release(fa0, fb0, false); mma(fa0, fb0);
        if (NSTORE > 0 && st_pend) asm volatile("s_waitcnt vmcnt(%0)" :: "n"(NSTORE) : "memory"); else asm volatile("s_waitcnt vmcnt(0)" ::: "memory");
        st_pend = false;
        release(fa1, fb1, true);
        __builtin_amdgcn_s_barrier();
        dma_a(k0_n, stg);
        const bool last = ((hs + 1) & (nh - 1)) == 0;
        if (!last) rd(fa0, fb0, sbn, o[0]);
        mma(fa1, fb1);
        dma_b(t_n, k0_n, stg);
        __builtin_amdgcn_sched_barrier(0);
        if (last) {
            epi(hs >> nksh, acc);
#ifdef XP_DUPEPI
            asm volatile("" ::: "memory"); epi(hs >> nksh, acc);
#endif
#pragma unroll
            for (int mi = 0; mi < 2; ++mi)
#pragma unroll
                for (int ni = 0; ni < NI; ++ni)
#pragma unroll
                    for (int i = 0; i < 16; ++i) acc[mi][ni][i] = 0.f;
            rd(fa0, fb0, sbn, o[0]);
            st_pend = true;
        }
        st ^= 1;
    }
    release(fa0, fb0, true);
    asm volatile("s_waitcnt vmcnt(0) lgkmcnt(0)" ::: "memory");
    __builtin_amdgcn_s_barrier();
}

struct DenseRows { static constexpr bool kDense = true; const bf16_t* base; int ld; DI const bf16_t* operator()(int r) const { return base + (size_t)r * ld; } };

DI void epi_rows_bf16(char* smem, const f32x16 (&acc)[2][4], int row0, bf16_t* __restrict__ dst, int ldo, int cb, const float* gain, bool do_norm) {
    const int otid = opaque_tid(), lane = otid & 63, w = otid >> 6, wm = w >> 1, wn = w & 1, hf = lane >> 5;
#pragma unroll
    for (int mi = 0; mi < 2; ++mi)
#pragma unroll
        for (int pr = 0; pr < 2; ++pr) {
            float rstd = 1.f;
            if (do_norm) {
                float ss = 0.f;
#pragma unroll
                for (int n2 = 0; n2 < 2; ++n2)
#pragma unroll
                    for (int i = 0; i < 16; ++i) ss += acc[mi][2 * pr + n2][i] * acc[mi][2 * pr + n2][i];
                ss += __shfl_xor(ss, 32);
                rstd = rsqrtf(ss * (1.f / 64.f) + EPSF);
            }
            bf16_t* base = dst + (size_t)(row0 + 64 * wm + 32 * mi) * ldo + cb + 128 * wn + 64 * pr;
            int zo = 0; asm volatile("" : "+v"(zo));
            const float* gch = gain + zo;
            stage_store_chunk(smem, acc[mi][2 * pr], acc[mi][2 * pr + 1],
                              [&](int n2, int i, float x) { float o = x * rstd; if (do_norm) o *= gch[32 * n2 + crow(i, hf)]; return o; },
                              [&](int r) { return base + (size_t)r * ldo; });
        }
}
DI void epi_vt(char* smem, const f32x16 (&acc)[2][4], int row0, bf16_t* __restrict__ vt, int dv, int nheads, int colbase  ) {
    const int w = opaque_tid() >> 6, wm = w >> 1, wn = w & 1;
    const int b = row0 >> 13, s0 = row0 & (NS - 1);
#pragma unroll
    for (int ni = 0; ni < 4; ++ni) {
        const int c0 = colbase + 128 * wn + 32 * ni;
        bf16_t* base = vt + ((size_t)b * 512 + c0) * NS + s0 + 64 * wm;
        stage_store_chunk<true>(smem, acc[0][ni], acc[1][ni], [](int, int, float x) { return x; }, [&](int r) { return base + (size_t)r * NS; });
    }
}
DI void phase_inproj(const Params& P, char* smem) {
    const bf16_t* zrow = (const bf16_t*)(P.ws + OFF_ZROW);
    const bf16_t* h = (const bf16_t*)(P.ws + OFF_H);
    const bf16_t* win = (const bf16_t*)(P.ws + OFF_WIN);
    float* gl = (float*)(smem + SM_EXTRA);
    __syncthreads();
    {
        const int v = threadIdx.x >> 6, i = threadIdx.x & 63;
        if (v == 0) gl[i] = P.dq_g[i];
        else if (v == 1) gl[64 + i] = P.dk_g[i];
        else if (v == 2) gl[128 + i] = P.sq_g[i];
        else if (v == 3) gl[192 + i] = P.sk_g[i];
        else if (v == 4) gl[256 + i] = P.ik_g[i];
    }
    __syncthreads();
    const XPart xp1 = xcd_part(P.ws, smem, (NT / 256) * 10);
    for (int it = xp1.start; it < xp1.end; it += xp1.step) {
        const int jj = it % 10, mt = it / 10;
        const int j = jj < 4 ? jj : jj < 8 ? jj + 2 : jj + 4;
        const int row0 = mt * 256, grp = j >> 1, cb = (j & 1) * 256;
        DenseRows ar{h + (size_t)row0 * 1024, 1024};
        bf16_t* dst = (bf16_t*)(P.ws + (grp == 0 ? OFF_QD : grp == 1 ? OFF_KD : grp == 3 ? OFF_QS : grp == 4 ? OFF_KS : OFF_IQ));
        const float* gain = gl + 64 * (grp == 0 ? 0 : grp == 1 ? 1 : grp == 3 ? 2 : 3);
        const bool do_norm = grp != 6;
#ifdef XP_DUPEPI
        gemm_dma<true, 256>(smem, ar, win + (size_t)j * 256 * 1024, 1024, 4, 1, zrow, [&](int, const f32x16 (&acc)[2][4]) { epi_rows_bf16(smem, acc, row0, dst, 512, cb, gain, do_norm); asm volatile("" ::: "memory"); epi_rows_bf16(smem, acc, row0, dst, 512, cb, gain, do_norm); });
#else
        gemm_dma<true, 256, 32>(smem, ar, win + (size_t)j * 256 * 1024, 1024, 4, 1, zrow, [&](int, const f32x16 (&acc)[2][4]) { epi_rows_bf16(smem, acc, row0, dst, 512, cb, gain, do_norm); });
#endif
    }
    const XPart xp2 = xcd_part(P.ws, smem, (NT / 256) * 4);
    for (int it = xp2.start; it < xp2.end; it += xp2.step) {
        const int jj = it & 3, mt = it >> 2;
        const int j = jj < 2 ? 4 + jj : 8 + jj;
        const int row0 = mt * 256, cb = (j & 1) * 256;
        DenseRows ar{h + (size_t)row0 * 1024, 1024};
        bf16_t* vt = (bf16_t*)(P.ws + (jj < 2 ? OFF_VDT : OFF_VST));
        const int dv = jj < 2 ? 128 : 64, nh = jj < 2 ? 4 : 8;
        gemm_dma<false, 256, 32>(smem, ar, win + (size_t)j * 256 * 1024, 1024, 4, 1, zrow, [&](int, const f32x16 (&acc)[2][4]) { epi_vt(smem, acc, row0, vt, dv, nh, cb); });
    }
    for (int mt = blockIdx.x; mt < NT / 256; mt += gridDim.x) {
        const int row0 = mt * 256;
        DenseRows ar{h + (size_t)row0 * 1024, 1024};
        gemm_dma<true, 256>(smem, ar, win + (size_t)14 * 256 * 1024, 1024, 4, 1, zrow, [&](int, const f32x16 (&acc)[2][4]) {
            const int otid = opaque_tid(), lane = otid & 63, w = otid >> 6, wm = w >> 1, wn = w & 1, l31 = lane & 31, hf = lane >> 5;
            if (wn == 0) {
                bf16_t* ik = (bf16_t*)(P.ws + OFF_IK);
                float* iw = (float*)(P.ws + OFF_IW);
                const float s = 0.35355339059327373f * 0.125f;
#pragma unroll
                for (int mi = 0; mi < 2; ++mi) {
                    const int tok = row0 + 64 * wm + 32 * mi + l31;
                    float ss = 0.f;
#pragma unroll
                    for (int ni = 0; ni < 2; ++ni)
#pragma unroll
                        for (int i = 0; i < 16; ++i) ss += acc[mi][ni][i] * acc[mi][ni][i];
                    ss += __shfl_xor(ss, 32);
                    const float rstd = rsqrtf(ss * (1.f / 64.f) + EPSF);
#pragma unroll
                    for (int ni = 0; ni < 2; ++ni)
#pragma unroll
                        for (int q4 = 0; q4 < 4; ++q4) {
                            const int f = 32 * ni + 8 * q4 + 4 * hf;
                            float o[4];
#pragma unroll
                            for (int r = 0; r < 4; ++r) o[r] = acc[mi][ni][4 * q4 + r] * rstd * gl[256 + f + r];
                            u32x2 pk; pk[0] = pk2(o[0], o[1]); pk[1] = pk2(o[2], o[3]);
                            *(u32x2*)(ik + ((((size_t)(tok >> 5) * 4 + (2 * ni + (q4 >> 1))) * 64 + 32 * (q4 & 1) + (tok & 31)) * 8 + 4 * hf)) = pk;
                        }
                    f32x4 o = {acc[mi][2][0] * s, acc[mi][2][1] * s, acc[mi][2][2] * s, acc[mi][2][3] * s};
                    *(f32x4*)(iw + (size_t)tok * 8 + 4 * hf) = o;
                }
            }
        });
    }
}

constexpr int TK_CAP = 512, TK_HI = 448;
template <int NPASS>
DI unsigned topk_prune(volatile LAS unsigned* buf, volatile LAS unsigned* hist, int cnt, int& kept) {
    const int lane = threadIdx.x & 63;
    unsigned e[8];
#pragma unroll
    for (int i = 0; i < 8; ++i) { const int idx = lane + 64 * i; e[i] = idx < cnt ? buf[idx] : 0u; }
    unsigned prefix = 0u, want = 256u;
#pragma unroll
    for (int p = 3; p >= 4 - NPASS; --p) {
        const int sh = 8 * p;
#pragma unroll
        for (int j = 0; j < 4; ++j) hist[4 * lane + j] = 0u;
        asm volatile("" ::: "memory");
#pragma unroll
        for (int i = 0; i < 8; ++i) {
            const bool m = (e[i] != 0u) && (p == 3 || (e[i] >> (sh + 8)) == prefix);
            if (m) __hip_atomic_fetch_add((LAS unsigned*)&hist[(e[i] >> sh) & 255u], 1u, __ATOMIC_RELAXED, __HIP_MEMORY_SCOPE_WORKGROUP);
        }
        asm volatile("" ::: "memory");
        const unsigned h0 = hist[4 * lane], h1 = hist[4 * lane + 1], h2 = hist[4 * lane + 2], h3 = hist[4 * lane + 3];
        const unsigned s4 = h0 + h1 + h2 + h3;
        int suf_i = (int)s4;
        suf_i += __builtin_amdgcn_update_dpp(0, suf_i, 0x101, 0xf, 0xf, true);
        suf_i += __builtin_amdgcn_update_dpp(0, suf_i, 0x102, 0xf, 0xf, true);
        suf_i += __builtin_amdgcn_update_dpp(0, suf_i, 0x104, 0xf, 0xf, true);
        suf_i += __builtin_amdgcn_update_dpp(0, suf_i, 0x108, 0xf, 0xf, true);
        const int t1 = __builtin_amdgcn_readlane(suf_i, 16), t2 = __builtin_amdgcn_readlane(suf_i, 32), t3 = __builtin_amdgcn_readlane(suf_i, 48);
        const int row = lane >> 4;
        const unsigned suf = (unsigned)(suf_i + (row == 0 ? t1 + t2 + t3 : row == 1 ? t2 + t3 : row == 2 ? t3 : 0));
        const unsigned above = suf - s4;
        const bool own = (above < want) && (want <= suf);
        unsigned bsel = 0u, cum = above;
        if (cum + h3 >= want) bsel = 3u;
        else { cum += h3; if (cum + h2 >= want) bsel = 2u; else { cum += h2; if (cum + h1 >= want) bsel = 1u; else { cum += h1; bsel = 0u; } } }
        const u64 om = __builtin_amdgcn_ballot_w64(own);
        const int ol = om ? (int)__builtin_ctzll(om) : 0;
        const unsigned bin = (unsigned)__builtin_amdgcn_readlane((int)(4u * lane + bsel), ol);
        const unsigned cm = (unsigned)__builtin_amdgcn_readlane((int)cum, ol);
        prefix = (prefix << 8) | bin; want -= cm;
    }
    const unsigned V = NPASS == 4 ? prefix : (prefix << 16);
    int base = 0;
#pragma unroll
    for (int i = 0; i < 8; ++i) {
        const bool keep = (e[i] != 0u) && (e[i] >= V);
        const u64 mk = __ballot(keep);
        const int pos = base + __builtin_popcountll(mk & ((1ull << lane) - 1ull));
        if (keep) buf[pos] = e[i];
        base += __builtin_popcountll(mk);
    }
    asm volatile("" ::: "memory");
    kept = base;
    return NPASS == 4 ? V : (V ? V - 1u : 0u);
}

DI void indexer_item(const Params& P, char* smem, int b, int q0) {
    const int lane = threadIdx.x & 63, w = __builtin_amdgcn_readfirstlane(threadIdx.x >> 6), l31 = lane & 31, hf = lane >> 5;
    const int qbase = q0 + 8 * w;
    const bf16_t* IQ = (const bf16_t*)(P.ws + OFF_IQ);
    const bf16_t* IK = (const bf16_t*)(P.ws + OFF_IK);
    const float* IW = (const float*)(P.ws + OFF_IW);
    volatile LAS unsigned* buf = (volatile LAS unsigned*)(LAS char*)(smem + w * 8 * 2048);
    volatile LAS unsigned* hist = (volatile LAS unsigned*)(LAS char*)(smem + 131072 + w * 1024);
    bf16x8 af[2][4];
    {
        const int m = l31, qs = 2 * ((m >> 2) & 1) + (m >> 4), head = 4 * ((m >> 3) & 1) + (m & 3);
#pragma unroll
        for (int mt = 0; mt < 2; ++mt) {
            const size_t tok = (size_t)b * NS + qbase + 4 * mt + qs;
#pragma unroll
            for (int ks = 0; ks < 4; ++ks) af[mt][ks] = *(const bf16x8*)(IQ + tok * 512 + head * 64 + ks * 16 + hf * 8);
        }
    }
    float iwv[2][2][8]; int qpos[2][2]; unsigned tau[2][2]; int cnt[2][2];
#pragma unroll
    for (int mt = 0; mt < 2; ++mt)
#pragma unroll
        for (int j = 0; j < 2; ++j) {
            qpos[mt][j] = qbase + 4 * mt + 2 * hf + j; tau[mt][j] = 0u; cnt[mt][j] = 0;
            const float* p = IW + ((size_t)b * NS + qpos[mt][j]) * 8;
            const f32x4 a = *(const f32x4*)p, c = *(const f32x4*)(p + 4);
#pragma unroll
            for (int r = 0; r < 4; ++r) { iwv[mt][j][r] = a[r]; iwv[mt][j][4 + r] = c[r]; }
        }
    const int nkt = ((qbase + 7) >> 6) + 1;
    const bf16_t* ikb = IK + (size_t)b * NS * 64 + (size_t)lane * 8;
    bf16x8 bfr[2][4];
#pragma unroll
    for (int sb = 0; sb < 2; ++sb)
#pragma unroll
        for (int ks = 0; ks < 4; ++ks) bfr[sb][ks] = *(const bf16x8*)(ikb + (size_t)(sb * 4 + ks) * 512);
#pragma unroll 2
    for (int kt = 0; kt < nkt; ++kt) {
        bf16x8 bn[2][4];
        {
            const int kn = min(kt + 1, nkt - 1) * 64;
#ifdef XP_DUPIKLOAD
#pragma unroll
            for (int sb = 0; sb < 2; ++sb)
#pragma unroll
                for (int ks = 0; ks < 4; ++ks) { bf16x8 t = __builtin_nontemporal_load((const bf16x8*)(ikb + (size_t)kn * 64 + (size_t)(sb * 4 + ks) * 512)); asm volatile("" : "+v"(t)); }
#endif
#pragma unroll
            for (int sb = 0; sb < 2; ++sb)
#pragma unroll
                for (int ks = 0; ks < 4; ++ks) bn[sb][ks] = *(const bf16x8*)(ikb + (size_t)kn * 64 + (size_t)(sb * 4 + ks) * 512);
        }
#pragma unroll
        for (int sb = 0; sb < 2; ++sb) {
            const int k0 = kt * 64 + 32 * sb;
            if (k0 > qbase + 7) continue;
            const bool needcausal = k0 + 31 > qbase;
            f32x16 acc[2];
#pragma unroll
            for (int mt = 0; mt < 2; ++mt) {
#pragma unroll
                for (int i = 0; i < 16; ++i) acc[mt][i] = 0.f;
#pragma unroll
                for (int ks = 0; ks < 4; ++ks) acc[mt] = MFMA32(af[mt][ks], bfr[sb][ks], acc[mt]);
#ifdef XP_DUPIDXMFMA
                { f32x16 z; for (int i = 0; i < 16; ++i) z[i] = 0.f;
                  for (int ks = 0; ks < 4; ++ks) z = MFMA32(af[mt][ks], bfr[sb][ks], z);
                  asm volatile("" : "+v"(z)); }
#endif
            }
            const int kidx = k0 + l31;
#pragma unroll
            for (int mt = 0; mt < 2; ++mt)
#pragma unroll
                for (int j = 0; j < 2; ++j) {
                    float s = 0.f;
#ifdef XP_DUPSCORE
                    { float s2 = 0.f;
#pragma unroll
                      for (int t = 0; t < 8; ++t) s2 = __builtin_fmaf(iwv[mt][j][t], __int_as_float(max(__float_as_int(acc[mt][8 * j + t]), 0)), s2);
                      asm volatile("" : "+v"(s2)); s = s2 * 0.f; }
#endif
#pragma unroll
                    for (int t = 0; t < 8; ++t)
                        s = __builtin_fmaf(iwv[mt][j][t], __int_as_float(max(__float_as_int(acc[mt][8 * j + t]), 0)), s);
                    const int si = __float_as_int(s);
                    const unsigned ord = (unsigned)si ^ ((unsigned)(si >> 31) | 0x80000000u);
                    const unsigned pk = (ord & 0xFFFFE000u) | (unsigned)(8191 - kidx);
                    const bool pass = needcausal ? ((kidx <= qpos[mt][j]) && (pk > tau[mt][j])) : (pk > tau[mt][j]);
                    const u64 mk = __builtin_amdgcn_ballot_w64(pass);
                    const unsigned hm = hf ? (unsigned)(mk >> 32) : (unsigned)mk;
                    const int pos = cnt[mt][j] + __builtin_popcount(hm & ((1u << l31) - 1u));
                    { const int widx = pass ? (4 * mt + 2 * hf + j) * TK_CAP + pos : (int)(hist - buf) + lane; buf[widx] = pk; }
#ifdef XP_DUPAPPEND
                    {
                        unsigned pk2v = pk; asm volatile("" : "+v"(pk2v));
                        const bool pass2 = needcausal ? ((kidx <= qpos[mt][j]) && (pk2v > tau[mt][j])) : (pk2v > tau[mt][j]);
                        const u64 mk2 = __builtin_amdgcn_ballot_w64(pass2);
                        const unsigned hm2 = hf ? (unsigned)(mk2 >> 32) : (unsigned)mk2;
                        const int pos2 = cnt[mt][j] + __builtin_popcount(hm2 & ((1u << l31) - 1u));
                        if (pass2) buf[(4 * mt + 2 * hf + j) * TK_CAP + pos2] = pk2v;
                    }
#endif
                    cnt[mt][j] += __builtin_popcount(hm);
                }
        }
        const bool anyhi = cnt[0][0] > TK_HI || cnt[0][1] > TK_HI || cnt[1][0] > TK_HI || cnt[1][1] > TK_HI;
        if (__ballot(anyhi) != 0ull) {
#pragma unroll 1
            for (int s8 = 0; s8 < 8; ++s8) {
                const int mt = s8 >> 2, j = (s8 >> 1) & 1, h2 = s8 & 1;
                const int cv = mt ? (j ? cnt[1][1] : cnt[1][0]) : (j ? cnt[0][1] : cnt[0][0]);
                const int c = __builtin_amdgcn_readlane(cv, 32 * h2);
                if (c > TK_HI) {
                    volatile LAS unsigned* qb = buf + (4 * mt + 2 * h2 + j) * TK_CAP;
                    int nk = 0;
                    unsigned V = topk_prune<2>(qb, hist, c, nk);
#ifdef XP_DUPPRUNE
                    V = topk_prune<2>(qb, hist, nk, nk);
#endif
                    if (nk > TK_HI - 64) V = topk_prune<4>(qb, hist, nk, nk);
#pragma unroll
                    for (int a = 0; a < 2; ++a)
#pragma unroll
                        for (int d = 0; d < 2; ++d)
                            if (hf == h2 && a == mt && d == j) { tau[a][d] = V; cnt[a][d] = nk; }
                }
            }
        }
#pragma unroll
        for (int sb = 0; sb < 2; ++sb)
#pragma unroll
            for (int ks = 0; ks < 4; ++ks) bfr[sb][ks] = bn[sb][ks];
    }
#pragma unroll 1
    for (int s8 = 0; s8 < 8; ++s8) {
        const int mt = s8 >> 2, j = (s8 >> 1) & 1, h2 = s8 & 1;
        const int cv = mt ? (j ? cnt[1][1] : cnt[1][0]) : (j ? cnt[0][1] : cnt[0][0]);
        int c = __builtin_amdgcn_readlane(cv, 32 * h2);
        volatile LAS unsigned* qb = buf + (4 * mt + 2 * h2 + j) * TK_CAP;
        if (c > 256) { int nk = 0; (void)topk_prune<4>(qb, hist, c, nk); c = nk; }
#pragma unroll
        for (int t = 0; t < 4; ++t) qb[256 + 4 * lane + t] = 0u;
        asm volatile("" ::: "memory");
#pragma unroll
        for (int t = 0; t < 4; ++t) {
            const int idx = lane + 64 * t;
            if (idx < c) {
                const unsigned e = qb[idx]; const unsigned kk = 8191u - (e & 8191u);
                __hip_atomic_fetch_or((LAS unsigned*)&qb[256 + (kk >> 5)], 1u << (kk & 31u), __ATOMIC_RELAXED, __HIP_MEMORY_SCOPE_WORKGROUP);
            }
        }
        asm volatile("" ::: "memory");
    }
    u64* mask = (u64*)(P.ws + OFF_MASK);
    const int ktmax = (q0 | 255) >> 6;
    const int qi = lane & 7;
#pragma unroll 1
    for (int it = 0; it < 16; ++it) {
        const int kt = it * 8 + (lane >> 3);
        if (kt <= ktmax) {
            const unsigned lo = buf[qi * TK_CAP + 256 + 2 * kt], hi = buf[qi * TK_CAP + 256 + 2 * kt + 1];
            mask[((size_t)(b * 128 + kt)) * NS + qbase + qi] = ((u64)hi << 32) | lo;
        }
    }
}

constexpr int AT_K = 64 * LROW;
constexpr int AT_DSTAGE = 4 * AT_K;
template <int NDB, bool BM>
DI void attn_tile(const LAS char* Kt, const LAS char* Vt, const bf16x8 (&qf)[4], f32x16 (&o)[NDB], float off, float& mlow, float& lrun,
                  int qpos, int k0, float c1, float c2, bool diag, bool scan, u64 mword) {
    const int lane = threadIdx.x & 63, l31 = lane & 31, hf = lane >> 5;
    const int lanex = ((((l31 >> 1) & 7) ^ hf) << 4);
    const LAS char* kbase = Kt + l31 * 128;
    const LAS char* vbase = Vt + l31 * 128;
    const float bias0 = -c2 * (float)(qpos - k0 - 4 * hf) - off;
#pragma unroll 1
    for (int kbi = 0; kbi < 2; ++kbi) {
        const int kb = 1 - kbi;
        f32x16 st;
#pragma unroll
        for (int i = 0; i < 16; ++i) st[i] = 0.f;
#pragma unroll
        for (int ks = 0; ks < 4; ++ks) {
            const bf16x8 kf = *(const LAS bf16x8*)(kbase + kb * 4096 + (lanex ^ (ks << 5)));
            st = MFMA32(kf, qf[ks], st);
        }
        const unsigned mw = BM ? (unsigned)((kb ? (unsigned)(mword >> 32) : (unsigned)mword) >> (4 * hf)) : 0u;
        const float noff = bias0 + c2 * (float)(32 * kb);
        float ls = 0.f, mx = -INFINITY;
#pragma unroll
        for (int i = 0; i < 16; ++i) {
            const int ko = (i & 3) + 8 * (i >> 2);
            const float v = __builtin_fmaf(st[i], c1, __builtin_fmaf(c2, (float)ko, noff));
            bool ok = true;
            if (BM) ok = (mw >> ko) & 1u;
            if (diag) ok = ok && (k0 + 32 * kb + ko + 4 * hf <= qpos);
            float p = __builtin_amdgcn_exp2f(v);
            if (BM || diag) p = ok ? p : 0.f;
            if (scan) mx = fmaxf(mx, (BM || diag) ? (ok ? v : -INFINITY) : v);
            st[i] = p; ls += p;
        }
#ifdef XP_DUPSOFTMAX
        {
            float ls2 = 0.f;
#pragma unroll
            for (int i = 0; i < 16; ++i) {
                const int ko = (i & 3) + 8 * (i >> 2);
                float x = st[i]; asm volatile("" : "+v"(x));
                const float v = __builtin_fmaf(x, c1, __builtin_fmaf(c2, (float)ko, noff));
                ls2 += __builtin_amdgcn_exp2f(v);
            }
            asm volatile("" : "+v"(ls2));
            ls += ls2 * 0.f;
        }
#endif
        lrun += ls;
        if (scan) { mx = fmaxf(mx, __shfl_xor(mx, 32)); mlow = fmaxf(mlow, mx + off); }
        const int vx = lanex ^ (kb << 6);
#pragma unroll
        for (int s = 0; s < 2; ++s) {
            u32x4 pp;
#pragma unroll
            for (int t = 0; t < 4; ++t) pp[t] = pk2(st[8 * s + 2 * t], st[8 * s + 2 * t + 1]);
            const bf16x8 pf = __builtin_bit_cast(bf16x8, pp);
#pragma unroll
            for (int db = 0; db < NDB; ++db) {
                const bf16x8 vf = *(const LAS bf16x8*)(vbase + db * 4096 + (vx ^ (s << 5)));
                o[db] = MFMA32(vf, pf, o[db]);
            }
        }
    }
}

constexpr int AT_NST = 4;

DI void diffattn_item(const Params& P, char* smem, int b, int h, int qb) {
    const int tid = threadIdx.x, lane = tid & 63, w = __builtin_amdgcn_readfirstlane(tid >> 6), l31 = lane & 31, hf = lane >> 5;
    const int map = w & 1, qsub = w >> 1;
    const int q0 = qb * 128;
    LAS char* lds = (LAS char*)smem;
    const bf16_t* Qd = (const bf16_t*)(P.ws + OFF_QD);
    const bf16_t* Kd = (const bf16_t*)(P.ws + OFF_KD);
    const bf16_t* VdT = (const bf16_t*)(P.ws + OFF_VDT);
    const int qpos = q0 + 32 * qsub + l31;
    bf16x8 qf[4];
#pragma unroll
    for (int ks = 0; ks < 4; ++ks) qf[ks] = *(const bf16x8*)(Qd + ((size_t)b * NS + qpos) * 512 + h * 128 + map * 64 + ks * 16 + hf * 8);
    const float slope = exp2f(-2.f * (float)(h + 1));
    const float c1 = 0.125f * LOG2E, c2 = slope * LOG2E;
    float gq = fabsf(P.dq_g[lane]), gk = fabsf(P.dk_g[lane]);
#pragma unroll
    for (int d = 32; d >= 1; d >>= 1) { gq = fmaxf(gq, __shfl_xor(gq, d)); gk = fmaxf(gk, __shfl_xor(gk, d)); }
    const float B2 = 64.f * gq * gk * 1.008f * c1;
    int* flags = (int*)(smem + SM_EXTRA + 3072);
    int par = 0;
    f32x16 o[4];
#pragma unroll
    for (int db = 0; db < 4; ++db)
#pragma unroll
        for (int i = 0; i < 16; ++i) o[db][i] = 0.f;
    float mlow = -INFINITY, lrun = 0.f;
    int ndone = 0;
    const int drow = 8 * w + (lane >> 3), dch = (lane & 7) ^ ((drow >> 1) & 7);
    const bf16_t* ksrc = Kd + ((size_t)b * NS + drow) * 512 + h * 128 + dch * 8;
    const bf16_t* vsrc = VdT + ((size_t)(b * 4 + h) * 128 + drow) * NS + dch * 8;
    auto dma = [&](int kt, int stage) {
        LAS char* stg = lds + stage * 32768;
        const size_t k0 = (size_t)kt * 64;
        __builtin_amdgcn_global_load_lds((const unsigned*)(ksrc + k0 * 512), (LAS unsigned*)(stg + w * 1024), 16, 0, 0);
        __builtin_amdgcn_global_load_lds((const unsigned*)(ksrc + k0 * 512 + 64), (LAS unsigned*)(stg + 8192 + w * 1024), 16, 0, 0);
        __builtin_amdgcn_global_load_lds((const unsigned*)(vsrc + k0), (LAS unsigned*)(stg + 16384 + w * 1024), 16, 0, 0);
        __builtin_amdgcn_global_load_lds((const unsigned*)(vsrc + (size_t)64 * NS + k0), (LAS unsigned*)(stg + 16384 + 8192 + w * 1024), 16, 0, 0);
#ifdef XP_DUPDMA
        __builtin_amdgcn_global_load_lds((const unsigned*)(ksrc + k0 * 512), (LAS unsigned*)(stg + w * 1024), 16, 0, 0);
        __builtin_amdgcn_global_load_lds((const unsigned*)(ksrc + k0 * 512 + 64), (LAS unsigned*)(stg + 8192 + w * 1024), 16, 0, 0);
        __builtin_amdgcn_global_load_lds((const unsigned*)(vsrc + k0), (LAS unsigned*)(stg + 16384 + w * 1024), 16, 0, 0);
        __builtin_amdgcn_global_load_lds((const unsigned*)(vsrc + (size_t)64 * NS + k0), (LAS unsigned*)(stg + 16384 + 8192 + w * 1024), 16, 0, 0);
#endif
    };
    const int ktd = 2 * qb + 1;
    const int qwmax = q0 + 32 * qsub + 31, qwmin = q0 + 32 * qsub;
#ifdef XP_DUPLOOP
  for (int rep = 0; rep < 2; ++rep) {
    if (rep) { for (int db = 0; db < 4; ++db) for (int i = 0; i < 16; ++i) o[db][i] = 0.f; mlow = -INFINITY; lrun = 0.f; ndone = 0; par = 0; }
#endif
    asm volatile("s_waitcnt vmcnt(0) lgkmcnt(0)" ::: "memory");
    __builtin_amdgcn_s_barrier();
    dma(max(ktd, 0), 0); dma(max(ktd - 1, 0), 1); dma(max(ktd - 2, 0), 2);
    for (int j = 0; j <= ktd; ++j) {
        const int kt = ktd - j, k0 = kt * 64;
#ifdef XP_DUPDMA
        asm volatile("s_waitcnt vmcnt(16)" ::: "memory");
#else
        asm volatile("s_waitcnt vmcnt(8)" ::: "memory");
#endif
        asm volatile("s_waitcnt lgkmcnt(0)" ::: "memory");
        __builtin_amdgcn_s_barrier();
        int allstop = 0;
        if (j > 0) { allstop = 1;
#pragma unroll
            for (int i = 0; i < 8; ++i) allstop &= flags[(par ^ 1) * 8 + i]; }
        if (allstop) break;
        dma(max(kt - 3, 0), (j + 3) & 3);
        const LAS char* cur = lds + (j & 3) * 32768;
        if (k0 <= qwmax) {
            attn_tile<4, false>(cur + map * 8192, cur + 16384, qf, o, B2, mlow, lrun, qpos, k0, c1, c2, k0 + 63 > qwmin, ndone < 2, 0ull);
            ++ndone;
        }
        {
            const float ub = B2 - c2 * (float)(qpos - (k0 - 1));
            const bool stop = __all(ub < mlow - 30.f);
            if (lane == 0) flags[par * 8 + w] = stop ? 1 : 0;
        }
        par ^= 1;
    }
    asm volatile("s_waitcnt vmcnt(0) lgkmcnt(0)" ::: "memory");
    __builtin_amdgcn_s_barrier();
#ifdef XP_DUPLOOP
  }
#endif
    const float ltot = lrun + __shfl_xor(lrun, 32);
    const float inv = 1.f / ltot;
    float la, lb;
    { const float a = P.lq1[lane] * P.lk1[lane], c = P.lq2[lane] * P.lk2[lane]; la = wave_sum(a); lb = wave_sum(c); }
    const float lam = __expf(la) - __expf(lb) + 0.2f;
    float* X = (float*)smem;
    if (map == 1) {
#pragma unroll
        for (int db = 0; db < 4; ++db)
#pragma unroll
            for (int q4 = 0; q4 < 4; ++q4) {
                f32x4 v;
#pragma unroll
                for (int r = 0; r < 4; ++r) v[r] = o[db][4 * q4 + r] * inv * lam;
                *(f32x4*)(X + (qsub * 32 + l31) * 132 + 32 * db + 8 * q4 + 4 * hf) = v;
            }
    }
    __syncthreads();
    if (map == 0) {
        float ss = 0.f;
#pragma unroll
        for (int db = 0; db < 4; ++db)
#pragma unroll
            for (int q4 = 0; q4 < 4; ++q4) {
                const f32x4 v2 = *(const f32x4*)(X + (qsub * 32 + l31) * 132 + 32 * db + 8 * q4 + 4 * hf);
#pragma unroll
                for (int r = 0; r < 4; ++r) { const float v = o[db][4 * q4 + r] * inv - v2[r]; o[db][4 * q4 + r] = v; ss += v * v; }
            }
        ss += __shfl_xor(ss, 32);
        const float rstd = rsqrtf(ss * (1.f / 128.f) + EPSF) * 0.8f;
        bf16_t* ao = (bf16_t*)(P.ws + OFF_H) + ((size_t)b * NS + qpos) * 1024 + h * 128;
#pragma unroll
        for (int db = 0; db < 4; ++db)
#pragma unroll
            for (int q4 = 0; q4 < 4; ++q4) {
                const int d = 32 * db + 8 * q4 + 4 * hf;
                const f32x4 g = *(const f32x4*)((const float*)(smem + SM_EXTRA + 1024) + d);
                u32x2 pk; pk[0] = pk2(o[db][4 * q4] * rstd * g[0], o[db][4 * q4 + 1] * rstd * g[1]); pk[1] = pk2(o[db][4 * q4 + 2] * rstd * g[2], o[db][4 * q4 + 3] * rstd * g[3]);
                *(u32x2*)(ao + d) = pk;
            }
    }
    __syncthreads();
}

DI void dsa_item(const Params& P, char* smem, int b, int h, int qb) {
    const int tid = threadIdx.x, lane = tid & 63, w = __builtin_amdgcn_readfirstlane(tid >> 6), l31 = lane & 31, hf = lane >> 5;
    const int q0 = qb * 256;
    LAS char* lds = (LAS char*)smem;
    const bf16_t* Qs = (const bf16_t*)(P.ws + OFF_QS);
    const bf16_t* Ks = (const bf16_t*)(P.ws + OFF_KS);
    const bf16_t* VsT = (const bf16_t*)(P.ws + OFF_VST);
    const u64* mask = (const u64*)(P.ws + OFF_MASK);
    const int qpos = q0 + 32 * w + l31;
    bf16x8 qf[4];
#pragma unroll
    for (int ks = 0; ks < 4; ++ks) qf[ks] = *(const bf16x8*)(Qs + ((size_t)b * NS + qpos) * 512 + h * 64 + ks * 16 + hf * 8);
    const float slope = exp2f(-(float)(h + 1));
    const float c1 = 0.125f * LOG2E, c2 = slope * LOG2E;
    float gq = fabsf(P.sq_g[lane]), gk = fabsf(P.sk_g[lane]);
#pragma unroll
    for (int d = 32; d >= 1; d >>= 1) { gq = fmaxf(gq, __shfl_xor(gq, d)); gk = fmaxf(gk, __shfl_xor(gk, d)); }
    const float B2 = 64.f * gq * gk * 1.008f * c1;
    int* flags = (int*)(smem + SM_EXTRA + 3072);
    int par = 0;
    f32x16 o[2];
#pragma unroll
    for (int db = 0; db < 2; ++db)
#pragma unroll
        for (int i = 0; i < 16; ++i) o[db][i] = 0.f;
    float mlow = -INFINITY, lrun = 0.f, off = 0.f;
    bool offset_set = false;
    const int drow = 8 * w + (lane >> 3), dch = (lane & 7) ^ ((drow >> 1) & 7);
    const bf16_t* ksrc = Ks + ((size_t)b * NS + drow) * 512 + h * 64 + dch * 8;
    const bf16_t* vsrc = VsT + ((size_t)(b * 8 + h) * 64 + drow) * NS + dch * 8;
    const u64* msrc = mask + (size_t)b * 128 * NS + q0 + (w & 1) * 128 + lane * 2;
    auto dma = [&](int kt, int stage) {
        LAS char* stg = lds + stage * 18432;
        const size_t k0 = (size_t)kt * 64;
        __builtin_amdgcn_global_load_lds((const unsigned*)(ksrc + k0 * 512), (LAS unsigned*)(stg + w * 1024), 16, 0, 0);
        __builtin_amdgcn_global_load_lds((const unsigned*)(vsrc + k0), (LAS unsigned*)(stg + 8192 + w * 1024), 16, 0, 0);
        if (w < 2) __builtin_amdgcn_global_load_lds((const unsigned*)(msrc + (size_t)kt * NS), (LAS unsigned*)(stg + 16384 + w * 1024), 16, 0, 0);
    };
    const int ktd = 4 * qb + 3;
    const int qwmax = q0 + 32 * w + 31;
#ifdef XP_DUPLOOP
  for (int rep = 0; rep < 2; ++rep) {
    if (rep) { for (int db = 0; db < 2; ++db) for (int i = 0; i < 16; ++i) o[db][i] = 0.f; mlow = -INFINITY; lrun = 0.f; off = 0.f; offset_set = false; par = 0; }
#endif
    asm volatile("s_waitcnt vmcnt(0) lgkmcnt(0)" ::: "memory");
    __builtin_amdgcn_s_barrier();
    dma(max(ktd, 0), 0); dma(max(ktd - 1, 0), 1); dma(max(ktd - 2, 0), 2);
    for (int j = 0; j <= ktd; ++j) {
        const int kt = ktd - j, k0 = kt * 64;
        if (w < 2) asm volatile("s_waitcnt vmcnt(6)" ::: "memory"); else asm volatile("s_waitcnt vmcnt(4)" ::: "memory");
        asm volatile("s_waitcnt lgkmcnt(0)" ::: "memory");
        __builtin_amdgcn_s_barrier();
        int allstop = 0;
        if (j > 0) { allstop = 1;
#pragma unroll
            for (int i = 0; i < 8; ++i) allstop &= flags[(par ^ 1) * 8 + i]; }
        if (allstop) break;
        dma(max(kt - 3, 0), (j + 3) & 3);
        const LAS char* cur = lds + (j & 3) * 18432;
        u64 mword = 0ull;
        if (k0 <= qwmax) mword = *(const LAS u64*)(cur + 16384 + (32 * w + l31) * 8);
        if (k0 <= qwmax && __ballot(mword != 0ull) != 0ull) {
            if (!offset_set && mword != 0ull) { off = B2 - c2 * (float)max(qpos - (k0 + 63), 0); offset_set = true; }
            attn_tile<2, true>(cur, cur + 8192, qf, o, off, mlow, lrun, qpos, k0, c1, c2, false, __any(mlow == -INFINITY), mword);
        }
        {
            const float ub = B2 - c2 * (float)(qpos - (k0 - 1));
            const bool stop = __all(ub < mlow - 30.f);
            if (lane == 0) flags[par * 8 + w] = stop ? 1 : 0;
        }
        par ^= 1;
    }
    asm volatile("s_waitcnt vmcnt(0) lgkmcnt(0)" ::: "memory");
    __builtin_amdgcn_s_barrier();
#ifdef XP_DUPLOOP
  }
#endif
    const float ltot = lrun + __shfl_xor(lrun, 32);
    const float inv = 1.f / ltot;
    bf16_t* ao = (bf16_t*)(P.ws + OFF_H) + ((size_t)b * NS + qpos) * 1024 + 512 + h * 64;
#pragma unroll
    for (int db = 0; db < 2; ++db)
#pragma unroll
        for (int q4 = 0; q4 < 4; ++q4) {
            const int d = 32 * db + 8 * q4 + 4 * hf;
            u32x2 pk; pk[0] = pk2(o[db][4 * q4] * inv, o[db][4 * q4 + 1] * inv); pk[1] = pk2(o[db][4 * q4 + 2] * inv, o[db][4 * q4 + 3] * inv);
            *(u32x2*)(ao + d) = pk;
        }
}

constexpr int P3_ITEMS = 128 * 8;
DI void phase_indexer(const Params& P, char* smem) {
    const XPart xp = xcd_part(P.ws, smem, P3_ITEMS);
    const int lo = xp.start - (xp.start % 1 ? 0 : 0);
    const int step = xp.step;
    const int rank = ((const int*)(smem + XC_LDS))[1];
    const int base = xp.start - rank;
    for (int k = 0; base + k * step < xp.end; ++k) {
        const int i = base + k * step + ((k & 1) ? step - 1 - rank : rank);
        if (i >= xp.end) continue;
        const int b = i >> 7, g = 127 - (i & 127);
        __syncthreads();
        indexer_item(P, smem, b, g * 64);
    }
    __syncthreads();
    (void)lo;
}
DI void phase_attn(const Params& P, char* smem, int qidx) {
    int* qctr = (int*)(P.ws + OFF_Q) + qidx;
    const int* items = (const int*)(P.ws + OFF_ITEMS);
    volatile int* s_it = (volatile int*)(smem + SM_EXTRA + 3200);
    __syncthreads();
    if (threadIdx.x < 128) ((float*)(smem + SM_EXTRA + 1024))[threadIdx.x] = P.subln_g[threadIdx.x];
    __syncthreads();
    for (;;) {
        __syncthreads();
        if (threadIdx.x == 0) *s_it = atomicAdd(qctr, 1);
        __syncthreads();
        const int it = *s_it;
        if (it >= ATT_ITEMS) break;
        const int code = items[it];
        const int b = (code >> 16) & 15, h = (code >> 8) & 255, qb = code & 255;
        if ((code >> 20) == 0) diffattn_item(P, smem, b, h, qb);
        else dsa_item(P, smem, b, h, qb);
    }
}

constexpr int OUTPROJ_ITEMS = (NT / 256) * 4;
DI void phase_outproj(const Params& P, char* smem) {
    const bf16_t* zrow = (const bf16_t*)(P.ws + OFF_ZROW);
    const bf16_t* ao = (const bf16_t*)(P.ws + OFF_H);
    const bf16_t* wout = (const bf16_t*)(P.ws + OFF_WOUT);
    bf16_t* mix = (bf16_t*)(P.ws + OFF_QD);
    const int lane = threadIdx.x & 63, w = threadIdx.x >> 6, wm = w >> 1, wn = w & 1, l31 = lane & 31, hf = lane >> 5;
    const XPart xp = xcd_part(P.ws, smem, OUTPROJ_ITEMS);
    for (int it = xp.start; it < xp.end; it += xp.step) {
        const int mt = it >> 2, j = it & 3;
        const int row0 = mt * 256;
        DenseRows ar{ao + (size_t)row0 * 1024, 1024};
        gemm_dma<true, 256>(smem, ar, wout + (size_t)j * 256 * 1024, 1024, 4, 1, zrow, [&](int, const f32x16 (&acc)[2][4]) {
#pragma unroll
            for (int mi = 0; mi < 2; ++mi)
#pragma unroll
                for (int pr = 0; pr < 2; ++pr) {
                    bf16_t* base = mix + ((size_t)row0 + 64 * wm + 32 * mi) * 1024 + 256 * j + 128 * wn + 64 * pr;
                    stage_store_chunk(smem, acc[mi][2 * pr], acc[mi][2 * pr + 1], [](int, int, float x) { return x; }, [&](int r) { return base + (size_t)r * 1024; });
                }
        });
    }
}
DI void phase_resnorm2(const Params& P) {
    const bf16_t* mix = (const bf16_t*)(P.ws + OFF_QD);
    const float* mod = (const float*)(P.ws + OFF_MOD);
    bf16_t* h2 = (bf16_t*)(P.ws + OFF_H2);
    const int lane = threadIdx.x & 63, w = threadIdx.x >> 6, stride = gridDim.x * NW;
    f32x4 xa[4]; u32x2 ma[4];
    auto ld = [&](int r, f32x4 (&xv)[4], u32x2 (&mv)[4]) {
#pragma unroll
        for (int i = 0; i < 4; ++i) { const int col = 256 * i + 4 * lane; xv[i] = *(const f32x4*)(P.x + (size_t)r * 1024 + col); mv[i] = *(const u32x2*)(mix + (size_t)r * 1024 + col); }
    };
    int row = blockIdx.x * NW + w, bcur = -1;
    f32x4 g1v[4], ggv[4], shv[4], scv[4];
#pragma unroll
    for (int i = 0; i < 4; ++i) ggv[i] = *(const f32x4*)(P.norm2_g + 256 * i + 4 * lane);
    if (row < NT) ld(row, xa, ma);
    for (; row < NT; row += stride) {
        const int b = row >> 13;
        if (b != bcur) {
            const float* mb = mod + b * 6144;
#pragma unroll
            for (int i = 0; i < 4; ++i) { const int col = 256 * i + 4 * lane; g1v[i] = *(const f32x4*)(mb + 2048 + col); shv[i] = *(const f32x4*)(mb + 3072 + col); scv[i] = *(const f32x4*)(mb + 4096 + col); }
            bcur = b;
        }
        f32x4 xb[4]; u32x2 mb2[4];
        ld(row + stride < NT ? row + stride : row, xb, mb2);
        f32x4 v[4]; float ss = 0.f;
#pragma unroll
        for (int i = 0; i < 4; ++i) {
            const int col = 256 * i + 4 * lane;
            const f32x4 g1 = g1v[i];
            v[i][0] = xa[i][0] + g1[0] * bflo(ma[i][0]); v[i][1] = xa[i][1] + g1[1] * bfhi(ma[i][0]);
            v[i][2] = xa[i][2] + g1[2] * bflo(ma[i][1]); v[i][3] = xa[i][3] + g1[3] * bfhi(ma[i][1]);
            *(f32x4*)(P.out + (size_t)row * 1024 + col) = v[i];
            ss += v[i][0] * v[i][0] + v[i][1] * v[i][1] + v[i][2] * v[i][2] + v[i][3] * v[i][3];
        }
        ss = wave_sum(ss);
        const float rstd = rsqrtf(ss * (1.f / 1024.f) + EPSF);
#pragma unroll
        for (int i = 0; i < 4; ++i) {
            const int col = 256 * i + 4 * lane;
            const f32x4 gg = ggv[i], sh = shv[i], sc = scv[i];
            float o[4];
#pragma unroll
            for (int j = 0; j < 4; ++j) o[j] = v[i][j] * rstd * gg[j] * (1.f + sc[j]) + sh[j];
            u32x2 pk; pk[0] = pk2(o[0], o[1]); pk[1] = pk2(o[2], o[3]);
            *(u32x2*)(h2 + (size_t)row * 1024 + col) = pk;
        }
#pragma unroll
        for (int i = 0; i < 4; ++i) { xa[i] = xb[i]; ma[i] = mb2[i]; }
    }
}

constexpr int ROUTER_ITEMS = NT / 256;
DI void phase_router(const Params& P, char* smem) {
    const bf16_t* zrow = (const bf16_t*)(P.ws + OFF_ZROW);
    const bf16_t* h2 = (const bf16_t*)(P.ws + OFF_H2);
    const bf16_t* wrt = (const bf16_t*)(P.ws + OFF_WRT);
    float* logits = (float*)(P.ws + OFF_Y);
    const int lane = threadIdx.x & 63, w = threadIdx.x >> 6, wm = w >> 1, wn = w & 1, l31 = lane & 31, hf = lane >> 5;
    for (int it = blockIdx.x; it < ROUTER_ITEMS; it += gridDim.x) {
        const int row0 = it * 256;
        DenseRows ar{h2 + (size_t)row0 * 1024, 1024};
        gemm_dma<true, 256>(smem, ar, wrt, 1024, 4, 1, zrow, [&](int, const f32x16 (&acc)[2][4]) {
#pragma unroll
            for (int mi = 0; mi < 2; ++mi) {
                const size_t tok = (size_t)row0 + 64 * wm + 32 * mi + l31;
#pragma unroll
                for (int ni = 0; ni < 4; ++ni)
#pragma unroll
                    for (int q4 = 0; q4 < 4; ++q4) {
                        const int n = 128 * wn + 32 * ni + 8 * q4 + 4 * hf;
                        f32x4 ov = {acc[mi][ni][4 * q4], acc[mi][ni][4 * q4 + 1], acc[mi][ni][4 * q4 + 2], acc[mi][ni][4 * q4 + 3]};
                        *(f32x4*)(logits + tok * 256 + n) = ov;
                    }
            }
        });
    }
}

DI void phase_route(const Params& P) {
    const float* logits = (const float*)(P.ws + OFF_Y);
    int* cnt = (int*)(P.ws + OFF_CNT);
    int* list = (int*)(P.ws + OFF_LIST);
    int* eidx = (int*)(P.ws + OFF_EIDX);
    float* gates = (float*)(P.ws + OFF_GATE);
    const int lane = threadIdx.x & 63, w = threadIdx.x >> 6;
    const f32x4 bias = *(const f32x4*)(P.router_b + 4 * lane);
    for (int t = blockIdx.x * NW + w; t < NT; t += gridDim.x * NW) {
        const f32x4 lg = *(const f32x4*)(logits + (size_t)t * 256 + 4 * lane);
        float sc[4], cand[4];
#pragma unroll
        for (int i = 0; i < 4; ++i) { sc[i] = 1.f / (1.f + __expf(-lg[i])); cand[i] = sc[i] + bias[i]; }
        float t1 = fmaxf(cand[0], cand[1]), t2 = fminf(cand[0], cand[1]);
#pragma unroll
        for (int i = 2; i < 4; ++i) { const float v = cand[i]; t2 = fmaxf(t2, fminf(t1, v)); t1 = fmaxf(t1, v); }
#pragma unroll
        for (int d = 1; d < 8; d <<= 1) {
            const float o1 = __shfl_xor(t1, d), o2 = __shfl_xor(t2, d);
            const float n1 = fmaxf(t1, o1), n2 = fmaxf(fminf(t1, o1), fmaxf(t2, o2));
            t1 = n1; t2 = n2;
        }
        const float gs = t1 + t2;
        const int myg = lane >> 3;
        int rank = 0;
#pragma unroll
        for (int g = 0; g < 8; ++g) { const float sg = __shfl(gs, 8 * g); rank += (sg > gs || (sg == gs && g < myg)) ? 1 : 0; }
        if (rank >= 4) {
#pragma unroll
            for (int i = 0; i < 4; ++i) cand[i] = -INFINITY;
        }
        int sel[8]; float wv[8]; float wsum = 0.f;
#pragma unroll
        for (int k = 0; k < 8; ++k) {
            float bv = cand[0]; int bi = 0;
#pragma unroll
            for (int i = 1; i < 4; ++i) if (cand[i] > bv) { bv = cand[i]; bi = i; }
            int be = 4 * lane + bi;
#pragma unroll
            for (int d = 32; d >= 1; d >>= 1) {
                const float ov = __shfl_xor(bv, d); const int oe = __shfl_xor(be, d);
                if (ov > bv || (ov == bv && oe < be)) { bv = ov; be = oe; }
            }
            const int ol = be >> 2, oi = be & 3;
            float mys = (oi == 0) ? sc[0] : (oi == 1) ? sc[1] : (oi == 2) ? sc[2] : sc[3];
            const float ws_ = __shfl(mys, ol);
            if (lane == ol) {
#pragma unroll
                for (int i = 0; i < 4; ++i) if (i == oi) cand[i] = -INFINITY;
            }
            sel[k] = be; wv[k] = ws_; wsum += ws_;
        }
        const float rs = 2.5f / wsum;
        int my_e = 256; float my_g = 1.f;
#pragma unroll
        for (int k = 0; k < 8; ++k) if (lane == k) { my_e = sel[k]; my_g = wv[k] * rs; }
        const int c = t >> 14, tl = t & (CHUNK_T - 1);
        if (lane < 8) {
            gates[(size_t)t * 8 + lane] = my_g;
            const int pos = atomicAdd(&cnt[c * NEXP1 + my_e], 1);
            eidx[(size_t)t * 8 + lane] = my_e | (pos << 9);
            list[((size_t)c * NEXP1 + my_e) * CHUNK_T + pos] = tl * NPAIR + lane;
        } else if (lane == 8) {
            list[((size_t)c * NEXP1 + 256) * CHUNK_T + tl] = tl * NPAIR + 8;
        }
    }
}

typedef unsigned short u16;
DI void moe_build_base(const Params& P, char* smem, int c) {
    int* bs = (int*)(smem + SM_BASE);
    const int* cnt = (const int*)(P.ws + OFF_CNT) + c * NEXP1;
    const int e = threadIdx.x, lane = e & 63, w = e >> 6;
    __syncthreads();
    int n = 0, in = 0;
    if (e < 256) {
        n = cnt[e]; in = n;
#pragma unroll
        for (int d = 1; d < 64; d <<= 1) { const int t = __shfl_up(in, d); if (lane >= d) in += t; }
        if (lane == 63) bs[258 + w] = in;
    }
    __syncthreads();
    if (e < 256) {
        int o = 0;
#pragma unroll
        for (int i = 0; i < 4; ++i) if (i < w) o += bs[258 + i];
        bs[e] = o + in - n;
        if (e == 255) bs[256] = o + in;
    }
    __syncthreads();
}
DI void moe_build_tiles(const Params& P, char* smem, int c, int& totalA, int& totalB) {
    u16* tA = (u16*)(smem + SM_EXTRA);
    u16* tB = (u16*)(smem + SM_EXTRA + 528);
    int* wsum = (int*)(smem + SM_EXTRA + 1048);
    const int* cnt = (const int*)(P.ws + OFF_CNT) + c * NEXP1;
    moe_build_base(P, smem, c);
    const int e = threadIdx.x, lane = e & 63, w = e >> 6;
    __syncthreads();
    int na = 0, nb = 0, ia = 0, ib = 0;
    if (e < 256) {
        const int n = cnt[e], full = n >> 8, rem = n & 255;
        na = full + (rem > 128 ? 1 : 0); nb = (rem >= 1 && rem <= 128) ? 1 : 0;
        ia = na; ib = nb;
#pragma unroll
        for (int d = 1; d < 64; d <<= 1) { const int t = __shfl_up(ia, d), u = __shfl_up(ib, d); if (lane >= d) { ia += t; ib += u; } }
        if (lane == 63) { wsum[w] = ia; wsum[4 + w] = ib; }
    }
    __syncthreads();
    if (e < 256) {
        int oa = 0, ob = 0;
#pragma unroll
        for (int i = 0; i < 4; ++i) if (i < w) { oa += wsum[i]; ob += wsum[4 + i]; }
        tA[e] = (u16)(oa + ia - na); tB[e] = (u16)(ob + ib - nb);
        if (e == 255) { tA[256] = (u16)(oa + ia); tA[257] = (u16)(oa + ia + CHUNK_T / 256); tB[256] = (u16)(ob + ib); tB[257] = (u16)(ob + ib); }
    }
    __syncthreads();
    totalA = tA[NEXP1]; totalB = tB[NEXP1];
}
DI int moe_find_expert(const u16* tstart, int tile) {
    int lo = 0, hi = NEXP1;
    while (hi - lo > 1) { const int mid = (lo + hi) >> 1; if ((int)tstart[mid] <= tile) lo = mid; else hi = mid; }
    return lo;
}
struct GatherRows {
    static constexpr bool kDense = false;
    const bf16_t* base; int ld; const int* pid; int div;
    DI const bf16_t* operator()(int r) const { const int p = pid[r]; return p < 0 ? nullptr : base + (size_t)(p / div) * ld; }
};
template <int BM>
DI void moe_g1_tiles(const Params& P, char* smem, int c, const u16* tstart, int total) {
    const bf16_t* zrow = (const bf16_t*)(P.ws + OFF_ZROW);
    int* pid = (int*)(smem + SM_EXTRA + 1088);
    const int* cnt = (const int*)(P.ws + OFF_CNT) + c * NEXP1;
    const int* list = (const int*)(P.ws + OFF_LIST) + (size_t)c * NEXP1 * CHUNK_T;
    const bf16_t* h2 = (const bf16_t*)(P.ws + OFF_H2) + (size_t)c * CHUNK_T * 1024;
    const bf16_t* wgu = (const bf16_t*)(P.ws + OFF_WGU);
    bf16_t* act = (bf16_t*)(P.ws + OFF_ACT + (size_t)(c & 1) * ACT_BYTES);
    const int lane = threadIdx.x & 63, w = threadIdx.x >> 6, wm = BM == 256 ? (w >> 1) : (w >> 2), wn = BM == 256 ? (w & 1) : (w & 3), l31 = lane & 31, hf = lane >> 5;
    const XPart xp = xcd_part(P.ws, smem, total * 2);
    for (int it = xp.start; it < xp.end; it += xp.step) {
        const int tile = it >> 1, half = it & 1;
        const int e = moe_find_expert(tstart, tile), ti = tile - tstart[e];
        const int n = e < NEXP ? cnt[e] : CHUNK_T;
        const int li0 = BM == 256 ? ti * 256 : (n >> 8) * 256;
        const int srow0 = ((const int*)(smem + SM_BASE))[e] + li0, nvalid = n - li0;
        __syncthreads();
        if (threadIdx.x < BM) { const int li = li0 + threadIdx.x; pid[threadIdx.x] = li < n ? list[(size_t)e * CHUNK_T + li] : -1; }
        __syncthreads();
        GatherRows ar{h2, 1024, pid, NPAIR};
        if constexpr (BM == 256) {
            gemm_dma<true, 256>(smem, ar, wgu + ((size_t)e * 512 + half * 256) * 1024, 1024, 4, 1, zrow, [&](int, const f32x16 (&acc)[2][4]) {
#pragma unroll
                for (int mi = 0; mi < 2; ++mi) {
                    f32x16 t0, t1;
#pragma unroll
                    for (int i = 0; i < 16; ++i) { t0[i] = silu_f(acc[mi][0][i]) * acc[mi][1][i]; t1[i] = silu_f(acc[mi][2][i]) * acc[mi][3][i]; }
                    const int rb = 64 * wm + 32 * mi;
                    bf16_t* abase = act + (size_t)(srow0 + rb) * 256 + 128 * half + 64 * wn;
                    stage_store_chunk(smem, t0, t1, [](int, int, float x) { return x; }, [&](int r) { return rb + r < nvalid ? abase + (size_t)r * 256 : (bf16_t*)nullptr; });
                }
            });
        } else {
            gemm_dma<true, 128>(smem, ar, wgu + ((size_t)e * 512 + half * 256) * 1024, 1024, 4, 1, zrow, [&](int, const f32x16 (&acc)[2][2]) {
#pragma unroll
                for (int mi = 0; mi < 2; ++mi) {
                    const int rw = 64 * wm + 32 * mi + l31;
                    if (rw < nvalid) {
                        bf16_t* arow_ = act + (size_t)(srow0 + rw) * 256 + 128 * half + 32 * wn;
#pragma unroll
                        for (int q4 = 0; q4 < 4; ++q4) {
                            float o[4];
#pragma unroll
                            for (int r = 0; r < 4; ++r) { const float g = acc[mi][0][4 * q4 + r], u = acc[mi][1][4 * q4 + r]; o[r] = silu_f(g) * u; }
                            u32x2 pk; pk[0] = pk2(o[0], o[1]); pk[1] = pk2(o[2], o[3]);
                            *(u32x2*)(arow_ + 8 * q4 + 4 * hf) = pk;
                        }
                    }
                }
            });
        }
    }
}
DI void phase_moe_g1(const Params& P, char* smem, int c) {
    int totalA, totalB;
    moe_build_tiles(P, smem, c, totalA, totalB);
    moe_g1_tiles<256>(P, smem, c, (const u16*)(smem + SM_EXTRA), totalA);
    moe_g1_tiles<128>(P, smem, c, (const u16*)(smem + SM_EXTRA + 528), totalB);
}
template <int BM>
DI void moe_g2_tiles(const Params& P, char* smem, int c, const u16* tstart, int total) {
    const bf16_t* zrow = (const bf16_t*)(P.ws + OFF_ZROW);
    int* pid = (int*)(smem + SM_EXTRA + 1088);
    float* gsm = (float*)(smem + SM_EXTRA + 2112);
    const int* cnt = (const int*)(P.ws + OFF_CNT) + c * NEXP1;
    const int* list = (const int*)(P.ws + OFF_LIST) + (size_t)c * NEXP1 * CHUNK_T;
    const float* gates = (const float*)(P.ws + OFF_GATE) + (size_t)c * CHUNK_T * 8;
    const bf16_t* wd = (const bf16_t*)(P.ws + OFF_WD);
    const bf16_t* act = (const bf16_t*)(P.ws + OFF_ACT + (size_t)(c & 1) * ACT_BYTES);
    bf16_t* y = (bf16_t*)(P.ws + OFF_Y);
    const int lane = threadIdx.x & 63, w = threadIdx.x >> 6, wm = BM == 256 ? (w >> 1) : (w >> 2), wn = BM == 256 ? (w & 1) : (w & 3), l31 = lane & 31;
    const XPart xp = xcd_part(P.ws, smem, total * 2);
    for (int it = xp.start; it < xp.end; it += xp.step) {
        const int tile = it >> 1, half = it & 1;
        const int e = moe_find_expert(tstart, tile), ti = tile - tstart[e];
        const int n = e < NEXP ? cnt[e] : CHUNK_T;
        const int li0 = BM == 256 ? ti * 256 : (n >> 8) * 256;
        const int srow0 = ((const int*)(smem + SM_BASE))[e] + li0, nvalid = n - li0;
        __syncthreads();
        if (threadIdx.x < BM) {
            const int li = li0 + threadIdx.x; const int pp = li < n ? list[(size_t)e * CHUNK_T + li] : -1;
            float g = 1.f;
            if (pp >= 0 && (pp % NPAIR) < 8) g = gates[(size_t)(pp / NPAIR) * 8 + (pp % NPAIR)];
            gsm[threadIdx.x] = g;
        }
        __syncthreads();
        DenseRows ar{act + (size_t)srow0 * 256, 256};
        if constexpr (BM == 256) {
            gemm_dma<true, 256>(smem, ar, wd + ((size_t)e * 1024 + half * 512) * 256, 256, 2, 2, zrow, [&](int t, const f32x16 (&acc)[2][4]) {
#pragma unroll
                for (int mi = 0; mi < 2; ++mi) {
                    const float g = gsm[64 * wm + 32 * mi + l31];
                    const int rb = 64 * wm + 32 * mi;
#pragma unroll
                    for (int pr = 0; pr < 2; ++pr) {
                        const int cb = half * 512 + t * 256 + 128 * wn + 64 * pr;
                        bf16_t* yb = y + (size_t)(srow0 + rb) * 1024 + cb;
                        stage_store_chunk(smem, acc[mi][2 * pr], acc[mi][2 * pr + 1], [&](int, int, float x) { return x * g; }, [&](int r) { return rb + r < nvalid ? yb + (size_t)r * 1024 : (bf16_t*)nullptr; });
                    }
                }
            });
        } else {
            gemm_dma<true, 128>(smem, ar, wd + ((size_t)e * 1024 + half * 512) * 256, 256, 2, 2, zrow, [&](int t, const f32x16 (&acc)[2][2]) {
                const int cb = half * 512 + t * 256 + 64 * wn;
#pragma unroll
                for (int mi = 0; mi < 2; ++mi) {
                    const float g = gsm[64 * wm + 32 * mi + l31];
                    const int rb = 64 * wm + 32 * mi;
                    bf16_t* yb = y + (size_t)(srow0 + rb) * 1024 + cb;
                    stage_store_chunk(smem, acc[mi][0], acc[mi][1], [&](int, int, float x) { return x * g; }, [&](int r) { return rb + r < nvalid ? yb + (size_t)r * 1024 : (bf16_t*)nullptr; });
                }
            });
        }
    }
}
DI void phase_moe_g2(const Params& P, char* smem, int c) {
    int totalA, totalB;
    moe_build_tiles(P, smem, c, totalA, totalB);
    moe_g2_tiles<256>(P, smem, c, (const u16*)(smem + SM_EXTRA), totalA);
    moe_g2_tiles<128>(P, smem, c, (const u16*)(smem + SM_EXTRA + 528), totalB);
}
DI void phase_moe_combine(const Params& P, char* smem, int c) {
    const bf16_t* y = (const bf16_t*)(P.ws + OFF_Y);
    const float* mod = (const float*)(P.ws + OFF_MOD);
    const int* eidx = (const int*)(P.ws + OFF_EIDX);
    const int lane = threadIdx.x & 63, w = threadIdx.x >> 6, stride = gridDim.x * NW;
    moe_build_base(P, smem, c);
    const int* bs = (const int*)(smem + SM_BASE);
    int tl = blockIdx.x * NW + w;
    int evn = 0;
    if (tl < CHUNK_T && lane < 8) evn = eidx[((size_t)c * CHUNK_T + tl) * 8 + lane];
    for (; tl < CHUNK_T; tl += stride) {
        const size_t t = (size_t)c * CHUNK_T + tl;
        const int b = (int)(t >> 13);
        const float* g2 = mod + b * 6144 + 5120;
        const int ev = evn;
        { const int tn = tl + stride < CHUNK_T ? tl + stride : tl; if (lane < 8) evn = eidx[((size_t)c * CHUNK_T + tn) * 8 + lane]; }
        int myrow = bs[256] + tl;
        if (lane < 8) myrow = bs[ev & 511] + (ev >> 9);
        const bf16_t* yr[NPAIR];
#pragma unroll
        for (int k = 0; k < NPAIR; ++k) yr[k] = y + (size_t)__builtin_amdgcn_readlane(myrow, k) * 1024;
#pragma unroll
        for (int i = 0; i < 4; ++i) {
            const int col = 256 * i + 4 * lane;
            float s[4] = {0.f, 0.f, 0.f, 0.f};
#pragma unroll
            for (int k = 0; k < NPAIR; ++k) {
                const u32x2 v = *(const u32x2*)(yr[k] + col);
                s[0] += bflo(v[0]); s[1] += bfhi(v[0]); s[2] += bflo(v[1]); s[3] += bfhi(v[1]);
            }
            const f32x4 xv = *(const f32x4*)(P.out + t * 1024 + col);
            const f32x4 gv = *(const f32x4*)(g2 + col);
            f32x4 ov;
#pragma unroll
            for (int r = 0; r < 4; ++r) ov[r] = xv[r] + gv[r] * s[r];
            *(f32x4*)(P.out + t * 1024 + col) = ov;
        }
    }
}

constexpr int NPHASE = 18;
template <int PH, int REP = 0> DI void run_phase(const Params& Pin, char* smem) {
    Params P = Pin;
    { typedef __attribute__((address_space(1))) char gchar; gchar* g = (gchar*)Pin.ws; asm volatile("" : "+s"(g)); P.ws = (char*)g; }
    float* mod = (float*)(P.ws + OFF_MOD);
    if constexpr (PH == 0) phase_adaln(P, smem);
    else if constexpr (PH == 1) { phase_norm(P.x, P.norm1_g, mod, 0, 1024, (bf16_t*)(P.ws + OFF_H)); phase_convert(P, smem); }
    else if constexpr (PH == 2) phase_inproj(P, smem);
    else if constexpr (PH == 3) phase_indexer(P, smem);
    else if constexpr (PH == 4) phase_attn(P, smem, REP);
    else if constexpr (PH == 5) phase_outproj(P, smem);
    else if constexpr (PH == 6) phase_resnorm2(P);
    else if constexpr (PH == 7) phase_router(P, smem);
    else if constexpr (PH == 8) phase_route(P);
    else if constexpr (PH == 9) phase_moe_g1(P, smem, 0);
    else if constexpr (PH == 10) { phase_moe_g2(P, smem, 0); phase_moe_g1(P, smem, 1); }
    else if constexpr (PH == 11) phase_moe_combine(P, smem, 0);
    else if constexpr (PH == 12) { phase_moe_g2(P, smem, 1); phase_moe_g1(P, smem, 2); }
    else if constexpr (PH == 13) phase_moe_combine(P, smem, 1);
    else if constexpr (PH == 14) { phase_moe_g2(P, smem, 2); phase_moe_g1(P, smem, 3); }
    else if constexpr (PH == 15) phase_moe_combine(P, smem, 2);
    else if constexpr (PH == 16) phase_moe_g2(P, smem, 3);
    else if constexpr (PH == 17) phase_moe_combine(P, smem, 3);
}
#ifndef DUP_PHASE
#define DUP_PHASE -1
#endif
#ifndef PROBE_PHASE
#define PROBE_PHASE -1
#endif
#ifndef PROBE_SCALE
#define PROBE_SCALE 0.1f
#endif
#define MK_RUN(PH) if constexpr (P0 <= PH && PH < P1) { \
    unsigned long long t0_ = 0; if constexpr (PH == PROBE_PHASE) t0_ = __builtin_amdgcn_s_memrealtime(); \
    run_phase<PH>(P, smem); if constexpr (PH == DUP_PHASE) { xcd_barrier(bar); run_phase<PH, 1>(P, smem); } \
    if constexpr (PH + 1 < P1 || PH == PROBE_PHASE) xcd_barrier(bar); \
    if constexpr (PH == PROBE_PHASE) { if (blockIdx.x == 0 && threadIdx.x == 0) *(volatile unsigned*)(P.ws + OFF_ERR + 512) = (unsigned)(__builtin_amdgcn_s_memrealtime() - t0_); } }
template <int P0, int P1>
__global__ void __launch_bounds__(NTH, 2) mk_kernel(Params P) {
    __shared__ __attribute__((aligned(16))) char smem[SMEM_BYTES + 16];
    if (threadIdx.x == 0) {
        *(uint4*)(smem + SMEM_BYTES) = make_uint4(0u, 0u, 0u, 0u);
        const int x = (int)xb_xcc_id();
        ((int*)(smem + XC_LDS))[0] = x;
        ((int*)(smem + XC_LDS))[1] = atomicAdd((int*)(P.ws + OFF_XRANK) + x, 1);
    }
    __syncthreads();
    XcdBarrier bar;
    if constexpr (P1 - P0 > 1 || PROBE_PHASE >= 0) bar = xcd_barrier_post((unsigned*)(P.ws + OFF_BAR), (volatile LAS unsigned*)(LAS char*)(smem + SMEM_BYTES));
    MK_RUN(0) MK_RUN(1) MK_RUN(2) MK_RUN(3) MK_RUN(4) MK_RUN(5) MK_RUN(6) MK_RUN(7) MK_RUN(8)
    MK_RUN(9) MK_RUN(10) MK_RUN(11) MK_RUN(12) MK_RUN(13) MK_RUN(14) MK_RUN(15) MK_RUN(16) MK_RUN(17)
    if constexpr (PROBE_PHASE >= 0) {
        xcd_barrier(bar);
        const float us = (float)(*(volatile unsigned*)(P.ws + OFF_ERR + 512)) * 0.01f;
        const float cval = sqrtf(us * PROBE_SCALE);
        for (size_t i = (size_t)blockIdx.x * NTH + threadIdx.x; i < (size_t)NT * 1024 / 4; i += (size_t)gridDim.x * NTH) ((f32x4*)P.out)[i] = (f32x4){cval, cval, cval, cval};
    }
}

template <int P0, int P1> static void launch_range(const Params& p, hipStream_t stream) {
    static int grid = 0;
    if (!grid) {
        int dev = 0, cus = 0, per_cu = 0;
        (void)hipGetDevice(&dev);
        (void)hipDeviceGetAttribute(&cus, hipDeviceAttributeMultiprocessorCount, dev);
        (void)(void)hipOccupancyMaxActiveBlocksPerMultiprocessor(&per_cu, mk_kernel<P0, P1>, NTH, 0);
        if (cus <= 0) cus = 256;
        if (per_cu < 1) per_cu = 1;
        grid = cus * (per_cu < 1 ? 1 : 1);
    }
    mk_kernel<P0, P1><<<dim3(grid), dim3(NTH), 0, stream>>>(p);
}

extern "C" void kernel_launch(void* const* d_in, const int* in_sizes, int n_in, void* d_out, int out_size, void* d_ws, size_t ws_size, hipStream_t stream) {
    if (ws_size < WS_NEED) return;
    if (ws_size < WS_NEED) return;
    Params p{};
    const float** f = (const float**)&p;
    for (int i = 0; i < 26; ++i) f[i] = (const float*)d_in[i];
    p.out = (float*)d_out;
    p.ws = (char*)d_ws;
    (void)hipMemsetAsync(d_ws, 0, ZERO_BYTES, stream);
#if MK_ONE_LAUNCH
    launch_range<0, NPHASE>(p, stream);
#else
    launch_range<0, 1>(p, stream); launch_range<1, 2>(p, stream); launch_range<2, 3>(p, stream); launch_range<3, 4>(p, stream);
    launch_range<4, 5>(p, stream); launch_range<5, 6>(p, stream); launch_range<6, 7>(p, stream); launch_range<7, 8>(p, stream);
    launch_range<8, 9>(p, stream); launch_range<9, 10>(p, stream); launch_range<10, 11>(p, stream); launch_range<11, 12>(p, stream);
    launch_range<12, 13>(p, stream); launch_range<13, 14>(p, stream); launch_range<14, 15>(p, stream); launch_range<15, 16>(p, stream);
    launch_range<16, 17>(p, stream); launch_range<17, 18>(p, stream);
#endif
}
```

```cpp
#include <hip/hip_runtime.h>
#include <stdint.h>

#define DI __device__ __forceinline__
#define LAS __attribute__((address_space(3)))
typedef unsigned short bf16_t;
typedef short bf16x8 __attribute__((ext_vector_type(8)));
typedef short s16x4 __attribute__((ext_vector_type(4)));
typedef float f32x16 __attribute__((ext_vector_type(16)));
typedef float f32x4 __attribute__((ext_vector_type(4)));
typedef float f32x2 __attribute__((ext_vector_type(2)));
typedef __bf16 bf16v2 __attribute__((ext_vector_type(2)));
typedef unsigned u32x4 __attribute__((ext_vector_type(4)));
typedef unsigned u32x2 __attribute__((ext_vector_type(2)));
typedef unsigned long long u64;
#define MFMA32(a, b, c) __builtin_amdgcn_mfma_f32_32x32x16_bf16((a), (b), (c), 0, 0, 0)

constexpr int NB = 8, NS = 8192, ND = 1024, NT = NB * NS;
constexpr int IN_COLS = 3656, NPAD = 3840;
constexpr int NTH = 512, NW = 8;
constexpr int NEXP = 256, NEXP1 = 257;
constexpr int NCHUNK = 4, CHUNK_T = NT / NCHUNK;
constexpr int NPAIR = 9;
constexpr float EPSF = 1e-6f;
constexpr float LOG2E = 1.4426950408889634f;

constexpr size_t MiB = 1048576;
constexpr size_t OFF_BAR = 0;
constexpr size_t OFF_MOD = 16384;
constexpr size_t OFF_CNT = OFF_MOD + 196608;
constexpr size_t OFF_ERR = OFF_CNT + 8192;
constexpr size_t OFF_Q = OFF_ERR;
constexpr size_t OFF_XRANK = OFF_ERR + 128;
constexpr size_t OFF_XQ = OFF_ERR + 256;
constexpr size_t OFF_ITEMS = OFF_ERR + 1024;
constexpr size_t OFF_ZROW = 245760;
constexpr size_t ZERO_BYTES = 262144;
constexpr size_t OFF_WIN = 1 * MiB;
constexpr size_t OFF_WOUT = OFF_WIN + (size_t)NPAD * 1024 * 2;
constexpr size_t OFF_WRT = OFF_WOUT + 2 * MiB;
constexpr size_t OFF_WGU = 12 * MiB;
constexpr size_t OFF_WD = OFF_WGU + (size_t)NEXP1 * 512 * 1024 * 2;
constexpr size_t OFF_R1 = OFF_WD + (size_t)NEXP1 * 1024 * 256 * 2;
constexpr size_t OFF_H = OFF_R1;
constexpr size_t OFF_QD = OFF_H + 128 * MiB;
constexpr size_t OFF_KD = OFF_QD + 64 * MiB;
constexpr size_t OFF_VDT = OFF_KD + 64 * MiB;
constexpr size_t OFF_QS = OFF_VDT + 64 * MiB;
constexpr size_t OFF_KS = OFF_QS + 64 * MiB;
constexpr size_t OFF_VST = OFF_KS + 64 * MiB;
constexpr size_t OFF_IQ = OFF_VST + 64 * MiB;
constexpr size_t OFF_IK = OFF_IQ + 64 * MiB;
constexpr size_t OFF_IW = OFF_IK + 8 * MiB;
constexpr size_t OFF_MASK = OFF_IW + 2 * MiB;
constexpr size_t END_A = OFF_MASK + 64 * MiB;
constexpr size_t OFF_H2 = OFF_R1;
constexpr size_t OFF_LIST = OFF_H2 + 128 * MiB;
constexpr size_t OFF_EIDX = OFF_LIST + (size_t)NCHUNK * NEXP1 * CHUNK_T * 4;
constexpr size_t OFF_GATE = OFF_EIDX + 2 * MiB;
constexpr size_t OFF_ACT = OFF_GATE + 2 * MiB;
constexpr size_t ACT_BYTES = (size_t)CHUNK_T * NPAIR * 256 * 2;
constexpr size_t OFF_Y = OFF_ACT + 2 * ACT_BYTES;
constexpr size_t OFF_GS = OFF_Y + (size_t)CHUNK_T * NPAIR * 1024 * 2;
constexpr size_t END_B = OFF_GS + 2 * (size_t)CHUNK_T * NPAIR * 4;
constexpr size_t WS_NEED = END_A > END_B ? END_A : END_B;

struct Params {
    const float *x, *c, *ada_w, *ada_b, *norm1_g, *norm2_g, *w_in, *dq_g, *dk_g, *lq1, *lk1, *lq2, *lk2, *subln_g, *sq_g, *sk_g, *ik_g,
        *w_out, *router_w, *router_b, *ew_gate, *ew_up, *ew_down, *sw_gate, *sw_up, *sw_down;
    float* out;
    char* ws;
};

DI unsigned pk2(float a, float b) { f32x2 f = {a, b}; bf16v2 r = __builtin_convertvector(f, bf16v2); return __builtin_bit_cast(unsigned, r); }
DI float bf2f(bf16_t v) { return __uint_as_float(((unsigned)v) << 16); }
DI float bflo(unsigned u) { return __uint_as_float(u << 16); }
DI float bfhi(unsigned u) { return __uint_as_float(u & 0xffff0000u); }
DI int crow(int i, int hf) { return (i & 3) + 8 * (i >> 2) + 4 * hf; }
DI float wave_sum(float v) {
#pragma unroll
    for (int d = 32; d >= 1; d >>= 1) v += __shfl_xor(v, d);
    return v;
}
DI float silu_f(float v) { return v / (1.f + __expf(-v)); }
DI float silu_fast(float v) { return v * __builtin_amdgcn_rcpf(1.f + __expf(-v)); }

#define XB_TMO      128
#define XB_XCNT(j)  (256  + 64 * (j))
#define XB_XSUB(j)  (1280 + 64 * (j))
#define XB_XGEN(j)  (2304 + 64 * (j))
#define XB_TOP      3328
#define XB_TOPGEN   3392
#define XCD_BAR_WORDS 3456
#define XB_SPIN_CAP (1u << 18)

__device__ __forceinline__ unsigned xb_ld(unsigned* p)              { return __hip_atomic_load(p, __ATOMIC_RELAXED, __HIP_MEMORY_SCOPE_AGENT); }
__device__ __forceinline__ unsigned xb_add(unsigned* p, unsigned v) { return __hip_atomic_fetch_add(p, v, __ATOMIC_RELAXED, __HIP_MEMORY_SCOPE_AGENT); }
__device__ __forceinline__ unsigned xb_xcc_id() { return (unsigned)__builtin_amdgcn_s_getreg((3 << 11) | 20) & 0xFu; }
#define XB_SPIN(cond, bar) do { unsigned _sp = 0; while (cond) { __builtin_amdgcn_s_sleep(1); \
    if ((++_sp & 255u) == 0u) { if (xb_ld(&(bar)[XB_TMO])) break; if (_sp > XB_SPIN_CAP) { atomicAdd(&(bar)[XB_TMO], 1u); break; } } } } while (0)

struct XcdBarrier {
    unsigned* bar; unsigned x;
    volatile LAS unsigned* st;
};
__device__ __forceinline__ XcdBarrier xcd_barrier_post(unsigned* bar, volatile LAS unsigned* st) {
    XcdBarrier b; b.bar = bar; b.x = xb_xcc_id(); b.st = st;
    if (threadIdx.x == 0) (void)xb_add(&bar[XB_XCNT(b.x)], 1u);
    return b;
}
__device__ __forceinline__ void xcd_barrier_complete(unsigned* bar, unsigned x, unsigned& nloc, unsigned& nx) {
    const unsigned G = gridDim.x * gridDim.y * gridDim.z;
    unsigned sum, cnt, mine, sp = 0u;
    for (;;) {
        sum = 0u; cnt = 0u; mine = 0u;
#pragma unroll
        for (unsigned j = 0; j < 16; ++j) { const unsigned c = xb_ld(&bar[XB_XCNT(j)]); sum += c; cnt += (c > 0u) ? 1u : 0u; mine = (j == x) ? c : mine; }
        if (sum == G) break;
        __builtin_amdgcn_s_sleep(1);
        if ((++sp & 255u) == 0u) { if (xb_ld(&bar[XB_TMO])) break; if (sp > XB_SPIN_CAP) { atomicAdd(&bar[XB_TMO], 1u); break; } }
    }
    nloc = mine > 0u ? mine : 1u; nx = cnt > 0u ? cnt : 1u;
}
__device__ __forceinline__ void xcd_barrier(const XcdBarrier& b) {
    asm volatile("s_waitcnt vmcnt(0)" ::: "memory");
    __syncthreads();
    if (threadIdx.x == 0) {
        unsigned* bar = b.bar;
        __builtin_amdgcn_s_waitcnt(0);
        unsigned nloc = b.st[0], nx = b.st[1];
        if (nloc == 0u) { xcd_barrier_complete(bar, b.x, nloc, nx); b.st[0] = nloc; b.st[1] = nx; }
        const unsigned old = xb_add(&bar[XB_XSUB(b.x)], 1u);
        const unsigned gen = old / nloc;
        if (old + 1u == (gen + 1u) * nloc) {
            __builtin_amdgcn_fence(__ATOMIC_RELEASE, "agent");
            asm volatile("s_waitcnt vmcnt(0)" ::: "memory");
            const unsigned og = xb_add(&bar[XB_TOP], 1u);
            const unsigned tg = og / nx;
            if (og + 1u == (tg + 1u) * nx) xb_add(&bar[XB_TOPGEN], 1u);
            else XB_SPIN(xb_ld(&bar[XB_TOPGEN]) == tg, bar);
            __builtin_amdgcn_fence(__ATOMIC_ACQUIRE, "agent");
            xb_add(&bar[XB_XGEN(b.x)], 1u);
            asm volatile("s_waitcnt vmcnt(0)" ::: "memory");
        } else {
            XB_SPIN(xb_ld(&bar[XB_XGEN(b.x)]) == gen, bar);
            __builtin_amdgcn_fence(__ATOMIC_ACQUIRE, "agent");
            asm volatile("s_waitcnt vmcnt(0)" ::: "memory");
        }
    }
    __syncthreads();
}

struct XPart { int start, step, end, grp, ngrp; };
constexpr int XC_LDS = 149504 + 3584;
DI XPart xcd_part(const char* ws, const char* smem, int N) {
    const int x = ((const int*)(smem + XC_LDS))[0], r = ((const int*)(smem + XC_LDS))[1];
    const int* xc = (const int*)(smem + XC_LDS) + 2;
    (void)ws;
    int pre = 0, mine = 1, G = 0, grp = 0, ngrp = 0;
#pragma unroll
    for (int j = 0; j < 16; ++j) { const int c = xc[j]; if (j < x) { pre += c; grp += c > 0; } if (j == x) mine = c; G += c; ngrp += c > 0; }
    if (mine < 1) mine = 1; if (G < 1) G = 1;
    const long lo = (long)N * pre / G, hi = (long)N * (pre + mine) / G;
    XPart p; p.start = (int)lo + r; p.step = mine; p.end = (int)hi; p.grp = grp; p.ngrp = ngrp; return p;
}

constexpr int SM_EXTRA = 149504;
constexpr int SM_BASE = SM_EXTRA + 4096;
constexpr int MT_STRIDE = 2112;
constexpr int SMEM_BYTES = SM_BASE + 4 * MT_STRIDE;
#define MK_ONE_LAUNCH 1


constexpr int ATT_ITEMS = 4096;
DI int attn_item_cost(int type, int h, int qb) {
    if (type == 0) { const int win = h == 0 ? 2 : h == 1 ? 7 : h == 2 ? 28 : 109; const int tiles = min(2 * qb + 2, win + 2); return (tiles * 6) / 4; }
    const int win = h == 0 ? 1 : h == 1 ? 2 : h == 2 ? 4 : h == 3 ? 7 : h == 4 ? 14 : h == 5 ? 28 : h == 6 ? 55 : 109;
    const int tiles = min(4 * qb + 4, win + 4); return (tiles * 5) / 4;
}
DI int attn_item_code(int i) {
    if (i < 2048) { const int qb = i & 63, h = (i >> 6) & 3, b = i >> 8; return (b << 16) | (h << 8) | qb; }
    const int j = i - 2048; const int qb = j & 31, h = (j >> 5) & 7, b = j >> 8; return (1 << 20) | (b << 16) | (h << 8) | qb;
}
DI void build_attn_items(const Params& P, char* smem) {
    int* hist = (int*)smem;
    int* wsum = hist + 256;
    int* items = (int*)(P.ws + OFF_ITEMS);
    const int tid = threadIdx.x, lane = tid & 63, w = tid >> 6;
    __syncthreads();
    if (tid < 256) hist[tid] = 0;
    __syncthreads();
    for (int i = tid; i < ATT_ITEMS; i += NTH) { const int c = attn_item_code(i); atomicAdd(&hist[255 - min(255, attn_item_cost(c >> 20, (c >> 8) & 255, c & 255))], 1); }
    __syncthreads();
    int n = 0, inc = 0;
    if (tid < 256) {
        n = hist[tid]; inc = n;
#pragma unroll
        for (int d = 1; d < 64; d <<= 1) { const int t = __shfl_up(inc, d); if (lane >= d) inc += t; }
        if (lane == 63) wsum[w] = inc;
    }
    __syncthreads();
    if (tid < 256) {
        int off = 0;
#pragma unroll
        for (int i = 0; i < 4; ++i) if (i < w) off += wsum[i];
        hist[tid] = off + inc - n;
    }
    __syncthreads();
    for (int i = tid; i < ATT_ITEMS; i += NTH) {
        const int c = attn_item_code(i);
        const int pos = atomicAdd(&hist[255 - min(255, attn_item_cost(c >> 20, (c >> 8) & 255, c & 255))], 1);
        items[pos] = c;
    }
    __syncthreads();
}

DI void phase_adaln(const Params& P, char* smem) {
    float* mod = (float*)(P.ws + OFF_MOD);
    float* sc = (float*)smem;
    float* red = sc + 8192;
    const int tid = threadIdx.x;
    if (blockIdx.x == 0) build_attn_items(P, smem);
    __syncthreads();
    for (int i = tid; i < 8192; i += NTH) sc[i] = silu_f(P.c[i]);
    __syncthreads();
    const int kg = tid >> 4, cn = tid & 15;
    for (int it = blockIdx.x; it < 384; it += gridDim.x) {
        const int n = it * 16 + cn;
        float acc[8];
#pragma unroll
        for (int b = 0; b < 8; ++b) acc[b] = 0.f;
#pragma unroll 8
        for (int kk = 0; kk < 32; ++kk) {
            const int k = kg * 32 + kk;
            const float w = P.ada_w[(size_t)k * 6144 + n];
#pragma unroll
            for (int b = 0; b < 8; ++b) acc[b] += sc[b * 1024 + k] * w;
        }
#pragma unroll
        for (int b = 0; b < 8; ++b) red[(kg * 8 + b) * 16 + cn] = acc[b];
        __syncthreads();
        if (tid < 128) {
            const int b = tid >> 4;
            float s = P.ada_b[n];
#pragma unroll
            for (int g = 0; g < 32; ++g) s += red[(g * 8 + b) * 16 + cn];
            mod[b * 6144 + n] = s;
        }
        __syncthreads();
    }
}

DI void phase_norm(const float* __restrict__ xin, const float* __restrict__ g, const float* __restrict__ mod, int sh_off, int sc_off, bf16_t* __restrict__ dst) {
    const int lane = threadIdx.x & 63, w = threadIdx.x >> 6, stride = gridDim.x * NW;
    f32x4 ggv[4], shv[4], scv[4], xa[4];
#pragma unroll
    for (int i = 0; i < 4; ++i) ggv[i] = *(const f32x4*)(g + 256 * i + 4 * lane);
    int row = blockIdx.x * NW + w, bcur = -1;
    if (row < NT) {
#pragma unroll
        for (int i = 0; i < 4; ++i) xa[i] = __builtin_nontemporal_load((const f32x4*)(xin + (size_t)row * 1024 + 256 * i + 4 * lane));
    }
    for (; row < NT; row += stride) {
        const int b = row >> 13;
        if (b != bcur) {
#pragma unroll
            for (int i = 0; i < 4; ++i) { const int col = 256 * i + 4 * lane; shv[i] = *(const f32x4*)(mod + b * 6144 + sh_off + col); scv[i] = *(const f32x4*)(mod + b * 6144 + sc_off + col); }
            bcur = b;
        }
        f32x4 xb[4];
        const int prow = row + stride < NT ? row + stride : row;
#pragma unroll
        for (int i = 0; i < 4; ++i) xb[i] = __builtin_nontemporal_load((const f32x4*)(xin + (size_t)prow * 1024 + 256 * i + 4 * lane));
        float ss = 0.f;
#pragma unroll
        for (int i = 0; i < 4; ++i) ss += xa[i][0] * xa[i][0] + xa[i][1] * xa[i][1] + xa[i][2] * xa[i][2] + xa[i][3] * xa[i][3];
        ss = wave_sum(ss);
        const float rstd = rsqrtf(ss * (1.f / 1024.f) + EPSF);
#pragma unroll
        for (int i = 0; i < 4; ++i) {
            const int col = 256 * i + 4 * lane;
            float o[4];
#pragma unroll
            for (int j = 0; j < 4; ++j) o[j] = xa[i][j] * rstd * ggv[i][j] * (1.f + scv[i][j]) + shv[i][j];
            u32x2 pk; pk[0] = pk2(o[0], o[1]); pk[1] = pk2(o[2], o[3]);
            *(u32x2*)(dst + (size_t)row * 1024 + col) = pk;
        }
#pragma unroll
        for (int i = 0; i < 4; ++i) xa[i] = xb[i];
    }
}

DI int opaque_tid() { int t = threadIdx.x; asm volatile("" : "+v"(t)); return t; }
DI int gu_row(int f, int is_up) { return (f >> 6) * 128 + (((f >> 5) & 1) * 2 + is_up) * 32 + (f & 31); }
struct CvtDesc { const float* src; bf16_t* dst; int ldsrc, nvalid, k0, n0, ldd, mode; };
constexpr int CVT_WIN = 16 * (NPAD / 64);
constexpr int CVT_SMALL = CVT_WIN + 256 + 64;
constexpr int CVT_ITEMS = CVT_SMALL + NEXP1 * 192;
DI CvtDesc cvt_desc(const Params& P, int it) {
    CvtDesc d;
    if (it < CVT_WIN) { d.src = P.w_in; d.ldsrc = IN_COLS; d.nvalid = IN_COLS; d.k0 = (it & 15) * 64; d.n0 = (it >> 4) * 64; d.dst = (bf16_t*)(P.ws + OFF_WIN); d.ldd = 1024; d.mode = 0; }
    else if (it < CVT_WIN + 256) { const int r = it - CVT_WIN; d.src = P.w_out; d.ldsrc = 1024; d.nvalid = 1024; d.k0 = (r & 15) * 64; d.n0 = (r >> 4) * 64; d.dst = (bf16_t*)(P.ws + OFF_WOUT); d.ldd = 1024; d.mode = 0; }
    else if (it < CVT_SMALL) { const int r = it - CVT_WIN - 256; d.src = P.router_w; d.ldsrc = 256; d.nvalid = 256; d.k0 = (r & 15) * 64; d.n0 = (r >> 4) * 64; d.dst = (bf16_t*)(P.ws + OFF_WRT); d.ldd = 1024; d.mode = 0; }
    else {
        const int r = it - CVT_SMALL, e = r / 192, sub = r % 192;
        if (sub < 128) {
            const int up = sub >> 6, s2 = sub & 63;
            d.src = e < NEXP ? (up ? P.ew_up : P.ew_gate) + (size_t)e * 1024 * 256 : (up ? P.sw_up : P.sw_gate);
            d.ldsrc = 256; d.nvalid = 256; d.k0 = (s2 & 15) * 64; d.n0 = (s2 >> 4) * 64; d.dst = (bf16_t*)(P.ws + OFF_WGU) + (size_t)e * 512 * 1024; d.ldd = 1024; d.mode = 1 + up;
        } else {
            const int s2 = sub - 128;
            d.src = e < NEXP ? P.ew_down + (size_t)e * 256 * 1024 : P.sw_down;
            d.ldsrc = 1024; d.nvalid = 1024; d.k0 = (s2 & 3) * 64; d.n0 = (s2 >> 2) * 64; d.dst = (bf16_t*)(P.ws + OFF_WD) + (size_t)e * 1024 * 256; d.ldd = 256; d.mode = 0;
        }
    }
    return d;
}
DI void phase_convert(const Params& P, char* smem) {
    float* t = (float*)smem;
    const int tid = opaque_tid(), G = gridDim.x;
    f32x4 v[2][4][2];
    auto load = [&](int it0, f32x4 (&vv)[4][2]) {
#pragma unroll
        for (int r = 0; r < 4; ++r) {
            const int it = min(it0 + r * G, CVT_ITEMS - 1);
            const CvtDesc d = cvt_desc(P, it);
#pragma unroll
            for (int i = 0; i < 2; ++i) {
                const int idx = tid + NTH * i, kk = idx >> 4, nn = (idx & 15) * 4;
                const f32x4 z = {0.f, 0.f, 0.f, 0.f};
                vv[r][i] = (d.n0 + nn < d.nvalid) ? __builtin_nontemporal_load((const f32x4*)(d.src + (size_t)(d.k0 + kk) * d.ldsrc + d.n0 + nn)) : z;
            }
        }
    };
    auto finish = [&](int it0, f32x4 (&vv)[4][2]) {
        __syncthreads();
#pragma unroll
        for (int r = 0; r < 4; ++r)
#pragma unroll
            for (int i = 0; i < 2; ++i) {
                const int idx = tid + NTH * i, kk = idx >> 4, nn = (idx & 15) * 4;
#pragma unroll
                for (int j = 0; j < 4; ++j) t[r * 4160 + kk * 65 + nn + j] = vv[r][i][j];
            }
        __syncthreads();
        const int nn = tid >> 3, kq = (tid & 7) * 8;
#pragma unroll
        for (int r = 0; r < 4; ++r) {
            const int it = it0 + r * G;
            if (it < CVT_ITEMS) {
                const CvtDesc d = cvt_desc(P, it);
                unsigned pk[4];
#pragma unroll
                for (int j = 0; j < 4; ++j) pk[j] = pk2(t[r * 4160 + (kq + 2 * j) * 65 + nn], t[r * 4160 + (kq + 2 * j + 1) * 65 + nn]);
                const int n = d.n0 + nn;
                const int drow = d.mode == 0 ? n : gu_row(n, d.mode - 1);
                __builtin_nontemporal_store((u32x4){pk[0], pk[1], pk[2], pk[3]}, (u32x4*)(d.dst + (size_t)drow * d.ldd + d.k0 + kq));
            }
        }
    };
    const int step = 4 * G;
    int it0 = blockIdx.x;
    if (it0 < CVT_ITEMS) load(it0, v[0]);
#pragma unroll 1
    for (; it0 < CVT_ITEMS; it0 += 2 * step) {
        const bool h1 = it0 + step < CVT_ITEMS, h2 = it0 + 2 * step < CVT_ITEMS;
        if (h1) load(it0 + step, v[1]);
        finish(it0, v[0]);
        if (h1) {
            if (h2) load(it0 + 2 * step, v[0]);
            finish(it0 + step, v[1]);
        }
    }
}

template <int BM> struct GemmGeo { static constexpr int NI = BM == 256 ? 4 : 2, WN = BM == 256 ? 2 : 4, AP = BM / 64; };
constexpr int EP_SCR = 131072, EP_WAVE = 16 * 144;
static_assert(EP_SCR + 8 * EP_WAVE <= SM_EXTRA, "LDS layout");
template <bool PERM16 = false, bool NT = false, class XF, class RowPtrFn>
DI void stage_store_chunk(char* smem, const f32x16& a0, const f32x16& a1, XF xf, RowPtrFn rowptr) {
    const int otid = opaque_tid(), lane = otid & 63, w = otid >> 6, l31 = lane & 31, hf = lane >> 5;
    LAS char* scr = (LAS char*)smem + EP_SCR + w * EP_WAVE;
    u32x2 pk[2][4];
#pragma unroll
    for (int n2 = 0; n2 < 2; ++n2)
#pragma unroll
        for (int q4 = 0; q4 < 4; ++q4) {
            const f32x16& a = n2 ? a1 : a0;
            pk[n2][q4][0] = pk2(xf(n2, 4 * q4, a[4 * q4]), xf(n2, 4 * q4 + 1, a[4 * q4 + 1])); pk[n2][q4][1] = pk2(xf(n2, 4 * q4 + 2, a[4 * q4 + 2]), xf(n2, 4 * q4 + 3, a[4 * q4 + 3]));
        }
    const int rr = lane >> 3, c = lane & 7;
    u32x4 d[2][2];
#pragma unroll
    for (int ps = 0; ps < 2; ++ps) {
        if ((l31 >> 4) == ps) {
#pragma unroll
            for (int n2 = 0; n2 < 2; ++n2)
#pragma unroll
                for (int q4 = 0; q4 < 4; ++q4) {
                    const int col = PERM16 ? 32 * n2 + 16 * (q4 >> 1) + 8 * hf + 4 * (q4 & 1) : 32 * n2 + 8 * q4 + 4 * hf;
                    *(LAS u32x2*)(scr + (l31 & 15) * 144 + col * 2) = pk[n2][q4];
                }
        }
        asm volatile("" ::: "memory");
#pragma unroll
        for (int i = 0; i < 2; ++i) d[ps][i] = *(const LAS u32x4*)(scr + (rr + 8 * i) * 144 + c * 16);
        asm volatile("" ::: "memory");
    }
    asm volatile("s_waitcnt lgkmcnt(0)" : "+v"(d[0][0]), "+v"(d[0][1]), "+v"(d[1][0]), "+v"(d[1][1]) :: "memory");
#pragma unroll
    for (int ps = 0; ps < 2; ++ps)
#pragma unroll
        for (int i = 0; i < 2; ++i) {
            bf16_t* g = rowptr(16 * ps + rr + 8 * i);
            if (g) { if constexpr (NT) __builtin_nontemporal_store(d[ps][i], (u32x4*)(g + c * 8)); else *(u32x4*)(g + c * 8) = d[ps][i]; }
        }
}

struct NoPre { DI void operator()() const {} };
template <bool SWAP, int BM, int NSTORE = 0, class AFn, class Epi, class Pre = NoPre>
DI void gemm_dma(char* lds_generic, AFn arow, const bf16_t* __restrict__ Bt, int ldb, int nksh, int nsub, const bf16_t* zrow, Epi epi, Pre pre = Pre()) {
    constexpr int NI = GemmGeo<BM>::NI, WN = GemmGeo<BM>::WN, NA = BM / 64;
    constexpr int STG = (BM + 256) * 128, BOFF = BM * 128;
    LAS char* lds = (LAS char*)lds_generic;
    const int tid = opaque_tid(), lane = tid & 63, w = tid >> 6, wm = w / WN, wn = w % WN, l31 = lane & 31, hf = lane >> 5;
    const int nh = 1 << nksh, total = nsub * nh;
    typedef const __attribute__((address_space(1))) char* gcp_t;
    const char* wsg = (const char*)zrow - OFF_ZROW;
    auto uni = [](const char* p) { const unsigned long long v = (unsigned long long)p; const unsigned lo = __builtin_amdgcn_readfirstlane((unsigned)v), hi = __builtin_amdgcn_readfirstlane((unsigned)(v >> 32)); return (gcp_t)(((unsigned long long)hi << 32) | lo); };
    const gcp_t wsu = uni(wsg), btu = uni((const char*)Bt);
    unsigned aoff[NA], boff[4];
    const int csw = ((lane & 7) ^ ((4 * (w & 1) + (lane >> 4)) & 7)) * 16;
#pragma unroll
    for (int i = 0; i < NA; ++i) {
        const int row = 8 * (w + 8 * i) + (lane >> 3);
        const bf16_t* a = arow(row);
        aoff[i] = (unsigned)((const char*)(a ? a : zrow) - wsg) + csw;
    }
#pragma unroll
    for (int i = 0; i < 4; ++i) {
        const int row = 8 * (w + 8 * i) + (lane >> 3);
        boff[i] = (unsigned)(row * ldb * 2 + csw);
    }
    const size_t bsub = (size_t)256 * ldb;
    auto dma_a = [&](int k0, LAS char* stg) {
        gcp_t ab = wsu + k0 * 2; asm volatile("" : "+s"(ab));
#pragma unroll
        for (int i = 0; i < NA; ++i) {
            unsigned ao = aoff[i]; asm volatile("" : "+v"(ao));
            __builtin_amdgcn_global_load_lds((const __attribute__((address_space(1))) unsigned*)(ab + ao), (LAS unsigned*)(stg + (w + 8 * i) * 1024), 16, 0, 0);
        }
    };
    auto dma_b = [&](int t, int k0, LAS char* stg) {
        gcp_t bb = btu + (t * bsub + k0) * 2; asm volatile("" : "+s"(bb));
#pragma unroll
        for (int i = 0; i < 4; ++i) {
            unsigned bo = boff[i]; asm volatile("" : "+v"(bo));
            __builtin_amdgcn_global_load_lds((const __attribute__((address_space(1))) unsigned*)(bb + bo), (LAS unsigned*)(stg + BOFF + (w + 8 * i) * 1024), 16, 0, 0);
        }
    };
    auto dma = [&](int hs, int stage) {
        const int t = hs >> nksh, k0 = (hs - (t << nksh)) * 64;
        LAS char* stg = lds + stage * STG;
        dma_a(k0, stg); dma_b(t, k0, stg);
    };
    unsigned o[4];
#pragma unroll
    for (int ks = 0; ks < 4; ++ks) o[ks] = l31 * 128 + (((2 * ks + hf) ^ ((l31 >> 1) & 7)) << 4);
    f32x16 acc[2][NI];
#pragma unroll
    for (int mi = 0; mi < 2; ++mi)
#pragma unroll
        for (int ni = 0; ni < NI; ++ni)
#pragma unroll
            for (int i = 0; i < 16; ++i) acc[mi][ni][i] = 0.f;
    asm volatile("s_waitcnt lgkmcnt(0)" ::: "memory");
    __builtin_amdgcn_s_barrier();
    dma(0, 0); dma(1, 1);
    if constexpr (BM == 256) asm volatile("s_waitcnt vmcnt(8)" ::: "memory"); else asm volatile("s_waitcnt vmcnt(6)" ::: "memory");
    __builtin_amdgcn_s_barrier();
    pre();
    constexpr int NF = 2 + NI;
    const unsigned aofs = (64 * wm) * 128, bofs = (32 * NI * wn) * 128;
    auto rd = [&](bf16x8 (&a)[2], bf16x8 (&b)[NI], unsigned sbase, unsigned ok) {
        const unsigned pa = sbase + aofs + ok, pb = sbase + bofs + ok;
        asm volatile("ds_read_b128 %0, %1" : "=v"(a[0]) : "v"(pa));
        asm volatile("ds_read_b128 %0, %1 offset:4096" : "=v"(a[1]) : "v"(pa));
        asm volatile("ds_read_b128 %0, %1 offset:%2" : "=v"(b[0]) : "v"(pb), "n"(BOFF));
        asm volatile("ds_read_b128 %0, %1 offset:%2" : "=v"(b[1]) : "v"(pb), "n"(BOFF + 4096));
        if constexpr (NI == 4) {
            asm volatile("ds_read_b128 %0, %1 offset:%2" : "=v"(b[2]) : "v"(pb), "n"(BOFF + 8192));
            asm volatile("ds_read_b128 %0, %1 offset:%2" : "=v"(b[3]) : "v"(pb), "n"(BOFF + 12288));
        }
    };
    auto release = [&](bf16x8 (&a)[2], bf16x8 (&b)[NI], bool all) {
        if constexpr (NI == 4) {
            if (all) asm volatile("s_waitcnt lgkmcnt(0)" : "+v"(a[0]), "+v"(a[1]), "+v"(b[0]), "+v"(b[1]), "+v"(b[2]), "+v"(b[3]) :: "memory");
            else asm volatile("s_waitcnt lgkmcnt(6)" : "+v"(a[0]), "+v"(a[1]), "+v"(b[0]), "+v"(b[1]), "+v"(b[2]), "+v"(b[3]) :: "memory");
        } else {
            if (all) asm volatile("s_waitcnt lgkmcnt(0)" : "+v"(a[0]), "+v"(a[1]), "+v"(b[0]), "+v"(b[1]) :: "memory");
            else asm volatile("s_waitcnt lgkmcnt(4)" : "+v"(a[0]), "+v"(a[1]), "+v"(b[0]), "+v"(b[1]) :: "memory");
        }
    };
    auto mma = [&](const bf16x8 (&a)[2], const bf16x8 (&b)[NI]) {
        __builtin_amdgcn_sched_barrier(0);
#pragma unroll
        for (int mi = 0; mi < 2; ++mi)
#pragma unroll
            for (int ni = 0; ni < NI; ++ni)
                acc[mi][ni] = SWAP ? MFMA32(b[ni], a[mi], acc[mi][ni]) : MFMA32(a[mi], b[ni], acc[mi][ni]);
        __builtin_amdgcn_sched_barrier(0);
    };
    const unsigned lds0 = (unsigned)(size_t)lds;
    bf16x8 fa0[2], fb0[NI], fa1[2], fb1[NI];
    rd(fa0, fb0, lds0, o[0]);
    int st = 0;
    bool st_pend = false;
    for (int hs = 0; hs < total; ++hs) {
        const int hs_n = min(hs + 2, total - 1);
        const int t_n = hs_n >> nksh, k0_n = (hs_n - (t_n << nksh)) * 64;
        LAS char* stg = lds + st * STG;
        const unsigned sb = lds0 + st * STG, sbn = lds0 + (st ^ 1) * STG;
        rd(fa1, fb1, sb, o[1]); release(fa0, fb0, false); mma(fa0, fb0);
        rd(fa0, fb0, sb, o[2]); release(fa1, fb1, false); mma(fa1, fb1);
        rd(fa1, fb1, sb, o[3]); release(fa0, fb0, false); mma(fa0, fb0);
        if (NSTORE > 0 && st_pend) asm volatile("s_waitcnt vmcnt(%0)" :: "n"(NSTORE) : "memory"); else asm volatile("s_waitcnt vmcnt(0)" ::: "memory");
        st_pend = false;
        release(fa1, fb1, true);
        __builtin_amdgcn_s_barrier();
        dma_a(k0_n, stg);
        const bool last = ((hs + 1) & (nh - 1)) == 0;
        if (!last) rd(fa0, fb0, sbn, o[0]);
        mma(fa1, fb1);
        dma_b(t_n, k0_n, stg);
        __builtin_amdgcn_sched_barrier(0);
        if (last) {
            epi(hs >> nksh, acc);
#pragma unroll
            for (int mi = 0; mi < 2; ++mi)
#pragma unroll
                for (int ni = 0; ni < NI; ++ni)
#pragma unroll
                    for (int i = 0; i < 16; ++i) acc[mi][ni][i] = 0.f;
            rd(fa0, fb0, sbn, o[0]);
            st_pend = true;
        }
        st ^= 1;
    }
    release(fa0, fb0, true);
    asm volatile("s_waitcnt vmcnt(0) lgkmcnt(0)" ::: "memory");
    __builtin_amdgcn_s_barrier();
}

struct DenseRows { static constexpr bool kDense = true; const bf16_t* base; int ld; DI const bf16_t* operator()(int r) const { return base + (size_t)r * ld; } };

DI void epi_rows_bf16(char* smem, const f32x16 (&acc)[2][4], int row0, bf16_t* __restrict__ dst, int ldo, int cb, const float* gain, bool do_norm) {
    const int otid = opaque_tid(), lane = otid & 63, w = otid >> 6, wm = w >> 1, wn = w & 1, hf = lane >> 5;
#pragma unroll
    for (int mi = 0; mi < 2; ++mi)
#pragma unroll
        for (int pr = 0; pr < 2; ++pr) {
            float rstd = 1.f;
            if (do_norm) {
                float ss = 0.f;
#pragma unroll
                for (int n2 = 0; n2 < 2; ++n2)
#pragma unroll
                    for (int i = 0; i < 16; ++i) ss += acc[mi][2 * pr + n2][i] * acc[mi][2 * pr + n2][i];
                ss += __shfl_xor(ss, 32);
                rstd = rsqrtf(ss * (1.f / 64.f) + EPSF);
            }
            bf16_t* base = dst + (size_t)(row0 + 64 * wm + 32 * mi) * ldo + cb + 128 * wn + 64 * pr;
            int zo = 0; asm volatile("" : "+v"(zo));
            const float* gch = gain + zo + 4 * hf;
            f32x4 g4[2][4];
#pragma unroll
            for (int n2 = 0; n2 < 2; ++n2)
#pragma unroll
                for (int q4 = 0; q4 < 4; ++q4) g4[n2][q4] = *(const f32x4*)(gch + 32 * n2 + 8 * q4);
            stage_store_chunk<false, true>(smem, acc[mi][2 * pr], acc[mi][2 * pr + 1],
                              [&](int n2, int i, float x) { float o = x * rstd; if (do_norm) o *= g4[n2][i >> 2][i & 3]; return o; },
                              [&](int r) { return base + (size_t)r * ldo; });
        }
}
DI void epi_vt(char* smem, const f32x16 (&acc)[2][4], int row0, bf16_t* __restrict__ vt, int dv, int nheads, int colbase  ) {
    const int w = opaque_tid() >> 6, wm = w >> 1, wn = w & 1;
    const int b = row0 >> 13, s0 = row0 & (NS - 1);
#pragma unroll
    for (int ni = 0; ni < 4; ++ni) {
        const int c0 = colbase + 128 * wn + 32 * ni;
        bf16_t* base = vt + ((size_t)b * 512 + c0) * NS + s0 + 64 * wm;
        stage_store_chunk<true, true>(smem, acc[0][ni], acc[1][ni], [](int, int, float x) { return x; }, [&](int r) { return base + (size_t)r * NS; });
    }
}
DI void phase_inproj(const Params& P, char* smem) {
    const bf16_t* zrow = (const bf16_t*)(P.ws + OFF_ZROW);
    const bf16_t* h = (const bf16_t*)(P.ws + OFF_H);
    const bf16_t* win = (const bf16_t*)(P.ws + OFF_WIN);
    float* gl = (float*)(smem + SM_EXTRA);
    __syncthreads();
    {
        const int v = threadIdx.x >> 6, i = threadIdx.x & 63;
        if (v == 0) gl[i] = P.dq_g[i];
        else if (v == 1) gl[64 + i] = P.dk_g[i];
        else if (v == 2) gl[128 + i] = P.sq_g[i];
        else if (v == 3) gl[192 + i] = P.sk_g[i];
        else if (v == 4) gl[256 + i] = P.ik_g[i];
    }
    __syncthreads();
    const XPart xp1 = xcd_part(P.ws, smem, (NT / 256) * 10);
    for (int it = xp1.start; it < xp1.end; it += xp1.step) {
        const int jj = it % 10, mt = it / 10;
        const int j = jj < 4 ? jj : jj < 8 ? jj + 2 : jj + 4;
        const int row0 = mt * 256, grp = j >> 1, cb = (j & 1) * 256;
        DenseRows ar{h + (size_t)row0 * 1024, 1024};
        bf16_t* dst = (bf16_t*)(P.ws + (grp == 0 ? OFF_QD : grp == 1 ? OFF_KD : grp == 3 ? OFF_QS : grp == 4 ? OFF_KS : OFF_IQ));
        const float* gain = gl + 64 * (grp == 0 ? 0 : grp == 1 ? 1 : grp == 3 ? 2 : 3);
        const bool do_norm = grp != 6;
        gemm_dma<true, 256, 32>(smem, ar, win + (size_t)j * 256 * 1024, 1024, 4, 1, zrow, [&](int, const f32x16 (&acc)[2][4]) { epi_rows_bf16(smem, acc, row0, dst, 512, cb, gain, do_norm); });
    }
    const XPart xp2 = xcd_part(P.ws, smem, (NT / 256) * 4);
    for (int it = xp2.start; it < xp2.end; it += xp2.step) {
        const int jj = it & 3, mt = it >> 2;
        const int j = jj < 2 ? 4 + jj : 8 + jj;
        const int row0 = mt * 256, cb = (j & 1) * 256;
        DenseRows ar{h + (size_t)row0 * 1024, 1024};
        bf16_t* vt = (bf16_t*)(P.ws + (jj < 2 ? OFF_VDT : OFF_VST));
        const int dv = jj < 2 ? 128 : 64, nh = jj < 2 ? 4 : 8;
        gemm_dma<false, 256, 32>(smem, ar, win + (size_t)j * 256 * 1024, 1024, 4, 1, zrow, [&](int, const f32x16 (&acc)[2][4]) { epi_vt(smem, acc, row0, vt, dv, nh, cb); });
    }
    for (int mt = blockIdx.x; mt < NT / 256; mt += gridDim.x) {
        const int row0 = mt * 256;
        DenseRows ar{h + (size_t)row0 * 1024, 1024};
        gemm_dma<true, 256>(smem, ar, win + (size_t)14 * 256 * 1024, 1024, 4, 1, zrow, [&](int, const f32x16 (&acc)[2][4]) {
            const int otid = opaque_tid(), lane = otid & 63, w = otid >> 6, wm = w >> 1, wn = w & 1, l31 = lane & 31, hf = lane >> 5;
            if (wn == 0) {
                bf16_t* ik = (bf16_t*)(P.ws + OFF_IK);
                float* iw = (float*)(P.ws + OFF_IW);
                const float s = 0.35355339059327373f * 0.125f;
#pragma unroll
                for (int mi = 0; mi < 2; ++mi) {
                    const int tok = row0 + 64 * wm + 32 * mi + l31;
                    float ss = 0.f;
#pragma unroll
                    for (int ni = 0; ni < 2; ++ni)
#pragma unroll
                        for (int i = 0; i < 16; ++i) ss += acc[mi][ni][i] * acc[mi][ni][i];
                    ss += __shfl_xor(ss, 32);
                    const float rstd = rsqrtf(ss * (1.f / 64.f) + EPSF);
#pragma unroll
                    for (int ni = 0; ni < 2; ++ni)
#pragma unroll
                        for (int q4 = 0; q4 < 4; ++q4) {
                            const int f = 32 * ni + 8 * q4 + 4 * hf;
                            float o[4];
#pragma unroll
                            for (int r = 0; r < 4; ++r) o[r] = acc[mi][ni][4 * q4 + r] * rstd * gl[256 + f + r];
                            u32x2 pk; pk[0] = pk2(o[0], o[1]); pk[1] = pk2(o[2], o[3]);
                            *(u32x2*)(ik + ((((size_t)(tok >> 5) * 4 + (2 * ni + (q4 >> 1))) * 64 + 32 * (q4 & 1) + (tok & 31)) * 8 + 4 * hf)) = pk;
                        }
                    f32x4 o = {acc[mi][2][0] * s, acc[mi][2][1] * s, acc[mi][2][2] * s, acc[mi][2][3] * s};
                    *(f32x4*)(iw + (size_t)tok * 8 + 4 * hf) = o;
                }
            }
        });
    }
}

constexpr int TK_CAP = 512, TK_HI = 448;
template <int NPASS>
DI unsigned topk_prune(volatile LAS unsigned* buf, volatile LAS unsigned* hist, int cnt, int& kept) {
    const int lane = threadIdx.x & 63;
    unsigned e[8];
#pragma unroll
    for (int i = 0; i < 8; ++i) { const int idx = lane + 64 * i; e[i] = idx < cnt ? buf[idx] : 0u; }
    unsigned prefix = 0u, want = 256u;
#pragma unroll
    for (int p = 3; p >= 4 - NPASS; --p) {
        const int sh = 8 * p;
#pragma unroll
        for (int j = 0; j < 4; ++j) hist[4 * lane + j] = 0u;
        asm volatile("" ::: "memory");
#pragma unroll
        for (int i = 0; i < 8; ++i) {
            const bool m = (e[i] != 0u) && (p == 3 || (e[i] >> (sh + 8)) == prefix);
            if (m) __hip_atomic_fetch_add((LAS unsigned*)&hist[(e[i] >> sh) & 255u], 1u, __ATOMIC_RELAXED, __HIP_MEMORY_SCOPE_WORKGROUP);
        }
        asm volatile("" ::: "memory");
        const unsigned h0 = hist[4 * lane], h1 = hist[4 * lane + 1], h2 = hist[4 * lane + 2], h3 = hist[4 * lane + 3];
        const unsigned s4 = h0 + h1 + h2 + h3;
        int suf_i = (int)s4;
        suf_i += __builtin_amdgcn_update_dpp(0, suf_i, 0x101, 0xf, 0xf, true);
        suf_i += __builtin_amdgcn_update_dpp(0, suf_i, 0x102, 0xf, 0xf, true);
        suf_i += __builtin_amdgcn_update_dpp(0, suf_i, 0x104, 0xf, 0xf, true);
        suf_i += __builtin_amdgcn_update_dpp(0, suf_i, 0x108, 0xf, 0xf, true);
        const int t1 = __builtin_amdgcn_readlane(suf_i, 16), t2 = __builtin_amdgcn_readlane(suf_i, 32), t3 = __builtin_amdgcn_readlane(suf_i, 48);
        const int row = lane >> 4;
        const unsigned suf = (unsigned)(suf_i + (row == 0 ? t1 + t2 + t3 : row == 1 ? t2 + t3 : row == 2 ? t3 : 0));
        const unsigned above = suf - s4;
        const bool own = (above < want) && (want <= suf);
        unsigned bsel = 0u, cum = above;
        if (cum + h3 >= want) bsel = 3u;
        else { cum += h3; if (cum + h2 >= want) bsel = 2u; else { cum += h2; if (cum + h1 >= want) bsel = 1u; else { cum += h1; bsel = 0u; } } }
        const u64 om = __builtin_amdgcn_ballot_w64(own);
        const int ol = om ? (int)__builtin_ctzll(om) : 0;
        const unsigned bin = (unsigned)__builtin_amdgcn_readlane((int)(4u * lane + bsel), ol);
        const unsigned cm = (unsigned)__builtin_amdgcn_readlane((int)cum, ol);
        prefix = (prefix << 8) | bin; want -= cm;
    }
    const unsigned V = NPASS == 4 ? prefix : (prefix << 16);
    int base = 0;
#pragma unroll
    for (int i = 0; i < 8; ++i) {
        const bool keep = (e[i] != 0u) && (e[i] >= V);
        const u64 mk = __ballot(keep);
        const int pos = base + __builtin_popcountll(mk & ((1ull << lane) - 1ull));
        if (keep) buf[pos] = e[i];
        base += __builtin_popcountll(mk);
    }
    asm volatile("" ::: "memory");
    kept = base;
    return NPASS == 4 ? V : (V ? V - 1u : 0u);
}

DI void indexer_item(const Params& P, char* smem, int b, int q0) {
    const int lane = threadIdx.x & 63, w = __builtin_amdgcn_readfirstlane(threadIdx.x >> 6), l31 = lane & 31, hf = lane >> 5;
    const int qbase = q0 + 8 * w;
    const bf16_t* IQ = (const bf16_t*)(P.ws + OFF_IQ);
    const bf16_t* IK = (const bf16_t*)(P.ws + OFF_IK);
    const float* IW = (const float*)(P.ws + OFF_IW);
    volatile LAS unsigned* buf = (volatile LAS unsigned*)(LAS char*)(smem + w * 8 * 2048);
    volatile LAS unsigned* hist = (volatile LAS unsigned*)(LAS char*)(smem + 131072 + w * 1024);
    bf16x8 af[2][4];
    {
        const int m = l31, qs = 2 * ((m >> 2) & 1) + (m >> 4), head = 4 * ((m >> 3) & 1) + (m & 3);
#pragma unroll
        for (int mt = 0; mt < 2; ++mt) {
            const size_t tok = (size_t)b * NS + qbase + 4 * mt + qs;
#pragma unroll
            for (int ks = 0; ks < 4; ++ks) af[mt][ks] = *(const bf16x8*)(IQ + tok * 512 + head * 64 + ks * 16 + hf * 8);
        }
    }
    float iwv[2][2][8]; int qpos[2][2]; unsigned tau[2][2]; int cnt[2][2];
#pragma unroll
    for (int mt = 0; mt < 2; ++mt)
#pragma unroll
        for (int j = 0; j < 2; ++j) {
            qpos[mt][j] = qbase + 4 * mt + 2 * hf + j; tau[mt][j] = 0u; cnt[mt][j] = 0;
            const float* p = IW + ((size_t)b * NS + qpos[mt][j]) * 8;
            const f32x4 a = *(const f32x4*)p, c = *(const f32x4*)(p + 4);
#pragma unroll
            for (int r = 0; r < 4; ++r) { iwv[mt][j][r] = a[r]; iwv[mt][j][4 + r] = c[r]; }
        }
    const int nkt = ((qbase + 7) >> 6) + 1;
    const bf16_t* ikb = IK + (size_t)b * NS * 64 + (size_t)lane * 8;
    bf16x8 bfr[2][4];
#pragma unroll
    for (int sb = 0; sb < 2; ++sb)
#pragma unroll
        for (int ks = 0; ks < 4; ++ks) bfr[sb][ks] = *(const bf16x8*)(ikb + (size_t)(sb * 4 + ks) * 512);
#pragma unroll 2
    for (int kt = 0; kt < nkt; ++kt) {
        bf16x8 bn[2][4];
        {
            const int kn = min(kt + 1, nkt - 1) * 64;
#pragma unroll
            for (int sb = 0; sb < 2; ++sb)
#pragma unroll
                for (int ks = 0; ks < 4; ++ks) bn[sb][ks] = *(const bf16x8*)(ikb + (size_t)kn * 64 + (size_t)(sb * 4 + ks) * 512);
        }
#pragma unroll
        for (int sb = 0; sb < 2; ++sb) {
            const int k0 = kt * 64 + 32 * sb;
            if (k0 > qbase + 7) continue;
            const bool needcausal = k0 + 31 > qbase;
            f32x16 acc[2];
#pragma unroll
            for (int mt = 0; mt < 2; ++mt) {
#pragma unroll
                for (int i = 0; i < 16; ++i) acc[mt][i] = 0.f;
#pragma unroll
                for (int ks = 0; ks < 4; ++ks) acc[mt] = MFMA32(af[mt][ks], bfr[sb][ks], acc[mt]);
            }
            const int kidx = k0 + l31;
#pragma unroll
            for (int mt = 0; mt < 2; ++mt)
#pragma unroll
                for (int j = 0; j < 2; ++j) {
                    float s = 0.f;
#pragma unroll
                    for (int t = 0; t < 8; ++t)
                        s = __builtin_fmaf(iwv[mt][j][t], __int_as_float(max(__float_as_int(acc[mt][8 * j + t]), 0)), s);
                    const int si = __float_as_int(s);
                    const unsigned ord = (unsigned)si ^ ((unsigned)(si >> 31) | 0x80000000u);
                    const unsigned pk = (ord & 0xFFFFE000u) | (unsigned)(8191 - kidx);
                    const int qlim = needcausal ? qpos[mt][j] : 0x7fffffff;
                    const bool pass = (kidx <= qlim) & (pk > tau[mt][j]);
                    const u64 mk = __builtin_amdgcn_ballot_w64(pass);
                    const unsigned hm = hf ? (unsigned)(mk >> 32) : (unsigned)mk;
                    const int pos = cnt[mt][j] + __builtin_popcount(hm & ((1u << l31) - 1u));
                    { const int widx = pass ? (4 * mt + 2 * hf + j) * TK_CAP + pos : (int)(hist - buf) + lane; buf[widx] = pk; }
                    cnt[mt][j] += __builtin_popcount(hm);
                }
        }
        const bool anyhi = cnt[0][0] > TK_HI || cnt[0][1] > TK_HI || cnt[1][0] > TK_HI || cnt[1][1] > TK_HI;
        if (__ballot(anyhi) != 0ull) {
#pragma unroll 1
            for (int s8 = 0; s8 < 8; ++s8) {
                const int mt = s8 >> 2, j = (s8 >> 1) & 1, h2 = s8 & 1;
                const int cv = mt ? (j ? cnt[1][1] : cnt[1][0]) : (j ? cnt[0][1] : cnt[0][0]);
                const int c = __builtin_amdgcn_readlane(cv, 32 * h2);
                if (c > TK_HI) {
                    volatile LAS unsigned* qb = buf + (4 * mt + 2 * h2 + j) * TK_CAP;
                    int nk = 0;
                    unsigned V = topk_prune<2>(qb, hist, c, nk);
                    if (nk > TK_HI - 64) V = topk_prune<4>(qb, hist, nk, nk);
#pragma unroll
                    for (int a = 0; a < 2; ++a)
#pragma unroll
                        for (int d = 0; d < 2; ++d)
                            if (hf == h2 && a == mt && d == j) { tau[a][d] = V; cnt[a][d] = nk; }
                }
            }
        }
#pragma unroll
        for (int sb = 0; sb < 2; ++sb)
#pragma unroll
            for (int ks = 0; ks < 4; ++ks) bfr[sb][ks] = bn[sb][ks];
    }
#pragma unroll 1
    for (int s8 = 0; s8 < 8; ++s8) {
        const int mt = s8 >> 2, j = (s8 >> 1) & 1, h2 = s8 & 1;
        const int cv = mt ? (j ? cnt[1][1] : cnt[1][0]) : (j ? cnt[0][1] : cnt[0][0]);
        int c = __builtin_amdgcn_readlane(cv, 32 * h2);
        volatile LAS unsigned* qb = buf + (4 * mt + 2 * h2 + j) * TK_CAP;
        if (c > 256) { int nk = 0; (void)topk_prune<4>(qb, hist, c, nk); c = nk; }
#pragma unroll
        for (int t = 0; t < 4; ++t) qb[256 + 4 * lane + t] = 0u;
        asm volatile("" ::: "memory");
#pragma unroll
        for (int t = 0; t < 4; ++t) {
            const int idx = lane + 64 * t;
            if (idx < c) {
                const unsigned e = qb[idx]; const unsigned kk = 8191u - (e & 8191u);
                __hip_atomic_fetch_or((LAS unsigned*)&qb[256 + (kk >> 5)], 1u << (kk & 31u), __ATOMIC_RELAXED, __HIP_MEMORY_SCOPE_WORKGROUP);
            }
        }
        asm volatile("" ::: "memory");
    }
    u64* mask = (u64*)(P.ws + OFF_MASK);
    const int ktmax = (q0 | 255) >> 6;
    const int qi = lane & 7;
#pragma unroll 1
    for (int it = 0; it < 16; ++it) {
        const int kt = it * 8 + (lane >> 3);
        if (kt <= ktmax) {
            const unsigned lo = buf[qi * TK_CAP + 256 + 2 * kt], hi = buf[qi * TK_CAP + 256 + 2 * kt + 1];
            mask[((size_t)(b * 128 + kt)) * NS + qbase + qi] = ((u64)hi << 32) | lo;
        }
    }
}

template <int NDB, bool BM>
DI void attn_tile(const LAS char* Kt, const LAS char* Vt, const bf16x8 (&qf)[4], f32x16 (&o)[NDB], float off, float& mlow, float& lrun,
                  int qpos, int k0, float c1, float c2, bool diag, bool scan, u64 mword) {
    const int lane = threadIdx.x & 63, l31 = lane & 31, hf = lane >> 5;
    const int lanex = ((((l31 >> 1) & 7) ^ hf) << 4);
    const LAS char* kbase = Kt + l31 * 128;
    const LAS char* vbase = Vt + l31 * 128;
    const float bias0 = -c2 * (float)(qpos - k0 - 4 * hf) - off;
#pragma unroll 1
    for (int kbi = 0; kbi < 2; ++kbi) {
        const int kb = 1 - kbi;
        f32x16 st;
#pragma unroll
        for (int i = 0; i < 16; ++i) st[i] = 0.f;
#pragma unroll
        for (int ks = 0; ks < 4; ++ks) {
            const bf16x8 kf = *(const LAS bf16x8*)(kbase + kb * 4096 + (lanex ^ (ks << 5)));
            st = MFMA32(kf, qf[ks], st);
        }
        const unsigned mw = BM ? (unsigned)((kb ? (unsigned)(mword >> 32) : (unsigned)mword) >> (4 * hf)) : 0u;
        const float noff = bias0 + c2 * (float)(32 * kb);
        float ls = 0.f, mx = -INFINITY;
#pragma unroll
        for (int i = 0; i < 16; ++i) {
            const int ko = (i & 3) + 8 * (i >> 2);
            const float v = __builtin_fmaf(st[i], c1, __builtin_fmaf(c2, (float)ko, noff));
            bool ok = true;
            if (BM) ok = (mw >> ko) & 1u;
            if (diag) ok = ok && (k0 + 32 * kb + ko + 4 * hf <= qpos);
            float p = __builtin_amdgcn_exp2f(v);
            if (BM || diag) p = ok ? p : 0.f;
            if (scan) mx = fmaxf(mx, (BM || diag) ? (ok ? v : -INFINITY) : v);
            st[i] = p; ls += p;
        }
        lrun += ls;
        if (scan) { mx = fmaxf(mx, __shfl_xor(mx, 32)); mlow = fmaxf(mlow, mx + off); }
        const int vx = lanex ^ (kb << 6);
#pragma unroll
        for (int s = 0; s < 2; ++s) {
            u32x4 pp;
#pragma unroll
            for (int t = 0; t < 4; ++t) pp[t] = pk2(st[8 * s + 2 * t], st[8 * s + 2 * t + 1]);
            const bf16x8 pf = __builtin_bit_cast(bf16x8, pp);
#pragma unroll
            for (int db = 0; db < NDB; ++db) {
                const bf16x8 vf = *(const LAS bf16x8*)(vbase + db * 4096 + (vx ^ (s << 5)));
                o[db] = MFMA32(vf, pf, o[db]);
            }
        }
    }
}

constexpr int AT_NST = 4;

DI void diffattn_item(const Params& P, char* smem, int b, int h, int qb) {
    const int tid = threadIdx.x, lane = tid & 63, w = __builtin_amdgcn_readfirstlane(tid >> 6), l31 = lane & 31, hf = lane >> 5;
    const int map = w & 1, qsub = w >> 1;
    const int q0 = qb * 128;
    LAS char* lds = (LAS char*)smem;
    const bf16_t* Qd = (const bf16_t*)(P.ws + OFF_QD);
    const bf16_t* Kd = (const bf16_t*)(P.ws + OFF_KD);
    const bf16_t* VdT = (const bf16_t*)(P.ws + OFF_VDT);
    const int drow = 8 * w + (lane >> 3), dch = (lane & 7) ^ ((drow >> 1) & 7);
    const bf16_t* ksrc = Kd + ((size_t)b * NS + drow) * 512 + h * 128 + dch * 8;
    const bf16_t* vsrc = VdT + ((size_t)(b * 4 + h) * 128 + drow) * NS + dch * 8;
    auto dma = [&](int kt, int stage) {
        LAS char* stg = lds + stage * 32768;
        const size_t k0 = (size_t)kt * 64;
        __builtin_amdgcn_global_load_lds((const unsigned*)(ksrc + k0 * 512), (LAS unsigned*)(stg + w * 1024), 16, 0, 0);
        __builtin_amdgcn_global_load_lds((const unsigned*)(ksrc + k0 * 512 + 64), (LAS unsigned*)(stg + 8192 + w * 1024), 16, 0, 0);
        __builtin_amdgcn_global_load_lds((const unsigned*)(vsrc + k0), (LAS unsigned*)(stg + 16384 + w * 1024), 16, 0, 0);
        __builtin_amdgcn_global_load_lds((const unsigned*)(vsrc + (size_t)64 * NS + k0), (LAS unsigned*)(stg + 16384 + 8192 + w * 1024), 16, 0, 0);
    };
    const int ktd = 2 * qb + 1;
    asm volatile("s_waitcnt vmcnt(0) lgkmcnt(0)" ::: "memory");
    __builtin_amdgcn_s_barrier();
    dma(max(ktd, 0), 0); dma(max(ktd - 1, 0), 1); dma(max(ktd - 2, 0), 2);
    const int qpos = q0 + 32 * qsub + l31;
    const int qwmax = q0 + 32 * qsub + 31, qwmin = q0 + 32 * qsub;
    bf16x8 qf[4];
#pragma unroll
    for (int ks = 0; ks < 4; ++ks) qf[ks] = *(const bf16x8*)(Qd + ((size_t)b * NS + qpos) * 512 + h * 128 + map * 64 + ks * 16 + hf * 8);
    const float slope = exp2f(-2.f * (float)(h + 1));
    const float c1 = 0.125f * LOG2E, c2 = slope * LOG2E;
    float gq = fabsf(P.dq_g[lane]), gk = fabsf(P.dk_g[lane]);
#pragma unroll
    for (int d = 32; d >= 1; d >>= 1) { gq = fmaxf(gq, __shfl_xor(gq, d)); gk = fmaxf(gk, __shfl_xor(gk, d)); }
    const float B2 = 64.f * gq * gk * 1.008f * c1;
    int* flags = (int*)(smem + SM_EXTRA + 3072);
    int par = 0;
    f32x16 o[4];
#pragma unroll
    for (int db = 0; db < 4; ++db)
#pragma unroll
        for (int i = 0; i < 16; ++i) o[db][i] = 0.f;
    float mlow = -INFINITY, lrun = 0.f;
    int ndone = 0;
    for (int j = 0; j <= ktd; ++j) {
        const int kt = ktd - j, k0 = kt * 64;
        asm volatile("s_waitcnt vmcnt(8)" ::: "memory");
        asm volatile("s_waitcnt lgkmcnt(0)" ::: "memory");
        __builtin_amdgcn_s_barrier();
        int allstop = 0;
        if (j > 0) { allstop = 1;
#pragma unroll
            for (int i = 0; i < 8; ++i) allstop &= flags[(par ^ 1) * 8 + i]; }
        if (allstop) break;
        dma(max(kt - 3, 0), (j + 3) & 3);
        const LAS char* cur = lds + (j & 3) * 32768;
        if (k0 <= qwmax) {
            attn_tile<4, false>(cur + map * 8192, cur + 16384, qf, o, B2, mlow, lrun, qpos, k0, c1, c2, k0 + 63 > qwmin, ndone < 2, 0ull);
            ++ndone;
        }
        {
            const float ub = B2 - c2 * (float)(qpos - (k0 - 1));
            const bool stop = __all(ub < mlow - 30.f);
            if (lane == 0) flags[par * 8 + w] = stop ? 1 : 0;
        }
        par ^= 1;
    }
    asm volatile("s_waitcnt vmcnt(0) lgkmcnt(0)" ::: "memory");
    __builtin_amdgcn_s_barrier();
    const float ltot = lrun + __shfl_xor(lrun, 32);
    const float inv = 1.f / ltot;
    float la, lb;
    { const float a = P.lq1[lane] * P.lk1[lane], c = P.lq2[lane] * P.lk2[lane]; la = wave_sum(a); lb = wave_sum(c); }
    const float lam = __expf(la) - __expf(lb) + 0.2f;
    float* X = (float*)smem;
    if (map == 1) {
#pragma unroll
        for (int db = 0; db < 4; ++db)
#pragma unroll
            for (int q4 = 0; q4 < 4; ++q4) {
                f32x4 v;
#pragma unroll
                for (int r = 0; r < 4; ++r) v[r] = o[db][4 * q4 + r] * inv * lam;
                *(f32x4*)(X + (qsub * 32 + l31) * 132 + 32 * db + 8 * q4 + 4 * hf) = v;
            }
    }
    __syncthreads();
    if (map == 0) {
        float ss = 0.f;
#pragma unroll
        for (int db = 0; db < 4; ++db)
#pragma unroll
            for (int q4 = 0; q4 < 4; ++q4) {
                const f32x4 v2 = *(const f32x4*)(X + (qsub * 32 + l31) * 132 + 32 * db + 8 * q4 + 4 * hf);
#pragma unroll
                for (int r = 0; r < 4; ++r) { const float v = o[db][4 * q4 + r] * inv - v2[r]; o[db][4 * q4 + r] = v; ss += v * v; }
            }
        ss += __shfl_xor(ss, 32);
        const float rstd = rsqrtf(ss * (1.f / 128.f) + EPSF) * 0.8f;
        bf16_t* ao = (bf16_t*)(P.ws + OFF_H) + ((size_t)b * NS + qpos) * 1024 + h * 128;
#pragma unroll
        for (int db = 0; db < 4; ++db)
#pragma unroll
            for (int q4 = 0; q4 < 4; ++q4) {
                const int d = 32 * db + 8 * q4 + 4 * hf;
                const f32x4 g = *(const f32x4*)((const float*)(smem + SM_EXTRA + 1024) + d);
                u32x2 pk; pk[0] = pk2(o[db][4 * q4] * rstd * g[0], o[db][4 * q4 + 1] * rstd * g[1]); pk[1] = pk2(o[db][4 * q4 + 2] * rstd * g[2], o[db][4 * q4 + 3] * rstd * g[3]);
                *(u32x2*)(ao + d) = pk;
            }
    }
    __syncthreads();
}

DI void dsa_item(const Params& P, char* smem, int b, int h, int qb) {
    const int tid = threadIdx.x, lane = tid & 63, w = __builtin_amdgcn_readfirstlane(tid >> 6), l31 = lane & 31, hf = lane >> 5;
    const int q0 = qb * 256;
    LAS char* lds = (LAS char*)smem;
    const bf16_t* Qs = (const bf16_t*)(P.ws + OFF_QS);
    const bf16_t* Ks = (const bf16_t*)(P.ws + OFF_KS);
    const bf16_t* VsT = (const bf16_t*)(P.ws + OFF_VST);
    const u64* mask = (const u64*)(P.ws + OFF_MASK);
    const int drow = 8 * w + (lane >> 3), dch = (lane & 7) ^ ((drow >> 1) & 7);
    const bf16_t* ksrc = Ks + ((size_t)b * NS + drow) * 512 + h * 64 + dch * 8;
    const bf16_t* vsrc = VsT + ((size_t)(b * 8 + h) * 64 + drow) * NS + dch * 8;
    const u64* msrc = mask + (size_t)b * 128 * NS + q0 + (w & 1) * 128 + lane * 2;
    auto dma = [&](int kt, int stage) {
        LAS char* stg = lds + stage * 18432;
        const size_t k0 = (size_t)kt * 64;
        __builtin_amdgcn_global_load_lds((const unsigned*)(ksrc + k0 * 512), (LAS unsigned*)(stg + w * 1024), 16, 0, 0);
        __builtin_amdgcn_global_load_lds((const unsigned*)(vsrc + k0), (LAS unsigned*)(stg + 8192 + w * 1024), 16, 0, 0);
        if (w < 2) __builtin_amdgcn_global_load_lds((const unsigned*)(msrc + (size_t)kt * NS), (LAS unsigned*)(stg + 16384 + w * 1024), 16, 0, 0);
    };
    const int ktd = 4 * qb + 3;
    asm volatile("s_waitcnt vmcnt(0) lgkmcnt(0)" ::: "memory");
    __builtin_amdgcn_s_barrier();
    dma(max(ktd, 0), 0); dma(max(ktd - 1, 0), 1); dma(max(ktd - 2, 0), 2);
    const int qpos = q0 + 32 * w + l31;
    const int qwmax = q0 + 32 * w + 31;
    bf16x8 qf[4];
#pragma unroll
    for (int ks = 0; ks < 4; ++ks) qf[ks] = *(const bf16x8*)(Qs + ((size_t)b * NS + qpos) * 512 + h * 64 + ks * 16 + hf * 8);
    const float slope = exp2f(-(float)(h + 1));
    const float c1 = 0.125f * LOG2E, c2 = slope * LOG2E;
    float gq = fabsf(P.sq_g[lane]), gk = fabsf(P.sk_g[lane]);
#pragma unroll
    for (int d = 32; d >= 1; d >>= 1) { gq = fmaxf(gq, __shfl_xor(gq, d)); gk = fmaxf(gk, __shfl_xor(gk, d)); }
    const float B2 = 64.f * gq * gk * 1.008f * c1;
    int* flags = (int*)(smem + SM_EXTRA + 3072);
    int par = 0;
    f32x16 o[2];
#pragma unroll
    for (int db = 0; db < 2; ++db)
#pragma unroll
        for (int i = 0; i < 16; ++i) o[db][i] = 0.f;
    float mlow = -INFINITY, lrun = 0.f, off = 0.f;
    bool offset_set = false;
    for (int j = 0; j <= ktd; ++j) {
        const int kt = ktd - j, k0 = kt * 64;
        if (w < 2) asm volatile("s_waitcnt vmcnt(6)" ::: "memory"); else asm volatile("s_waitcnt vmcnt(4)" ::: "memory");
        asm volatile("s_waitcnt lgkmcnt(0)" ::: "memory");
        __builtin_amdgcn_s_barrier();
        int allstop = 0;
        if (j > 0) { allstop = 1;
#pragma unroll
            for (int i = 0; i < 8; ++i) allstop &= flags[(par ^ 1) * 8 + i]; }
        if (allstop) break;
        dma(max(kt - 3, 0), (j + 3) & 3);
        const LAS char* cur = lds + (j & 3) * 18432;
        u64 mword = 0ull;
        if (k0 <= qwmax) mword = *(const LAS u64*)(cur + 16384 + (32 * w + l31) * 8);
        if (k0 <= qwmax && __ballot(mword != 0ull) != 0ull) {
            if (!offset_set && mword != 0ull) { off = B2 - c2 * (float)max(qpos - (k0 + 63), 0); offset_set = true; }
            attn_tile<2, true>(cur, cur + 8192, qf, o, off, mlow, lrun, qpos, k0, c1, c2, false, __any(mlow == -INFINITY), mword);
        }
        {
            const float ub = B2 - c2 * (float)(qpos - (k0 - 1));
            const bool stop = __all(ub < mlow - 30.f);
            if (lane == 0) flags[par * 8 + w] = stop ? 1 : 0;
        }
        par ^= 1;
    }
    asm volatile("s_waitcnt vmcnt(0) lgkmcnt(0)" ::: "memory");
    __builtin_amdgcn_s_barrier();
    const float ltot = lrun + __shfl_xor(lrun, 32);
    const float inv = 1.f / ltot;
    bf16_t* ao = (bf16_t*)(P.ws + OFF_H) + ((size_t)b * NS + qpos) * 1024 + 512 + h * 64;
#pragma unroll
    for (int db = 0; db < 2; ++db)
#pragma unroll
        for (int q4 = 0; q4 < 4; ++q4) {
            const int d = 32 * db + 8 * q4 + 4 * hf;
            u32x2 pk; pk[0] = pk2(o[db][4 * q4] * inv, o[db][4 * q4 + 1] * inv); pk[1] = pk2(o[db][4 * q4 + 2] * inv, o[db][4 * q4 + 3] * inv);
            *(u32x2*)(ao + d) = pk;
        }
}

constexpr int P3_ITEMS = 128 * 8;
DI void phase_indexer(const Params& P, char* smem) {
    const XPart xp = xcd_part(P.ws, smem, P3_ITEMS);
    const int step = xp.step;
    const int rank = ((const int*)(smem + XC_LDS))[1];
    const int base = xp.start - rank;
    for (int k = 0; base + k * step < xp.end; ++k) {
        const int i = base + k * step + ((k & 1) ? step - 1 - rank : rank);
        if (i >= xp.end) continue;
        const int b = i >> 7, g = 127 - (i & 127);
        __syncthreads();
        indexer_item(P, smem, b, g * 64);
    }
    __syncthreads();
}
DI void phase_attn(const Params& P, char* smem, int qidx) {
    int* qctr = (int*)(P.ws + OFF_Q) + qidx;
    const int* items = (const int*)(P.ws + OFF_ITEMS);
    volatile int* s_it = (volatile int*)(smem + SM_EXTRA + 3200);
    __syncthreads();
    if (threadIdx.x < 128) ((float*)(smem + SM_EXTRA + 1024))[threadIdx.x] = P.subln_g[threadIdx.x];
    __syncthreads();
    int it = blockIdx.x;
    while (it < ATT_ITEMS) {
        int nxt = 0;
        if (threadIdx.x == 0) nxt = atomicAdd(qctr, 1) + (int)gridDim.x;
        const int code = items[it];
        const int b = (code >> 16) & 15, h = (code >> 8) & 255, qb = code & 255;
        if ((code >> 20) == 0) diffattn_item(P, smem, b, h, qb);
        else dsa_item(P, smem, b, h, qb);
        __syncthreads();
        if (threadIdx.x == 0) *s_it = nxt;
        __syncthreads();
        it = *s_it;
    }
}

constexpr int OUTPROJ_ITEMS = (NT / 256) * 4;
DI void phase_outproj(const Params& P, char* smem) {
    const bf16_t* zrow = (const bf16_t*)(P.ws + OFF_ZROW);
    const bf16_t* ao = (const bf16_t*)(P.ws + OFF_H);
    const bf16_t* wout = (const bf16_t*)(P.ws + OFF_WOUT);
    bf16_t* mix = (bf16_t*)(P.ws + OFF_QD);
    const int lane = threadIdx.x & 63, w = threadIdx.x >> 6, wm = w >> 1, wn = w & 1, l31 = lane & 31, hf = lane >> 5;
    const XPart xp = xcd_part(P.ws, smem, OUTPROJ_ITEMS);
    for (int it = xp.start; it < xp.end; it += xp.step) {
        const int mt = it >> 2, j = it & 3;
        const int row0 = mt * 256;
        DenseRows ar{ao + (size_t)row0 * 1024, 1024};
        gemm_dma<true, 256>(smem, ar, wout + (size_t)j * 256 * 1024, 1024, 4, 1, zrow, [&](int, const f32x16 (&acc)[2][4]) {
#pragma unroll
            for (int mi = 0; mi < 2; ++mi)
#pragma unroll
                for (int pr = 0; pr < 2; ++pr) {
                    bf16_t* base = mix + ((size_t)row0 + 64 * wm + 32 * mi) * 1024 + 256 * j + 128 * wn + 64 * pr;
                    stage_store_chunk<false, true>(smem, acc[mi][2 * pr], acc[mi][2 * pr + 1], [](int, int, float x) { return x; }, [&](int r) { return base + (size_t)r * 1024; });
                }
        });
    }
}
DI void phase_resnorm2(const Params& P) {
    const bf16_t* mix = (const bf16_t*)(P.ws + OFF_QD);
    const float* mod = (const float*)(P.ws + OFF_MOD);
    bf16_t* h2 = (bf16_t*)(P.ws + OFF_H2);
    const int lane = threadIdx.x & 63, w = threadIdx.x >> 6, stride = gridDim.x * NW;
    f32x4 xa[4]; u32x2 ma[4];
    auto ld = [&](int r, f32x4 (&xv)[4], u32x2 (&mv)[4]) {
#pragma unroll
        for (int i = 0; i < 4; ++i) { const int col = 256 * i + 4 * lane; xv[i] = __builtin_nontemporal_load((const f32x4*)(P.x + (size_t)r * 1024 + col)); mv[i] = __builtin_nontemporal_load((const u32x2*)(mix + (size_t)r * 1024 + col)); }
    };
    int row = blockIdx.x * NW + w, bcur = -1;
    f32x4 g1v[4], ggv[4], shv[4], scv[4];
#pragma unroll
    for (int i = 0; i < 4; ++i) ggv[i] = *(const f32x4*)(P.norm2_g + 256 * i + 4 * lane);
    if (row < NT) ld(row, xa, ma);
    for (; row < NT; row += stride) {
        const int b = row >> 13;
        if (b != bcur) {
            const float* mb = mod + b * 6144;
#pragma unroll
            for (int i = 0; i < 4; ++i) { const int col = 256 * i + 4 * lane; g1v[i] = *(const f32x4*)(mb + 2048 + col); shv[i] = *(const f32x4*)(mb + 3072 + col); scv[i] = *(const f32x4*)(mb + 4096 + col); }
            bcur = b;
        }
        f32x4 xb[4]; u32x2 mb2[4];
        ld(row + stride < NT ? row + stride : row, xb, mb2);
        f32x4 v[4]; float ss = 0.f;
#pragma unroll
        for (int i = 0; i < 4; ++i) {
            const int col = 256 * i + 4 * lane;
            const f32x4 g1 = g1v[i];
            v[i][0] = xa[i][0] + g1[0] * bflo(ma[i][0]); v[i][1] = xa[i][1] + g1[1] * bfhi(ma[i][0]);
            v[i][2] = xa[i][2] + g1[2] * bflo(ma[i][1]); v[i][3] = xa[i][3] + g1[3] * bfhi(ma[i][1]);
            __builtin_nontemporal_store(v[i], (f32x4*)(P.out + (size_t)row * 1024 + col));
            ss += v[i][0] * v[i][0] + v[i][1] * v[i][1] + v[i][2] * v[i][2] + v[i][3] * v[i][3];
        }
        ss = wave_sum(ss);
        const float rstd = rsqrtf(ss * (1.f / 1024.f) + EPSF);
#pragma unroll
        for (int i = 0; i < 4; ++i) {
            const int col = 256 * i + 4 * lane;
            const f32x4 gg = ggv[i], sh = shv[i], sc = scv[i];
            float o[4];
#pragma unroll
            for (int j = 0; j < 4; ++j) o[j] = v[i][j] * rstd * gg[j] * (1.f + sc[j]) + sh[j];
            u32x2 pk; pk[0] = pk2(o[0], o[1]); pk[1] = pk2(o[2], o[3]);
            *(u32x2*)(h2 + (size_t)row * 1024 + col) = pk;
        }
#pragma unroll
        for (int i = 0; i < 4; ++i) { xa[i] = xb[i]; ma[i] = mb2[i]; }
    }
}

constexpr int ROUTER_ITEMS = NT / 256;
DI void phase_router(const Params& P, char* smem) {
    const bf16_t* zrow = (const bf16_t*)(P.ws + OFF_ZROW);
    const bf16_t* h2 = (const bf16_t*)(P.ws + OFF_H2);
    const bf16_t* wrt = (const bf16_t*)(P.ws + OFF_WRT);
    float* logits = (float*)(P.ws + OFF_Y);
    const int lane = threadIdx.x & 63, w = threadIdx.x >> 6, wm = w >> 1, wn = w & 1, l31 = lane & 31, hf = lane >> 5;
    for (int it = blockIdx.x; it < ROUTER_ITEMS; it += gridDim.x) {
        const int row0 = it * 256;
        DenseRows ar{h2 + (size_t)row0 * 1024, 1024};
        gemm_dma<true, 256>(smem, ar, wrt, 1024, 4, 1, zrow, [&](int, const f32x16 (&acc)[2][4]) {
#pragma unroll
            for (int mi = 0; mi < 2; ++mi) {
                const size_t tok = (size_t)row0 + 64 * wm + 32 * mi + l31;
#pragma unroll
                for (int ni = 0; ni < 4; ++ni)
#pragma unroll
                    for (int q4 = 0; q4 < 4; ++q4) {
                        const int n = 128 * wn + 32 * ni + 8 * q4 + 4 * hf;
                        f32x4 ov = {acc[mi][ni][4 * q4], acc[mi][ni][4 * q4 + 1], acc[mi][ni][4 * q4 + 2], acc[mi][ni][4 * q4 + 3]};
                        *(f32x4*)(logits + tok * 256 + n) = ov;
                    }
            }
        });
    }
}

template <int CTRL> DI float dpp_f(float v) { return __builtin_bit_cast(float, __builtin_amdgcn_update_dpp(0, __builtin_bit_cast(int, v), CTRL, 0xf, 0xf, true)); }
template <int CTRL> DI int dpp_i(int v) { return __builtin_amdgcn_update_dpp(0, v, CTRL, 0xf, 0xf, true); }
template <int RU>
DI void route_tokens(const f32x4 (&lg)[RU], const f32x4 bias, int lane, int (&my_e)[RU], float (&my_g)[RU]) {
    float sc[RU][4], cand[RU][4];
#pragma unroll
    for (int u = 0; u < RU; ++u)
#pragma unroll
        for (int i = 0; i < 4; ++i) { sc[u][i] = 1.f / (1.f + __expf(-lg[u][i])); cand[u][i] = sc[u][i] + bias[i]; }
    float t1[RU], t2[RU];
#pragma unroll
    for (int u = 0; u < RU; ++u) {
        t1[u] = fmaxf(cand[u][0], cand[u][1]); t2[u] = fminf(cand[u][0], cand[u][1]);
#pragma unroll
        for (int i = 2; i < 4; ++i) { const float v = cand[u][i]; t2[u] = fmaxf(t2[u], fminf(t1[u], v)); t1[u] = fmaxf(t1[u], v); }
    }
#define TOP2_STEP(CTRL) _Pragma("unroll") for (int u = 0; u < RU; ++u) { \
            const float o1 = dpp_f<CTRL>(t1[u]), o2 = dpp_f<CTRL>(t2[u]); \
            const float n1 = fmaxf(t1[u], o1), n2 = fmaxf(fminf(t1[u], o1), fmaxf(t2[u], o2)); \
            t1[u] = n1; t2[u] = n2; }
    TOP2_STEP(0xB1) TOP2_STEP(0x4E) TOP2_STEP(0x141)
#undef TOP2_STEP
    const int myg = lane >> 3;
    int rank[RU];
#pragma unroll
    for (int u = 0; u < RU; ++u) rank[u] = 0;
#pragma unroll
    for (int g = 0; g < 8; ++g)
#pragma unroll
        for (int u = 0; u < RU; ++u) {
            const float gs = t1[u] + t2[u];
            const float sg = __builtin_bit_cast(float, __builtin_amdgcn_readlane(__builtin_bit_cast(int, gs), 8 * g));
            const bool ahead = (sg > gs) | ((sg == gs) & (g < myg));
            rank[u] += ahead ? 1 : 0;
        }
#pragma unroll
    for (int u = 0; u < RU; ++u)
#pragma unroll
        for (int i = 0; i < 4; ++i) cand[u][i] = rank[u] >= 4 ? -INFINITY : cand[u][i];
    float my_w[RU], wsum[RU];
#pragma unroll
    for (int u = 0; u < RU; ++u) { my_e[u] = 256; my_w[u] = 1.f; wsum[u] = 0.f; }
#pragma unroll
    for (int k = 0; k < 8; ++k) {
        float bv[RU]; int be[RU];
#pragma unroll
        for (int u = 0; u < RU; ++u) {
            bv[u] = cand[u][0]; int bi = 0;
#pragma unroll
            for (int i = 1; i < 4; ++i) { const bool gt = cand[u][i] > bv[u]; bv[u] = gt ? cand[u][i] : bv[u]; bi = gt ? i : bi; }
            be[u] = 4 * lane + bi;
        }
#define AMAX_STEP(OV, OE) _Pragma("unroll") for (int u = 0; u < RU; ++u) { \
                const float ov = OV; const int oe = OE; \
                const bool take = (ov > bv[u]) | ((ov == bv[u]) & (oe < be[u])); \
                bv[u] = take ? ov : bv[u]; be[u] = take ? oe : be[u]; }
        AMAX_STEP(dpp_f<0xB1>(bv[u]), dpp_i<0xB1>(be[u])) AMAX_STEP(dpp_f<0x4E>(bv[u]), dpp_i<0x4E>(be[u]))
        AMAX_STEP(dpp_f<0x141>(bv[u]), dpp_i<0x141>(be[u])) AMAX_STEP(dpp_f<0x140>(bv[u]), dpp_i<0x140>(be[u]))
        AMAX_STEP(__shfl_xor(bv[u], 16), __shfl_xor(be[u], 16)) AMAX_STEP(__shfl_xor(bv[u], 32), __shfl_xor(be[u], 32))
#undef AMAX_STEP
#pragma unroll
        for (int u = 0; u < RU; ++u) {
            const int beu = __builtin_amdgcn_readfirstlane(be[u]);
            const int ol = beu >> 2, oi = beu & 3;
            float q0 = sc[u][0], q1 = sc[u][1], q2 = sc[u][2], q3 = sc[u][3];
            asm volatile("" : "+v"(q0), "+v"(q1), "+v"(q2), "+v"(q3));
            const float m01 = (oi & 1) ? q1 : q0, m23 = (oi & 1) ? q3 : q2;
            const float mys = (oi & 2) ? m23 : m01;
            const float ws_ = __builtin_bit_cast(float, __builtin_amdgcn_readlane(__builtin_bit_cast(int, mys), ol));
            const bool mine = lane == ol;
#pragma unroll
            for (int i = 0; i < 4; ++i) cand[u][i] = (mine & (i == oi)) ? -INFINITY : cand[u][i];
            wsum[u] += ws_;
            my_e[u] = lane == k ? beu : my_e[u]; my_w[u] = lane == k ? ws_ : my_w[u];
        }
    }
#pragma unroll
    for (int u = 0; u < RU; ++u) { const float rs = 2.5f / wsum[u]; my_g[u] = lane < 8 ? my_w[u] * rs : 1.f; }
}
DI void route_token(const f32x4 lg, const f32x4 bias, int lane, int& my_e, float& my_g) {
    const f32x4 l1[1] = {lg}; int e1[1]; float g1[1];
    route_tokens<1>(l1, bias, lane, e1, g1);
    my_e = e1[0]; my_g = g1[0];
}
DI void phase_route(const Params& P, char* smem) {
    const float* logits = (const float*)(P.ws + OFF_Y);
    int* cnt = (int*)(P.ws + OFF_CNT);
    int* list = (int*)(P.ws + OFF_LIST);
    int* eidx = (int*)(P.ws + OFF_EIDX);
    float* gates = (float*)(P.ws + OFF_GATE);
    const int tid = threadIdx.x, lane = tid & 63, w = tid >> 6, G = gridDim.x;
    const f32x4 bias = *(const f32x4*)(P.router_b + 4 * lane);
    const int TPB = NT / G;
    if (NT % G == 0 && TPB <= 256 && CHUNK_T % TPB == 0 && TPB % NW == 0) {
        int* lcnt = (int*)smem;
        int* lbase = lcnt + 256;
        int* pe = lbase + 256;
        float* pg = (float*)(pe + 2048);
        __syncthreads();
        if (tid < 256) lcnt[tid] = 0;
        __syncthreads();
        const int tbase = blockIdx.x * TPB, c = tbase >> 14;
        constexpr int RU = 2;
        for (int l0 = w; l0 < TPB; l0 += NW * RU) {
            f32x4 lg[RU]; int my_e[RU]; float my_g[RU];
#pragma unroll
            for (int u = 0; u < RU; ++u) lg[u] = *(const f32x4*)(logits + (size_t)(tbase + min(l0 + u * NW, TPB - 1)) * 256 + 4 * lane);
            route_tokens<RU>(lg, bias, lane, my_e, my_g);
#pragma unroll
            for (int u = 0; u < RU; ++u) {
                const int li = l0 + u * NW;
                if (lane < 8 && li < TPB) { const int lp = atomicAdd(&lcnt[my_e[u]], 1); pe[li * 8 + lane] = my_e[u] | (lp << 9); pg[li * 8 + lane] = my_g[u]; }
            }
        }
        __syncthreads();
        if (tid < 256) { const int n = lcnt[tid]; lbase[tid] = n ? atomicAdd(&cnt[c * NEXP1 + tid], n) : 0; }
        __syncthreads();
        for (int i = tid; i < TPB * 8; i += NTH) {
            const int v = pe[i], e = v & 511, pos = lbase[e] + (v >> 9), t = tbase + (i >> 3), k = i & 7, tl = t & (CHUNK_T - 1);
            eidx[(size_t)t * 8 + k] = e | (pos << 9);
            gates[(size_t)t * 8 + k] = pg[i];
            list[((size_t)c * NEXP1 + e) * CHUNK_T + pos] = tl * NPAIR + k;
        }
        for (int i = tid; i < TPB; i += NTH) { const int tl = (tbase + i) & (CHUNK_T - 1); list[((size_t)c * NEXP1 + 256) * CHUNK_T + tl] = tl * NPAIR + 8; }
        __syncthreads();
    } else {
        for (int t = blockIdx.x * NW + w; t < NT; t += G * NW) {
            const f32x4 lg = *(const f32x4*)(logits + (size_t)t * 256 + 4 * lane);
            int my_e; float my_g;
            route_token(lg, bias, lane, my_e, my_g);
            const int c = t >> 14, tl = t & (CHUNK_T - 1);
            if (lane < 8) {
                gates[(size_t)t * 8 + lane] = my_g;
                const int pos = atomicAdd(&cnt[c * NEXP1 + my_e], 1);
                eidx[(size_t)t * 8 + lane] = my_e | (pos << 9);
                list[((size_t)c * NEXP1 + my_e) * CHUNK_T + pos] = tl * NPAIR + lane;
            } else if (lane == 8) {
                list[((size_t)c * NEXP1 + 256) * CHUNK_T + tl] = tl * NPAIR + 8;
            }
        }
    }
}

typedef unsigned short u16;
DI void moe_build_base(const Params& P, char* smem, int c) {
    int* bs = (int*)(smem + SM_BASE + c * MT_STRIDE);
    const int* cnt = (const int*)(P.ws + OFF_CNT) + c * NEXP1;
    const int e = threadIdx.x, lane = e & 63, w = e >> 6;
    __syncthreads();
    int n = 0, in = 0;
    if (e < 256) {
        n = cnt[e]; in = n;
#pragma unroll
        for (int d = 1; d < 64; d <<= 1) { const int t = __shfl_up(in, d); if (lane >= d) in += t; }
        if (lane == 63) bs[258 + w] = in;
    }
    __syncthreads();
    if (e < 256) {
        int o = 0;
#pragma unroll
        for (int i = 0; i < 4; ++i) if (i < w) o += bs[258 + i];
        bs[e] = o + in - n;
        if (e == 255) bs[256] = o + in;
    }
    __syncthreads();
}
DI void moe_build_tiles(const Params& P, char* smem, int c) {
    u16* tA = (u16*)(smem + SM_BASE + c * MT_STRIDE + 1056);
    u16* tB = (u16*)(smem + SM_BASE + c * MT_STRIDE + 1584);
    int* wsum = (int*)(smem + SM_EXTRA + 1048);
    const int* cnt = (const int*)(P.ws + OFF_CNT) + c * NEXP1;
    moe_build_base(P, smem, c);
    const int e = threadIdx.x, lane = e & 63, w = e >> 6;
    __syncthreads();
    int na = 0, nb = 0, ia = 0, ib = 0;
    if (e < 256) {
        const int n = cnt[e], full = n >> 8, rem = n & 255;
        na = full + (rem > 128 ? 1 : 0); nb = (rem >= 1 && rem <= 128) ? 1 : 0;
        ia = na; ib = nb;
#pragma unroll
        for (int d = 1; d < 64; d <<= 1) { const int t = __shfl_up(ia, d), u = __shfl_up(ib, d); if (lane >= d) { ia += t; ib += u; } }
        if (lane == 63) { wsum[w] = ia; wsum[4 + w] = ib; }
    }
    __syncthreads();
    if (e < 256) {
        int oa = 0, ob = 0;
#pragma unroll
        for (int i = 0; i < 4; ++i) if (i < w) { oa += wsum[i]; ob += wsum[4 + i]; }
        tA[e] = (u16)(oa + ia - na); tB[e] = (u16)(ob + ib - nb);
        if (e == 255) { tA[256] = (u16)(oa + ia); tA[257] = (u16)(oa + ia + CHUNK_T / 256); tB[256] = (u16)(ob + ib); tB[257] = (u16)(ob + ib); }
    }
    __syncthreads();
}
DI void moe_build_all(const Params& P, char* smem) {
#pragma unroll 1
    for (int c = 0; c < NCHUNK; ++c) moe_build_tiles(P, smem, c);
}
DI int moe_find_expert(const u16* tstart, int tile) {
    int lo = 0, hi = NEXP1;
    while (hi - lo > 1) { const int mid = (lo + hi) >> 1; if ((int)tstart[mid] <= tile) lo = mid; else hi = mid; }
    return lo;
}
struct GatherRows {
    static constexpr bool kDense = false;
    const bf16_t* base; int ld; const int* pid; int div;
    DI const bf16_t* operator()(int r) const { const int p = pid[r]; return p < 0 ? nullptr : base + (size_t)(p / div) * ld; }
};
template <int BM>
DI void moe_g1_tiles(const Params& P, char* smem, int c, const u16* tstart, int total) {
    const bf16_t* zrow = (const bf16_t*)(P.ws + OFF_ZROW);
    int* pid = (int*)(smem + SM_EXTRA + 1088);
    const int* cnt = (const int*)(P.ws + OFF_CNT) + c * NEXP1;
    const int* list = (const int*)(P.ws + OFF_LIST) + (size_t)c * NEXP1 * CHUNK_T;
    const bf16_t* h2 = (const bf16_t*)(P.ws + OFF_H2) + (size_t)c * CHUNK_T * 1024;
    const bf16_t* wgu = (const bf16_t*)(P.ws + OFF_WGU);
    bf16_t* act = (bf16_t*)(P.ws + OFF_ACT + (size_t)(c & 1) * ACT_BYTES);
    const float* gates = (const float*)(P.ws + OFF_GATE) + (size_t)c * CHUNK_T * 8;
    float* gsort = (float*)(P.ws + OFF_GS) + (size_t)(c & 1) * CHUNK_T * NPAIR;
    const int lane = threadIdx.x & 63, w = threadIdx.x >> 6, wm = BM == 256 ? (w >> 1) : (w >> 2), wn = BM == 256 ? (w & 1) : (w & 3), l31 = lane & 31, hf = lane >> 5;
    const XPart xp = xcd_part(P.ws, smem, total * 2);
    int* pidA = pid; int* pidB = (int*)(smem + SM_EXTRA + 2112);
    bool have = false; int par = 0;
    const int* bs = (const int*)(smem + SM_BASE + c * MT_STRIDE);
    for (int it = xp.start; it < xp.end; it += xp.step) {
        const int tile = it >> 1, half = it & 1;
        const int e = moe_find_expert(tstart, tile), ti = tile - tstart[e];
        const int n = e < NEXP ? bs[e + 1] - bs[e] : CHUNK_T;
        const int li0 = BM == 256 ? ti * 256 : (n >> 8) * 256;
        const int srow0 = bs[e] + li0, nvalid = n - li0;
        int* pidc = par ? pidB : pidA; int* pidn = par ? pidA : pidB;
        __syncthreads();
        if (!have && threadIdx.x < BM) { const int li = li0 + threadIdx.x; pidc[threadIdx.x] = li < n ? list[(size_t)e * CHUNK_T + li] : -1; }
        __syncthreads();
        const int ppv = threadIdx.x < BM ? pidc[threadIdx.x] : -1;
        float gq = 1.f;
        if (half == 0 && ppv >= 0 && (ppv % NPAIR) < 8) gq = gates[(size_t)(ppv / NPAIR) * 8 + (ppv % NPAIR)];
        const int itn = it + xp.step; const bool hasn = itn < xp.end;
        int ppn = -1;
        if (hasn) {
            const int tilen = itn >> 1, en = moe_find_expert(tstart, tilen), tin = tilen - tstart[en];
            const int nn = en < NEXP ? bs[en + 1] - bs[en] : CHUNK_T;
            const int li0n = BM == 256 ? tin * 256 : (nn >> 8) * 256;
            if (threadIdx.x < BM) { const int li = li0n + threadIdx.x; ppn = li < nn ? list[(size_t)en * CHUNK_T + li] : -1; }
        }
        auto pre = [&]() {
            if (half == 0 && (int)threadIdx.x < BM && (int)threadIdx.x < nvalid) gsort[srow0 + threadIdx.x] = gq;
            if (hasn && threadIdx.x < BM) pidn[threadIdx.x] = ppn;
        };
        have = hasn; par ^= 1;
        pid = pidc;
        GatherRows ar{h2, 1024, pid, NPAIR};
        if constexpr (BM == 256) {
            gemm_dma<true, 256>(smem, ar, wgu + ((size_t)e * 512 + half * 256) * 1024, 1024, 4, 1, zrow, [&](int, const f32x16 (&acc)[2][4]) {
#pragma unroll
                for (int mi = 0; mi < 2; ++mi) {
                    f32x16 t0, t1;
#pragma unroll
                    for (int i = 0; i < 16; ++i) { t0[i] = silu_fast(acc[mi][0][i]) * acc[mi][1][i]; t1[i] = silu_fast(acc[mi][2][i]) * acc[mi][3][i]; }
                    const int rb = 64 * wm + 32 * mi;
                    bf16_t* abase = act + (size_t)(srow0 + rb) * 256 + 128 * half + 64 * wn;
                    stage_store_chunk<false, true>(smem, t0, t1, [](int, int, float x) { return x; }, [&](int r) { return rb + r < nvalid ? abase + (size_t)r * 256 : (bf16_t*)nullptr; });
                }
            }, pre);
        } else {
            gemm_dma<true, 128>(smem, ar, wgu + ((size_t)e * 512 + half * 256) * 1024, 1024, 4, 1, zrow, [&](int, const f32x16 (&acc)[2][2]) {
#pragma unroll
                for (int mi = 0; mi < 2; ++mi) {
                    const int rw = 64 * wm + 32 * mi + l31;
                    if (rw < nvalid) {
                        bf16_t* arow_ = act + (size_t)(srow0 + rw) * 256 + 128 * half + 32 * wn;
#pragma unroll
                        for (int q4 = 0; q4 < 4; ++q4) {
                            float o[4];
#pragma unroll
                            for (int r = 0; r < 4; ++r) { const float g = acc[mi][0][4 * q4 + r], u = acc[mi][1][4 * q4 + r]; o[r] = silu_fast(g) * u; }
                            u32x2 pk; pk[0] = pk2(o[0], o[1]); pk[1] = pk2(o[2], o[3]);
                            *(u32x2*)(arow_ + 8 * q4 + 4 * hf) = pk;
                        }
                    }
                }
            }, pre);
        }
    }
}
DI void phase_moe_g1(const Params& P, char* smem, int c) {
    if (c == 0) moe_build_all(P, smem);
    const u16* tA = (const u16*)(smem + SM_BASE + c * MT_STRIDE + 1056); const u16* tB = (const u16*)(smem + SM_BASE + c * MT_STRIDE + 1584);
    moe_g1_tiles<256>(P, smem, c, tA, tA[NEXP1]);
    moe_g1_tiles<128>(P, smem, c, tB, tB[NEXP1]);
}
template <int BM>
DI void moe_g2_tiles(const Params& P, char* smem, int c, const u16* tstart, int total) {
    const bf16_t* zrow = (const bf16_t*)(P.ws + OFF_ZROW);
    int* pid = (int*)(smem + SM_EXTRA + 1088);
    float* gsm = (float*)(smem + SM_EXTRA + 2112);
    const int* cnt = (const int*)(P.ws + OFF_CNT) + c * NEXP1;
    const int* list = (const int*)(P.ws + OFF_LIST) + (size_t)c * NEXP1 * CHUNK_T;
    const float* gsort = (const float*)(P.ws + OFF_GS) + (size_t)(c & 1) * CHUNK_T * NPAIR;
    const bf16_t* wd = (const bf16_t*)(P.ws + OFF_WD);
    const bf16_t* act = (const bf16_t*)(P.ws + OFF_ACT + (size_t)(c & 1) * ACT_BYTES);
    bf16_t* y = (bf16_t*)(P.ws + OFF_Y);
    const int lane = threadIdx.x & 63, w = threadIdx.x >> 6, wm = BM == 256 ? (w >> 1) : (w >> 2), wn = BM == 256 ? (w & 1) : (w & 3), l31 = lane & 31;
    const XPart xp = xcd_part(P.ws, smem, total * 2);
    for (int it = xp.start; it < xp.end; it += xp.step) {
        const int tile = it >> 1, half = it & 1;
        const int e = moe_find_expert(tstart, tile), ti = tile - tstart[e];
        const int* bs = (const int*)(smem + SM_BASE + c * MT_STRIDE);
        const int n = e < NEXP ? bs[e + 1] - bs[e] : CHUNK_T;
        const int li0 = BM == 256 ? ti * 256 : (n >> 8) * 256;
        const int srow0 = bs[e] + li0, nvalid = n - li0;
        float gq = 1.f;
        if ((int)threadIdx.x < BM && (int)threadIdx.x < nvalid) gq = gsort[srow0 + threadIdx.x];
        auto pre = [&]() { if ((int)threadIdx.x < BM) gsm[threadIdx.x] = gq; };
        DenseRows ar{act + (size_t)srow0 * 256, 256};
        if constexpr (BM == 256) {
            gemm_dma<true, 256>(smem, ar, wd + ((size_t)e * 1024 + half * 512) * 256, 256, 2, 2, zrow, [&](int t, const f32x16 (&acc)[2][4]) {
#pragma unroll
                for (int mi = 0; mi < 2; ++mi) {
                    const float g = gsm[64 * wm + 32 * mi + l31];
                    const int rb = 64 * wm + 32 * mi;
#pragma unroll
                    for (int pr = 0; pr < 2; ++pr) {
                        const int cb = half * 512 + t * 256 + 128 * wn + 64 * pr;
                        bf16_t* yb = y + (size_t)(srow0 + rb) * 1024 + cb;
                        stage_store_chunk<false, true>(smem, acc[mi][2 * pr], acc[mi][2 * pr + 1], [&](int, int, float x) { return x * g; }, [&](int r) { return rb + r < nvalid ? yb + (size_t)r * 1024 : (bf16_t*)nullptr; });
                    }
                }
            }, pre);
        } else {
            gemm_dma<true, 128>(smem, ar, wd + ((size_t)e * 1024 + half * 512) * 256, 256, 2, 2, zrow, [&](int t, const f32x16 (&acc)[2][2]) {
                const int cb = half * 512 + t * 256 + 64 * wn;
#pragma unroll
                for (int mi = 0; mi < 2; ++mi) {
                    const float g = gsm[64 * wm + 32 * mi + l31];
                    const int rb = 64 * wm + 32 * mi;
                    bf16_t* yb = y + (size_t)(srow0 + rb) * 1024 + cb;
                    stage_store_chunk<false, true>(smem, acc[mi][0], acc[mi][1], [&](int, int, float x) { return x * g; }, [&](int r) { return rb + r < nvalid ? yb + (size_t)r * 1024 : (bf16_t*)nullptr; });
                }
            }, pre);
        }
    }
}
DI void phase_moe_g2(const Params& P, char* smem, int c) {
    const u16* tA = (const u16*)(smem + SM_BASE + c * MT_STRIDE + 1056); const u16* tB = (const u16*)(smem + SM_BASE + c * MT_STRIDE + 1584);
    moe_g2_tiles<256>(P, smem, c, tA, tA[NEXP1]);
    moe_g2_tiles<128>(P, smem, c, tB, tB[NEXP1]);
}
DI void phase_moe_combine(const Params& P, char* smem, int c) {
    const bf16_t* y = (const bf16_t*)(P.ws + OFF_Y);
    const float* mod = (const float*)(P.ws + OFF_MOD);
    const int* eidx = (const int*)(P.ws + OFF_EIDX);
    const int lane = threadIdx.x & 63, w = threadIdx.x >> 6, stride = gridDim.x * NW;
    const int* bs = (const int*)(smem + SM_BASE + c * MT_STRIDE);
    int tl = blockIdx.x * NW + w;
    int evn = 0;
    if (tl < CHUNK_T && lane < 8) evn = eidx[((size_t)c * CHUNK_T + tl) * 8 + lane];
    for (; tl < CHUNK_T; tl += stride) {
        const size_t t = (size_t)c * CHUNK_T + tl;
        const int b = (int)(t >> 13);
        const float* g2 = mod + b * 6144 + 5120;
        const int ev = evn;
        { const int tn = tl + stride < CHUNK_T ? tl + stride : tl; if (lane < 8) evn = eidx[((size_t)c * CHUNK_T + tn) * 8 + lane]; }
        int myrow = bs[256] + tl;
        if (lane < 8) myrow = bs[ev & 511] + (ev >> 9);
        const bf16_t* yr[NPAIR];
#pragma unroll
        for (int k = 0; k < NPAIR; ++k) yr[k] = y + (size_t)__builtin_amdgcn_readlane(myrow, k) * 1024;
#pragma unroll
        for (int i = 0; i < 2; ++i) {
            const int col = 512 * i + 8 * lane;
            float s[8] = {0.f, 0.f, 0.f, 0.f, 0.f, 0.f, 0.f, 0.f};
#pragma unroll
            for (int k = 0; k < NPAIR; ++k) {
                const u32x4 v = __builtin_nontemporal_load((const u32x4*)(yr[k] + col));
#pragma unroll
                for (int q = 0; q < 4; ++q) { s[2 * q] += bflo(v[q]); s[2 * q + 1] += bfhi(v[q]); }
            }
#pragma unroll
            for (int hq = 0; hq < 2; ++hq) {
                const f32x4 xv = *(const f32x4*)(P.out + t * 1024 + col + 4 * hq);
                const f32x4 gv = *(const f32x4*)(g2 + col + 4 * hq);
                f32x4 ov;
#pragma unroll
                for (int r = 0; r < 4; ++r) ov[r] = xv[r] + gv[r] * s[4 * hq + r];
                __builtin_nontemporal_store(ov, (f32x4*)(P.out + t * 1024 + col + 4 * hq));
            }
        }
    }
}

constexpr int NPHASE = 18;
template <int PH, int REP = 0> DI void run_phase(const Params& Pin, char* smem) {
    Params P = Pin;
    { typedef __attribute__((address_space(1))) char gchar; gchar* g = (gchar*)Pin.ws; asm volatile("" : "+s"(g)); P.ws = (char*)g; }
    float* mod = (float*)(P.ws + OFF_MOD);
    if constexpr (PH == 0) phase_adaln(P, smem);
    else if constexpr (PH == 1) { phase_norm(P.x, P.norm1_g, mod, 0, 1024, (bf16_t*)(P.ws + OFF_H)); phase_convert(P, smem); }
    else if constexpr (PH == 2) phase_inproj(P, smem);
    else if constexpr (PH == 3) phase_indexer(P, smem);
    else if constexpr (PH == 4) phase_attn(P, smem, REP);
    else if constexpr (PH == 5) phase_outproj(P, smem);
    else if constexpr (PH == 6) phase_resnorm2(P);
    else if constexpr (PH == 7) phase_router(P, smem);
    else if constexpr (PH == 8) phase_route(P, smem);
    else if constexpr (PH == 9) phase_moe_g1(P, smem, 0);
    else if constexpr (PH == 10) { phase_moe_g2(P, smem, 0); phase_moe_g1(P, smem, 1); }
    else if constexpr (PH == 11) phase_moe_combine(P, smem, 0);
    else if constexpr (PH == 12) { phase_moe_g2(P, smem, 1); phase_moe_g1(P, smem, 2); }
    else if constexpr (PH == 13) phase_moe_combine(P, smem, 1);
    else if constexpr (PH == 14) { phase_moe_g2(P, smem, 2); phase_moe_g1(P, smem, 3); }
    else if constexpr (PH == 15) phase_moe_combine(P, smem, 2);
    else if constexpr (PH == 16) phase_moe_g2(P, smem, 3);
    else if constexpr (PH == 17) phase_moe_combine(P, smem, 3);
}
#define MK_RUN(PH) if constexpr (P0 <= PH && PH < P1) { run_phase<PH>(P, smem); if constexpr (PH + 1 < P1) xcd_barrier(bar); }
template <int P0, int P1>
__global__ void __launch_bounds__(NTH, 2) mk_kernel(Params P) {
    __shared__ __attribute__((aligned(16))) char smem[SMEM_BYTES + 16];
    if (threadIdx.x == 0) {
        *(uint4*)(smem + SMEM_BYTES) = make_uint4(0u, 0u, 0u, 0u);
        const int x = (int)xb_xcc_id();
        ((int*)(smem + XC_LDS))[0] = x;
        ((int*)(smem + XC_LDS))[1] = atomicAdd((int*)(P.ws + OFF_XRANK) + x, 1);
    }
    __syncthreads();
    XcdBarrier bar;
    if constexpr (P1 - P0 > 1) bar = xcd_barrier_post((unsigned*)(P.ws + OFF_BAR), (volatile LAS unsigned*)(LAS char*)(smem + SMEM_BYTES));
    MK_RUN(0)
    if constexpr (P0 == 0 && P1 > 1) {
        if (threadIdx.x < 16) ((int*)(smem + XC_LDS))[2 + threadIdx.x] = ((const int*)(P.ws + OFF_XRANK))[threadIdx.x];
        __syncthreads();
    }
    MK_RUN(1) MK_RUN(2) MK_RUN(3) MK_RUN(4) MK_RUN(5) MK_RUN(6) MK_RUN(7) MK_RUN(8)
    MK_RUN(9) MK_RUN(10) MK_RUN(11) MK_RUN(12) MK_RUN(13) MK_RUN(14) MK_RUN(15) MK_RUN(16) MK_RUN(17)
}

template <int P0, int P1> static void launch_range(const Params& p, hipStream_t stream) {
    static int grid = 0;
    if (!grid) {
        int dev = 0, cus = 0, per_cu = 0;
        (void)hipGetDevice(&dev);
        (void)hipDeviceGetAttribute(&cus, hipDeviceAttributeMultiprocessorCount, dev);
        (void)(void)hipOccupancyMaxActiveBlocksPerMultiprocessor(&per_cu, mk_kernel<P0, P1>, NTH, 0);
        if (cus <= 0) cus = 256;
        (void)per_cu;
        grid = cus;
    }
    mk_kernel<P0, P1><<<dim3(grid), dim3(NTH), 0, stream>>>(p);
}

extern "C" void kernel_launch(void* const* d_in, const int* in_sizes, int n_in, void* d_out, int out_size, void* d_ws, size_t ws_size, hipStream_t stream) {
    if (ws_size < WS_NEED) return;
    Params p{};
    const float** f = (const float**)&p;
    for (int i = 0; i < 26; ++i) f[i] = (const float*)d_in[i];
    p.out = (float*)d_out;
    p.ws = (char*)d_ws;
    (void)hipMemsetAsync(d_ws, 0, ZERO_BYTES, stream);
    launch_range<0, NPHASE>(p, stream);
}
```
